# Optimizing an MI355X kernel written in HIP

```python
import math
import jax
import jax.numpy as jnp
from jax import lax
import numpy as np

D_MODEL = 1024
BATCH = 32
SEQ = 256
DEPTH = 4
DEC_BATCH = 8
DEC_SEQ = 1024
PAST_LEN = 256

GRID_W = 64
SSD_HEADS = 6
SSD_HEAD_DIM = 64
SSD_D = SSD_HEADS * SSD_HEAD_DIM
SSD_GROUPS = 2
SSD_STATE = 64
SSD_CONV = 5
SSD_CHUNK = 128
SSD_CONV_DIM = SSD_D + 2 * SSD_GROUPS * SSD_STATE
S5_GROUPS = 16
S5_GROUP_CH = 16
S5_D = S5_GROUPS * S5_GROUP_CH
S5_STATE = 64
NAT_HEADS = 6
NAT_HEAD_DIM = 64
NAT_D = NAT_HEADS * NAT_HEAD_DIM
NAT_KH = 8
NAT_KW = 16
Q_BLOCK = 128
MIX_D = SSD_D + S5_D + NAT_D
D_FF = 4 * D_MODEL
IN_COLS = SSD_D + SSD_CONV_DIM + 2 * SSD_HEADS + S5_D + 3 * NAT_D
N_MOD = 6
EPS = 1e-6

kernel_name = 'hybrid_dit_ssd_s5_natten_step'


def rmsnorm(x, g):
    xf = x.astype(jnp.float32)
    y = xf * lax.rsqrt(jnp.mean(xf * xf, axis=-1, keepdims=True) + EPS)
    return (y * g.astype(jnp.float32)).astype(x.dtype)


def split_proj(p):
    sizes = (SSD_D, SSD_CONV_DIM, 2 * SSD_HEADS, S5_D, NAT_D, NAT_D)
    return jnp.split(p, np.cumsum(sizes).tolist(), axis=-1)


def centred_depthwise_conv(x, w, b):
    ch = x.shape[-1]
    y = lax.conv_general_dilated(x, w[:, None, :].astype(x.dtype), window_strides=(1,),
                                 padding=[(SSD_CONV // 2, SSD_CONV // 2)],
                                 dimension_numbers=('NWC', 'WIO', 'NWC'), feature_group_count=ch)
    return y + b.astype(x.dtype)


def ssd_scan(x, dt, a, bm, cm, h0):
    b, L, H, P = x.shape
    G, N = bm.shape[2], bm.shape[3]
    f32 = jnp.float32
    nc, Q = L // SSD_CHUNK, SSD_CHUNK
    xc = x.astype(f32).reshape(b, nc, Q, H, P)
    dtc = dt.reshape(b, nc, Q, H)
    bc = jnp.repeat(bm.astype(f32), H // G, axis=2).reshape(b, nc, Q, H, N)
    cc = jnp.repeat(cm.astype(f32), H // G, axis=2).reshape(b, nc, Q, H, N)
    a_cum = jnp.cumsum(dtc * a, axis=2)
    lower = jnp.tril(jnp.ones((Q, Q), dtype=bool))[None, None, :, :, None]
    seg = a_cum[:, :, :, None, :] - a_cum[:, :, None, :, :]
    decay = jnp.exp(jnp.where(lower, seg, -jnp.inf))
    xdt = xc * dtc[..., None]
    scores = jnp.einsum('bcihn,bcjhn->bcijh', cc, bc) * decay
    y_intra = jnp.einsum('bcijh,bcjhp->bcihp', scores, xdt)
    decay_end = jnp.exp(a_cum[:, :, -1:, :] - a_cum)
    chunk_states = jnp.einsum('bcjhn,bcjh,bcjhp->bchpn', bc, decay_end, xdt)
    chunk_decay = jnp.exp(a_cum[:, :, -1, :])

    def step(h, inp):
        s, d = inp
        return d[:, :, None, None] * h + s, h

    h_last, h_in = lax.scan(step, h0.astype(f32),
                            (jnp.moveaxis(chunk_states, 1, 0), jnp.moveaxis(chunk_decay, 1, 0)))
    h_in = jnp.moveaxis(h_in, 0, 1)
    y_inter = jnp.einsum('bcihn,bchpn->bcihp', cc, h_in) * jnp.exp(a_cum)[..., None]
    return (y_intra + y_inter).reshape(b, L, H, P), h_last


def ssd_mixer(z, xbc, dt_raw, lw, h0_f, h0_b):
    b, L, _ = xbc.shape
    f32 = jnp.float32
    xbc = jax.nn.silu(centred_depthwise_conv(xbc, lw['ssd_conv_w'], lw['ssd_conv_b']))
    xs, bm, cm = jnp.split(xbc, [SSD_D, SSD_D + SSD_GROUPS * SSD_STATE], axis=-1)
    xs = xs.reshape(b, L, SSD_HEADS, SSD_HEAD_DIM)
    bm = bm.reshape(b, L, SSD_GROUPS, SSD_STATE)
    cm = cm.reshape(b, L, SSD_GROUPS, SSD_STATE)
    dt = jax.nn.softplus(dt_raw.astype(f32).reshape(b, L, 2, SSD_HEADS) + lw['ssd_dt_bias'].astype(f32))
    a = -jnp.exp(lw['ssd_a_log'].astype(f32))
    y_f, h_f = ssd_scan(xs, dt[:, :, 0], a[0], bm, cm, h0_f)
    y_b, h_b = ssd_scan(jnp.flip(xs, 1), jnp.flip(dt[:, :, 1], 1), a[1],
                        jnp.flip(bm, 1), jnp.flip(cm, 1), h0_b)
    y = y_f + jnp.flip(y_b, 1) + lw['ssd_d'].astype(f32)[:, None] * xs.astype(f32)
    y = y.reshape(b, L, SSD_D) * jax.nn.silu(z.astype(f32))
    return rmsnorm(y, lw['ssd_norm']), jnp.stack([h_f, h_b], axis=1)


def s5_scan(ug, lam, log_dt, bmat, h0):
    a_bar = jnp.exp(lam * jnp.exp(log_dt)[:, None])
    b_bar = ((a_bar - 1.0) / lam)[..., None] * bmat
    bu = jnp.einsum('blgc,gpc->blgp', ug, b_bar)
    bu = bu.at[:, 0].add(a_bar * h0)

    def combine(e1, e2):
        a1, b1 = e1
        a2, b2 = e2
        return a1 * a2, a2 * b1 + b2

    _, h = lax.associative_scan(combine, (jnp.broadcast_to(a_bar, bu.shape), bu), axis=1)
    return h, h[:, -1]


def s5_mixer(u, lw, h0_re, h0_im):
    b, L, _ = u.shape
    f32 = jnp.float32
    uf = u.astype(f32)
    ug = uf.reshape(b, L, S5_GROUPS, S5_GROUP_CH)
    lam = lax.complex(lw['s5_a_re'].astype(f32), lw['s5_a_im'].astype(f32))
    bmat = lax.complex(lw['s5_b_re'].astype(f32), lw['s5_b_im'].astype(f32))
    cmat = lax.complex(lw['s5_c_re'].astype(f32), lw['s5_c_im'].astype(f32))
    h0 = lax.complex(h0_re.astype(f32), h0_im.astype(f32))
    log_dt = lw['s5_log_dt'].astype(f32)
    h_f, last_f = s5_scan(ug, lam[0], log_dt[0], bmat, h0[:, 0])
    h_b, last_b = s5_scan(jnp.flip(ug, 1), lam[1], log_dt[1], bmat, h0[:, 1])
    h = h_f + jnp.flip(h_b, 1)
    y = jnp.einsum('blgp,gcp->blgc', h, cmat).real.reshape(b, L, S5_D) + lw['s5_d'].astype(f32) * uf
    g = jax.nn.gelu(y)
    out = g * jax.nn.sigmoid(g @ lw['s5_w_glu'].astype(f32) + lw['s5_b_glu'].astype(f32))
    last = jnp.stack([last_f, last_b], axis=1)
    return out, last.real, last.imag


def context_attention(q, k, v):
    b, Lc, H, Dh = q.shape
    scale = Dh ** -0.5
    qb = jnp.moveaxis(q.reshape(b, Lc // Q_BLOCK, Q_BLOCK, H, Dh), 1, 0)

    def block(qi):
        s = jnp.einsum('bqhd,bkhd->bhqk', qi, k).astype(jnp.float32) * scale
        p = jax.nn.softmax(s, axis=-1).astype(v.dtype)
        return jnp.einsum('bhqk,bkhd->bqhd', p, v)

    out = lax.map(block, qb)
    return jnp.moveaxis(out, 0, 1).reshape(b, Lc, H * Dh)


def neighbourhood_attention(q, k, v, k_ctx, v_ctx, rpb):
    b, L, H, Dh = q.shape
    rows = L // GRID_W
    kh = min(NAT_KH, rows)
    scale = Dh ** -0.5
    f32 = jnp.float32
    qg = q.reshape(b, rows, GRID_W, H, Dh)
    kg = k.reshape(b, rows, GRID_W, H, Dh)
    vg = v.reshape(b, rows, GRID_W, H, Dh)
    r_idx = jnp.arange(rows)
    r_start = jnp.clip(r_idx - kh // 2, 0, rows - kh)
    cols = jnp.arange(GRID_W)
    c_start = jnp.clip(cols - NAT_KW // 2, 0, GRID_W - NAT_KW)
    col_mask = (cols[None, :] >= c_start[:, None]) & (cols[None, :] < c_start[:, None] + NAT_KW)
    col_bias_idx = jnp.clip(cols[None, :] - cols[:, None] + NAT_KW - 1, 0, 2 * NAT_KW - 2)
    rpb = rpb.astype(f32)

    def row_block(args):
        q_r, rs, r = args
        k_b = lax.dynamic_slice_in_dim(kg, rs, kh, axis=1)
        v_b = lax.dynamic_slice_in_dim(vg, rs, kh, axis=1)
        row_bias_idx = rs + jnp.arange(kh) - r + NAT_KH - 1
        bias = jnp.take(rpb[:, row_bias_idx], col_bias_idx, axis=2)
        s_lat = jnp.einsum('bqhd,bikhd->bhqik', q_r, k_b).astype(f32) * scale
        s_lat = jnp.where(col_mask[:, None, :], s_lat + bias.transpose(0, 2, 1, 3), -jnp.inf)
        s_lat = s_lat.reshape(b, H, GRID_W, kh * GRID_W)
        s_ctx = jnp.einsum('bqhd,bmhd->bhqm', q_r, k_ctx).astype(f32) * scale
        p = jax.nn.softmax(jnp.concatenate([s_lat, s_ctx], axis=-1), axis=-1).astype(v.dtype)
        p_lat = p[..., :kh * GRID_W].reshape(b, H, GRID_W, kh, GRID_W)
        p_ctx = p[..., kh * GRID_W:]
        return (jnp.einsum('bhqik,bikhd->bqhd', p_lat, v_b)
                + jnp.einsum('bhqm,bmhd->bqhd', p_ctx, v_ctx.astype(v.dtype)))

    out = lax.map(row_block, (jnp.moveaxis(qg, 1, 0), r_start, r_idx))
    return jnp.moveaxis(out, 0, 1).reshape(b, L, H * Dh)


def trunk_layer(x, cond, lw, cache=None):
    b, L, _ = x.shape
    mods = jax.nn.silu(cond) @ lw['w_mod'] + lw['b_mod']
    sh1, sc1, g1, sh2, sc2, g2 = jnp.split(mods[:, None, :], N_MOD, axis=-1)
    h = rmsnorm(x, lw['norm_mix']) * (1 + sc1) + sh1
    z, xbc, dt_raw, u, q, k, v = split_proj(h @ lw['w_in'])
    q = q.reshape(b, L, NAT_HEADS, NAT_HEAD_DIM)
    k = k.reshape(b, L, NAT_HEADS, NAT_HEAD_DIM)
    v = v.reshape(b, L, NAT_HEADS, NAT_HEAD_DIM)
    if cache is None:
        ssd0 = jnp.zeros((b, 2, SSD_HEADS, SSD_HEAD_DIM, SSD_STATE), jnp.float32)
        s5_re0 = jnp.zeros((b, 2, S5_GROUPS, S5_STATE), jnp.float32)
        s5_im0 = s5_re0
        y_nat = context_attention(q, k, v)
    else:
        k_ctx, v_ctx, ssd0, s5_re0, s5_im0 = cache
        y_nat = neighbourhood_attention(q, k, v, k_ctx, v_ctx, lw['nat_rpb'])
    y_ssd, ssd_state = ssd_mixer(z, xbc, dt_raw, lw, ssd0[:, 0], ssd0[:, 1])
    y_s5, s5_re, s5_im = s5_mixer(u, lw, s5_re0, s5_im0)
    mix = jnp.concatenate([y_ssd.astype(x.dtype), y_s5.astype(x.dtype), y_nat.astype(x.dtype)], axis=-1)
    x = x + g1 * (mix @ lw['w_out'])
    h2 = rmsnorm(x, lw['norm_mlp']) * (1 + sc2) + sh2
    x = x + g2 * (jnp.square(jax.nn.relu(h2 @ lw['w_ff1'])) @ lw['w_ff2'])
    return x, (k, v, ssd_state, s5_re, s5_im)


def setup_inputs(seed: int = 0) -> dict:
    key = jax.random.key(seed)
    ks = jax.random.split(key, 40)
    f32 = jnp.float32

    def nrm(k, shape, scale):
        return jax.random.normal(k, shape, f32) * scale

    log_lo, log_hi = math.log(1e-3), math.log(1e-1)
    ssd_dt = jnp.exp(jax.random.uniform(ks[10], (DEPTH, 2, SSD_HEADS), f32, log_lo, log_hi))
    s5_shape = (DEPTH, 2, S5_GROUPS, S5_STATE)
    return {
        'x_prompt': nrm(ks[0], (BATCH, SEQ, D_MODEL), 1.0),
        'x_sample': nrm(ks[1], (DEC_BATCH, DEC_SEQ, D_MODEL), 1.0),
        'cache_nat_k': nrm(ks[2], (DEC_BATCH, DEPTH, PAST_LEN, NAT_HEADS, NAT_HEAD_DIM), 1.0),
        'cache_nat_v': nrm(ks[3], (DEC_BATCH, DEPTH, PAST_LEN, NAT_HEADS, NAT_HEAD_DIM), 1.0),
        'state_ssd': nrm(ks[4], (DEC_BATCH, DEPTH, 2, SSD_HEADS, SSD_HEAD_DIM, SSD_STATE), 0.1),
        'state_s5_re': nrm(ks[5], (DEC_BATCH, DEPTH, 2, S5_GROUPS, S5_STATE), 0.05),
        'state_s5_im': nrm(ks[6], (DEC_BATCH, DEPTH, 2, S5_GROUPS, S5_STATE), 0.05),
        'c': nrm(ks[7], (DEC_BATCH, D_MODEL), 1.0),
        'c_ctx': nrm(ks[8], (D_MODEL,), 1.0),
        'w_mod': nrm(ks[9], (DEPTH, D_MODEL, N_MOD * D_MODEL), 0.5 * D_MODEL ** -0.5),
        'b_mod': nrm(ks[11], (DEPTH, N_MOD * D_MODEL), 0.02),
        'norm_mix': 1.0 + nrm(ks[12], (DEPTH, D_MODEL), 0.01),
        'norm_mlp': 1.0 + nrm(ks[13], (DEPTH, D_MODEL), 0.01),
        'w_in': nrm(ks[14], (DEPTH, D_MODEL, IN_COLS), D_MODEL ** -0.5),
        'ssd_conv_w': nrm(ks[15], (DEPTH, SSD_CONV, SSD_CONV_DIM), SSD_CONV ** -0.5),
        'ssd_conv_b': nrm(ks[16], (DEPTH, SSD_CONV_DIM), 0.01),
        'ssd_dt_bias': ssd_dt + jnp.log(-jnp.expm1(-ssd_dt)),
        'ssd_a_log': jnp.log(jax.random.uniform(ks[17], (DEPTH, 2, SSD_HEADS), f32, 1.0, 16.0)),
        'ssd_d': 1.0 + nrm(ks[18], (DEPTH, SSD_HEADS), 0.1),
        'ssd_norm': 1.0 + nrm(ks[19], (DEPTH, SSD_D), 0.01),
        's5_a_re': -0.5 + nrm(ks[20], s5_shape, 0.01),
        's5_a_im': jnp.pi * jnp.arange(S5_STATE, dtype=f32) + nrm(ks[21], s5_shape, 0.01),
        's5_log_dt': jax.random.uniform(ks[22], (DEPTH, 2, S5_GROUPS), f32, log_lo, log_hi),
        's5_b_re': nrm(ks[23], (DEPTH, S5_GROUPS, S5_STATE, S5_GROUP_CH), (2 * S5_GROUP_CH) ** -0.5),
        's5_b_im': nrm(ks[24], (DEPTH, S5_GROUPS, S5_STATE, S5_GROUP_CH), (2 * S5_GROUP_CH) ** -0.5),
        's5_c_re': nrm(ks[25], (DEPTH, S5_GROUPS, S5_GROUP_CH, S5_STATE), 0.5),
        's5_c_im': nrm(ks[26], (DEPTH, S5_GROUPS, S5_GROUP_CH, S5_STATE), 0.5),
        's5_d': nrm(ks[27], (DEPTH, S5_D), 1.0),
        's5_w_glu': nrm(ks[28], (DEPTH, S5_D, S5_D), S5_D ** -0.5),
        's5_b_glu': nrm(ks[29], (DEPTH, S5_D), 0.01),
        'nat_rpb': nrm(ks[30], (DEPTH, NAT_HEADS, 2 * NAT_KH - 1, 2 * NAT_KW - 1), 0.1),
        'w_out': nrm(ks[31], (DEPTH, MIX_D, D_MODEL), MIX_D ** -0.5),
        'w_ff1': nrm(ks[32], (DEPTH, D_MODEL, D_FF), D_MODEL ** -0.5),
        'w_ff2': nrm(ks[33], (DEPTH, D_FF, D_MODEL), D_FF ** -0.5),
        'norm_f': 1.0 + nrm(ks[34], (D_MODEL,), 0.01),
    }


def reference(x_prompt, x_sample, cache_nat_k, cache_nat_v, state_ssd, state_s5_re, state_s5_im,
              c, c_ctx, w_mod, b_mod, norm_mix, norm_mlp, w_in, ssd_conv_w, ssd_conv_b,
              ssd_dt_bias, ssd_a_log, ssd_d, ssd_norm, s5_a_re, s5_a_im, s5_log_dt,
              s5_b_re, s5_b_im, s5_c_re, s5_c_im, s5_d, s5_w_glu, s5_b_glu, nat_rpb,
              w_out, w_ff1, w_ff2, norm_f):
    xp = x_prompt
    xs = x_sample
    new_k, new_v, new_ssd, new_re, new_im = [], [], [], [], []
    for l in range(DEPTH):
        lw = {
            'w_mod': w_mod[l], 'b_mod': b_mod[l], 'norm_mix': norm_mix[l], 'norm_mlp': norm_mlp[l],
            'w_in': w_in[l], 'ssd_conv_w': ssd_conv_w[l], 'ssd_conv_b': ssd_conv_b[l],
            'ssd_dt_bias': ssd_dt_bias[l], 'ssd_a_log': ssd_a_log[l], 'ssd_d': ssd_d[l],
            'ssd_norm': ssd_norm[l], 's5_a_re': s5_a_re[l], 's5_a_im': s5_a_im[l],
            's5_log_dt': s5_log_dt[l], 's5_b_re': s5_b_re[l], 's5_b_im': s5_b_im[l],
            's5_c_re': s5_c_re[l], 's5_c_im': s5_c_im[l], 's5_d': s5_d[l],
            's5_w_glu': s5_w_glu[l], 's5_b_glu': s5_b_glu[l], 'nat_rpb': nat_rpb[l],
            'w_out': w_out[l], 'w_ff1': w_ff1[l], 'w_ff2': w_ff2[l],
        }
        xp, (k_l, v_l, ssd_l, re_l, im_l) = trunk_layer(xp, c_ctx[None, :], lw)
        new_k.append(k_l)
        new_v.append(v_l)
        new_ssd.append(ssd_l)
        new_re.append(re_l)
        new_im.append(im_l)
        xs, _ = trunk_layer(xs, c, lw, (cache_nat_k[:, l], cache_nat_v[:, l], state_ssd[:, l],
                                        state_s5_re[:, l], state_s5_im[:, l]))
    y_prompt = rmsnorm(xp, norm_f)
    y_sample = rmsnorm(xs, norm_f)
    return (y_prompt, y_sample, jnp.stack(new_k, axis=1), jnp.stack(new_v, axis=1),
            jnp.stack(new_ssd, axis=1), jnp.stack(new_re, axis=1), jnp.stack(new_im, axis=1))
```

```cpp
#include <hip/hip_runtime.h>
#include <stdint.h>
#include <stdio.h>

typedef unsigned short bf16_t;
typedef short bf16x8 __attribute__((ext_vector_type(8)));
typedef float f32x4 __attribute__((ext_vector_type(4)));

constexpr int D = 1024, DEPTH = 4;
constexpr int CB = 32, CL = 256, LB = 8, LL = 1024;
constexpr int MC = CB * CL;
constexpr int M = MC + LB * LL;
constexpr int NSEQ = CB + LB;
constexpr int IN_COLS = 2444;
constexpr int PN = 2432, PNP = 2560;
constexpr int PZ = 0, PX = 384, PU = 1024, PQ = 1280, PK = 1664, PV = 2048;
constexpr int DFF = 4096;
constexpr float EPS = 1e-6f;

constexpr size_t MiB = 1u << 20;
constexpr size_t OFF_CTL = 0, OFF_MODS = 1 * MiB, OFF_TAB = 2 * MiB, OFF_WIN = 8 * MiB, OFF_WOUT = 28 * MiB, OFF_WFF1 = 36 * MiB,
                 OFF_WFF2 = 68 * MiB, OFF_WGLU = 100 * MiB, OFF_DT = 101 * MiB, OFF_X = 102 * MiB, OFF_PROJ = 166 * MiB, OFF_MIX = 242 * MiB,
                 OFF_FFH = 166 * MiB, OFF_H = 294 * MiB, OFF_XBC = 294 * MiB, OFF_YSSD = 334 * MiB, OFF_YS5 = 358 * MiB, WS_END = 374 * MiB;
constexpr size_t TAB_ABAR = 0;
constexpr size_t TAB_BBAR = 256 * 1024;
constexpr size_t TAB_WDT = 2 * MiB;

__device__ __forceinline__ float bf2f(bf16_t v) { return __uint_as_float((unsigned)v << 16); }
__device__ __forceinline__ bf16_t f2bf(float f) { unsigned u = __float_as_uint(f); return (bf16_t)((u + 0x7fffu + ((u >> 16) & 1u)) >> 16); }
__device__ __forceinline__ float silu_f(float x) { return x / (1.f + __expf(-x)); }
__device__ __forceinline__ float softplus_f(float x) { return x > 20.f ? x : log1pf(__expf(x)); }
__device__ __forceinline__ float gelu_tanh_f(float x) { const float u = 0.7978845608028654f * (x + 0.044715f * x * x * x); return 0.5f * x * (1.f + tanhf(u)); }
__device__ __forceinline__ float wave_sum(float v) {
#pragma unroll
    for (int o = 1; o < 64; o <<= 1) v += __shfl_xor(v, o);
    return v;
}
__device__ __forceinline__ float wave_max(float v) {
#pragma unroll
    for (int o = 1; o < 64; o <<= 1) v = fmaxf(v, __shfl_xor(v, o));
    return v;
}
__device__ __forceinline__ int mod_row(int row) { return row < MC ? 0 : 1 + ((row - MC) >> 10); }

struct P {
    const float* in[35];
    float* out;
    unsigned char* ws;
};
constexpr size_t O_YP = 0, O_YS = 8388608, O_K = 16777216, O_V = O_K + 12582912, O_SSD = O_V + 12582912, O_RE = O_SSD + 6291456, O_IM = O_RE + 262144, O_END = O_IM + 262144;

__global__ void k_transpose(const float* __restrict__ W, int K, int Nsrc, bf16_t* __restrict__ WT, int Ndst, int nvalid, int shift_from, int shift) {
    __shared__ float tile[32][33];
    const int n0 = blockIdx.x * 32, k0 = blockIdx.y * 32;
    const int tx = threadIdx.x & 31, ty = threadIdx.x >> 5;
    for (int i = ty; i < 32; i += 8) {
        const int n = n0 + tx; float v = 0.f;
        if (n < nvalid) v = W[(size_t)(k0 + i) * Nsrc + n + (n >= shift_from ? shift : 0)];
        tile[i][tx] = v;
    }
    __syncthreads();
    for (int i = ty; i < 32; i += 8) WT[(size_t)(n0 + i) * K + k0 + tx] = f2bf(tile[tx][i]);
}
__global__ void k_mods(P p) {
    __shared__ float sc[9][1024];
    const int l = blockIdx.y, n = blockIdx.x * 256 + threadIdx.x;
    for (int i = threadIdx.x; i < 9 * 1024; i += 256) { const int r = i >> 10, k = i & 1023; const float v = r == 0 ? p.in[8][k] : p.in[7][(r - 1) * 1024 + k]; sc[r][k] = silu_f(v); }
    __syncthreads();
    float acc[9];
#pragma unroll
    for (int r = 0; r < 9; ++r) acc[r] = 0.f;
    const float* w = p.in[9] + (size_t)l * 1024 * 6144 + n;
    for (int k = 0; k < 1024; ++k) { const float wv = w[(size_t)k * 6144];
#pragma unroll
        for (int r = 0; r < 9; ++r) acc[r] += sc[r][k] * wv; }
    float* mods = (float*)(p.ws + OFF_MODS);
    const float b = p.in[10][l * 6144 + n];
#pragma unroll
    for (int r = 0; r < 9; ++r) mods[(size_t)(l * 9 + r) * 6144 + n] = acc[r] + b;
}
__global__ void k_tables(P p) {
    const int idx = blockIdx.x * 256 + threadIdx.x;
    if (idx < 8192) {
        const int pp = idx & 63, g = (idx >> 6) & 15, dir = (idx >> 10) & 1, l = idx >> 11;
        const float are = p.in[20][idx], aim = p.in[21][idx];
        const float dt = __expf(p.in[22][(l * 2 + dir) * 16 + g]);
        const float zr = are * dt, zi = aim * dt;
        const float e = expf(zr); float rev = zi * 0.15915494309189535f; rev -= rintf(rev);
        const float ar = e * cosf(rev * 6.283185307179586f), ai = e * sinf(rev * 6.283185307179586f);
        float* abar = (float*)(p.ws + OFF_TAB + TAB_ABAR);
        abar[idx * 2] = ar; abar[idx * 2 + 1] = ai;
        const float xr = ar - 1.f, xi = ai, den = are * are + aim * aim;
        const float fr = (xr * are + xi * aim) / den, fi = (xi * are - xr * aim) / den;
        float* bbar = (float*)(p.ws + OFF_TAB + TAB_BBAR);
        for (int c = 0; c < 16; ++c) {
            const float br = p.in[23][((l * 16 + g) * 64 + pp) * 16 + c], bi = p.in[24][((l * 16 + g) * 64 + pp) * 16 + c];
            bbar[((size_t)idx * 16 + c) * 2] = fr * br - fi * bi; bbar[((size_t)idx * 16 + c) * 2 + 1] = fr * bi + fi * br;
        }
    }
    for (int i = idx; i < 4 * 12 * 1024; i += gridDim.x * 256) {
        const int k = i & 1023, j = (i >> 10) % 12, l = i / (12 * 1024);
        ((float*)(p.ws + OFF_TAB + TAB_WDT))[i] = p.in[13][((size_t)l * 1024 + k) * IN_COLS + 1024 + j];
    }
}

__global__ void k_norm(P p, int l, int which, const float* __restrict__ X) {
    const int lane = threadIdx.x & 63, row = blockIdx.x * 4 + (threadIdx.x >> 6);
    const float* xr = X + (size_t)row * D; const int r = mod_row(row);
    const float* mods = (const float*)(p.ws + OFF_MODS) + (size_t)(l * 9 + r) * 6144;
    const float* gw = p.in[which ? 12 : 11] + l * D;
    const float* sh = mods + (which ? 3 : 0) * 1024; const float* sc = mods + (which ? 4 : 1) * 1024;
    f32x4 v[4]; float s = 0.f;
#pragma unroll
    for (int j = 0; j < 4; ++j) { v[j] = *(const f32x4*)(xr + 4 * lane + 256 * j); s += v[j].x * v[j].x + v[j].y * v[j].y + v[j].z * v[j].z + v[j].w * v[j].w; }
    const float rstd = rsqrtf(wave_sum(s) * (1.f / D) + EPS);
    bf16_t* h = (bf16_t*)(p.ws + OFF_H) + (size_t)row * D;
#pragma unroll
    for (int j = 0; j < 4; ++j) { const int c = 4 * lane + 256 * j; const f32x4 g = *(const f32x4*)(gw + c), a = *(const f32x4*)(sc + c), b = *(const f32x4*)(sh + c);
        v[j].x = v[j].x * rstd * g.x * (1.f + a.x) + b.x; v[j].y = v[j].y * rstd * g.y * (1.f + a.y) + b.y; v[j].z = v[j].z * rstd * g.z * (1.f + a.z) + b.z; v[j].w = v[j].w * rstd * g.w * (1.f + a.w) + b.w;
        ushort4 o; o.x = f2bf(v[j].x); o.y = f2bf(v[j].y); o.z = f2bf(v[j].z); o.w = f2bf(v[j].w); *(ushort4*)(h + c) = o; }
    if (which == 0) {
        const float* wdt = (const float*)(p.ws + OFF_TAB + TAB_WDT) + (size_t)l * 12 * 1024;
        float* dt = (float*)(p.ws + OFF_DT) + (size_t)row * 12;
        for (int jj = 0; jj < 12; ++jj) { float a = 0.f;
#pragma unroll
            for (int j = 0; j < 4; ++j) { const f32x4 w = *(const f32x4*)(wdt + jj * 1024 + 4 * lane + 256 * j); a += v[j].x * w.x + v[j].y * w.y + v[j].z * w.z + v[j].w * w.w; }
            a = wave_sum(a); if (lane == 0) dt[jj] = a; }
    }
}
__global__ void k_final_norm(P p, const float* __restrict__ X) {
    const int lane = threadIdx.x & 63, row = blockIdx.x * 4 + (threadIdx.x >> 6);
    const float* xr = X + (size_t)row * D; const float* gw = p.in[34];
    f32x4 v[4]; float s = 0.f;
#pragma unroll
    for (int j = 0; j < 4; ++j) { v[j] = *(const f32x4*)(xr + 4 * lane + 256 * j); s += v[j].x * v[j].x + v[j].y * v[j].y + v[j].z * v[j].z + v[j].w * v[j].w; }
    const float rstd = rsqrtf(wave_sum(s) * (1.f / D) + EPS);
    float* o = p.out + (size_t)row * D;
#pragma unroll
    for (int j = 0; j < 4; ++j) { const int c = 4 * lane + 256 * j; const f32x4 g = *(const f32x4*)(gw + c); f32x4 r = {v[j].x * rstd * g.x, v[j].y * rstd * g.y, v[j].z * rstd * g.z, v[j].w * rstd * g.w}; *(f32x4*)(o + c) = r; }
}

struct EpiProj { bf16_t* proj; float* ok; float* ov; int l;
    __device__ __forceinline__ void operator()(int row, int col, float v) const {
        if (col < PN) proj[(size_t)row * PN + col] = f2bf(v);
        if (row < MC && col >= PK && col < PN) { const int b = row >> 8, t = row & 255; const size_t base = ((size_t)(b * 4 + l) * 256 + t) * 384;
            if (col < PV) ok[base + col - PK] = v; else ov[base + col - PV] = v; } } };
struct EpiRes { const float* xin; float* xout; const float* mods; int chunk;
    __device__ __forceinline__ void operator()(int row, int col, float v) const { const float g = mods[(size_t)mod_row(row) * 6144 + chunk * 1024 + col]; xout[(size_t)row * D + col] = xin[(size_t)row * D + col] + g * v; } };
struct EpiFF1 { bf16_t* h;
    __device__ __forceinline__ void operator()(int row, int col, float v) const { const float r = fmaxf(v, 0.f); h[(size_t)row * DFF + col] = f2bf(r * r); } };
template <class Epi>
__global__ void __launch_bounds__(256) k_gemm(const bf16_t* __restrict__ A, const bf16_t* __restrict__ Bt, int K, Epi E) {
    const int lane = threadIdx.x & 63, w = threadIdx.x >> 6, fr = lane & 15, fq = lane >> 4;
    const int row0 = blockIdx.y * 64 + w * 16, col0 = blockIdx.x * 64;
    f32x4 acc[4] = {};
    const bf16_t* ap = A + (size_t)(row0 + fr) * K + fq * 8;
    const bf16_t* bp = Bt + (size_t)(col0 + fr) * K + fq * 8;
    for (int k0 = 0; k0 < K; k0 += 32) {
        const bf16x8 a = *(const bf16x8*)(ap + k0);
#pragma unroll
        for (int j = 0; j < 4; ++j) { const bf16x8 b = *(const bf16x8*)(bp + (size_t)j * 16 * K + k0); acc[j] = __builtin_amdgcn_mfma_f32_16x16x32_bf16(a, b, acc[j], 0, 0, 0); }
    }
#pragma unroll
    for (int j = 0; j < 4; ++j)
#pragma unroll
        for (int i = 0; i < 4; ++i) E(row0 + fq * 4 + i, col0 + j * 16 + fr, acc[j][i]);
}

struct SeqInfo { int start, L, b, ctx; };
__device__ __forceinline__ SeqInfo seq_info(int s) { SeqInfo q; if (s < CB) { q.start = s * CL; q.L = CL; q.b = s; q.ctx = 1; } else { q.start = MC + (s - CB) * LL; q.L = LL; q.b = s - CB; q.ctx = 0; } return q; }
__device__ __forceinline__ SeqInfo row_seq(int row) { return seq_info(row < MC ? (row >> 8) : CB + ((row - MC) >> 10)); }
__global__ void k_conv(P p, int l) {
    const int row = blockIdx.x, c = threadIdx.x;
    const SeqInfo q = row_seq(row); const int t = row - q.start;
    const bf16_t* proj = (const bf16_t*)(p.ws + OFF_PROJ);
    const float* cw = p.in[14] + l * 5 * 640; float acc = p.in[15][l * 640 + c];
#pragma unroll
    for (int j = 0; j < 5; ++j) { const int tt = t + j - 2; if (tt >= 0 && tt < q.L) acc += cw[j * 640 + c] * bf2f(proj[(size_t)(q.start + tt) * PN + PX + c]); }
    ((float*)(p.ws + OFF_XBC))[(size_t)row * 640 + c] = silu_f(acc);
}
__global__ void __launch_bounds__(256) k_ssd_scan(P p, int l) {
    const int s = blockIdx.x / 6, h = blockIdx.x % 6, g = h / 3;
    const SeqInfo q = seq_info(s);
    const int tid = threadIdx.x, pp = tid >> 2, nq = tid & 3;
    const float* xbc = (const float*)(p.ws + OFF_XBC); const float* dtb = (const float*)(p.ws + OFF_DT);
    float* Y = (float*)(p.ws + OFF_YSSD);
    for (int dir = 0; dir < 2; ++dir) {
        const float a = -__expf(p.in[17][(l * 2 + dir) * 6 + h]); const float bias = p.in[16][(l * 2 + dir) * 6 + h];
        float st[16];
        if (q.ctx) {
#pragma unroll
            for (int i = 0; i < 16; ++i) st[i] = 0.f;
        } else { const float* s0 = p.in[4] + ((((size_t)q.b * 4 + l) * 2 + dir) * 6 + h) * 4096 + pp * 64 + nq * 16;
#pragma unroll
            for (int i = 0; i < 16; ++i) st[i] = s0[i]; }
        for (int step = 0; step < q.L; ++step) {
            const int t = dir == 0 ? step : q.L - 1 - step; const size_t row = q.start + t;
            const float x = xbc[row * 640 + h * 64 + pp];
            const float dt = softplus_f(dtb[row * 12 + dir * 6 + h] + bias);
            const float dA = __expf(dt * a), dx = dt * x;
            const float* Bv = xbc + row * 640 + 384 + g * 64 + nq * 16; const float* Cv = xbc + row * 640 + 512 + g * 64 + nq * 16;
            float y = 0.f;
#pragma unroll
            for (int i = 0; i < 16; ++i) { st[i] = dA * st[i] + dx * Bv[i]; y += Cv[i] * st[i]; }
            y += __shfl_xor(y, 1); y += __shfl_xor(y, 2);
            if (nq == 0) { if (dir == 0) Y[row * 384 + h * 64 + pp] = y; else Y[row * 384 + h * 64 + pp] += y; }
        }
        if (q.ctx) { float* o = p.out + O_SSD + ((((size_t)q.b * 4 + l) * 2 + dir) * 6 + h) * 4096 + pp * 64 + nq * 16;
#pragma unroll
            for (int i = 0; i < 16; ++i) o[i] = st[i]; }
        __syncthreads();
    }
}
__global__ void k_ssd_combine(P p, int l) {
    const int lane = threadIdx.x & 63, row = blockIdx.x * 4 + (threadIdx.x >> 6);
    const float* Y = (const float*)(p.ws + OFF_YSSD) + (size_t)row * 384; const float* xbc = (const float*)(p.ws + OFF_XBC) + (size_t)row * 640;
    const bf16_t* z = (const bf16_t*)(p.ws + OFF_PROJ) + (size_t)row * PN + PZ;
    float v[6]; float s = 0.f;
#pragma unroll
    for (int j = 0; j < 6; ++j) { const int c = lane + 64 * j; const float y = Y[c] + p.in[18][l * 6 + j] * xbc[c]; v[j] = y * silu_f(bf2f(z[c])); s += v[j] * v[j]; }
    const float rstd = rsqrtf(wave_sum(s) * (1.f / 384.f) + EPS);
    bf16_t* mix = (bf16_t*)(p.ws + OFF_MIX) + (size_t)row * D;
#pragma unroll
    for (int j = 0; j < 6; ++j) { const int c = lane + 64 * j; mix[c] = f2bf(v[j] * rstd * p.in[19][l * 384 + c]); }
}

__global__ void __launch_bounds__(64) k_s5_scan(P p, int l) {
    const int s = blockIdx.x >> 4, g = blockIdx.x & 15, lane = threadIdx.x;
    const SeqInfo q = seq_info(s);
    const bf16_t* proj = (const bf16_t*)(p.ws + OFF_PROJ); float* Y = (float*)(p.ws + OFF_YS5);
    float cre[16], cim[16];
#pragma unroll
    for (int c = 0; c < 16; ++c) { cre[c] = p.in[25][((l * 16 + g) * 16 + c) * 64 + lane]; cim[c] = p.in[26][((l * 16 + g) * 16 + c) * 64 + lane]; }
    for (int dir = 0; dir < 2; ++dir) {
        const int ti = ((l * 2 + dir) * 16 + g) * 64 + lane;
        const float* abar = (const float*)(p.ws + OFF_TAB + TAB_ABAR) + (size_t)ti * 2; const float ar = abar[0], ai = abar[1];
        const float* bb = (const float*)(p.ws + OFF_TAB + TAB_BBAR) + (size_t)ti * 32;
        float br[16], bi[16];
#pragma unroll
        for (int c = 0; c < 16; ++c) { br[c] = bb[2 * c]; bi[c] = bb[2 * c + 1]; }
        float hr = 0.f, hi = 0.f;
        if (!q.ctx) { const size_t o = (((size_t)q.b * 4 + l) * 2 + dir) * 1024 + g * 64 + lane; hr = p.in[5][o]; hi = p.in[6][o]; }
        for (int step = 0; step < q.L; ++step) {
            const int t = dir == 0 ? step : q.L - 1 - step; const size_t row = q.start + t;
            const bf16_t* u = proj + row * PN + PU + g * 16;
            float bur = 0.f, bui = 0.f;
#pragma unroll
            for (int c = 0; c < 16; ++c) { const float uv = bf2f(u[c]); bur += br[c] * uv; bui += bi[c] * uv; }
            const float nr = ar * hr - ai * hi + bur, ni = ar * hi + ai * hr + bui; hr = nr; hi = ni;
            float mine = 0.f;
#pragma unroll
            for (int c = 0; c < 16; ++c) { const float v = wave_sum(cre[c] * hr - cim[c] * hi); if (lane == c) mine = v; }
            if (lane < 16) { if (dir == 0) Y[row * 256 + g * 16 + lane] = mine; else Y[row * 256 + g * 16 + lane] += mine; }
        }
        if (q.ctx) { const size_t o = (((size_t)q.b * 4 + l) * 2 + dir) * 1024 + g * 64 + lane; p.out[O_RE + o] = hr; p.out[O_IM + o] = hi; }
    }
}
__global__ void __launch_bounds__(256) k_s5_glu(P p, int l) {
    __shared__ float gs[256];
    const int row = blockIdx.x, n = threadIdx.x;
    const bf16_t* proj = (const bf16_t*)(p.ws + OFF_PROJ);
    const float y = ((const float*)(p.ws + OFF_YS5))[(size_t)row * 256 + n] + p.in[27][l * 256 + n] * bf2f(proj[(size_t)row * PN + PU + n]);
    const float gv = gelu_tanh_f(y); gs[n] = gv;
    __syncthreads();
    const float* w = p.in[28] + (size_t)l * 65536 + n; float acc = p.in[29][l * 256 + n];
    for (int k = 0; k < 256; ++k) acc += gs[k] * w[(size_t)k * 256];
    ((bf16_t*)(p.ws + OFF_MIX))[(size_t)row * D + 384 + n] = f2bf(gv / (1.f + __expf(-acc)));
}

__global__ void __launch_bounds__(256) k_attn(P p, int l) {
    __shared__ float qs[4][64]; __shared__ float ps[4][768];
    const int w = threadIdx.x >> 6, lane = threadIdx.x & 63;
    const int wid = blockIdx.x * 4 + w; const int row = wid / 6, h = wid % 6;
    const bf16_t* proj = (const bf16_t*)(p.ws + OFF_PROJ);
    qs[w][lane] = bf2f(proj[(size_t)row * PN + PQ + h * 64 + lane]);
    __syncthreads();
    float o = 0.f;
    if (row < MC) {
        const int b = row >> 8; float sc[4]; float mx = -INFINITY;
#pragma unroll
        for (int j = 0; j < 4; ++j) { const int key = lane + 64 * j; const bf16_t* kp = proj + (size_t)(b * 256 + key) * PN + PK + h * 64; float a = 0.f;
            for (int d = 0; d < 64; ++d) a += qs[w][d] * bf2f(kp[d]);
            sc[j] = a * 0.125f; mx = fmaxf(mx, sc[j]); }
        mx = wave_max(mx); float sum = 0.f;
#pragma unroll
        for (int j = 0; j < 4; ++j) { sc[j] = __expf(sc[j] - mx); sum += sc[j]; ps[w][lane + 64 * j] = sc[j]; }
        sum = wave_sum(sum);
        __syncthreads();
        for (int key = 0; key < 256; ++key) o += ps[w][key] * bf2f(proj[(size_t)(b * 256 + key) * PN + PV + h * 64 + lane]);
        o /= sum;
    } else {
        const int rr = row - MC, b = rr >> 10, t = rr & 1023, r = t >> 6, qc = t & 63;
        int rs = r - 4; rs = rs < 0 ? 0 : (rs > 8 ? 8 : rs); int cs = qc - 8; cs = cs < 0 ? 0 : (cs > 48 ? 48 : cs);
        const float* rpb = p.in[30] + (size_t)(l * 6 + h) * 15 * 31;
        float sc[6]; float mx = -INFINITY;
#pragma unroll
        for (int j = 0; j < 2; ++j) { const int idx = lane + 64 * j, i = idx >> 4, kc = cs + (idx & 15), kr = rs + i;
            const bf16_t* kp = proj + (size_t)(MC + b * 1024 + kr * 64 + kc) * PN + PK + h * 64; float a = 0.f;
            for (int d = 0; d < 64; ++d) a += qs[w][d] * bf2f(kp[d]);
            sc[j] = a * 0.125f + rpb[(kr - r + 7) * 31 + (kc - qc + 15)]; mx = fmaxf(mx, sc[j]); }
        const float* ck = p.in[2] + ((size_t)(b * 4 + l) * 256) * 384 + h * 64; const float* cv = p.in[3] + ((size_t)(b * 4 + l) * 256) * 384 + h * 64;
#pragma unroll
        for (int j = 0; j < 4; ++j) { const int key = lane + 64 * j; const float* kp = ck + (size_t)key * 384; float a = 0.f;
            for (int d = 0; d < 64; ++d) a += qs[w][d] * kp[d];
            sc[2 + j] = a * 0.125f; mx = fmaxf(mx, sc[2 + j]); }
        mx = wave_max(mx); float sum = 0.f;
#pragma unroll
        for (int j = 0; j < 6; ++j) { sc[j] = __expf(sc[j] - mx); sum += sc[j]; ps[w][lane + 64 * j] = sc[j]; }
        sum = wave_sum(sum);
        __syncthreads();
        for (int idx = 0; idx < 128; ++idx) { const int kr = rs + (idx >> 4), kc = cs + (idx & 15);
            o += ps[w][idx] * bf2f(proj[(size_t)(MC + b * 1024 + kr * 64 + kc) * PN + PV + h * 64 + lane]); }
        for (int key = 0; key < 256; ++key) o += ps[w][128 + key] * cv[(size_t)key * 384 + lane];
        o /= sum;
    }
    ((bf16_t*)(p.ws + OFF_MIX))[(size_t)row * D + 640 + h * 64 + lane] = f2bf(o);
}

extern "C" void kernel_launch(void* const* d_in, const int* in_sizes, int n_in, void* d_out, int out_size, void* d_ws, size_t ws_size, hipStream_t stream) {
    if (n_in != 35 || out_size != (int)O_END || ws_size < WS_END) { fprintf(stderr, "kernel_launch: unexpected shapes n_in %d out %d ws %zu\n", n_in, out_size, ws_size); return; }
    P p{}; for (int i = 0; i < 35; ++i) p.in[i] = (const float*)d_in[i]; p.out = (float*)d_out; p.ws = (unsigned char*)d_ws;
    unsigned char* ws = p.ws;
    for (int l = 0; l < DEPTH; ++l) {
        k_transpose<<<dim3(PNP / 32, 1024 / 32), 256, 0, stream>>>(p.in[13] + (size_t)l * 1024 * IN_COLS, 1024, IN_COLS, (bf16_t*)(ws + OFF_WIN) + (size_t)l * PNP * 1024, PNP, PN, 1024, 12);
        k_transpose<<<dim3(1024 / 32, 1024 / 32), 256, 0, stream>>>(p.in[31] + (size_t)l * 1024 * 1024, 1024, 1024, (bf16_t*)(ws + OFF_WOUT) + (size_t)l * 1024 * 1024, 1024, 1024, 1 << 30, 0);
        k_transpose<<<dim3(DFF / 32, 1024 / 32), 256, 0, stream>>>(p.in[32] + (size_t)l * 1024 * DFF, 1024, DFF, (bf16_t*)(ws + OFF_WFF1) + (size_t)l * DFF * 1024, DFF, DFF, 1 << 30, 0);
        k_transpose<<<dim3(1024 / 32, DFF / 32), 256, 0, stream>>>(p.in[33] + (size_t)l * DFF * 1024, DFF, 1024, (bf16_t*)(ws + OFF_WFF2) + (size_t)l * 1024 * DFF, 1024, 1024, 1 << 30, 0);
    }
    k_mods<<<dim3(6144 / 256, DEPTH), 256, 0, stream>>>(p);
    k_tables<<<192, 256, 0, stream>>>(p);
    float* X = (float*)(ws + OFF_X);
    (void)hipMemcpyAsync(X, d_in[0], (size_t)MC * D * 4, hipMemcpyDeviceToDevice, stream);
    (void)hipMemcpyAsync(X + (size_t)MC * D, d_in[1], (size_t)(M - MC) * D * 4, hipMemcpyDeviceToDevice, stream);
    const float* mods = (const float*)(ws + OFF_MODS);
    for (int l = 0; l < DEPTH; ++l) {
        k_norm<<<M / 4, 256, 0, stream>>>(p, l, 0, X);
        { EpiProj E{(bf16_t*)(ws + OFF_PROJ), p.out + O_K, p.out + O_V, l};
          k_gemm<EpiProj><<<dim3(PNP / 64, M / 64), 256, 0, stream>>>((const bf16_t*)(ws + OFF_H), (const bf16_t*)(ws + OFF_WIN) + (size_t)l * PNP * 1024, 1024, E); }
        k_conv<<<M, 640, 0, stream>>>(p, l);
        k_ssd_scan<<<NSEQ * 6, 256, 0, stream>>>(p, l);
        k_ssd_combine<<<M / 4, 256, 0, stream>>>(p, l);
        k_s5_scan<<<NSEQ * 16, 64, 0, stream>>>(p, l);
        k_s5_glu<<<M, 256, 0, stream>>>(p, l);
        k_attn<<<M * 6 / 4, 256, 0, stream>>>(p, l);
        { EpiRes E{X, X, mods + (size_t)l * 9 * 6144, 2};
          k_gemm<EpiRes><<<dim3(D / 64, M / 64), 256, 0, stream>>>((const bf16_t*)(ws + OFF_MIX), (const bf16_t*)(ws + OFF_WOUT) + (size_t)l * 1024 * 1024, 1024, E); }
        k_norm<<<M / 4, 256, 0, stream>>>(p, l, 1, X);
        { EpiFF1 E{(bf16_t*)(ws + OFF_FFH)};
          k_gemm<EpiFF1><<<dim3(DFF / 64, M / 64), 256, 0, stream>>>((const bf16_t*)(ws + OFF_H), (const bf16_t*)(ws + OFF_WFF1) + (size_t)l * DFF * 1024, 1024, E); }
        { EpiRes E{X, X, mods + (size_t)l * 9 * 6144, 5};
          k_gemm<EpiRes><<<dim3(D / 64, M / 64), 256, 0, stream>>>((const bf16_t*)(ws + OFF_FFH), (const bf16_t*)(ws + OFF_WFF2) + (size_t)l * 1024 * DFF, DFF, E); }
    }
    k_final_norm<<<M / 4, 256, 0, stream>>>(p, X);
}
```

```cpp
#include <hip/hip_runtime.h>
#include <stdint.h>
#include <stdio.h>

typedef unsigned short bf16_t;
typedef short bf16x8 __attribute__((ext_vector_type(8)));
typedef float f32x4 __attribute__((ext_vector_type(4)));

constexpr int D = 1024, DEPTH = 4;
constexpr int CB = 32, CL = 256, LB = 8, LL = 1024;
constexpr int MC = CB * CL;
constexpr int M = MC + LB * LL;
constexpr int NSEQ = CB + LB;
constexpr int IN_COLS = 2444;
constexpr int PN = 2432, PNP = 2560;
constexpr int PZ = 0, PX = 384, PU = 1024, PQ = 1280, PK = 1664, PV = 2048;
constexpr int DFF = 4096;
constexpr float EPS = 1e-6f;

constexpr size_t MiB = 1u << 20;
constexpr size_t OFF_CTL = 0, OFF_MODS = 1 * MiB, OFF_TAB = 2 * MiB, OFF_WIN = 8 * MiB, OFF_WOUT = 28 * MiB, OFF_WFF1 = 36 * MiB,
                 OFF_WFF2 = 68 * MiB, OFF_WGLU = 100 * MiB, OFF_DT = 101 * MiB, OFF_X = 102 * MiB, OFF_PROJ = 166 * MiB, OFF_MIX = 242 * MiB,
                 OFF_FFH = 166 * MiB, OFF_H = 294 * MiB, OFF_XBC = 294 * MiB, OFF_YSSD = 334 * MiB, OFF_YS5 = 358 * MiB, WS_END = 374 * MiB;
constexpr size_t TAB_ABAR = 0;
constexpr size_t TAB_BBAR = 256 * 1024;
constexpr size_t TAB_WDT = 2 * MiB;

__device__ __forceinline__ float bf2f(bf16_t v) { return __uint_as_float((unsigned)v << 16); }
__device__ __forceinline__ bf16_t f2bf(float f) { unsigned u = __float_as_uint(f); return (bf16_t)((u + 0x7fffu + ((u >> 16) & 1u)) >> 16); }
__device__ __forceinline__ float silu_f(float x) { return x / (1.f + __expf(-x)); }
__device__ __forceinline__ float softplus_f(float x) { return x > 20.f ? x : log1pf(__expf(x)); }
__device__ __forceinline__ float gelu_tanh_f(float x) { const float u = 0.7978845608028654f * (x + 0.044715f * x * x * x); return 0.5f * x * (1.f + tanhf(u)); }
__device__ __forceinline__ float wave_sum(float v) {
#pragma unroll
    for (int o = 1; o < 64; o <<= 1) v += __shfl_xor(v, o);
    return v;
}
__device__ __forceinline__ float wave_max(float v) {
#pragma unroll
    for (int o = 1; o < 64; o <<= 1) v = fmaxf(v, __shfl_xor(v, o));
    return v;
}
__device__ __forceinline__ int mod_row(int row) { return row < MC ? 0 : 1 + ((row - MC) >> 10); }

struct P {
    const float* in[35];
    float* out;
    unsigned char* ws;
};
constexpr size_t O_YP = 0, O_YS = 8388608, O_K = 16777216, O_V = O_K + 12582912, O_SSD = O_V + 12582912, O_RE = O_SSD + 6291456, O_IM = O_RE + 262144, O_END = O_IM + 262144;


struct SeqInfo { int start, L, b, ctx; };
__device__ __forceinline__ SeqInfo seq_info(int s) { SeqInfo q; if (s < CB) { q.start = s * CL; q.L = CL; q.b = s; q.ctx = 1; } else { q.start = MC + (s - CB) * LL; q.L = LL; q.b = s - CB; q.ctx = 0; } return q; }
__device__ __forceinline__ SeqInfo row_seq(int row) { return seq_info(row < MC ? (row >> 8) : CB + ((row - MC) >> 10)); }
#define LAS __attribute__((address_space(3)))
struct PP { const float* const* in; float* out; unsigned char* ws; };
__device__ __forceinline__ void d_conv(const PP& p, int l, int row, int c) {
    const SeqInfo q = row_seq(row); const int t = row - q.start;
    const bf16_t* proj = (const bf16_t*)(p.ws + OFF_PROJ);
    const float* cw = p.in[14] + l * 5 * 640; float acc = p.in[15][l * 640 + c];
#pragma unroll
    for (int j = 0; j < 5; ++j) { const int tt = t + j - 2; if (tt >= 0 && tt < q.L) acc += cw[j * 640 + c] * bf2f(proj[(size_t)(q.start + tt) * PN + PX + c]); }
    ((float*)(p.ws + OFF_XBC))[(size_t)row * 640 + c] = silu_f(acc);
}
__device__ __forceinline__ void d_ssd_scan(const PP& p, int l, int vb, int tid) {
    const int s = vb / 6, h = vb % 6, g = h / 3;
    const SeqInfo q = seq_info(s);
    const int pp = tid >> 2, nq = tid & 3;
    const float* xbc = (const float*)(p.ws + OFF_XBC); const float* dtb = (const float*)(p.ws + OFF_DT);
    float* Y = (float*)(p.ws + OFF_YSSD);
    for (int dir = 0; dir < 2; ++dir) {
        const float a = -__expf(p.in[17][(l * 2 + dir) * 6 + h]); const float bias = p.in[16][(l * 2 + dir) * 6 + h];
        float st[16];
        if (q.ctx) {
#pragma unroll
            for (int i = 0; i < 16; ++i) st[i] = 0.f;
        } else { const float* s0 = p.in[4] + ((((size_t)q.b * 4 + l) * 2 + dir) * 6 + h) * 4096 + pp * 64 + nq * 16;
#pragma unroll
            for (int i = 0; i < 16; ++i) st[i] = s0[i]; }
        for (int step = 0; step < q.L; ++step) {
            const int t = dir == 0 ? step : q.L - 1 - step; const size_t row = q.start + t;
            const float x = xbc[row * 640 + h * 64 + pp];
            const float dt = softplus_f(dtb[row * 12 + dir * 6 + h] + bias);
            const float dA = __expf(dt * a), dx = dt * x;
            const float* Bv = xbc + row * 640 + 384 + g * 64 + nq * 16; const float* Cv = xbc + row * 640 + 512 + g * 64 + nq * 16;
            float y = 0.f;
#pragma unroll
            for (int i = 0; i < 16; ++i) { st[i] = dA * st[i] + dx * Bv[i]; y += Cv[i] * st[i]; }
            y += __shfl_xor(y, 1); y += __shfl_xor(y, 2);
            if (nq == 0) { if (dir == 0) Y[row * 384 + h * 64 + pp] = y; else Y[row * 384 + h * 64 + pp] += y; }
        }
        if (q.ctx) { float* o = p.out + O_SSD + ((((size_t)q.b * 4 + l) * 2 + dir) * 6 + h) * 4096 + pp * 64 + nq * 16;
#pragma unroll
            for (int i = 0; i < 16; ++i) o[i] = st[i]; }
    }
}
__device__ __forceinline__ void d_ssd_combine(const PP& p, int l, int row, int lane) {
    const float* Y = (const float*)(p.ws + OFF_YSSD) + (size_t)row * 384; const float* xbc = (const float*)(p.ws + OFF_XBC) + (size_t)row * 640;
    const bf16_t* z = (const bf16_t*)(p.ws + OFF_PROJ) + (size_t)row * PN + PZ;
    float v[6]; float s = 0.f;
#pragma unroll
    for (int j = 0; j < 6; ++j) { const int c = lane + 64 * j; const float y = Y[c] + p.in[18][l * 6 + j] * xbc[c]; v[j] = y * silu_f(bf2f(z[c])); s += v[j] * v[j]; }
    const float rstd = rsqrtf(wave_sum(s) * (1.f / 384.f) + EPS);
    bf16_t* mix = (bf16_t*)(p.ws + OFF_MIX) + (size_t)row * D;
#pragma unroll
    for (int j = 0; j < 6; ++j) { const int c = lane + 64 * j; mix[c] = f2bf(v[j] * rstd * p.in[19][l * 384 + c]); }
}

__device__ __forceinline__ void d_s5_scan(const PP& p, int l, int vb, int lane) {
    const int s = vb >> 4, g = vb & 15;
    const SeqInfo q = seq_info(s);
    const bf16_t* proj = (const bf16_t*)(p.ws + OFF_PROJ); float* Y = (float*)(p.ws + OFF_YS5);
    float cre[16], cim[16];
#pragma unroll
    for (int c = 0; c < 16; ++c) { cre[c] = p.in[25][((l * 16 + g) * 16 + c) * 64 + lane]; cim[c] = p.in[26][((l * 16 + g) * 16 + c) * 64 + lane]; }
    for (int dir = 0; dir < 2; ++dir) {
        const int ti = ((l * 2 + dir) * 16 + g) * 64 + lane;
        const float* abar = (const float*)(p.ws + OFF_TAB + TAB_ABAR) + (size_t)ti * 2; const float ar = abar[0], ai = abar[1];
        const float* bb = (const float*)(p.ws + OFF_TAB + TAB_BBAR) + (size_t)ti * 32;
        float br[16], bi[16];
#pragma unroll
        for (int c = 0; c < 16; ++c) { br[c] = bb[2 * c]; bi[c] = bb[2 * c + 1]; }
        float hr = 0.f, hi = 0.f;
        if (!q.ctx) { const size_t o = (((size_t)q.b * 4 + l) * 2 + dir) * 1024 + g * 64 + lane; hr = p.in[5][o]; hi = p.in[6][o]; }
        for (int step = 0; step < q.L; ++step) {
            const int t = dir == 0 ? step : q.L - 1 - step; const size_t row = q.start + t;
            const bf16_t* u = proj + row * PN + PU + g * 16;
            float bur = 0.f, bui = 0.f;
#pragma unroll
            for (int c = 0; c < 16; ++c) { const float uv = bf2f(u[c]); bur += br[c] * uv; bui += bi[c] * uv; }
            const float nr = ar * hr - ai * hi + bur, ni = ar * hi + ai * hr + bui; hr = nr; hi = ni;
            float mine = 0.f;
#pragma unroll
            for (int c = 0; c < 16; ++c) { const float v = wave_sum(cre[c] * hr - cim[c] * hi); if (lane == c) mine = v; }
            if (lane < 16) { if (dir == 0) Y[row * 256 + g * 16 + lane] = mine; else Y[row * 256 + g * 16 + lane] += mine; }
        }
        if (q.ctx) { const size_t o = (((size_t)q.b * 4 + l) * 2 + dir) * 1024 + g * 64 + lane; p.out[O_RE + o] = hr; p.out[O_IM + o] = hi; }
    }
}
__device__ __forceinline__ void d_s5_glu(const PP& p, int l, int row, int n, LAS float* gs) {
    const bf16_t* proj = (const bf16_t*)(p.ws + OFF_PROJ);
    const float y = ((const float*)(p.ws + OFF_YS5))[(size_t)row * 256 + n] + p.in[27][l * 256 + n] * bf2f(proj[(size_t)row * PN + PU + n]);
    const float gv = gelu_tanh_f(y); gs[n] = gv;
    __syncthreads();
    const float* w = p.in[28] + (size_t)l * 65536 + n; float acc = p.in[29][l * 256 + n];
    for (int k = 0; k < 256; ++k) acc += gs[k] * w[(size_t)k * 256];
    ((bf16_t*)(p.ws + OFF_MIX))[(size_t)row * D + 384 + n] = f2bf(gv / (1.f + __expf(-acc)));
}

__device__ __forceinline__ void d_attn(const PP& p, int l, int wid, int lane, LAS float* qsw, LAS float* psw) {
    const int row = wid / 6, h = wid % 6;
    const bf16_t* proj = (const bf16_t*)(p.ws + OFF_PROJ);
    qsw[lane] = bf2f(proj[(size_t)row * PN + PQ + h * 64 + lane]);
    __syncthreads();
    float o = 0.f;
    if (row < MC) {
        const int b = row >> 8; float sc[4]; float mx = -INFINITY;
#pragma unroll
        for (int j = 0; j < 4; ++j) { const int key = lane + 64 * j; const bf16_t* kp = proj + (size_t)(b * 256 + key) * PN + PK + h * 64; float a = 0.f;
            for (int d = 0; d < 64; ++d) a += qsw[d] * bf2f(kp[d]);
            sc[j] = a * 0.125f; mx = fmaxf(mx, sc[j]); }
        mx = wave_max(mx); float sum = 0.f;
#pragma unroll
        for (int j = 0; j < 4; ++j) { sc[j] = __expf(sc[j] - mx); sum += sc[j]; psw[lane + 64 * j] = sc[j]; }
        sum = wave_sum(sum);
        __syncthreads();
        for (int key = 0; key < 256; ++key) o += psw[key] * bf2f(proj[(size_t)(b * 256 + key) * PN + PV + h * 64 + lane]);
        o /= sum;
    } else {
        const int rr = row - MC, b = rr >> 10, t = rr & 1023, r = t >> 6, qc = t & 63;
        int rs = r - 4; rs = rs < 0 ? 0 : (rs > 8 ? 8 : rs); int cs = qc - 8; cs = cs < 0 ? 0 : (cs > 48 ? 48 : cs);
        const float* rpb = p.in[30] + (size_t)(l * 6 + h) * 15 * 31;
        float sc[6]; float mx = -INFINITY;
#pragma unroll
        for (int j = 0; j < 2; ++j) { const int idx = lane + 64 * j, i = idx >> 4, kc = cs + (idx & 15), kr = rs + i;
            const bf16_t* kp = proj + (size_t)(MC + b * 1024 + kr * 64 + kc) * PN + PK + h * 64; float a = 0.f;
            for (int d = 0; d < 64; ++d) a += qsw[d] * bf2f(kp[d]);
            sc[j] = a * 0.125f + rpb[(kr - r + 7) * 31 + (kc - qc + 15)]; mx = fmaxf(mx, sc[j]); }
        const float* ck = p.in[2] + ((size_t)(b * 4 + l) * 256) * 384 + h * 64; const float* cv = p.in[3] + ((size_t)(b * 4 + l) * 256) * 384 + h * 64;
#pragma unroll
        for (int j = 0; j < 4; ++j) { const int key = lane + 64 * j; const float* kp = ck + (size_t)key * 384; float a = 0.f;
            for (int d = 0; d < 64; ++d) a += qsw[d] * kp[d];
            sc[2 + j] = a * 0.125f; mx = fmaxf(mx, sc[2 + j]); }
        mx = wave_max(mx); float sum = 0.f;
#pragma unroll
        for (int j = 0; j < 6; ++j) { sc[j] = __expf(sc[j] - mx); sum += sc[j]; psw[lane + 64 * j] = sc[j]; }
        sum = wave_sum(sum);
        __syncthreads();
        for (int idx = 0; idx < 128; ++idx) { const int kr = rs + (idx >> 4), kc = cs + (idx & 15);
            o += psw[idx] * bf2f(proj[(size_t)(MC + b * 1024 + kr * 64 + kc) * PN + PV + h * 64 + lane]); }
        for (int key = 0; key < 256; ++key) o += psw[128 + key] * cv[(size_t)key * 384 + lane];
        o /= sum;
    }
    ((bf16_t*)(p.ws + OFF_MIX))[(size_t)row * D + 640 + h * 64 + lane] = f2bf(o);
}


namespace pg8 {
#define PG8_LAS __attribute__((address_space(3)))
typedef unsigned short bf16_t;
typedef short bf16x8 __attribute__((ext_vector_type(8)));
typedef float f32x4 __attribute__((ext_vector_type(4)));
typedef unsigned u32x4 __attribute__((ext_vector_type(4)));
constexpr int BM = 256, BK = 64, HALF = 128, HTB = HALF * BK * 2  , STAGE_BYTES = 8 * HTB, NXCD = 8, WGM = 8;

__host__ __device__ __forceinline__ int lds_byte(int r, int c) { const int st = (r >> 4) * 2 + (c >> 5), rr = r & 15, cc = c & 31, ob = rr * 64 + cc * 2; return st * 1024 + (ob ^ (((ob >> 9) & 1) << 5)); }
__host__ __device__ __forceinline__ void stage_rc(int b, int& R, int& C) { const int st = b / 1024, sb = b % 1024, swz = sb ^ (((sb >> 9) & 1) << 5); R = (st >> 1) * 16 + swz / 64; C = (st & 1) * 32 + (swz % 64) / 2; }
__host__ __device__ __forceinline__ int perm32(int rho) { const int n = rho >> 4, i = rho & 15; return 8 * (i >> 2) + 4 * n + (i & 3); }

struct Unit { int pm, pn; };
struct Gemm { const bf16_t* A; const bf16_t* Bt; int M, N, K; };

struct StaticOrder {
    int nM, nN, nwg, G, c;
    __host__ __device__ void init(int M, int N, int G_, int c_) { nM = M / BM; nN = N / BM; nwg = nM * nN; G = G_; c = c_; }
    __host__ __device__ bool next(int i, Unit& u) const {
        const long L = (long)i * G + c; if (L >= nwg) return false;
        int wgid = (int)L; { const int q = nwg / NXCD, r = nwg % NXCD, xcd = wgid % NXCD, off = wgid / NXCD; wgid = (xcd < r ? xcd * (q + 1) : r * (q + 1) + (xcd - r) * q) + off; }
        const int nig = WGM * nN, gid = wgid / nig, fm = gid * WGM, gsz = (nM - fm) < WGM ? (nM - fm) : WGM;
        u.pm = fm + ((wgid % nig) % gsz); u.pn = (wgid % nig) / gsz; return true;
    }
    __device__ __forceinline__ void a_ready(const Unit&) const {}
    __device__ __forceinline__ void done(const Unit&) const {}
};

__device__ __forceinline__ unsigned cvt_pk_bf16(float lo, float hi) { unsigned r; asm volatile("v_cvt_pk_bf16_f32 %0, %1, %2" : "=v"(r) : "v"(lo), "v"(hi)); return r; }
struct EpiProj {
    static constexpr bool PERM = true, AFTER_DRAIN = false;
    bf16_t* proj; float* ok; float* ov; int l;
    __device__ __forceinline__ void operator()(const f32x4 (&acc)[2][2][4][2], const Unit& u, int wr, int wc, int fr, int fq) const {
        const int row0 = u.pm * BM + wr * 64 + fr;
#pragma unroll
        for (int bj = 0; bj < 2; ++bj) {
            const int cb = u.pn * BM + bj * HALF;
            if (cb >= ::PN) continue;
            const int col = cb + wc * 32 + 8 * fq;
            const bool isk = (cb >= ::PK && cb < ::PV), isv = (cb >= ::PV);
#pragma unroll
            for (int ai = 0; ai < 2; ++ai)
#pragma unroll
                for (int m = 0; m < 4; ++m) {
                    const int row = row0 + ai * HALF + m * 16;
                    const f32x4 v0 = acc[ai][bj][m][0], v1 = acc[ai][bj][m][1];
                    u32x4 w; w.x = cvt_pk_bf16(v0[0], v0[1]); w.y = cvt_pk_bf16(v0[2], v0[3]); w.z = cvt_pk_bf16(v1[0], v1[1]); w.w = cvt_pk_bf16(v1[2], v1[3]);
                    *(u32x4*)(proj + (size_t)row * ::PN + col) = w;
                    if (u.pm < 32 && (isk || isv)) {
                        const int b = row >> 8, t = row & 255;
                        float* o = (isk ? ok : ov) + ((size_t)(b * 4 + l) * 256 + t) * 384 + (col - (isk ? ::PK : ::PV));
                        *(f32x4*)o = v0; *(f32x4*)(o + 4) = v1;
                    }
                }
        }
    }
};
struct EpiRes {
    static constexpr bool PERM = false, AFTER_DRAIN = false;
    const float* xin_c; const float* xin_l; float* xout; const float* mods; int chunk;
    __device__ __forceinline__ void operator()(const f32x4 (&acc)[2][2][4][2], const Unit& u, int wr, int wc, int fr, int fq) const {
        const int row0 = u.pm * BM + wr * 64 + fr, col0 = u.pn * BM + wc * 32 + 4 * fq;
        const int r = u.pm < 32 ? 0 : 1 + ((u.pm - 32) >> 2);
        const float* gate = mods + (size_t)r * 6144 + chunk * 1024;
        const float* xin = u.pm < 32 ? xin_c : xin_l;
#pragma unroll
        for (int bj = 0; bj < 2; ++bj)
#pragma unroll
            for (int n = 0; n < 2; ++n) {
                const int col = col0 + bj * HALF + n * 16;
                const f32x4 g = *(const f32x4*)(gate + col);
#pragma unroll
                for (int ai = 0; ai < 2; ++ai)
#pragma unroll
                    for (int m = 0; m < 4; ++m) {
                        const size_t off = (size_t)(row0 + ai * HALF + m * 16) * ::D + col;
                        const f32x4 xi = *(const f32x4*)(xin + off);
                        *(f32x4*)(xout + off) = xi + g * acc[ai][bj][m][n];
                    }
            }
    }
};
struct EpiFF1 {
    static constexpr bool PERM = true, AFTER_DRAIN = false;
    bf16_t* h;
    __device__ __forceinline__ void operator()(const f32x4 (&acc)[2][2][4][2], const Unit& u, int wr, int wc, int fr, int fq) const {
        const int row0 = u.pm * BM + wr * 64 + fr, col0 = u.pn * BM + wc * 32 + 8 * fq;
#pragma unroll
        for (int ai = 0; ai < 2; ++ai)
#pragma unroll
            for (int m = 0; m < 4; ++m) {
                bf16_t* rowp = h + (size_t)(row0 + ai * HALF + m * 16) * ::DFF + col0;
#pragma unroll
                for (int bj = 0; bj < 2; ++bj) {
                    f32x4 v0 = acc[ai][bj][m][0], v1 = acc[ai][bj][m][1];
#pragma unroll
                    for (int e = 0; e < 4; ++e) { const float a = fmaxf(v0[e], 0.f), b = fmaxf(v1[e], 0.f); v0[e] = a * a; v1[e] = b * b; }
                    u32x4 w; w.x = cvt_pk_bf16(v0[0], v0[1]); w.y = cvt_pk_bf16(v0[2], v0[3]); w.z = cvt_pk_bf16(v1[0], v1[1]); w.w = cvt_pk_bf16(v1[2], v1[3]);
                    *(u32x4*)(rowp + bj * HALF) = w;
                }
            }
    }
};
template <class Epi, class Sched, bool ALIGN_EPI = false, bool SP2 = false>
__device__ __forceinline__ void gemm_phase(PG8_LAS unsigned char* lds, const Gemm g, const Sched& S, const Epi& E) {
    int tid_ = threadIdx.x; asm volatile("" : "+v"(tid_));
    const int tid = tid_, wid = __builtin_amdgcn_readfirstlane(tid >> 6), lane = tid & 63, wr = wid >> 2, wc = wid & 3, fr = lane & 15, fq = lane >> 4;
    const int K = g.K, nt = K / BK;
    unsigned voffA[2], voffB[2];
#pragma unroll
    for (int i = 0; i < 2; ++i) { int R, C; stage_rc(tid * 16 + i * 8192, R, C); const int Rb = Epi::PERM ? ((R & ~31) + perm32(R & 31)) : R;
        voffA[i] = (unsigned)(R * K + C) * 2u; voffB[i] = (unsigned)(Rb * K + C) * 2u; }
    const size_t kstep = (size_t)(BK * 2);
    const size_t hstep = (size_t)HALF * K * 2;
    const size_t tstep = 2 * hstep;
    const unsigned ldsw = (unsigned)wid * 1024u;
    const int aoff = lds_byte(wr * 64 + fr, fq * 8), boff = lds_byte(wc * 32 + fr, fq * 8);
#define PG8_SA(b, h) (((b) * 2 + (h)) * HTB)
#define PG8_SB(b, h) ((4 + (b) * 2 + (h)) * HTB)
#define PG8_STAGE(bufoff, gbase, voff) do { _Pragma("unroll") for (int _i = 0; _i < 2; ++_i) \
        __builtin_amdgcn_global_load_lds((const unsigned*)((const char*)(gbase) + (voff)[_i]), (PG8_LAS unsigned*)(lds + (bufoff) + ldsw + _i * 8192), 16, 0, 0); } while (0)
#define PG8_LDA(dst, b, h) do { _Pragma("unroll") for (int m = 0; m < 4; ++m) _Pragma("unroll") for (int k = 0; k < 2; ++k) dst[m][k] = *(const PG8_LAS bf16x8*)(lds + PG8_SA(b, h) + aoff + m * 2048 + k * 1024); } while (0)
#define PG8_LDB(dst, b, h) do { _Pragma("unroll") for (int n = 0; n < 2; ++n) _Pragma("unroll") for (int k = 0; k < 2; ++k) dst[n][k] = *(const PG8_LAS bf16x8*)(lds + PG8_SB(b, h) + boff + n * 2048 + k * 1024); } while (0)
#define PG8_MMA(ai, bj, At, Bt) do { __builtin_amdgcn_s_setprio(1); _Pragma("unroll") for (int m = 0; m < 4; ++m) _Pragma("unroll") for (int n = 0; n < 2; ++n) _Pragma("unroll") for (int k = 0; k < 2; ++k) \
        acc[ai][bj][m][n] = __builtin_amdgcn_mfma_f32_16x16x32_bf16(Bt[n][k], At[m][k], acc[ai][bj][m][n], 0, 0, 0); __builtin_amdgcn_s_setprio(0); } while (0)
#define PG8_WAIT_V(n) asm volatile("s_waitcnt vmcnt(" #n ")" ::: "memory")
#define PG8_WAIT_L(n) asm volatile("s_waitcnt lgkmcnt(" #n ")" ::: "memory")
#define PG8_BAR __builtin_amdgcn_s_barrier()
#define PG8_SCHED __builtin_amdgcn_sched_barrier(0)
    Unit cur, nxt; int ui = 0;
    if (!S.next(0, cur)) return;
    f32x4 acc[2][2][4][2];
#pragma unroll
    for (int a = 0; a < 2; ++a)
#pragma unroll
        for (int b = 0; b < 2; ++b)
#pragma unroll
            for (int m = 0; m < 4; ++m)
#pragma unroll
                for (int n = 0; n < 2; ++n) acc[a][b][m][n] = (f32x4){0.f, 0.f, 0.f, 0.f};
    bf16x8 At[4][2], B0[2][2], B1[2][2];
    const char* cA = (const char*)g.A + (size_t)cur.pm * tstep; const char* cB = (const char*)g.Bt + (size_t)cur.pn * tstep;
    S.a_ready(cur);
    if constexpr (SP2) {
        PG8_STAGE(PG8_SB(0, 0), cB, voffB); PG8_STAGE(PG8_SB(0, 1), cB + hstep, voffB); PG8_STAGE(PG8_SA(0, 0), cA, voffA); PG8_STAGE(PG8_SA(0, 1), cA + hstep, voffA);
        if (wr == 1) PG8_BAR;
        PG8_WAIT_V(2); PG8_BAR;
        PG8_STAGE(PG8_SB(1, 0), cB + kstep, voffB); PG8_STAGE(PG8_SA(1, 0), cA + kstep, voffA); PG8_STAGE(PG8_SB(1, 1), cB + hstep + kstep, voffB);
        PG8_WAIT_V(6); PG8_BAR;
    } else {
        PG8_STAGE(PG8_SB(0, 0), cB, voffB); PG8_STAGE(PG8_SA(0, 0), cA, voffA); PG8_STAGE(PG8_SB(0, 1), cB + hstep, voffB); PG8_STAGE(PG8_SA(0, 1), cA + hstep, voffA);
        if (wr == 1) PG8_BAR;
        PG8_WAIT_V(4); PG8_BAR;
        PG8_STAGE(PG8_SB(1, 0), cB + kstep, voffB); PG8_STAGE(PG8_SA(1, 0), cA + kstep, voffA); PG8_STAGE(PG8_SB(1, 1), cB + hstep + kstep, voffB);
        PG8_WAIT_V(6); PG8_BAR;
    }
    for (;;) {
        const bool has_next = S.next(ui + 1, nxt);
        const char* nA = has_next ? (const char*)g.A + (size_t)nxt.pm * tstep : cA; const char* nB = has_next ? (const char*)g.Bt + (size_t)nxt.pn * tstep : cB;
        for (int t = 0; t < nt; t += 2) {
            const bool last = (t == nt - 2);
            const char* a1 = cA + (size_t)(t + 1) * kstep;
            const char* a2 = last ? nA : cA + (size_t)(t + 2) * kstep; const char* b2 = last ? nB : cB + (size_t)(t + 2) * kstep;
            const char* a3 = a2 + kstep; const char* b3 = b2 + kstep;
            if (last && has_next) S.a_ready(nxt);
            if constexpr (SP2) {
            PG8_LDB(B0, 0, 0); PG8_LDB(B1, 0, 1); PG8_SCHED; PG8_LDA(At, 0, 0); PG8_STAGE(PG8_SA(1, 1), a1 + hstep, voffA);
            PG8_WAIT_V(8); PG8_WAIT_L(0); PG8_BAR; PG8_MMA(0, 0, At, B0); PG8_MMA(0, 1, At, B1); PG8_BAR; PG8_SCHED;
            PG8_LDA(At, 0, 1); PG8_STAGE(PG8_SB(0, 0), b2, voffB); PG8_STAGE(PG8_SB(0, 1), b2 + hstep, voffB); PG8_STAGE(PG8_SA(0, 0), a2, voffA);
            PG8_WAIT_V(8); PG8_WAIT_L(0); PG8_BAR; PG8_MMA(1, 0, At, B0); PG8_MMA(1, 1, At, B1); PG8_BAR; PG8_SCHED;
            PG8_LDB(B0, 1, 0); PG8_LDB(B1, 1, 1); PG8_SCHED; PG8_LDA(At, 1, 0); PG8_STAGE(PG8_SA(0, 1), a2 + hstep, voffA);
            PG8_WAIT_V(8); PG8_WAIT_L(0); PG8_BAR; PG8_MMA(0, 0, At, B0); PG8_MMA(0, 1, At, B1); PG8_BAR; PG8_SCHED;
            PG8_LDA(At, 1, 1); PG8_STAGE(PG8_SB(1, 0), b3, voffB); PG8_STAGE(PG8_SB(1, 1), b3 + hstep, voffB); PG8_STAGE(PG8_SA(1, 0), a3, voffA);
            PG8_WAIT_V(8); PG8_WAIT_L(0); PG8_BAR; PG8_MMA(1, 0, At, B0); PG8_MMA(1, 1, At, B1); PG8_BAR; PG8_SCHED;
            } else {
            PG8_LDB(B0, 0, 0); PG8_SCHED; PG8_LDA(At, 0, 0); PG8_STAGE(PG8_SA(1, 1), a1 + hstep, voffA);
            PG8_WAIT_L(8); PG8_BAR; PG8_WAIT_L(0); PG8_MMA(0, 0, At, B0); PG8_BAR; PG8_SCHED;
            PG8_LDB(B1, 0, 1); PG8_STAGE(PG8_SB(0, 0), b2, voffB);
            PG8_BAR; PG8_WAIT_L(0); PG8_MMA(0, 1, At, B1); PG8_BAR;
            PG8_LDA(At, 0, 1); PG8_STAGE(PG8_SA(0, 0), a2, voffA);
            PG8_BAR; PG8_WAIT_L(0); PG8_MMA(1, 0, At, B0); PG8_BAR; PG8_SCHED;
            PG8_STAGE(PG8_SB(0, 1), b2 + hstep, voffB);
            PG8_WAIT_V(6); PG8_BAR; PG8_MMA(1, 1, At, B1); PG8_BAR;
            PG8_LDB(B0, 1, 0); PG8_SCHED; PG8_LDA(At, 1, 0); PG8_STAGE(PG8_SA(0, 1), a2 + hstep, voffA);
            PG8_WAIT_L(8); PG8_BAR; PG8_WAIT_L(0); PG8_MMA(0, 0, At, B0); PG8_BAR; PG8_SCHED;
            PG8_LDB(B1, 1, 1); PG8_STAGE(PG8_SB(1, 0), b3, voffB);
            PG8_BAR; PG8_WAIT_L(0); PG8_MMA(0, 1, At, B1); PG8_BAR;
            PG8_LDA(At, 1, 1); PG8_STAGE(PG8_SA(1, 0), a3, voffA);
            PG8_BAR; PG8_WAIT_L(0); PG8_MMA(1, 0, At, B0); PG8_BAR; PG8_SCHED;
            PG8_STAGE(PG8_SB(1, 1), b3 + hstep, voffB);
            PG8_WAIT_V(6); PG8_BAR; PG8_MMA(1, 1, At, B1); PG8_BAR;
            }
        }
        if constexpr (ALIGN_EPI) { if (wr == 0) PG8_BAR; }
        if constexpr (!Epi::AFTER_DRAIN) { E(acc, cur, wr, wc, fr, fq); S.done(cur); }
        if (!has_next) break;
#pragma unroll
        for (int a = 0; a < 2; ++a)
#pragma unroll
            for (int b = 0; b < 2; ++b)
#pragma unroll
                for (int m = 0; m < 4; ++m)
#pragma unroll
                    for (int n = 0; n < 2; ++n) acc[a][b][m][n] = (f32x4){0.f, 0.f, 0.f, 0.f};
        cur = nxt; cA = nA; cB = nB; ++ui;
        if constexpr (ALIGN_EPI) { if (wr == 1) PG8_BAR; }
    }
    PG8_WAIT_V(0);
    if constexpr (!ALIGN_EPI) { if (wr == 0) PG8_BAR; }
    PG8_BAR;
    if constexpr (Epi::AFTER_DRAIN) { E.fused(acc, cur, wr, wc, fr, fq, lds, wid, lane); S.done(cur); }
#undef PG8_SA
#undef PG8_SB
#undef PG8_STAGE
#undef PG8_LDA
#undef PG8_LDB
#undef PG8_MMA
#undef PG8_WAIT_V
#undef PG8_WAIT_L
#undef PG8_BAR
#undef PG8_SCHED
}
}

constexpr int NWAVES = 8, NTHREADS = 512;
constexpr int RING_BYTES = 131072, LDSCTL_OFF = RING_BYTES, MISC_OFF = LDSCTL_OFF + 320, LDS_BYTES = 147456;
#define GAS __attribute__((address_space(1)))
typedef unsigned v4u __attribute__((ext_vector_type(4)));
typedef GAS unsigned gu32;
#define LDS_WAIT() asm volatile("s_waitcnt lgkmcnt(0)" ::: "memory")
#define VM_WAIT() asm volatile("s_waitcnt vmcnt(0)" ::: "memory")
__device__ __forceinline__ unsigned pk2(float lo, float hi) { return (unsigned)f2bf(lo) | ((unsigned)f2bf(hi) << 16); }
constexpr int CW_BAR = 4096, CW_Q = 65536;
constexpr size_t CTL_ZERO_BYTES = 1 * MiB;

#define XB_TMO      128
#define XB_XCNT(j)  (256  + 64 * (j))
#define XB_XSUB(j)  (1280 + 64 * (j))
#define XB_XGEN(j)  (2304 + 64 * (j))
#define XB_TOP      3328
#define XB_TOPGEN   3392
#define XCD_BAR_WORDS 3456
#define XB_SPIN_CAP (1u << 18)

__device__ __forceinline__ unsigned xb_ld(unsigned* p)              { return __hip_atomic_load(p, __ATOMIC_RELAXED, __HIP_MEMORY_SCOPE_AGENT); }
__device__ __forceinline__ unsigned xb_add(unsigned* p, unsigned v) { return __hip_atomic_fetch_add(p, v, __ATOMIC_RELAXED, __HIP_MEMORY_SCOPE_AGENT); }
__device__ __forceinline__ unsigned xb_xcc_id() { return (unsigned)__builtin_amdgcn_s_getreg((3 << 11) | 20) & 0xFu; }
#define XB_SPIN(cond, bar) do { unsigned _sp = 0; while (cond) { __builtin_amdgcn_s_sleep(1); \
    if ((++_sp & 255u) == 0u) { if (xb_ld(&(bar)[XB_TMO])) break; if (_sp > XB_SPIN_CAP) { atomicAdd(&(bar)[XB_TMO], 1u); break; } } } } while (0)

struct XcdBarrier {
    unsigned* bar; unsigned x;
    volatile LAS unsigned* st;
};

__device__ __forceinline__ XcdBarrier xcd_barrier_post(unsigned* bar, volatile LAS unsigned* st) {
    XcdBarrier b; b.bar = bar; b.x = xb_xcc_id(); b.st = st;
    if (threadIdx.x == 0) (void)xb_add(&bar[XB_XCNT(b.x)], 1u);
    return b;
}
__device__ __forceinline__ void xcd_barrier_complete(unsigned* bar, unsigned x, unsigned& nloc, unsigned& nx) {
    const unsigned G = gridDim.x * gridDim.y * gridDim.z;
    unsigned sum, cnt, mine, sp = 0u;
    for (;;) {
        sum = 0u; cnt = 0u; mine = 0u;
#pragma unroll
        for (unsigned j = 0; j < 16; ++j) { const unsigned c = xb_ld(&bar[XB_XCNT(j)]); sum += c; cnt += (c > 0u) ? 1u : 0u; mine = (j == x) ? c : mine; }
        if (sum == G) break;
        __builtin_amdgcn_s_sleep(1);
        if ((++sp & 255u) == 0u) { if (xb_ld(&bar[XB_TMO])) break; if (sp > XB_SPIN_CAP) { atomicAdd(&bar[XB_TMO], 1u); break; } }
    }
    nloc = mine > 0u ? mine : 1u; nx = cnt > 0u ? cnt : 1u;
}

__device__ __forceinline__ void xcd_barrier(const XcdBarrier& b) {
    asm volatile("s_waitcnt vmcnt(0)" ::: "memory");
    __syncthreads();
    if (threadIdx.x == 0) {
        unsigned* bar = b.bar;
        __builtin_amdgcn_s_waitcnt(0);
        unsigned nloc = b.st[0], nx = b.st[1];
        if (nloc == 0u) { xcd_barrier_complete(bar, b.x, nloc, nx); b.st[0] = nloc; b.st[1] = nx; }
        const unsigned old = xb_add(&bar[XB_XSUB(b.x)], 1u);
        const unsigned gen = old / nloc;
        if (old + 1u == (gen + 1u) * nloc) {
            __builtin_amdgcn_fence(__ATOMIC_RELEASE, "agent");
            asm volatile("s_waitcnt vmcnt(0)" ::: "memory");
            const unsigned og = xb_add(&bar[XB_TOP], 1u);
            const unsigned tg = og / nx;
            if (og + 1u == (tg + 1u) * nx) xb_add(&bar[XB_TOPGEN], 1u);
            else XB_SPIN(xb_ld(&bar[XB_TOPGEN]) == tg, bar);
            __builtin_amdgcn_fence(__ATOMIC_ACQUIRE, "agent");
            xb_add(&bar[XB_XGEN(b.x)], 1u);
            asm volatile("s_waitcnt vmcnt(0)" ::: "memory");
        } else {
            XB_SPIN(xb_ld(&bar[XB_XGEN(b.x)]) == gen, bar);
            __builtin_amdgcn_fence(__ATOMIC_ACQUIRE, "agent");
            asm volatile("s_waitcnt vmcnt(0)" ::: "memory");
        }
    }
    __syncthreads();
}


struct Frame {
    LAS unsigned char* lds;
    volatile LAS unsigned* MISC;
    unsigned* ctl;
    int tid, lane, wave, vcu, G;
    const float* const* in; float* out; unsigned char* ws;
};
constexpr int PH_PRO = 0, PH_PER_LAYER = 9, PH_NORM1 = 0, PH_G1 = 1, PH_MIXA = 2, PH_MIXB = 3, PH_MIXC = 4, PH_G3 = 5, PH_NORM2 = 6, PH_G4 = 7, PH_G5 = 8, PH_FINAL = 1 + DEPTH * PH_PER_LAYER, PH_END = PH_FINAL + 1;

__device__ __forceinline__ void transpose_item(const float* W, int K, int Nsrc, int src_n0, bf16_t* WT, int dst_n0, int k0, LAS float* scr, int lane) {
#pragma unroll 8
    for (int i = 0; i < 32; ++i) { const int kk = 2 * i + (lane >> 5); scr[kk * 33 + (lane & 31)] = src_n0 >= 0 ? W[(size_t)(k0 + kk) * Nsrc + src_n0 + (lane & 31)] : 0.f; }
    LDS_WAIT(); asm volatile("" ::: "memory");
    const int c = lane & 7;
#pragma unroll
    for (int j = 0; j < 4; ++j) { const int n = (lane >> 3) + 8 * j; const LAS float* s = scr + (8 * c) * 33 + n;
        v4u o; o.x = pk2(s[0 * 33], s[1 * 33]); o.y = pk2(s[2 * 33], s[3 * 33]); o.z = pk2(s[4 * 33], s[5 * 33]); o.w = pk2(s[6 * 33], s[7 * 33]);
        *(v4u*)(WT + (size_t)(dst_n0 + n) * K + k0 + 8 * c) = o; }
    LDS_WAIT(); asm volatile("" ::: "memory");
}
__device__ __forceinline__ void phase_prologue(Frame& F) {
    const float* const* in = F.in;
    if (F.vcu < 192) {
        LAS float* ssil = (LAS float*)F.lds;
        LAS float* part = (LAS float*)(F.lds + 9 * 1024 * 4);
        for (int i = F.tid; i < 9 * 1024; i += NTHREADS) { const int r = i >> 10, k = i & 1023; const float v = r == 0 ? in[8][k] : in[7][(r - 1) * 1024 + k]; ssil[i] = silu_f(v); }
        __syncthreads();
        const int l = F.vcu / 48, n0 = (F.vcu % 48) * 128;
        const float* w = in[9] + (size_t)l * 1024 * 6144 + n0 + 2 * F.lane;
        float a0[9], a1[9];
#pragma unroll
        for (int r = 0; r < 9; ++r) { a0[r] = 0.f; a1[r] = 0.f; }
        const int kb = F.wave * 128;
#pragma unroll 4
        for (int k = 0; k < 128; ++k) { const float2 wv = *(const float2*)(w + (size_t)(kb + k) * 6144);
#pragma unroll
            for (int r = 0; r < 9; ++r) { const float s = ssil[r * 1024 + kb + k]; a0[r] += s * wv.x; a1[r] += s * wv.y; } }
#pragma unroll
        for (int r = 0; r < 9; ++r) { part[(F.wave * 9 + r) * 128 + 2 * F.lane] = a0[r]; part[(F.wave * 9 + r) * 128 + 2 * F.lane + 1] = a1[r]; }
        __syncthreads();
        float* mods = (float*)(F.ws + OFF_MODS);
        for (int i = F.tid; i < 9 * 128; i += NTHREADS) { const int r = i >> 7, j = i & 127; float s = in[10][l * 6144 + n0 + j];
#pragma unroll
            for (int w8 = 0; w8 < 8; ++w8) s += part[(w8 * 9 + r) * 128 + j];
            mods[(size_t)(l * 9 + r) * 6144 + n0 + j] = s; }
        __syncthreads();
    }
    for (int idx = F.vcu * NTHREADS + F.tid; idx < 8192; idx += F.G * NTHREADS) {
        const int pp = idx & 63, g = (idx >> 6) & 15, dir = (idx >> 10) & 1, l = idx >> 11;
        const float are = in[20][idx], aim = in[21][idx];
        const float dt = __expf(in[22][(l * 2 + dir) * 16 + g]);
        const float zr = are * dt, zi = aim * dt;
        const float e = expf(zr); float rev = zi * 0.15915494309189535f; rev -= rintf(rev);
        const float ar = e * cosf(rev * 6.283185307179586f), ai = e * sinf(rev * 6.283185307179586f);
        float* abar = (float*)(F.ws + OFF_TAB + TAB_ABAR);
        abar[idx * 2] = ar; abar[idx * 2 + 1] = ai;
        const float xr = ar - 1.f, xi = ai, den = are * are + aim * aim;
        const float fr = (xr * are + xi * aim) / den, fi = (xi * are - xr * aim) / den;
        float* bbar = (float*)(F.ws + OFF_TAB + TAB_BBAR);
        for (int c = 0; c < 16; ++c) {
            const float br = in[23][((l * 16 + g) * 64 + pp) * 16 + c], bi = in[24][((l * 16 + g) * 64 + pp) * 16 + c];
            bbar[((size_t)idx * 16 + c) * 2] = fr * br - fi * bi; bbar[((size_t)idx * 16 + c) * 2 + 1] = fr * bi + fi * br;
        }
    }
    for (int i = F.vcu * NTHREADS + F.tid; i < 4 * 12 * 1024; i += F.G * NTHREADS) {
        const int k = i & 1023, j = (i >> 10) % 12, l = i / (12 * 1024);
        ((float*)(F.ws + OFF_TAB + TAB_WDT))[i] = in[13][((size_t)l * 1024 + k) * IN_COLS + 1024 + j];
    }
    {
        LAS float* scr = (LAS float*)(F.lds + F.wave * 16384);
        const int gw = F.vcu * NWAVES + F.wave, NGW = F.G * NWAVES;
        constexpr int I_IN = 16 * (PNP / 32), I_OUT = 16 * 32, I_F1 = 16 * (DFF / 32), I_F2 = (DFF / 64) * 32, I_GLU = 4 * 8, I_L = I_IN + I_OUT + I_F1 + I_F2 + I_GLU;
        for (int it = gw; it < DEPTH * I_L; it += NGW) {
            const int l = it / I_L; int r = it % I_L;
            if (r < I_IN) { const int nb = r % (PNP / 32), kb = r / (PNP / 32), n0 = nb * 32; const int src = n0 >= PN ? -1 : (n0 >= 1024 ? n0 + 12 : n0);
                transpose_item(in[13] + (size_t)l * 1024 * IN_COLS, 1024, IN_COLS, src, (bf16_t*)(F.ws + OFF_WIN) + (size_t)l * PNP * 1024, n0, kb * 64, scr, F.lane); continue; } r -= I_IN;
            if (r < I_OUT) { const int nb = r % 32, kb = r / 32; transpose_item(in[31] + (size_t)l * 1024 * 1024, 1024, 1024, nb * 32, (bf16_t*)(F.ws + OFF_WOUT) + (size_t)l * 1024 * 1024, nb * 32, kb * 64, scr, F.lane); continue; } r -= I_OUT;
            if (r < I_F1) { const int nb = r % (DFF / 32), kb = r / (DFF / 32); transpose_item(in[32] + (size_t)l * 1024 * DFF, 1024, DFF, nb * 32, (bf16_t*)(F.ws + OFF_WFF1) + (size_t)l * DFF * 1024, nb * 32, kb * 64, scr, F.lane); continue; } r -= I_F1;
            if (r < I_F2) { const int nb = r % 32, kb = r / 32; transpose_item(in[33] + (size_t)l * DFF * 1024, DFF, 1024, nb * 32, (bf16_t*)(F.ws + OFF_WFF2) + (size_t)l * 1024 * DFF, nb * 32, kb * 64, scr, F.lane); continue; } r -= I_F2;
            { const int nb = r % 8, kb = r / 8; transpose_item(in[28] + (size_t)l * 65536, 256, 256, nb * 32, (bf16_t*)(F.ws + OFF_WGLU) + (size_t)l * 65536, nb * 32, kb * 64, scr, F.lane); }
        }
    }
}
__device__ __forceinline__ void phase_norm(Frame& F, int l, int which) {
    const float* const* in = F.in; const int lane = F.lane;
    const float* gw = in[which ? 12 : 11] + l * D;
    for (int row = F.vcu * NWAVES + F.wave; row < M; row += F.G * NWAVES) {
        const float* xr = (l == 0 && which == 0) ? (row < MC ? in[0] + (size_t)row * D : in[1] + (size_t)(row - MC) * D) : (const float*)(F.ws + OFF_X) + (size_t)row * D;
        const float* mods = (const float*)(F.ws + OFF_MODS) + (size_t)(l * 9 + mod_row(row)) * 6144;
        const float* sh = mods + (which ? 3 : 0) * 1024; const float* sc = mods + (which ? 4 : 1) * 1024;
        f32x4 v[4]; float s = 0.f;
#pragma unroll
        for (int j = 0; j < 4; ++j) { v[j] = *(const f32x4*)(xr + 4 * lane + 256 * j); s += v[j].x * v[j].x + v[j].y * v[j].y + v[j].z * v[j].z + v[j].w * v[j].w; }
        const float rstd = rsqrtf(wave_sum(s) * (1.f / D) + EPS);
        bf16_t* h = (bf16_t*)(F.ws + OFF_H) + (size_t)row * D;
#pragma unroll
        for (int j = 0; j < 4; ++j) { const int c = 4 * lane + 256 * j; const f32x4 g = *(const f32x4*)(gw + c), a = *(const f32x4*)(sc + c), b = *(const f32x4*)(sh + c);
            v[j].x = v[j].x * rstd * g.x * (1.f + a.x) + b.x; v[j].y = v[j].y * rstd * g.y * (1.f + a.y) + b.y; v[j].z = v[j].z * rstd * g.z * (1.f + a.z) + b.z; v[j].w = v[j].w * rstd * g.w * (1.f + a.w) + b.w;
            uint2 o; o.x = pk2(v[j].x, v[j].y); o.y = pk2(v[j].z, v[j].w); *(uint2*)(h + c) = o; }
        if (which == 0) {
            const float* wdt = (const float*)(F.ws + OFF_TAB + TAB_WDT) + (size_t)l * 12 * 1024;
            float* dt = (float*)(F.ws + OFF_DT) + (size_t)row * 12;
            float mine = 0.f;
#pragma unroll
            for (int jj = 0; jj < 12; ++jj) { float a = 0.f;
#pragma unroll
                for (int j = 0; j < 4; ++j) { const f32x4 w = *(const f32x4*)(wdt + jj * 1024 + 4 * lane + 256 * j); a += v[j].x * w.x + v[j].y * w.y + v[j].z * w.z + v[j].w * w.w; }
                a = wave_sum(a); if (lane == jj) mine = a; }
            if (lane < 12) dt[lane] = mine;
        }
    }
}
__device__ __forceinline__ void phase_final(Frame& F) {
    const int lane = F.lane; const float* gw = F.in[34];
    for (int row = F.vcu * NWAVES + F.wave; row < M; row += F.G * NWAVES) {
        const float* xr = (const float*)(F.ws + OFF_X) + (size_t)row * D;
        f32x4 v[4]; float s = 0.f;
#pragma unroll
        for (int j = 0; j < 4; ++j) { v[j] = *(const f32x4*)(xr + 4 * lane + 256 * j); s += v[j].x * v[j].x + v[j].y * v[j].y + v[j].z * v[j].z + v[j].w * v[j].w; }
        const float rstd = rsqrtf(wave_sum(s) * (1.f / D) + EPS);
        float* o = F.out + (size_t)row * D;
#pragma unroll
        for (int j = 0; j < 4; ++j) { const int c = 4 * lane + 256 * j; const f32x4 g = *(const f32x4*)(gw + c); f32x4 r = {v[j].x * rstd * g.x, v[j].y * rstd * g.y, v[j].z * rstd * g.z, v[j].w * rstd * g.w}; *(f32x4*)(o + c) = r; }
    }
}


__device__ __forceinline__ void naive_mixa(Frame& F, int l) {
    PP p{F.in, F.out, F.ws};
    for (int row = F.vcu; row < M; row += F.G) for (int c = F.tid; c < 640; c += NTHREADS) d_conv(p, l, row, c);
}
__device__ __forceinline__ void naive_mixb(Frame& F, int l) {
    PP p{F.in, F.out, F.ws};
    for (int it = F.vcu; it < 120; it += F.G) d_ssd_scan(p, l, 2 * it + (F.tid >> 8), F.tid & 255);
    for (int it = F.wave * F.G + (F.G - 1 - F.vcu); it < NSEQ * 16; it += NWAVES * F.G) d_s5_scan(p, l, it, F.lane);
    LAS float* qsw = (LAS float*)F.lds + F.wave * 832; LAS float* psw = qsw + 64;
    for (int it = F.vcu; it < M * 6 / 8; it += F.G) { __syncthreads(); d_attn(p, l, it * 8 + F.wave, F.lane, qsw, psw); }
}
__device__ __forceinline__ void naive_mixc(Frame& F, int l) {
    PP p{F.in, F.out, F.ws};
    for (int row = F.vcu * NWAVES + F.wave; row < M; row += F.G * NWAVES) d_ssd_combine(p, l, row, F.lane);
    LAS float* gs = (LAS float*)F.lds + (F.tid >> 8) * 256;
    for (int it = F.vcu; it < M / 2; it += F.G) { __syncthreads(); d_s5_glu(p, l, 2 * it + (F.tid >> 8), F.tid & 255, gs); }
}
struct Args { const float* in[35]; float* out; unsigned char* ws; int ph_lo, ph_hi, li, pad; };
__global__ void __launch_bounds__(NTHREADS, 2) mega(Args args) {
    extern __shared__ __attribute__((aligned(16))) unsigned char lds[];
    Frame F;
    F.lds = (LAS unsigned char*)lds;
    F.MISC = (volatile LAS unsigned*)(F.lds + MISC_OFF);
    F.tid = threadIdx.x; F.lane = F.tid & 63; F.wave = __builtin_amdgcn_readfirstlane(F.tid >> 6);
    F.G = gridDim.x; { const int bx = blockIdx.x; F.vcu = (F.G % 8 == 0) ? (bx % 8) * (F.G / 8) + bx / 8 : bx; }
    F.in = args.in; F.out = args.out; F.ws = args.ws; F.ctl = (unsigned*)(args.ws + OFF_CTL);
    for (int u = F.tid; u < (LDS_BYTES - LDSCTL_OFF) / 4; u += NTHREADS) ((LAS unsigned*)(F.lds + LDSCTL_OFF))[u] = 0u;
    __syncthreads();
    XcdBarrier bar = xcd_barrier_post(F.ctl + CW_BAR + args.li * XCD_BAR_WORDS, F.MISC + 8);
    const int lo = args.ph_lo, hi = args.ph_hi;
    const float* modsb = (const float*)(F.ws + OFF_MODS);
    float* X = (float*)(F.ws + OFF_X);
#define IN(k) (lo <= (k) && (k) < hi)
#define REFRESH() do { int t_ = threadIdx.x; asm volatile("" : "+v"(t_)); F.tid = t_; F.lane = t_ & 63; } while (0)
#define SEAM(k) do { if (IN(k) && IN((k) + 1)) xcd_barrier(bar); } while (0)
    if (IN(PH_PRO)) phase_prologue(F);
    SEAM(PH_PRO);
    for (int l = 0; l < DEPTH; ++l) {
        const int pb = 1 + l * PH_PER_LAYER;
        if (IN(pb + PH_NORM1)) { REFRESH(); phase_norm(F, l, 0); }
        SEAM(pb + PH_NORM1);
        if (IN(pb + PH_G1)) {
            pg8::Gemm g{(const bf16_t*)(F.ws + OFF_H), (const bf16_t*)(F.ws + OFF_WIN) + (size_t)l * PNP * 1024, M, PNP, 1024}; pg8::StaticOrder S; S.init(M, PNP, F.G, (int)blockIdx.x);
            pg8::EpiProj E{(bf16_t*)(F.ws + OFF_PROJ), F.out + O_K, F.out + O_V, l};
            pg8::gemm_phase<pg8::EpiProj, pg8::StaticOrder, true, true>(F.lds, g, S, E);
        }
        SEAM(pb + PH_G1);
        if (IN(pb + PH_MIXA)) { REFRESH(); naive_mixa(F, l); }
        SEAM(pb + PH_MIXA);
        if (IN(pb + PH_MIXB)) { REFRESH(); naive_mixb(F, l); }
        SEAM(pb + PH_MIXB);
        if (IN(pb + PH_MIXC)) { REFRESH(); naive_mixc(F, l); }
        SEAM(pb + PH_MIXC);
        if (IN(pb + PH_G3)) {
            pg8::Gemm g{(const bf16_t*)(F.ws + OFF_MIX), (const bf16_t*)(F.ws + OFF_WOUT) + (size_t)l * 1024 * 1024, M, D, 1024}; pg8::StaticOrder S; S.init(M, D, F.G, (int)blockIdx.x);
            pg8::EpiRes E{l == 0 ? F.in[0] : X, l == 0 ? F.in[1] - (size_t)MC * D : X, X, modsb + (size_t)l * 9 * 6144, 2};
            pg8::gemm_phase<pg8::EpiRes, pg8::StaticOrder, true, true>(F.lds, g, S, E);
        }
        SEAM(pb + PH_G3);
        if (IN(pb + PH_NORM2)) { REFRESH(); phase_norm(F, l, 1); }
        SEAM(pb + PH_NORM2);
        if (IN(pb + PH_G4)) {
            pg8::Gemm g{(const bf16_t*)(F.ws + OFF_H), (const bf16_t*)(F.ws + OFF_WFF1) + (size_t)l * DFF * 1024, M, DFF, 1024}; pg8::StaticOrder S; S.init(M, DFF, F.G, (int)blockIdx.x);
            pg8::EpiFF1 E{(bf16_t*)(F.ws + OFF_FFH)};
            pg8::gemm_phase<pg8::EpiFF1, pg8::StaticOrder, true, true>(F.lds, g, S, E);
        }
        SEAM(pb + PH_G4);
        if (IN(pb + PH_G5)) {
            pg8::Gemm g{(const bf16_t*)(F.ws + OFF_FFH), (const bf16_t*)(F.ws + OFF_WFF2) + (size_t)l * 1024 * DFF, M, D, DFF}; pg8::StaticOrder S; S.init(M, D, F.G, (int)blockIdx.x);
            pg8::EpiRes E{X, X, X, modsb + (size_t)l * 9 * 6144, 5};
            pg8::gemm_phase<pg8::EpiRes, pg8::StaticOrder, true, true>(F.lds, g, S, E);
        }
        SEAM(pb + PH_G5);
    }
    if (IN(PH_FINAL)) phase_final(F);
#undef IN
#undef SEAM
}
static void launch_mega(const Args& base, int lo, int hi, int li, hipStream_t stream) {
    Args a = base; a.ph_lo = lo; a.ph_hi = hi; a.li = li;
    hipLaunchKernelGGL(mega, dim3(256), dim3(NTHREADS), LDS_BYTES, stream, a);
}
extern "C" void kernel_launch(void* const* d_in, const int* in_sizes, int n_in, void* d_out, int out_size, void* d_ws, size_t ws_size, hipStream_t stream) {
    static int ready = 0;
    if (!ready) {
        if (n_in != 35 || out_size != (int)O_END || ws_size < WS_END) { fprintf(stderr, "kernel_launch: unexpected shapes n_in %d out %d ws %zu\n", n_in, out_size, ws_size); ready = -1; return; }
        if (hipFuncSetAttribute((const void*)mega, hipFuncAttributeMaxDynamicSharedMemorySize, LDS_BYTES) != hipSuccess) { fprintf(stderr, "kernel_launch: hipFuncSetAttribute failed\n"); ready = -1; return; }
        ready = 1;
    }
    if (ready < 0) return;
    Args a{}; for (int i = 0; i < 35; ++i) a.in[i] = (const float*)d_in[i]; a.out = (float*)d_out; a.ws = (unsigned char*)d_ws;
    (void)hipMemsetAsync((char*)d_ws + OFF_CTL, 0, CTL_ZERO_BYTES, stream);
    launch_mega(a, 0, PH_END, 0, stream);
}
```

```cpp
#include <hip/hip_runtime.h>
#include <stdint.h>
#include <stdio.h>

typedef unsigned short bf16_t;
typedef short bf16x8 __attribute__((ext_vector_type(8)));
typedef float f32x4 __attribute__((ext_vector_type(4)));

constexpr int D = 1024, DEPTH = 4;
constexpr int CB = 32, CL = 256, LB = 8, LL = 1024;
constexpr int MC = CB * CL;
constexpr int M = MC + LB * LL;
constexpr int NSEQ = CB + LB;
constexpr int IN_COLS = 2444;
constexpr int PN = 2432, PNP = 2560;
constexpr int PZ = 0, PX = 384, PU = 1024, PQ = 1280, PK = 1664, PV = 2048;
constexpr int DFF = 4096;
constexpr float EPS = 1e-6f;

constexpr size_t MiB = 1u << 20;
constexpr size_t OFF_CTL = 0, OFF_MODS = 1 * MiB, OFF_TAB = 2 * MiB, OFF_WIN = 8 * MiB, OFF_WOUT = 28 * MiB, OFF_WFF1 = 36 * MiB,
                 OFF_WFF2 = 68 * MiB, OFF_WGLU = 100 * MiB, OFF_DT = 101 * MiB, OFF_X = 102 * MiB, OFF_PROJ = 166 * MiB, OFF_MIX = 242 * MiB,
                 OFF_FFH = 166 * MiB, OFF_H = 294 * MiB, OFF_XBC = 294 * MiB, OFF_YSSD = 334 * MiB, OFF_YS5 = 358 * MiB, WS_END = 374 * MiB;
constexpr size_t TAB_ABAR = 0;
constexpr size_t TAB_BBAR = 256 * 1024;
constexpr size_t TAB_WDT = 2 * MiB;
constexpr size_t TAB_CD = 3 * MiB;
constexpr size_t OFF_CS = 334 * MiB;
constexpr size_t TAB_CC2 = 4 * MiB;
constexpr size_t TAB_BBT = 3 * MiB + 512 * 1024;
constexpr size_t OFF_E = 358 * MiB;

__device__ __forceinline__ float bf2f(bf16_t v) { return __uint_as_float((unsigned)v << 16); }
__device__ __forceinline__ bf16_t f2bf(float f) { unsigned u = __float_as_uint(f); return (bf16_t)((u + 0x7fffu + ((u >> 16) & 1u)) >> 16); }
__device__ __forceinline__ float silu_f(float x) { return x / (1.f + __expf(-x)); }
__device__ __forceinline__ float softplus_f(float x) { return x > 20.f ? x : log1pf(__expf(x)); }
__device__ __forceinline__ float gelu_tanh_f(float x) { const float u = 0.7978845608028654f * (x + 0.044715f * x * x * x); return 0.5f * x * (1.f + tanhf(u)); }
__device__ __forceinline__ float wave_sum(float v) {
#pragma unroll
    for (int o = 1; o < 64; o <<= 1) v += __shfl_xor(v, o);
    return v;
}
__device__ __forceinline__ float wave_max(float v) {
#pragma unroll
    for (int o = 1; o < 64; o <<= 1) v = fmaxf(v, __shfl_xor(v, o));
    return v;
}
__device__ __forceinline__ int mod_row(int row) { return row < MC ? 0 : 1 + ((row - MC) >> 10); }

struct P {
    const float* in[35];
    float* out;
    unsigned char* ws;
};
constexpr size_t O_YP = 0, O_YS = 8388608, O_K = 16777216, O_V = O_K + 12582912, O_SSD = O_V + 12582912, O_RE = O_SSD + 6291456, O_IM = O_RE + 262144, O_END = O_IM + 262144;


struct SeqInfo { int start, L, b, ctx; };
__device__ __forceinline__ SeqInfo seq_info(int s) { SeqInfo q; if (s < CB) { q.start = s * CL; q.L = CL; q.b = s; q.ctx = 1; } else { q.start = MC + (s - CB) * LL; q.L = LL; q.b = s - CB; q.ctx = 0; } return q; }
__device__ __forceinline__ SeqInfo row_seq(int row) { return seq_info(row < MC ? (row >> 8) : CB + ((row - MC) >> 10)); }
#define LAS __attribute__((address_space(3)))
struct PP { const float* const* in; float* out; unsigned char* ws; };
__device__ __forceinline__ void d_conv(const PP& p, int l, int row, int c) {
    const SeqInfo q = row_seq(row); const int t = row - q.start;
    const bf16_t* proj = (const bf16_t*)(p.ws + OFF_PROJ);
    const float* cw = p.in[14] + l * 5 * 640; float acc = p.in[15][l * 640 + c];
#pragma unroll
    for (int j = 0; j < 5; ++j) { const int tt = t + j - 2; if (tt >= 0 && tt < q.L) acc += cw[j * 640 + c] * bf2f(proj[(size_t)(q.start + tt) * PN + PX + c]); }
    ((float*)(p.ws + OFF_XBC))[(size_t)row * 640 + c] = silu_f(acc);
}
__device__ __forceinline__ void d_ssd_scan(const PP& p, int l, int vb, int tid) {
    const int s = vb / 6, h = vb % 6, g = h / 3;
    const SeqInfo q = seq_info(s);
    const int pp = tid >> 2, nq = tid & 3;
    const float* xbc = (const float*)(p.ws + OFF_XBC); const float* dtb = (const float*)(p.ws + OFF_DT);
    float* Y = (float*)(p.ws + OFF_YSSD);
    for (int dir = 0; dir < 2; ++dir) {
        const float a = -__expf(p.in[17][(l * 2 + dir) * 6 + h]); const float bias = p.in[16][(l * 2 + dir) * 6 + h];
        float st[16];
        if (q.ctx) {
#pragma unroll
            for (int i = 0; i < 16; ++i) st[i] = 0.f;
        } else { const float* s0 = p.in[4] + ((((size_t)q.b * 4 + l) * 2 + dir) * 6 + h) * 4096 + pp * 64 + nq * 16;
#pragma unroll
            for (int i = 0; i < 16; ++i) st[i] = s0[i]; }
        for (int step = 0; step < q.L; ++step) {
            const int t = dir == 0 ? step : q.L - 1 - step; const size_t row = q.start + t;
            const float x = xbc[row * 640 + h * 64 + pp];
            const float dt = softplus_f(dtb[row * 12 + dir * 6 + h] + bias);
            const float dA = __expf(dt * a), dx = dt * x;
            const float* Bv = xbc + row * 640 + 384 + g * 64 + nq * 16; const float* Cv = xbc + row * 640 + 512 + g * 64 + nq * 16;
            float y = 0.f;
#pragma unroll
            for (int i = 0; i < 16; ++i) { st[i] = dA * st[i] + dx * Bv[i]; y += Cv[i] * st[i]; }
            y += __shfl_xor(y, 1); y += __shfl_xor(y, 2);
            if (nq == 0) { if (dir == 0) Y[row * 384 + h * 64 + pp] = y; else Y[row * 384 + h * 64 + pp] += y; }
        }
        if (q.ctx) { float* o = p.out + O_SSD + ((((size_t)q.b * 4 + l) * 2 + dir) * 6 + h) * 4096 + pp * 64 + nq * 16;
#pragma unroll
            for (int i = 0; i < 16; ++i) o[i] = st[i]; }
    }
}
__device__ __forceinline__ void d_ssd_combine(const PP& p, int l, int row, int lane) {
    const float* Y = (const float*)(p.ws + OFF_YSSD) + (size_t)row * 384; const float* xbc = (const float*)(p.ws + OFF_XBC) + (size_t)row * 640;
    const bf16_t* z = (const bf16_t*)(p.ws + OFF_PROJ) + (size_t)row * PN + PZ;
    float v[6]; float s = 0.f;
#pragma unroll
    for (int j = 0; j < 6; ++j) { const int c = lane + 64 * j; const float y = Y[c] + p.in[18][l * 6 + j] * xbc[c]; v[j] = y * silu_f(bf2f(z[c])); s += v[j] * v[j]; }
    const float rstd = rsqrtf(wave_sum(s) * (1.f / 384.f) + EPS);
    bf16_t* mix = (bf16_t*)(p.ws + OFF_MIX) + (size_t)row * D;
#pragma unroll
    for (int j = 0; j < 6; ++j) { const int c = lane + 64 * j; mix[c] = f2bf(v[j] * rstd * p.in[19][l * 384 + c]); }
}

__device__ __forceinline__ void d_s5_scan(const PP& p, int l, int vb, int lane) {
    const int s = vb >> 4, g = vb & 15;
    const SeqInfo q = seq_info(s);
    const bf16_t* proj = (const bf16_t*)(p.ws + OFF_PROJ); float* Y = (float*)(p.ws + OFF_YS5);
    float cre[16], cim[16];
#pragma unroll
    for (int c = 0; c < 16; ++c) { cre[c] = p.in[25][((l * 16 + g) * 16 + c) * 64 + lane]; cim[c] = p.in[26][((l * 16 + g) * 16 + c) * 64 + lane]; }
    for (int dir = 0; dir < 2; ++dir) {
        const int ti = ((l * 2 + dir) * 16 + g) * 64 + lane;
        const float* abar = (const float*)(p.ws + OFF_TAB + TAB_ABAR) + (size_t)ti * 2; const float ar = abar[0], ai = abar[1];
        const float* bb = (const float*)(p.ws + OFF_TAB + TAB_BBAR) + (size_t)ti * 32;
        float br[16], bi[16];
#pragma unroll
        for (int c = 0; c < 16; ++c) { br[c] = bb[2 * c]; bi[c] = bb[2 * c + 1]; }
        float hr = 0.f, hi = 0.f;
        if (!q.ctx) { const size_t o = (((size_t)q.b * 4 + l) * 2 + dir) * 1024 + g * 64 + lane; hr = p.in[5][o]; hi = p.in[6][o]; }
        for (int step = 0; step < q.L; ++step) {
            const int t = dir == 0 ? step : q.L - 1 - step; const size_t row = q.start + t;
            const bf16_t* u = proj + row * PN + PU + g * 16;
            float bur = 0.f, bui = 0.f;
#pragma unroll
            for (int c = 0; c < 16; ++c) { const float uv = bf2f(u[c]); bur += br[c] * uv; bui += bi[c] * uv; }
            const float nr = ar * hr - ai * hi + bur, ni = ar * hi + ai * hr + bui; hr = nr; hi = ni;
            float mine = 0.f;
#pragma unroll
            for (int c = 0; c < 16; ++c) { const float v = wave_sum(cre[c] * hr - cim[c] * hi); if (lane == c) mine = v; }
            if (lane < 16) { if (dir == 0) Y[row * 256 + g * 16 + lane] = mine; else Y[row * 256 + g * 16 + lane] += mine; }
        }
        if (q.ctx) { const size_t o = (((size_t)q.b * 4 + l) * 2 + dir) * 1024 + g * 64 + lane; p.out[O_RE + o] = hr; p.out[O_IM + o] = hi; }
    }
}
__device__ __forceinline__ void d_s5_glu(const PP& p, int l, int row, int n, LAS float* gs) {
    const bf16_t* proj = (const bf16_t*)(p.ws + OFF_PROJ);
    const float y = ((const float*)(p.ws + OFF_YS5))[(size_t)row * 256 + n] + p.in[27][l * 256 + n] * bf2f(proj[(size_t)row * PN + PU + n]);
    const float gv = gelu_tanh_f(y); gs[n] = gv;
    __syncthreads();
    const float* w = p.in[28] + (size_t)l * 65536 + n; float acc = p.in[29][l * 256 + n];
    for (int k = 0; k < 256; ++k) acc += gs[k] * w[(size_t)k * 256];
    ((bf16_t*)(p.ws + OFF_MIX))[(size_t)row * D + 384 + n] = f2bf(gv / (1.f + __expf(-acc)));
}

__device__ __forceinline__ void d_attn(const PP& p, int l, int wid, int lane, LAS float* qsw, LAS float* psw) {
    const int row = wid / 6, h = wid % 6;
    const bf16_t* proj = (const bf16_t*)(p.ws + OFF_PROJ);
    qsw[lane] = bf2f(proj[(size_t)row * PN + PQ + h * 64 + lane]);
    __syncthreads();
    float o = 0.f;
    if (row < MC) {
        const int b = row >> 8; float sc[4]; float mx = -INFINITY;
#pragma unroll
        for (int j = 0; j < 4; ++j) { const int key = lane + 64 * j; const bf16_t* kp = proj + (size_t)(b * 256 + key) * PN + PK + h * 64; float a = 0.f;
            for (int d = 0; d < 64; ++d) a += qsw[d] * bf2f(kp[d]);
            sc[j] = a * 0.125f; mx = fmaxf(mx, sc[j]); }
        mx = wave_max(mx); float sum = 0.f;
#pragma unroll
        for (int j = 0; j < 4; ++j) { sc[j] = __expf(sc[j] - mx); sum += sc[j]; psw[lane + 64 * j] = sc[j]; }
        sum = wave_sum(sum);
        __syncthreads();
        for (int key = 0; key < 256; ++key) o += psw[key] * bf2f(proj[(size_t)(b * 256 + key) * PN + PV + h * 64 + lane]);
        o /= sum;
    } else {
        const int rr = row - MC, b = rr >> 10, t = rr & 1023, r = t >> 6, qc = t & 63;
        int rs = r - 4; rs = rs < 0 ? 0 : (rs > 8 ? 8 : rs); int cs = qc - 8; cs = cs < 0 ? 0 : (cs > 48 ? 48 : cs);
        const float* rpb = p.in[30] + (size_t)(l * 6 + h) * 15 * 31;
        float sc[6]; float mx = -INFINITY;
#pragma unroll
        for (int j = 0; j < 2; ++j) { const int idx = lane + 64 * j, i = idx >> 4, kc = cs + (idx & 15), kr = rs + i;
            const bf16_t* kp = proj + (size_t)(MC + b * 1024 + kr * 64 + kc) * PN + PK + h * 64; float a = 0.f;
            for (int d = 0; d < 64; ++d) a += qsw[d] * bf2f(kp[d]);
            sc[j] = a * 0.125f + rpb[(kr - r + 7) * 31 + (kc - qc + 15)]; mx = fmaxf(mx, sc[j]); }
        const float* ck = p.in[2] + ((size_t)(b * 4 + l) * 256) * 384 + h * 64; const float* cv = p.in[3] + ((size_t)(b * 4 + l) * 256) * 384 + h * 64;
#pragma unroll
        for (int j = 0; j < 4; ++j) { const int key = lane + 64 * j; const float* kp = ck + (size_t)key * 384; float a = 0.f;
            for (int d = 0; d < 64; ++d) a += qsw[d] * kp[d];
            sc[2 + j] = a * 0.125f; mx = fmaxf(mx, sc[2 + j]); }
        mx = wave_max(mx); float sum = 0.f;
#pragma unroll
        for (int j = 0; j < 6; ++j) { sc[j] = __expf(sc[j] - mx); sum += sc[j]; psw[lane + 64 * j] = sc[j]; }
        sum = wave_sum(sum);
        __syncthreads();
        for (int idx = 0; idx < 128; ++idx) { const int kr = rs + (idx >> 4), kc = cs + (idx & 15);
            o += psw[idx] * bf2f(proj[(size_t)(MC + b * 1024 + kr * 64 + kc) * PN + PV + h * 64 + lane]); }
        for (int key = 0; key < 256; ++key) o += psw[128 + key] * cv[(size_t)key * 384 + lane];
        o /= sum;
    }
    ((bf16_t*)(p.ws + OFF_MIX))[(size_t)row * D + 640 + h * 64 + lane] = f2bf(o);
}


namespace pg8 {
#define PG8_LAS __attribute__((address_space(3)))
typedef unsigned short bf16_t;
typedef short bf16x8 __attribute__((ext_vector_type(8)));
typedef float f32x4 __attribute__((ext_vector_type(4)));
typedef unsigned u32x4 __attribute__((ext_vector_type(4)));
constexpr int BM = 256, BK = 64, HALF = 128, HTB = HALF * BK * 2  , STAGE_BYTES = 8 * HTB, NXCD = 8, WGM = 8;

__host__ __device__ __forceinline__ int lds_byte(int r, int c) { const int st = (r >> 4) * 2 + (c >> 5), rr = r & 15, cc = c & 31, ob = rr * 64 + cc * 2; return st * 1024 + (ob ^ (((ob >> 9) & 1) << 5)); }
__host__ __device__ __forceinline__ void stage_rc(int b, int& R, int& C) { const int st = b / 1024, sb = b % 1024, swz = sb ^ (((sb >> 9) & 1) << 5); R = (st >> 1) * 16 + swz / 64; C = (st & 1) * 32 + (swz % 64) / 2; }
__host__ __device__ __forceinline__ int perm32(int rho) { const int n = rho >> 4, i = rho & 15; return 8 * (i >> 2) + 4 * n + (i & 3); }

struct Unit { int pm, pn; };
struct Gemm { const bf16_t* A; const bf16_t* Bt; int M, N, K; };

struct StaticOrder {
    int nM, nN, nwg, G, c;
    __host__ __device__ void init(int M, int N, int G_, int c_) { nM = M / BM; nN = N / BM; nwg = nM * nN; G = G_; c = c_; }
    __host__ __device__ bool next(int i, Unit& u) const {
        const long L = (long)i * G + c; if (L >= nwg) return false;
        int wgid = (int)L; { const int q = nwg / NXCD, r = nwg % NXCD, xcd = wgid % NXCD, off = wgid / NXCD; wgid = (xcd < r ? xcd * (q + 1) : r * (q + 1) + (xcd - r) * q) + off; }
        const int nig = WGM * nN, gid = wgid / nig, fm = gid * WGM, gsz = (nM - fm) < WGM ? (nM - fm) : WGM;
        u.pm = fm + ((wgid % nig) % gsz); u.pn = (wgid % nig) / gsz; return true;
    }
    __device__ __forceinline__ void a_ready(const Unit&) const {}
    __device__ __forceinline__ void done(const Unit&) const {}
};

__device__ __forceinline__ unsigned cvt_pk_bf16(float lo, float hi) { unsigned r; asm volatile("v_cvt_pk_bf16_f32 %0, %1, %2" : "=v"(r) : "v"(lo), "v"(hi)); return r; }
struct EpiProj {
    static constexpr bool PERM = true, AFTER_DRAIN = false;
    bf16_t* proj; float* ok; float* ov; int l;
    __device__ __forceinline__ void operator()(const f32x4 (&acc)[2][2][4][2], const Unit& u, int wr, int wc, int fr, int fq) const {
        const int row0 = u.pm * BM + wr * 64 + fr;
#pragma unroll
        for (int bj = 0; bj < 2; ++bj) {
            const int cb = u.pn * BM + bj * HALF;
            if (cb >= ::PN) continue;
            const int col = cb + wc * 32 + 8 * fq;
            const bool isk = (cb >= ::PK && cb < ::PV), isv = (cb >= ::PV);
#pragma unroll
            for (int ai = 0; ai < 2; ++ai)
#pragma unroll
                for (int m = 0; m < 4; ++m) {
                    const int row = row0 + ai * HALF + m * 16;
                    const f32x4 v0 = acc[ai][bj][m][0], v1 = acc[ai][bj][m][1];
                    u32x4 w; w.x = cvt_pk_bf16(v0[0], v0[1]); w.y = cvt_pk_bf16(v0[2], v0[3]); w.z = cvt_pk_bf16(v1[0], v1[1]); w.w = cvt_pk_bf16(v1[2], v1[3]);
                    *(u32x4*)(proj + (size_t)row * ::PN + col) = w;
                    if (u.pm < 32 && (isk || isv)) {
                        const int b = row >> 8, t = row & 255;
                        float* o = (isk ? ok : ov) + ((size_t)(b * 4 + l) * 256 + t) * 384 + (col - (isk ? ::PK : ::PV));
                        *(f32x4*)o = v0; *(f32x4*)(o + 4) = v1;
                    }
                }
        }
    }
};
struct EpiRes {
    static constexpr bool PERM = false, AFTER_DRAIN = false;
    const float* xin_c; const float* xin_l; float* xout; const float* mods; int chunk;
    __device__ __forceinline__ void operator()(const f32x4 (&acc)[2][2][4][2], const Unit& u, int wr, int wc, int fr, int fq) const {
        const int row0 = u.pm * BM + wr * 64 + fr, col0 = u.pn * BM + wc * 32 + 4 * fq;
        const int r = u.pm < 32 ? 0 : 1 + ((u.pm - 32) >> 2);
        const float* gate = mods + (size_t)r * 6144 + chunk * 1024;
        const float* xin = u.pm < 32 ? xin_c : xin_l;
#pragma unroll
        for (int bj = 0; bj < 2; ++bj)
#pragma unroll
            for (int n = 0; n < 2; ++n) {
                const int col = col0 + bj * HALF + n * 16;
                const f32x4 g = *(const f32x4*)(gate + col);
#pragma unroll
                for (int ai = 0; ai < 2; ++ai)
#pragma unroll
                    for (int m = 0; m < 4; ++m) {
                        const size_t off = (size_t)(row0 + ai * HALF + m * 16) * ::D + col;
                        const f32x4 xi = *(const f32x4*)(xin + off);
                        *(f32x4*)(xout + off) = xi + g * acc[ai][bj][m][n];
                    }
            }
    }
};
struct EpiFF1 {
    static constexpr bool PERM = true, AFTER_DRAIN = false;
    bf16_t* h;
    __device__ __forceinline__ void operator()(const f32x4 (&acc)[2][2][4][2], const Unit& u, int wr, int wc, int fr, int fq) const {
        const int row0 = u.pm * BM + wr * 64 + fr, col0 = u.pn * BM + wc * 32 + 8 * fq;
#pragma unroll
        for (int ai = 0; ai < 2; ++ai)
#pragma unroll
            for (int m = 0; m < 4; ++m) {
                bf16_t* rowp = h + (size_t)(row0 + ai * HALF + m * 16) * ::DFF + col0;
#pragma unroll
                for (int bj = 0; bj < 2; ++bj) {
                    f32x4 v0 = acc[ai][bj][m][0], v1 = acc[ai][bj][m][1];
#pragma unroll
                    for (int e = 0; e < 4; ++e) { const float a = fmaxf(v0[e], 0.f), b = fmaxf(v1[e], 0.f); v0[e] = a * a; v1[e] = b * b; }
                    u32x4 w; w.x = cvt_pk_bf16(v0[0], v0[1]); w.y = cvt_pk_bf16(v0[2], v0[3]); w.z = cvt_pk_bf16(v1[0], v1[1]); w.w = cvt_pk_bf16(v1[2], v1[3]);
                    *(u32x4*)(rowp + bj * HALF) = w;
                }
            }
    }
};
template <class Epi, class Sched, bool ALIGN_EPI = false, bool SP2 = false>
__device__ __forceinline__ void gemm_phase(PG8_LAS unsigned char* lds, const Gemm g, const Sched& S, const Epi& E) {
    int tid_ = threadIdx.x; asm volatile("" : "+v"(tid_));
    const int tid = tid_, wid = __builtin_amdgcn_readfirstlane(tid >> 6), lane = tid & 63, wr = wid >> 2, wc = wid & 3, fr = lane & 15, fq = lane >> 4;
    const int K = g.K, nt = K / BK;
    unsigned voffA[2], voffB[2];
#pragma unroll
    for (int i = 0; i < 2; ++i) { int R, C; stage_rc(tid * 16 + i * 8192, R, C); const int Rb = Epi::PERM ? ((R & ~31) + perm32(R & 31)) : R;
        voffA[i] = (unsigned)(R * K + C) * 2u; voffB[i] = (unsigned)(Rb * K + C) * 2u; }
    const size_t kstep = (size_t)(BK * 2);
    const size_t hstep = (size_t)HALF * K * 2;
    const size_t tstep = 2 * hstep;
    const unsigned ldsw = (unsigned)wid * 1024u;
    const int aoff = lds_byte(wr * 64 + fr, fq * 8), boff = lds_byte(wc * 32 + fr, fq * 8);
#define PG8_SA(b, h) (((b) * 2 + (h)) * HTB)
#define PG8_SB(b, h) ((4 + (b) * 2 + (h)) * HTB)
#define PG8_STAGE(bufoff, gbase, voff) do { _Pragma("unroll") for (int _i = 0; _i < 2; ++_i) \
        __builtin_amdgcn_global_load_lds((const unsigned*)((const char*)(gbase) + (voff)[_i]), (PG8_LAS unsigned*)(lds + (bufoff) + ldsw + _i * 8192), 16, 0, 0); } while (0)
#define PG8_LDA(dst, b, h) do { _Pragma("unroll") for (int m = 0; m < 4; ++m) _Pragma("unroll") for (int k = 0; k < 2; ++k) dst[m][k] = *(const PG8_LAS bf16x8*)(lds + PG8_SA(b, h) + aoff + m * 2048 + k * 1024); } while (0)
#define PG8_LDB(dst, b, h) do { _Pragma("unroll") for (int n = 0; n < 2; ++n) _Pragma("unroll") for (int k = 0; k < 2; ++k) dst[n][k] = *(const PG8_LAS bf16x8*)(lds + PG8_SB(b, h) + boff + n * 2048 + k * 1024); } while (0)
#define PG8_MMA(ai, bj, At, Bt) do { __builtin_amdgcn_s_setprio(1); _Pragma("unroll") for (int m = 0; m < 4; ++m) _Pragma("unroll") for (int n = 0; n < 2; ++n) _Pragma("unroll") for (int k = 0; k < 2; ++k) \
        acc[ai][bj][m][n] = __builtin_amdgcn_mfma_f32_16x16x32_bf16(Bt[n][k], At[m][k], acc[ai][bj][m][n], 0, 0, 0); __builtin_amdgcn_s_setprio(0); } while (0)
#define PG8_WAIT_V(n) asm volatile("s_waitcnt vmcnt(" #n ")" ::: "memory")
#define PG8_WAIT_L(n) asm volatile("s_waitcnt lgkmcnt(" #n ")" ::: "memory")
#define PG8_BAR __builtin_amdgcn_s_barrier()
#define PG8_SCHED __builtin_amdgcn_sched_barrier(0)
    Unit cur, nxt; int ui = 0;
    if (!S.next(0, cur)) return;
    f32x4 acc[2][2][4][2];
#pragma unroll
    for (int a = 0; a < 2; ++a)
#pragma unroll
        for (int b = 0; b < 2; ++b)
#pragma unroll
            for (int m = 0; m < 4; ++m)
#pragma unroll
                for (int n = 0; n < 2; ++n) acc[a][b][m][n] = (f32x4){0.f, 0.f, 0.f, 0.f};
    bf16x8 At[4][2], B0[2][2], B1[2][2];
    const char* cA = (const char*)g.A + (size_t)cur.pm * tstep; const char* cB = (const char*)g.Bt + (size_t)cur.pn * tstep;
    S.a_ready(cur);
    if constexpr (SP2) {
        PG8_STAGE(PG8_SB(0, 0), cB, voffB); PG8_STAGE(PG8_SB(0, 1), cB + hstep, voffB); PG8_STAGE(PG8_SA(0, 0), cA, voffA); PG8_STAGE(PG8_SA(0, 1), cA + hstep, voffA);
        if (wr == 1) PG8_BAR;
        PG8_WAIT_V(2); PG8_BAR;
        PG8_STAGE(PG8_SB(1, 0), cB + kstep, voffB); PG8_STAGE(PG8_SA(1, 0), cA + kstep, voffA); PG8_STAGE(PG8_SB(1, 1), cB + hstep + kstep, voffB);
        PG8_WAIT_V(6); PG8_BAR;
    } else {
        PG8_STAGE(PG8_SB(0, 0), cB, voffB); PG8_STAGE(PG8_SA(0, 0), cA, voffA); PG8_STAGE(PG8_SB(0, 1), cB + hstep, voffB); PG8_STAGE(PG8_SA(0, 1), cA + hstep, voffA);
        if (wr == 1) PG8_BAR;
        PG8_WAIT_V(4); PG8_BAR;
        PG8_STAGE(PG8_SB(1, 0), cB + kstep, voffB); PG8_STAGE(PG8_SA(1, 0), cA + kstep, voffA); PG8_STAGE(PG8_SB(1, 1), cB + hstep + kstep, voffB);
        PG8_WAIT_V(6); PG8_BAR;
    }
    for (;;) {
        const bool has_next = S.next(ui + 1, nxt);
        const char* nA = has_next ? (const char*)g.A + (size_t)nxt.pm * tstep : cA; const char* nB = has_next ? (const char*)g.Bt + (size_t)nxt.pn * tstep : cB;
        for (int t = 0; t < nt; t += 2) {
            const bool last = (t == nt - 2);
            const char* a1 = cA + (size_t)(t + 1) * kstep;
            const char* a2 = last ? nA : cA + (size_t)(t + 2) * kstep; const char* b2 = last ? nB : cB + (size_t)(t + 2) * kstep;
            const char* a3 = a2 + kstep; const char* b3 = b2 + kstep;
            if (last && has_next) S.a_ready(nxt);
            if constexpr (SP2) {
            PG8_LDB(B0, 0, 0); PG8_LDB(B1, 0, 1); PG8_SCHED; PG8_LDA(At, 0, 0); PG8_STAGE(PG8_SA(1, 1), a1 + hstep, voffA);
            PG8_WAIT_V(8); PG8_WAIT_L(0); PG8_BAR; PG8_MMA(0, 0, At, B0); PG8_MMA(0, 1, At, B1); PG8_BAR; PG8_SCHED;
            PG8_LDA(At, 0, 1); PG8_STAGE(PG8_SB(0, 0), b2, voffB); PG8_STAGE(PG8_SB(0, 1), b2 + hstep, voffB); PG8_STAGE(PG8_SA(0, 0), a2, voffA);
            PG8_WAIT_V(8); PG8_WAIT_L(0); PG8_BAR; PG8_MMA(1, 0, At, B0); PG8_MMA(1, 1, At, B1); PG8_BAR; PG8_SCHED;
            PG8_LDB(B0, 1, 0); PG8_LDB(B1, 1, 1); PG8_SCHED; PG8_LDA(At, 1, 0); PG8_STAGE(PG8_SA(0, 1), a2 + hstep, voffA);
            PG8_WAIT_V(8); PG8_WAIT_L(0); PG8_BAR; PG8_MMA(0, 0, At, B0); PG8_MMA(0, 1, At, B1); PG8_BAR; PG8_SCHED;
            PG8_LDA(At, 1, 1); PG8_STAGE(PG8_SB(1, 0), b3, voffB); PG8_STAGE(PG8_SB(1, 1), b3 + hstep, voffB); PG8_STAGE(PG8_SA(1, 0), a3, voffA);
            PG8_WAIT_V(8); PG8_WAIT_L(0); PG8_BAR; PG8_MMA(1, 0, At, B0); PG8_MMA(1, 1, At, B1); PG8_BAR; PG8_SCHED;
            } else {
            PG8_LDB(B0, 0, 0); PG8_SCHED; PG8_LDA(At, 0, 0); PG8_STAGE(PG8_SA(1, 1), a1 + hstep, voffA);
            PG8_WAIT_L(8); PG8_BAR; PG8_WAIT_L(0); PG8_MMA(0, 0, At, B0); PG8_BAR; PG8_SCHED;
            PG8_LDB(B1, 0, 1); PG8_STAGE(PG8_SB(0, 0), b2, voffB);
            PG8_BAR; PG8_WAIT_L(0); PG8_MMA(0, 1, At, B1); PG8_BAR;
            PG8_LDA(At, 0, 1); PG8_STAGE(PG8_SA(0, 0), a2, voffA);
            PG8_BAR; PG8_WAIT_L(0); PG8_MMA(1, 0, At, B0); PG8_BAR; PG8_SCHED;
            PG8_STAGE(PG8_SB(0, 1), b2 + hstep, voffB);
            PG8_WAIT_V(6); PG8_BAR; PG8_MMA(1, 1, At, B1); PG8_BAR;
            PG8_LDB(B0, 1, 0); PG8_SCHED; PG8_LDA(At, 1, 0); PG8_STAGE(PG8_SA(0, 1), a2 + hstep, voffA);
            PG8_WAIT_L(8); PG8_BAR; PG8_WAIT_L(0); PG8_MMA(0, 0, At, B0); PG8_BAR; PG8_SCHED;
            PG8_LDB(B1, 1, 1); PG8_STAGE(PG8_SB(1, 0), b3, voffB);
            PG8_BAR; PG8_WAIT_L(0); PG8_MMA(0, 1, At, B1); PG8_BAR;
            PG8_LDA(At, 1, 1); PG8_STAGE(PG8_SA(1, 0), a3, voffA);
            PG8_BAR; PG8_WAIT_L(0); PG8_MMA(1, 0, At, B0); PG8_BAR; PG8_SCHED;
            PG8_STAGE(PG8_SB(1, 1), b3 + hstep, voffB);
            PG8_WAIT_V(6); PG8_BAR; PG8_MMA(1, 1, At, B1); PG8_BAR;
            }
        }
        if constexpr (ALIGN_EPI) { if (wr == 0) PG8_BAR; }
        if constexpr (!Epi::AFTER_DRAIN) { E(acc, cur, wr, wc, fr, fq); S.done(cur); }
        if (!has_next) break;
#pragma unroll
        for (int a = 0; a < 2; ++a)
#pragma unroll
            for (int b = 0; b < 2; ++b)
#pragma unroll
                for (int m = 0; m < 4; ++m)
#pragma unroll
                    for (int n = 0; n < 2; ++n) acc[a][b][m][n] = (f32x4){0.f, 0.f, 0.f, 0.f};
        cur = nxt; cA = nA; cB = nB; ++ui;
        if constexpr (ALIGN_EPI) { if (wr == 1) PG8_BAR; }
    }
    PG8_WAIT_V(0);
    if constexpr (!ALIGN_EPI) { if (wr == 0) PG8_BAR; }
    PG8_BAR;
    if constexpr (Epi::AFTER_DRAIN) { E.fused(acc, cur, wr, wc, fr, fq, lds, wid, lane); S.done(cur); }
#undef PG8_SA
#undef PG8_SB
#undef PG8_STAGE
#undef PG8_LDA
#undef PG8_LDB
#undef PG8_MMA
#undef PG8_WAIT_V
#undef PG8_WAIT_L
#undef PG8_BAR
#undef PG8_SCHED
}
}

constexpr int NWAVES = 8, NTHREADS = 512;
constexpr int RING_BYTES = 131072, LDSCTL_OFF = RING_BYTES, MISC_OFF = LDSCTL_OFF + 320, LDS_BYTES = 147456;
#define GAS __attribute__((address_space(1)))
typedef unsigned v4u __attribute__((ext_vector_type(4)));
typedef GAS unsigned gu32;
#define LDS_WAIT() asm volatile("s_waitcnt lgkmcnt(0)" ::: "memory")
#define VM_WAIT() asm volatile("s_waitcnt vmcnt(0)" ::: "memory")
__device__ __forceinline__ unsigned pk2(float lo, float hi) { return (unsigned)f2bf(lo) | ((unsigned)f2bf(hi) << 16); }
constexpr int CW_BAR = 4096, CW_Q = 65536;
constexpr size_t CTL_ZERO_BYTES = 1 * MiB;

#define XB_TMO      128
#define XB_XCNT(j)  (256  + 64 * (j))
#define XB_XSUB(j)  (1280 + 64 * (j))
#define XB_XGEN(j)  (2304 + 64 * (j))
#define XB_TOP      3328
#define XB_TOPGEN   3392
#define XCD_BAR_WORDS 3456
#define XB_SPIN_CAP (1u << 18)

__device__ __forceinline__ unsigned xb_ld(unsigned* p)              { return __hip_atomic_load(p, __ATOMIC_RELAXED, __HIP_MEMORY_SCOPE_AGENT); }
__device__ __forceinline__ unsigned xb_add(unsigned* p, unsigned v) { return __hip_atomic_fetch_add(p, v, __ATOMIC_RELAXED, __HIP_MEMORY_SCOPE_AGENT); }
__device__ __forceinline__ unsigned xb_xcc_id() { return (unsigned)__builtin_amdgcn_s_getreg((3 << 11) | 20) & 0xFu; }
#define XB_SPIN(cond, bar) do { unsigned _sp = 0; while (cond) { __builtin_amdgcn_s_sleep(1); \
    if ((++_sp & 255u) == 0u) { if (xb_ld(&(bar)[XB_TMO])) break; if (_sp > XB_SPIN_CAP) { atomicAdd(&(bar)[XB_TMO], 1u); break; } } } } while (0)

struct XcdBarrier {
    unsigned* bar; unsigned x;
    volatile LAS unsigned* st;
};

__device__ __forceinline__ XcdBarrier xcd_barrier_post(unsigned* bar, volatile LAS unsigned* st) {
    XcdBarrier b; b.bar = bar; b.x = xb_xcc_id(); b.st = st;
    if (threadIdx.x == 0) (void)xb_add(&bar[XB_XCNT(b.x)], 1u);
    return b;
}
__device__ __forceinline__ void xcd_barrier_complete(unsigned* bar, unsigned x, unsigned& nloc, unsigned& nx) {
    const unsigned G = gridDim.x * gridDim.y * gridDim.z;
    unsigned sum, cnt, mine, sp = 0u;
    for (;;) {
        sum = 0u; cnt = 0u; mine = 0u;
#pragma unroll
        for (unsigned j = 0; j < 16; ++j) { const unsigned c = xb_ld(&bar[XB_XCNT(j)]); sum += c; cnt += (c > 0u) ? 1u : 0u; mine = (j == x) ? c : mine; }
        if (sum == G) break;
        __builtin_amdgcn_s_sleep(1);
        if ((++sp & 255u) == 0u) { if (xb_ld(&bar[XB_TMO])) break; if (sp > XB_SPIN_CAP) { atomicAdd(&bar[XB_TMO], 1u); break; } }
    }
    nloc = mine > 0u ? mine : 1u; nx = cnt > 0u ? cnt : 1u;
}

__device__ __forceinline__ void xcd_barrier(const XcdBarrier& b) {
    asm volatile("s_waitcnt vmcnt(0)" ::: "memory");
    __syncthreads();
    if (threadIdx.x == 0) {
        unsigned* bar = b.bar;
        __builtin_amdgcn_s_waitcnt(0);
        unsigned nloc = b.st[0], nx = b.st[1];
        if (nloc == 0u) { xcd_barrier_complete(bar, b.x, nloc, nx); b.st[0] = nloc; b.st[1] = nx; }
        const unsigned old = xb_add(&bar[XB_XSUB(b.x)], 1u);
        const unsigned gen = old / nloc;
        if (old + 1u == (gen + 1u) * nloc) {
            __builtin_amdgcn_fence(__ATOMIC_RELEASE, "agent");
            asm volatile("s_waitcnt vmcnt(0)" ::: "memory");
            const unsigned og = xb_add(&bar[XB_TOP], 1u);
            const unsigned tg = og / nx;
            if (og + 1u == (tg + 1u) * nx) xb_add(&bar[XB_TOPGEN], 1u);
            else XB_SPIN(xb_ld(&bar[XB_TOPGEN]) == tg, bar);
            __builtin_amdgcn_fence(__ATOMIC_ACQUIRE, "agent");
            xb_add(&bar[XB_XGEN(b.x)], 1u);
            asm volatile("s_waitcnt vmcnt(0)" ::: "memory");
        } else {
            XB_SPIN(xb_ld(&bar[XB_XGEN(b.x)]) == gen, bar);
            __builtin_amdgcn_fence(__ATOMIC_ACQUIRE, "agent");
            asm volatile("s_waitcnt vmcnt(0)" ::: "memory");
        }
    }
    __syncthreads();
}


struct Frame {
    LAS unsigned char* lds;
    volatile LAS unsigned* MISC;
    unsigned* ctl;
    int tid, lane, wave, vcu, G;
    const float* const* in; float* out; unsigned char* ws;
};
constexpr int PH_PRO = 0, PH_PER_LAYER = 8, PH_NORM1 = 0, PH_G1 = 1, PH_MIXA = 2, PH_MIXB = 3, PH_G3 = 4, PH_NORM2 = 5, PH_G4 = 6, PH_G5 = 7, PH_FINAL = 1 + DEPTH * PH_PER_LAYER, PH_END = PH_FINAL + 1;

__device__ __forceinline__ void transpose_item(const float* W, int K, int Nsrc, int src_n0, bf16_t* WT, int dst_n0, int k0, LAS float* scr, int lane) {
#pragma unroll 8
    for (int i = 0; i < 32; ++i) { const int kk = 2 * i + (lane >> 5); scr[kk * 33 + (lane & 31)] = src_n0 >= 0 ? W[(size_t)(k0 + kk) * Nsrc + src_n0 + (lane & 31)] : 0.f; }
    LDS_WAIT(); asm volatile("" ::: "memory");
    const int c = lane & 7;
#pragma unroll
    for (int j = 0; j < 4; ++j) { const int n = (lane >> 3) + 8 * j; const LAS float* s = scr + (8 * c) * 33 + n;
        v4u o; o.x = pk2(s[0 * 33], s[1 * 33]); o.y = pk2(s[2 * 33], s[3 * 33]); o.z = pk2(s[4 * 33], s[5 * 33]); o.w = pk2(s[6 * 33], s[7 * 33]);
        *(v4u*)(WT + (size_t)(dst_n0 + n) * K + k0 + 8 * c) = o; }
    LDS_WAIT(); asm volatile("" ::: "memory");
}
__device__ __forceinline__ void phase_prologue(Frame& F) {
    const float* const* in = F.in;
    if (F.vcu < 192) {
        LAS float* ssil = (LAS float*)F.lds;
        LAS float* part = (LAS float*)(F.lds + 9 * 1024 * 4);
        for (int i = F.tid; i < 9 * 1024; i += NTHREADS) { const int r = i >> 10, k = i & 1023; const float v = r == 0 ? in[8][k] : in[7][(r - 1) * 1024 + k]; ssil[i] = silu_f(v); }
        __syncthreads();
        const int l = F.vcu / 48, n0 = (F.vcu % 48) * 128;
        const float* w = in[9] + (size_t)l * 1024 * 6144 + n0 + 2 * F.lane;
        float a0[9], a1[9];
#pragma unroll
        for (int r = 0; r < 9; ++r) { a0[r] = 0.f; a1[r] = 0.f; }
        const int kb = F.wave * 128;
#pragma unroll 4
        for (int k = 0; k < 128; ++k) { const float2 wv = *(const float2*)(w + (size_t)(kb + k) * 6144);
#pragma unroll
            for (int r = 0; r < 9; ++r) { const float s = ssil[r * 1024 + kb + k]; a0[r] += s * wv.x; a1[r] += s * wv.y; } }
#pragma unroll
        for (int r = 0; r < 9; ++r) { part[(F.wave * 9 + r) * 128 + 2 * F.lane] = a0[r]; part[(F.wave * 9 + r) * 128 + 2 * F.lane + 1] = a1[r]; }
        __syncthreads();
        float* mods = (float*)(F.ws + OFF_MODS);
        for (int i = F.tid; i < 9 * 128; i += NTHREADS) { const int r = i >> 7, j = i & 127; float s = in[10][l * 6144 + n0 + j];
#pragma unroll
            for (int w8 = 0; w8 < 8; ++w8) s += part[(w8 * 9 + r) * 128 + j];
            mods[(size_t)(l * 9 + r) * 6144 + n0 + j] = s; }
        __syncthreads();
    }
    for (int idx = F.vcu * NTHREADS + F.tid; idx < 8192; idx += F.G * NTHREADS) {
        const int pp = idx & 63, g = (idx >> 6) & 15, dir = (idx >> 10) & 1, l = idx >> 11;
        const float are = in[20][idx], aim = in[21][idx];
        const float dt = __expf(in[22][(l * 2 + dir) * 16 + g]);
        const float zr = are * dt, zi = aim * dt;
        const float e = expf(zr); float rev = zi * 0.15915494309189535f; rev -= rintf(rev);
        const float ar = e * cosf(rev * 6.283185307179586f), ai = e * sinf(rev * 6.283185307179586f);
        float* abar = (float*)(F.ws + OFF_TAB + TAB_ABAR);
        abar[idx * 2] = ar; abar[idx * 2 + 1] = ai;
        const float xr = ar - 1.f, xi = ai, den = are * are + aim * aim;
        const float fr = (xr * are + xi * aim) / den, fi = (xi * are - xr * aim) / den;
        float* bbar = (float*)(F.ws + OFF_TAB + TAB_BBAR);
        for (int c = 0; c < 16; ++c) {
            const float br = in[23][((l * 16 + g) * 64 + pp) * 16 + c], bi = in[24][((l * 16 + g) * 64 + pp) * 16 + c];
            bbar[((size_t)idx * 16 + c) * 2] = fr * br - fi * bi; bbar[((size_t)idx * 16 + c) * 2 + 1] = fr * bi + fi * br;
            bf16_t* bbt = (bf16_t*)(F.ws + OFF_TAB + TAB_BBT) + ((size_t)(((l * 2 + dir) * 16 + g) * 2) * 64 + pp) * 16 + c;
            bbt[0] = f2bf(fr * br - fi * bi); bbt[64 * 16] = f2bf(fr * bi + fi * br);
        }
    }
    for (int i = F.vcu * NTHREADS + F.tid; i < 4 * 16 * 16 * 256; i += F.G * NTHREADS) {
        const int k = i & 255, c = (i >> 8) & 15, g = (i >> 12) & 15, l = i >> 16, ri = (k >> 6) & 1, pp = k & 63;
        const size_t si = ((size_t)(l * 16 + g) * 16 + c) * 64 + pp;
        ((bf16_t*)(F.ws + OFF_TAB + TAB_CC2))[i] = f2bf(ri ? -in[26][si] : in[25][si]);
    }
    for (int i = F.vcu * NTHREADS + F.tid; i < 4 * 12 * 1024; i += F.G * NTHREADS) {
        const int k = i & 1023, j = (i >> 10) % 12, l = i / (12 * 1024);
        ((float*)(F.ws + OFF_TAB + TAB_WDT))[i] = in[13][((size_t)l * 1024 + k) * IN_COLS + 1024 + j];
    }
    {
        LAS float* scr = (LAS float*)(F.lds + F.wave * 16384);
        const int gw = F.vcu * NWAVES + F.wave, NGW = F.G * NWAVES;
        constexpr int I_IN = 16 * (PNP / 32), I_OUT = 16 * 32, I_F1 = 16 * (DFF / 32), I_F2 = (DFF / 64) * 32, I_GLU = 4 * 8, I_L = I_IN + I_OUT + I_F1 + I_F2 + I_GLU;
        for (int it = gw; it < DEPTH * I_L; it += NGW) {
            const int l = it / I_L; int r = it % I_L;
            if (r < I_IN) { const int nb = r % (PNP / 32), kb = r / (PNP / 32), n0 = nb * 32; const int src = n0 >= PN ? -1 : (n0 >= 1024 ? n0 + 12 : n0);
                transpose_item(in[13] + (size_t)l * 1024 * IN_COLS, 1024, IN_COLS, src, (bf16_t*)(F.ws + OFF_WIN) + (size_t)l * PNP * 1024, n0, kb * 64, scr, F.lane); continue; } r -= I_IN;
            if (r < I_OUT) { const int nb = r % 32, kb = r / 32; transpose_item(in[31] + (size_t)l * 1024 * 1024, 1024, 1024, nb * 32, (bf16_t*)(F.ws + OFF_WOUT) + (size_t)l * 1024 * 1024, nb * 32, kb * 64, scr, F.lane); continue; } r -= I_OUT;
            if (r < I_F1) { const int nb = r % (DFF / 32), kb = r / (DFF / 32); transpose_item(in[32] + (size_t)l * 1024 * DFF, 1024, DFF, nb * 32, (bf16_t*)(F.ws + OFF_WFF1) + (size_t)l * DFF * 1024, nb * 32, kb * 64, scr, F.lane); continue; } r -= I_F1;
            if (r < I_F2) { const int nb = r % 32, kb = r / 32; transpose_item(in[33] + (size_t)l * DFF * 1024, DFF, 1024, nb * 32, (bf16_t*)(F.ws + OFF_WFF2) + (size_t)l * 1024 * DFF, nb * 32, kb * 64, scr, F.lane); continue; } r -= I_F2;
            { const int nb = r % 8, kb = r / 8; transpose_item(in[28] + (size_t)l * 65536, 256, 256, nb * 32, (bf16_t*)(F.ws + OFF_WGLU) + (size_t)l * 65536, nb * 32, kb * 64, scr, F.lane); }
        }
    }
}
__device__ __forceinline__ void phase_norm(Frame& F, int l, int which) {
    const float* const* in = F.in; const int lane = F.lane;
    const float* gw = in[which ? 12 : 11] + l * D;
    for (int row = F.vcu * NWAVES + F.wave; row < M; row += F.G * NWAVES) {
        const float* xr = (l == 0 && which == 0) ? (row < MC ? in[0] + (size_t)row * D : in[1] + (size_t)(row - MC) * D) : (const float*)(F.ws + OFF_X) + (size_t)row * D;
        const float* mods = (const float*)(F.ws + OFF_MODS) + (size_t)(l * 9 + mod_row(row)) * 6144;
        const float* sh = mods + (which ? 3 : 0) * 1024; const float* sc = mods + (which ? 4 : 1) * 1024;
        f32x4 v[4]; float s = 0.f;
#pragma unroll
        for (int j = 0; j < 4; ++j) { v[j] = *(const f32x4*)(xr + 4 * lane + 256 * j); s += v[j].x * v[j].x + v[j].y * v[j].y + v[j].z * v[j].z + v[j].w * v[j].w; }
        const float rstd = rsqrtf(wave_sum(s) * (1.f / D) + EPS);
        bf16_t* h = (bf16_t*)(F.ws + OFF_H) + (size_t)row * D;
#pragma unroll
        for (int j = 0; j < 4; ++j) { const int c = 4 * lane + 256 * j; const f32x4 g = *(const f32x4*)(gw + c), a = *(const f32x4*)(sc + c), b = *(const f32x4*)(sh + c);
            v[j].x = v[j].x * rstd * g.x * (1.f + a.x) + b.x; v[j].y = v[j].y * rstd * g.y * (1.f + a.y) + b.y; v[j].z = v[j].z * rstd * g.z * (1.f + a.z) + b.z; v[j].w = v[j].w * rstd * g.w * (1.f + a.w) + b.w;
            uint2 o; o.x = pk2(v[j].x, v[j].y); o.y = pk2(v[j].z, v[j].w); *(uint2*)(h + c) = o; }
        if (which == 0) {
            const float* wdt = (const float*)(F.ws + OFF_TAB + TAB_WDT) + (size_t)l * 12 * 1024;
            float* dt = (float*)(F.ws + OFF_DT) + (size_t)row * 12;
            float mine = 0.f;
#pragma unroll
            for (int jj = 0; jj < 12; ++jj) { float a = 0.f;
#pragma unroll
                for (int j = 0; j < 4; ++j) { const f32x4 w = *(const f32x4*)(wdt + jj * 1024 + 4 * lane + 256 * j); a += v[j].x * w.x + v[j].y * w.y + v[j].z * w.z + v[j].w * w.w; }
                a = wave_sum(a); if (lane == jj) mine = a; }
            if (lane < 12) dt[lane] = mine;
        }
    }
}
__device__ __forceinline__ void phase_final(Frame& F) {
    const int lane = F.lane; const float* gw = F.in[34];
    for (int row = F.vcu * NWAVES + F.wave; row < M; row += F.G * NWAVES) {
        const float* xr = (const float*)(F.ws + OFF_X) + (size_t)row * D;
        f32x4 v[4]; float s = 0.f;
#pragma unroll
        for (int j = 0; j < 4; ++j) { v[j] = *(const f32x4*)(xr + 4 * lane + 256 * j); s += v[j].x * v[j].x + v[j].y * v[j].y + v[j].z * v[j].z + v[j].w * v[j].w; }
        const float rstd = rsqrtf(wave_sum(s) * (1.f / D) + EPS);
        float* o = F.out + (size_t)row * D;
#pragma unroll
        for (int j = 0; j < 4; ++j) { const int c = 4 * lane + 256 * j; const f32x4 g = *(const f32x4*)(gw + c); f32x4 r = {v[j].x * rstd * g.x, v[j].y * rstd * g.y, v[j].z * rstd * g.z, v[j].w * rstd * g.w}; *(f32x4*)(o + c) = r; }
    }
}


typedef short v4i16_t __attribute__((ext_vector_type(4)));
constexpr int AT_KP = 160;
constexpr int AT_TILE = 64 * AT_KP;
constexpr int AT_K0 = 0, AT_V0 = 2 * AT_TILE, AT_RPB = 4 * AT_TILE, AT_END = AT_RPB + 2048;
__device__ __forceinline__ int queue_next(Frame& F, unsigned* ctr) {
    __syncthreads();
    if (F.tid == 0) F.MISC[16] = atomicAdd(ctr, 1u);
    __syncthreads();
    { int t_ = F.tid; asm volatile("" : "+v"(t_)); F.tid = t_; F.lane = t_ & 63; }
    return (int)F.MISC[16];
}
__device__ __forceinline__ bf16x8 tr2(LAS const unsigned char* a, LAS const unsigned char* b) {
    const v4i16_t x = __builtin_amdgcn_ds_read_tr16_b64_v4i16((LAS v4i16_t*)a), y = __builtin_amdgcn_ds_read_tr16_b64_v4i16((LAS v4i16_t*)b);
    return (bf16x8){x[0], x[1], x[2], x[3], y[0], y[1], y[2], y[3]};
}
struct AttnState { f32x4 o[4]; float m, l; };
template <int NKB, bool MASKED>
__device__ __forceinline__ void attn_tile(AttnState& st, LAS const unsigned char* Kt, LAS const unsigned char* Vt, const bf16x8 (&qf)[2], int c0, int lane,
                                          LAS const float* rpbrow, const int (&dk)[2][4]) {
    const int fr = lane & 15, fq = lane >> 4;
    f32x4 s[NKB];
#pragma unroll
    for (int kb = 0; kb < NKB; ++kb) {
        s[kb] = (f32x4){0.f, 0.f, 0.f, 0.f};
#pragma unroll
        for (int ks = 0; ks < 2; ++ks) {
            const bf16x8 a = *(LAS const bf16x8*)(Kt + (c0 + 16 * kb + fr) * AT_KP + (32 * ks + 8 * fq) * 2);
            s[kb] = __builtin_amdgcn_mfma_f32_16x16x32_bf16(a, qf[ks], s[kb], 0, 0, 0);
        }
    }
    float mloc = -1e30f;
#pragma unroll
    for (int kb = 0; kb < NKB; ++kb)
#pragma unroll
        for (int i = 0; i < 4; ++i) {
            float t = s[kb][i] * 0.125f;
            if (MASKED) { const int d = dk[kb & 1][i]; t = d >= 0 ? t + rpbrow[d] : -1e30f; }
            s[kb][i] = t; mloc = fmaxf(mloc, t);
        }
    mloc = fmaxf(mloc, __shfl_xor(mloc, 16)); mloc = fmaxf(mloc, __shfl_xor(mloc, 32));
    const float mn = fmaxf(st.m, mloc), alpha = __expf(st.m - mn);
    st.m = mn;
    float ls = 0.f;
#pragma unroll
    for (int kb = 0; kb < NKB; ++kb)
#pragma unroll
        for (int i = 0; i < 4; ++i) { const float pv = __expf(s[kb][i] - mn); s[kb][i] = pv; ls += pv; }
    st.l = st.l * alpha + ls;
#pragma unroll
    for (int db = 0; db < 4; ++db) st.o[db] = st.o[db] * alpha;
#pragma unroll
    for (int kk = 0; kk < NKB / 2; ++kk) {
        union { bf16x8 v; unsigned u[4]; } pf;
        pf.u[0] = pk2(s[2 * kk][0], s[2 * kk][1]); pf.u[1] = pk2(s[2 * kk][2], s[2 * kk][3]);
        pf.u[2] = pk2(s[2 * kk + 1][0], s[2 * kk + 1][1]); pf.u[3] = pk2(s[2 * kk + 1][2], s[2 * kk + 1][3]);
        LAS const unsigned char* va = Vt + (c0 + 32 * kk + 4 * fq + (fr >> 2)) * AT_KP + (4 * (fr & 3)) * 2;
#pragma unroll
        for (int db = 0; db < 4; ++db) {
            const bf16x8 vf = tr2(va + db * 32, va + 16 * AT_KP + db * 32);
            st.o[db] = __builtin_amdgcn_mfma_f32_16x16x32_bf16(vf, pf.v, st.o[db], 0, 0, 0);
        }
    }
}
__device__ __forceinline__ void attn_unit(Frame& F, int l, int unit) {
    const int tid = F.tid, lane = F.lane, w = F.wave, fr = lane & 15, fq = lane >> 4;
    const bf16_t* proj = (const bf16_t*)(F.ws + OFF_PROJ);
    LAS unsigned char* lds = F.lds;
    const bool nat = unit < 384;
    int b, h, qrow, r = 0, rs_w = 0, rs0 = 0, nlat = 0, c0 = 0;
    if (nat) { b = unit / 48; h = (unit / 8) % 6; const int rp = unit % 8; r = 2 * rp + (w >> 2); const int j = w & 3;
        qrow = MC + b * 1024 + r * 64 + 16 * j + fr;
        rs_w = min(max(r - 4, 0), 8); rs0 = min(max(2 * rp - 4, 0), 8); const int rs1 = min(max(2 * rp + 1 - 4, 0), 8); nlat = rs1 + 8 - rs0;
        c0 = j == 0 ? 0 : (j == 1 ? 8 : (j == 2 ? 24 : 32));
    } else { const int u = unit - 384; b = u / 12; h = (u / 2) % 6; const int qb = u % 2; qrow = b * 256 + qb * 128 + 16 * w + fr; }
    const int ntiles = nat ? nlat + 4 : 4;
    bf16x8 qf[2];
#pragma unroll
    for (int ks = 0; ks < 2; ++ks) qf[ks] = *(const bf16x8*)(proj + (size_t)qrow * PN + PQ + h * 64 + 32 * ks + 8 * fq);
    int dk[2][4];
    if (nat) {
        const int qc = (qrow - MC) & 63; const int cs = min(max(qc - 8, 0), 48);
#pragma unroll
        for (int kb = 0; kb < 2; ++kb)
#pragma unroll
            for (int i = 0; i < 4; ++i) { const int kc = c0 + 16 * kb + 4 * fq + i; dk[kb][i] = (kc >= cs && kc < cs + 16) ? kc - qc + 15 : -1; }
        const float* rpb = F.in[30] + (size_t)(l * 6 + h) * 465;
        for (int i = tid; i < 465; i += NTHREADS) ((LAS float*)(lds + AT_RPB))[i] = rpb[i];
    } else {
#pragma unroll
        for (int kb = 0; kb < 2; ++kb)
#pragma unroll
            for (int i = 0; i < 4; ++i) dk[kb][i] = 0;
    }
    AttnState st; st.m = -1e30f; st.l = 0.f;
#pragma unroll
    for (int db = 0; db < 4; ++db) st.o[db] = (f32x4){0.f, 0.f, 0.f, 0.f};
    const int skey = tid >> 3, sch = tid & 7;
    v4u rk = {0u, 0u, 0u, 0u}, rv = {0u, 0u, 0u, 0u}; f32x4 fk0 = {0.f, 0.f, 0.f, 0.f}, fk1 = fk0, fv0 = fk0, fv1 = fk0; bool isf = false;
#define AT_LOAD(ti_) do { const int ti__ = (ti_); \
        if (nat && ti__ >= nlat) { isf = true; const size_t off = ((size_t)(b * 4 + l) * 256 + (ti__ - nlat) * 64 + skey) * 384 + h * 64 + sch * 8; \
            fk0 = *(const f32x4*)(F.in[2] + off); fk1 = *(const f32x4*)(F.in[2] + off + 4); fv0 = *(const f32x4*)(F.in[3] + off); fv1 = *(const f32x4*)(F.in[3] + off + 4); \
        } else { isf = false; const int grow = nat ? MC + b * 1024 + (rs0 + ti__) * 64 + skey : b * 256 + ti__ * 64 + skey; \
            const bf16_t* pr = proj + (size_t)grow * PN + h * 64 + sch * 8; rk = *(const v4u*)(pr + PK); rv = *(const v4u*)(pr + PV); } } while (0)
#define AT_WRITE(buf_) do { const int buf__ = (buf_); \
        if (isf) { rk.x = pk2(fk0[0], fk0[1]); rk.y = pk2(fk0[2], fk0[3]); rk.z = pk2(fk1[0], fk1[1]); rk.w = pk2(fk1[2], fk1[3]); \
                   rv.x = pk2(fv0[0], fv0[1]); rv.y = pk2(fv0[2], fv0[3]); rv.z = pk2(fv1[0], fv1[1]); rv.w = pk2(fv1[2], fv1[3]); } \
        *(LAS v4u*)(lds + AT_K0 + buf__ * AT_TILE + skey * AT_KP + sch * 16) = rk; \
        *(LAS v4u*)(lds + AT_V0 + buf__ * AT_TILE + skey * AT_KP + sch * 16) = rv; } while (0)
    AT_LOAD(0); AT_WRITE(0);
    __syncthreads();
    for (int ti = 0; ti < ntiles; ++ti) {
        const int buf = ti & 1;
        if (ti + 1 < ntiles) AT_LOAD(ti + 1);
        LAS const unsigned char* Kt = lds + AT_K0 + buf * AT_TILE; LAS const unsigned char* Vt = lds + AT_V0 + buf * AT_TILE;
        if (nat && ti < nlat) {
            const int kr = rs0 + ti;
            if (kr >= rs_w && kr < rs_w + 8) attn_tile<2, true>(st, Kt, Vt, qf, c0, lane, (LAS const float*)(lds + AT_RPB) + (kr - r + 7) * 31, dk);
        } else attn_tile<4, false>(st, Kt, Vt, qf, 0, lane, (LAS const float*)(lds + AT_RPB), dk);
        if (ti + 1 < ntiles) AT_WRITE(buf ^ 1);
        __syncthreads();
    }
    float lt = st.l; lt += __shfl_xor(lt, 16); lt += __shfl_xor(lt, 32);
    const float inv = 1.f / lt;
    bf16_t* mix = (bf16_t*)(F.ws + OFF_MIX) + (size_t)qrow * D + 640 + h * 64 + 4 * fq;
#pragma unroll
    for (int db = 0; db < 4; ++db) { uint2 o; o.x = pk2(st.o[db][0] * inv, st.o[db][1] * inv); o.y = pk2(st.o[db][2] * inv, st.o[db][3] * inv); *(uint2*)(mix + 16 * db) = o; }
}
__device__ __forceinline__ void phase_attn(Frame& F, int l, unsigned* ctr) {
    for (;;) { const int u = queue_next(F, ctr); if (u >= 768) break; attn_unit(F, l, u); }
}

constexpr int SS_P = 160;
constexpr int SS_IMG = 128 * SS_P;
constexpr int SS_B = 0, SS_C = SS_IMG, SS_X = 2 * SS_IMG, SS_X2 = 3 * SS_IMG, SS_TAB = 4 * SS_IMG;
constexpr int SS_HP = 144;
__device__ __forceinline__ void conv16(const bf16_t* proj, const float* cw, const float* cb, int seq_start, int seq_L, int t, int ch0, float (&v)[16]) {
#pragma unroll
    for (int e = 0; e < 16; e += 4) { const f32x4 b = *(const f32x4*)(cb + ch0 + e); v[e] = b[0]; v[e + 1] = b[1]; v[e + 2] = b[2]; v[e + 3] = b[3]; }
#pragma unroll
    for (int j = 0; j < 5; ++j) {
        const int tt = t + j - 2;
        if (tt >= 0 && tt < seq_L) {
            const bf16_t* src = proj + (size_t)(seq_start + tt) * PN + PX + ch0;
            const v4u r0 = *(const v4u*)src, r1 = *(const v4u*)(src + 8);
            const unsigned rr[8] = {r0[0], r0[1], r0[2], r0[3], r1[0], r1[1], r1[2], r1[3]};
#pragma unroll
            for (int e = 0; e < 16; e += 4) { const f32x4 w = *(const f32x4*)(cw + j * 640 + ch0 + e);
                v[e] += w[0] * __uint_as_float(rr[e / 2] << 16); v[e + 1] += w[1] * __uint_as_float(rr[e / 2] & 0xffff0000u);
                v[e + 2] += w[2] * __uint_as_float(rr[e / 2 + 1] << 16); v[e + 3] += w[3] * __uint_as_float(rr[e / 2 + 1] & 0xffff0000u); }
        }
    }
#pragma unroll
    for (int e = 0; e < 16; ++e) v[e] = silu_f(v[e]);
}
__device__ __forceinline__ void ssd_table(const float* dtraw  , float bias, float a, int dir, LAS float* tab, int lane) {
    const float d0 = softplus_f(dtraw[(2 * lane) * 12] + bias), d1 = softplus_f(dtraw[(2 * lane + 1) * 12] + bias);
    const float ps = d0 + d1; float x = ps;
#pragma unroll
    for (int o = 1; o < 64; o <<= 1) { const float y = __shfl_up(x, o); if (lane >= o) x += y; }
    tab[2 * lane] = d0; tab[2 * lane + 1] = d1;
    if (dir == 0) { const float ex = x - ps; tab[128 + 2 * lane] = a * (ex + d0); tab[128 + 2 * lane + 1] = a * (ex + ps); }
    else { const float tot = __shfl(x, 63); const float sx = tot - x; tab[128 + 2 * lane + 1] = a * (sx + d1); tab[128 + 2 * lane] = a * (sx + ps); }
}
__device__ __forceinline__ void ssd_a_unit(Frame& F, int l, int unit) {
    const int tid = F.tid, lane = F.lane, w = F.wave, fr = lane & 15, fq = lane >> 4;
    const int ci = unit >> 1, g = unit & 1, row0 = ci * 128;
    const SeqInfo q = row_seq(row0); const int t0 = row0 - q.start;
    const bf16_t* proj = (const bf16_t*)(F.ws + OFF_PROJ);
    const float* cw = F.in[14] + l * 5 * 640; const float* cb = F.in[15] + l * 640;
    LAS unsigned char* lds = F.lds; LAS float* tabs = (LAS float*)(lds + SS_TAB);
    if (w < 6) { const int hh = w >> 1, dir = w & 1, h = 3 * g + hh;
        ssd_table((const float*)(F.ws + OFF_DT) + (size_t)row0 * 12 + dir * 6 + h, F.in[16][(l * 2 + dir) * 6 + h], -__expf(F.in[17][(l * 2 + dir) * 6 + h]), dir, tabs + (hh * 4 + dir * 2) * 128, lane); }
    { const int t = tid >> 2, chq = tid & 3; float v[16];
      conv16(proj, cw, cb, q.start, q.L, t0 + t, 384 + g * 64 + chq * 16, v);
      v4u o0, o1; o0[0] = pk2(v[0], v[1]); o0[1] = pk2(v[2], v[3]); o0[2] = pk2(v[4], v[5]); o0[3] = pk2(v[6], v[7]); o1[0] = pk2(v[8], v[9]); o1[1] = pk2(v[10], v[11]); o1[2] = pk2(v[12], v[13]); o1[3] = pk2(v[14], v[15]);
      *(LAS v4u*)(lds + SS_B + t * SS_P + chq * 32) = o0; *(LAS v4u*)(lds + SS_B + t * SS_P + chq * 32 + 16) = o1; }
    __syncthreads();
    for (int hh = 0; hh < 3; ++hh) {
        const int h = 3 * g + hh;
        LAS const float* tb = tabs + hh * 4 * 128;
        { const int t = tid >> 2, chq = tid & 3; float v[16];
          conv16(proj, cw, cb, q.start, q.L, t0 + t, h * 64 + chq * 16, v);
          const float wf = __expf(tb[128 + 127] - tb[128 + t]) * tb[t], wb = __expf(tb[384] - tb[384 + t]) * tb[256 + t];
          v4u o0, o1;
          o0[0] = pk2(v[0] * wf, v[1] * wf); o0[1] = pk2(v[2] * wf, v[3] * wf); o0[2] = pk2(v[4] * wf, v[5] * wf); o0[3] = pk2(v[6] * wf, v[7] * wf);
          o1[0] = pk2(v[8] * wf, v[9] * wf); o1[1] = pk2(v[10] * wf, v[11] * wf); o1[2] = pk2(v[12] * wf, v[13] * wf); o1[3] = pk2(v[14] * wf, v[15] * wf);
          *(LAS v4u*)(lds + SS_X + t * SS_P + chq * 32) = o0; *(LAS v4u*)(lds + SS_X + t * SS_P + chq * 32 + 16) = o1;
          o0[0] = pk2(v[0] * wb, v[1] * wb); o0[1] = pk2(v[2] * wb, v[3] * wb); o0[2] = pk2(v[4] * wb, v[5] * wb); o0[3] = pk2(v[6] * wb, v[7] * wb);
          o1[0] = pk2(v[8] * wb, v[9] * wb); o1[1] = pk2(v[10] * wb, v[11] * wb); o1[2] = pk2(v[12] * wb, v[13] * wb); o1[3] = pk2(v[14] * wb, v[15] * wb);
          *(LAS v4u*)(lds + SS_X2 + t * SS_P + chq * 32) = o0; *(LAS v4u*)(lds + SS_X2 + t * SS_P + chq * 32 + 16) = o1; }
        __syncthreads();
        {
          const int dir = w >> 2, pb = w & 3;
          LAS const unsigned char* xa = lds + (dir ? SS_X2 : SS_X) + (4 * fq + (fr >> 2)) * SS_P + (16 * pb + 4 * (fr & 3)) * 2;
          LAS const unsigned char* ba = lds + SS_B + (4 * fq + (fr >> 2)) * SS_P + (4 * (fr & 3)) * 2;
          f32x4 acc[4];
#pragma unroll
          for (int nb = 0; nb < 4; ++nb) acc[nb] = (f32x4){0.f, 0.f, 0.f, 0.f};
#pragma unroll
          for (int kk = 0; kk < 4; ++kk) {
              const bf16x8 af = tr2(xa + kk * 32 * SS_P, xa + (kk * 32 + 16) * SS_P);
#pragma unroll
              for (int nb = 0; nb < 4; ++nb) { const bf16x8 bfr = tr2(ba + kk * 32 * SS_P + nb * 32, ba + (kk * 32 + 16) * SS_P + nb * 32); acc[nb] = __builtin_amdgcn_mfma_f32_16x16x32_bf16(af, bfr, acc[nb], 0, 0, 0); }
          }
          float* cs = (float*)(F.ws + OFF_CS) + ((size_t)(ci * 6 + h) * 2 + dir) * 4096;
#pragma unroll
          for (int nb = 0; nb < 4; ++nb)
#pragma unroll
              for (int i = 0; i < 4; ++i) cs[(16 * pb + 4 * fq + i) * 64 + 16 * nb + fr] = acc[nb][i];
          if (tid == 0) { float* cd = (float*)(F.ws + OFF_TAB + TAB_CD) + (size_t)(ci * 6 + h) * 2; cd[0] = __expf(tb[128 + 127]); cd[1] = __expf(tb[384]); }
        }
        __syncthreads();
    }
}
__device__ __forceinline__ void ssd_b_unit(Frame& F, int l, int ci) {
    const int tid = F.tid, lane = F.lane, w = F.wave, fr = lane & 15, fq = lane >> 4;
    const int row0 = ci * 128;
    const SeqInfo q = row_seq(row0); const int t0 = row0 - q.start, c = t0 >> 7, nch = q.L >> 7, ci0 = ci - c;
    const bf16_t* proj = (const bf16_t*)(F.ws + OFF_PROJ);
    const float* cw = F.in[14] + l * 5 * 640; const float* cb = F.in[15] + l * 640;
    LAS unsigned char* lds = F.lds; LAS float* tabs = (LAS float*)(lds + SS_TAB);
    for (int task = w; task < 12; task += NWAVES) { const int h = task >> 1, dir = task & 1;
        ssd_table((const float*)(F.ws + OFF_DT) + (size_t)row0 * 12 + dir * 6 + h, F.in[16][(l * 2 + dir) * 6 + h], -__expf(F.in[17][(l * 2 + dir) * 6 + h]), dir, tabs + (h * 4 + dir * 2) * 128, lane); }
    float ss[4] = {0.f, 0.f, 0.f, 0.f};
    bf16_t* mixp = (bf16_t*)(F.ws + OFF_MIX) + (size_t)(row0 + 16 * w + 4 * fq) * D + fr;
    const float* cdt = (const float*)(F.ws + OFF_TAB + TAB_CD);
    const float* csb = (const float*)(F.ws + OFF_CS);
    for (int g = 0; g < 2; ++g) {
        { const int t = tid >> 2, chq = tid & 3;
#pragma unroll
          for (int bc = 0; bc < 2; ++bc) { float v[16];
            conv16(proj, cw, cb, q.start, q.L, t0 + t, 384 + bc * 128 + g * 64 + chq * 16, v);
            v4u o0, o1; o0[0] = pk2(v[0], v[1]); o0[1] = pk2(v[2], v[3]); o0[2] = pk2(v[4], v[5]); o0[3] = pk2(v[6], v[7]); o1[0] = pk2(v[8], v[9]); o1[1] = pk2(v[10], v[11]); o1[2] = pk2(v[12], v[13]); o1[3] = pk2(v[14], v[15]);
            *(LAS v4u*)(lds + (bc ? SS_C : SS_B) + t * SS_P + chq * 32) = o0; *(LAS v4u*)(lds + (bc ? SS_C : SS_B) + t * SS_P + chq * 32 + 16) = o1; } }
        __syncthreads();
        bf16x8 cf[2];
#pragma unroll
        for (int ks = 0; ks < 2; ++ks) cf[ks] = *(LAS const bf16x8*)(lds + SS_C + (16 * w + fr) * SS_P + (32 * ks + 8 * fq) * 2);
        f32x4 gt[8];
#pragma unroll
        for (int sb = 0; sb < 8; ++sb) { gt[sb] = (f32x4){0.f, 0.f, 0.f, 0.f};
#pragma unroll
            for (int ks = 0; ks < 2; ++ks) { const bf16x8 bfr = *(LAS const bf16x8*)(lds + SS_B + (16 * sb + fr) * SS_P + (32 * ks + 8 * fq) * 2); gt[sb] = __builtin_amdgcn_mfma_f32_16x16x32_bf16(bfr, cf[ks], gt[sb], 0, 0, 0); } }
        for (int hh = 0; hh < 3; ++hh) {
            const int h = 3 * g + hh;
            LAS const float* tb = tabs + h * 4 * 128;
            { const int t = tid >> 2, chq = tid & 3; float v[16];
              conv16(proj, cw, cb, q.start, q.L, t0 + t, h * 64 + chq * 16, v);
              v4u o0, o1; o0[0] = pk2(v[0], v[1]); o0[1] = pk2(v[2], v[3]); o0[2] = pk2(v[4], v[5]); o0[3] = pk2(v[6], v[7]); o1[0] = pk2(v[8], v[9]); o1[1] = pk2(v[10], v[11]); o1[2] = pk2(v[12], v[13]); o1[3] = pk2(v[14], v[15]);
              *(LAS v4u*)(lds + SS_X + t * SS_P + chq * 32) = o0; *(LAS v4u*)(lds + SS_X + t * SS_P + chq * 32 + 16) = o1; }
            { const int p = tid >> 3, n0 = (tid & 7) * 8;
#pragma unroll
              for (int dir = 0; dir < 2; ++dir) {
                f32x4 s0 = {0.f, 0.f, 0.f, 0.f}, s1 = s0;
                if (!q.ctx) { const float* h0 = F.in[4] + ((((size_t)q.b * 4 + l) * 2 + dir) * 6 + h) * 4096 + p * 64 + n0; s0 = *(const f32x4*)h0; s1 = *(const f32x4*)(h0 + 4); }
                const int nprev = dir == 0 ? c : nch - 1 - c;
                for (int k = 0; k < nprev; ++k) { const int cc = dir == 0 ? k : nch - 1 - k; const size_t ix = (size_t)((ci0 + cc) * 6 + h) * 2 + dir;
                    const float dcy = cdt[ix]; const float* cs = csb + ix * 4096 + p * 64 + n0;
                    s0 = s0 * dcy + *(const f32x4*)cs; s1 = s1 * dcy + *(const f32x4*)(cs + 4); }
                v4u o; o[0] = pk2(s0[0], s0[1]); o[1] = pk2(s0[2], s0[3]); o[2] = pk2(s1[0], s1[1]); o[3] = pk2(s1[2], s1[3]);
                *(LAS v4u*)(lds + SS_X2 + dir * 64 * SS_HP + p * SS_HP + n0 * 2) = o;
                if (q.ctx && ((dir == 0 && c == nch - 1) || (dir == 1 && c == 0))) { const size_t ix = (size_t)(ci * 6 + h) * 2 + dir; const float dcy = cdt[ix]; const float* cs = csb + ix * 4096 + p * 64 + n0;
                    float* o4 = F.out + O_SSD + ((((size_t)q.b * 4 + l) * 2 + dir) * 6 + h) * 4096 + p * 64 + n0;
                    *(f32x4*)o4 = s0 * dcy + *(const f32x4*)cs; *(f32x4*)(o4 + 4) = s1 * dcy + *(const f32x4*)(cs + 4); }
              } }
            __syncthreads();
            const float at = tb[128 + 16 * w + fr], bt = tb[384 + 16 * w + fr];
            f32x4 y[4];
#pragma unroll
            for (int pb = 0; pb < 4; ++pb) y[pb] = (f32x4){0.f, 0.f, 0.f, 0.f};
            LAS const unsigned char* xa = lds + SS_X + (4 * fq + (fr >> 2)) * SS_P + (4 * (fr & 3)) * 2;
#pragma unroll
            for (int kk = 0; kk < 4; ++kk) {
                float mv[8];
#pragma unroll
                for (int half = 0; half < 2; ++half) { const int sb = 2 * kk + half; const int s0i = 16 * sb + 4 * fq;
                    const f32x4 cumf = *(LAS const f32x4*)(tb + 128 + s0i), dtf = *(LAS const f32x4*)(tb + s0i), cumb = *(LAS const f32x4*)(tb + 384 + s0i), dtb = *(LAS const f32x4*)(tb + 256 + s0i);
#pragma unroll
                    for (int i = 0; i < 4; ++i) { const int s = s0i + i, t = 16 * w + fr; float m = 0.f;
                        if (s <= t) m += __expf(at - cumf[i]) * dtf[i];
                        if (s >= t) m += __expf(bt - cumb[i]) * dtb[i];
                        mv[half * 4 + i] = m * gt[sb][i]; } }
                union { bf16x8 v; unsigned u[4]; } mf; mf.u[0] = pk2(mv[0], mv[1]); mf.u[1] = pk2(mv[2], mv[3]); mf.u[2] = pk2(mv[4], mv[5]); mf.u[3] = pk2(mv[6], mv[7]);
#pragma unroll
                for (int pb = 0; pb < 4; ++pb) { const bf16x8 xf = tr2(xa + kk * 32 * SS_P + pb * 32, xa + (kk * 32 + 16) * SS_P + pb * 32); y[pb] = __builtin_amdgcn_mfma_f32_16x16x32_bf16(mf.v, xf, y[pb], 0, 0, 0); }
            }
            f32x4 yf[4], yb[4];
#pragma unroll
            for (int pb = 0; pb < 4; ++pb) { yf[pb] = (f32x4){0.f, 0.f, 0.f, 0.f}; yb[pb] = yf[pb];
#pragma unroll
                for (int ks = 0; ks < 2; ++ks) {
                    const bf16x8 hf = *(LAS const bf16x8*)(lds + SS_X2 + (16 * pb + fr) * SS_HP + (32 * ks + 8 * fq) * 2);
                    const bf16x8 hb = *(LAS const bf16x8*)(lds + SS_X2 + 64 * SS_HP + (16 * pb + fr) * SS_HP + (32 * ks + 8 * fq) * 2);
                    yf[pb] = __builtin_amdgcn_mfma_f32_16x16x32_bf16(cf[ks], hf, yf[pb], 0, 0, 0);
                    yb[pb] = __builtin_amdgcn_mfma_f32_16x16x32_bf16(cf[ks], hb, yb[pb], 0, 0, 0); } }
            const float dsk = F.in[18][l * 6 + h];
            const f32x4 cumf4 = *(LAS const f32x4*)(tb + 128 + 16 * w + 4 * fq), cumb4 = *(LAS const f32x4*)(tb + 384 + 16 * w + 4 * fq);
#pragma unroll
            for (int i = 0; i < 4; ++i) { const float ef = __expf(cumf4[i]), eb = __expf(cumb4[i]); const int tl = 16 * w + 4 * fq + i;
                const bf16_t* zr = proj + (size_t)(row0 + tl) * PN + PZ + h * 64 + fr;
#pragma unroll
                for (int pb = 0; pb < 4; ++pb) { const float xv = bf2f(*(LAS const bf16_t*)(lds + SS_X + tl * SS_P + (16 * pb + fr) * 2));
                    const float yv = y[pb][i] + ef * yf[pb][i] + eb * yb[pb][i] + dsk * xv;
                    const float gv = yv * silu_f(bf2f(zr[16 * pb])); const bf16_t gb = f2bf(gv); const float gr = bf2f(gb); ss[i] += gr * gr;
                    mixp[(size_t)i * D + h * 64 + 16 * pb] = gb; } }
            __syncthreads();
        }
    }
#pragma unroll
    for (int i = 0; i < 4; ++i) { float v = ss[i]; v += __shfl_xor(v, 1); v += __shfl_xor(v, 2); v += __shfl_xor(v, 4); v += __shfl_xor(v, 8); ss[i] = rsqrtf(v * (1.f / 384.f) + EPS); }
    const float* nw = F.in[19] + l * 384;
    for (int hp = 0; hp < 24; ++hp) { const float gwt = nw[hp * 16 + fr];
#pragma unroll
        for (int i = 0; i < 4; ++i) { bf16_t* a = mixp + (size_t)i * D + hp * 16; *a = f2bf(bf2f(*a) * ss[i] * gwt); } }
}
constexpr int S5_HP = 528;
constexpr int S5_IMG = 64 * S5_HP;
constexpr int S5_H0 = 0, S5_H1 = S5_IMG, S5_G = 2 * S5_IMG, S5_END = 3 * S5_IMG;
typedef float f32x16 __attribute__((ext_vector_type(16)));
template <int DIR, bool FULL>
__device__ __forceinline__ void s5_wave_unit(Frame& F, int l, int row0, int g, int ph, float& cr, float& ci, LAS unsigned char* himg) {
    const int lane = F.lane, r32 = lane & 31, hi = lane >> 5, p = 32 * ph + r32;
    const bf16_t* proj = (const bf16_t*)(F.ws + OFF_PROJ);
    const float* ab = (const float*)(F.ws + OFF_TAB + TAB_ABAR) + (size_t)((((l * 2 + DIR) * 16 + g) * 64) + p) * 2;
    const float ar = ab[0], ai = ab[1];
    const float a2r = ar * ar - ai * ai, a2i = 2.f * ar * ai, a3r = a2r * ar - a2i * ai, a3i = a2r * ai + a2i * ar, a4r = a2r * a2r - a2i * a2i, a4i = 2.f * a2r * a2i;
    const bf16_t* bbt = (const bf16_t*)(F.ws + OFF_TAB + TAB_BBT) + ((size_t)(((l * 2 + DIR) * 16 + g) * 2) * 64 + p) * 16 + 8 * hi;
    const bf16x8 bre = *(const bf16x8*)bbt, bim = *(const bf16x8*)(bbt + 64 * 16);
    f32x16 xr[2], xi[2];
#pragma unroll
    for (int rb = 0; rb < 2; ++rb) {
        const bf16x8 uf = *(const bf16x8*)(proj + (size_t)(row0 + 32 * rb + r32) * PN + PU + g * 16 + 8 * hi);
        const f32x16 z = {0.f, 0.f, 0.f, 0.f, 0.f, 0.f, 0.f, 0.f, 0.f, 0.f, 0.f, 0.f, 0.f, 0.f, 0.f, 0.f};
        xr[rb] = __builtin_amdgcn_mfma_f32_32x32x16_bf16(uf, bre, z, 0, 0, 0);
        xi[rb] = __builtin_amdgcn_mfma_f32_32x32x16_bf16(uf, bim, z, 0, 0, 0);
    }
#pragma unroll
    for (int rb = 0; rb < 2; ++rb)
#pragma unroll
        for (int G4 = 0; G4 < 4; ++G4) {
            if (DIR == 0) {
#pragma unroll
                for (int e = 1; e < 4; ++e) { const int i = 4 * G4 + e; const float pr = xr[rb][i - 1], pi = xi[rb][i - 1]; xr[rb][i] += ar * pr - ai * pi; xi[rb][i] += ar * pi + ai * pr; }
            } else {
#pragma unroll
                for (int e = 2; e >= 0; --e) { const int i = 4 * G4 + e; const float pr = xr[rb][i + 1], pi = xi[rb][i + 1]; xr[rb][i] += ar * pr - ai * pi; xi[rb][i] += ar * pi + ai * pr; }
            }
        }
    typedef float f32x8 __attribute__((ext_vector_type(8)));
    f32x8 cinr = {0.f, 0.f, 0.f, 0.f, 0.f, 0.f, 0.f, 0.f}, cini = cinr;
#pragma unroll
    for (int kk = 0; kk < 16; ++kk) {
        const int k = DIR == 0 ? kk : 15 - kk, gi = k >> 1, rb = gi >> 2, G4 = gi & 3, il = 4 * G4 + (DIR == 0 ? 3 : 0);
        const bool own = (hi == (k & 1));
        const float xlr = xr[rb][il], xli = xi[rb][il];
        const float nr = a4r * cr - a4i * ci + xlr, ni = a4r * ci + a4i * cr + xli;
        cinr[gi] = own ? cr : cinr[gi]; cini[gi] = own ? ci : cini[gi]; cr = own ? nr : cr; ci = own ? ni : ci;
        const float tr = __shfl_xor(cr, 32), ti = __shfl_xor(ci, 32);
        cr = own ? cr : tr; ci = own ? ci : ti;
    }
    if (FULL) {
#pragma unroll
        for (int rb = 0; rb < 2; ++rb)
#pragma unroll
            for (int G4 = 0; G4 < 4; ++G4) {
                const float c0r = cinr[rb * 4 + G4], c0i = cini[rb * 4 + G4];
#pragma unroll
                for (int e = 0; e < 4; ++e) {
                    const int pw = DIR == 0 ? e + 1 : 4 - e;
                    const float pr = pw == 1 ? ar : (pw == 2 ? a2r : (pw == 3 ? a3r : a4r)), pi = pw == 1 ? ai : (pw == 2 ? a2i : (pw == 3 ? a3i : a4i));
                    const int i = 4 * G4 + e, t = 32 * rb + 8 * G4 + 4 * hi + e;
                    const float hr = xr[rb][i] + pr * c0r - pi * c0i, hq = xi[rb][i] + pr * c0i + pi * c0r;
                    LAS bf16_t* d = (LAS bf16_t*)(himg + t * S5_HP) + DIR * 128 + p;
                    d[0] = f2bf(hr); d[64] = f2bf(hq);
                }
            }
    }
}
__device__ __forceinline__ void cpow64(float ar, float ai, float& or_, float& oi_) {
#pragma unroll
    for (int s = 0; s < 6; ++s) { const float nr = ar * ar - ai * ai, ni = 2.f * ar * ai; ar = nr; ai = ni; }
    or_ = ar; oi_ = ai;
}
__device__ __forceinline__ void s5_a_unit(Frame& F, int l, int cj) {
    const int w = F.wave, lane = F.lane, row0 = cj * 64;
    float* E = (float*)(F.ws + OFF_E);
    for (int it = w; it < 64; it += NWAVES) {
        const int g = it >> 2, dir = (it >> 1) & 1, ph = it & 1;
        float cr = 0.f, ci = 0.f;
        if (dir == 0) s5_wave_unit<0, false>(F, l, row0, g, ph, cr, ci, F.lds); else s5_wave_unit<1, false>(F, l, row0, g, ph, cr, ci, F.lds);
        if (lane < 32) { float2 v; v.x = cr; v.y = ci; *(float2*)(E + ((size_t)((cj * 2 + dir) * 16 + g) * 64 + 32 * ph + lane) * 2) = v; }
    }
}
__device__ __forceinline__ void s5_b_unit(Frame& F, int l, int cj) {
    const int w = F.wave, lane = F.lane, tid = F.tid, fr = lane & 15, fq = lane >> 4, row0 = cj * 64;
    const SeqInfo q = row_seq(row0); const int j = (row0 - q.start) >> 6, nj = q.L >> 6, cj0 = cj - j;
    const bf16_t* proj = (const bf16_t*)(F.ws + OFF_PROJ);
    const float* E = (const float*)(F.ws + OFF_E);
    LAS unsigned char* lds = F.lds;
    for (int gp = 0; gp < 8; ++gp) {
        {
            const int g = 2 * gp + (w >> 2), dir = (w >> 1) & 1, ph = w & 1, p = 32 * ph + (lane & 31);
            const float* ab = (const float*)(F.ws + OFF_TAB + TAB_ABAR) + (size_t)((((l * 2 + dir) * 16 + g) * 64) + p) * 2;
            float a64r, a64i; cpow64(ab[0], ab[1], a64r, a64i);
            float cr = 0.f, ci = 0.f;
            if (!q.ctx) { const size_t o = (((size_t)q.b * 4 + l) * 2 + dir) * 1024 + g * 64 + p; cr = F.in[5][o]; ci = F.in[6][o]; }
            const int nprev = dir == 0 ? j : nj - 1 - j;
            for (int k = 0; k < nprev; ++k) { const int jj = dir == 0 ? k : nj - 1 - k;
                const float2 e = *(const float2*)(E + ((size_t)(((cj0 + jj) * 2 + dir) * 16 + g) * 64 + p) * 2);
                const float nr = a64r * cr - a64i * ci + e.x, ni = a64r * ci + a64i * cr + e.y; cr = nr; ci = ni; }
            LAS unsigned char* himg = lds + ((w >> 2) ? S5_H1 : S5_H0);
            if (dir == 0) s5_wave_unit<0, true>(F, l, row0, g, ph, cr, ci, himg); else s5_wave_unit<1, true>(F, l, row0, g, ph, cr, ci, himg);
            if (q.ctx && lane < 32 && ((dir == 0 && j == nj - 1) || (dir == 1 && j == 0))) { const size_t o = (((size_t)q.b * 4 + l) * 2 + dir) * 1024 + g * 64 + p; F.out[O_RE + o] = cr; F.out[O_IM + o] = ci; }
        }
        __syncthreads();
        {
            const int gsel = w >> 2, tb = w & 3, g = 2 * gp + gsel;
            LAS const unsigned char* hrow = lds + (gsel ? S5_H1 : S5_H0) + (16 * tb + fr) * S5_HP + 16 * fq;
            const bf16_t* cc = (const bf16_t*)(F.ws + OFF_TAB + TAB_CC2) + ((size_t)(l * 16 + g) * 16 + fr) * 256 + 8 * fq;
            f32x4 y = {0.f, 0.f, 0.f, 0.f};
#pragma unroll
            for (int ks = 0; ks < 8; ++ks) { const bf16x8 a = *(LAS const bf16x8*)(hrow + ks * 64); const bf16x8 bfr = *(const bf16x8*)(cc + ks * 32); y = __builtin_amdgcn_mfma_f32_16x16x32_bf16(a, bfr, y, 0, 0, 0); }
            const float dsk = F.in[27][l * 256 + g * 16 + fr];
#pragma unroll
            for (int i = 0; i < 4; ++i) { const int t = 16 * tb + 4 * fq + i; const float u = bf2f(proj[(size_t)(row0 + t) * PN + PU + g * 16 + fr]);
                *((LAS bf16_t*)(lds + S5_G + t * S5_HP) + g * 16 + fr) = f2bf(gelu_tanh_f(y[i] + dsk * u)); }
        }
        __syncthreads();
    }
    {
        f32x4 acc[2][4];
#pragma unroll
        for (int a = 0; a < 2; ++a)
#pragma unroll
            for (int tb = 0; tb < 4; ++tb) acc[a][tb] = (f32x4){0.f, 0.f, 0.f, 0.f};
        const bf16_t* wg = (const bf16_t*)(F.ws + OFF_WGLU) + (size_t)l * 65536 + (size_t)(32 * w + fr) * 256 + 8 * fq;
#pragma unroll
        for (int ks = 0; ks < 8; ++ks) {
            const bf16x8 b0 = *(const bf16x8*)(wg + ks * 32), b1 = *(const bf16x8*)(wg + 16 * 256 + ks * 32);
#pragma unroll
            for (int tb = 0; tb < 4; ++tb) { const bf16x8 a = *(LAS const bf16x8*)(lds + S5_G + (16 * tb + fr) * S5_HP + ks * 64 + 16 * fq);
                acc[0][tb] = __builtin_amdgcn_mfma_f32_16x16x32_bf16(a, b0, acc[0][tb], 0, 0, 0); acc[1][tb] = __builtin_amdgcn_mfma_f32_16x16x32_bf16(a, b1, acc[1][tb], 0, 0, 0); }
        }
#pragma unroll
        for (int a = 0; a < 2; ++a) { const int n = 32 * w + 16 * a + fr; const float bg = F.in[29][l * 256 + n];
#pragma unroll
            for (int tb = 0; tb < 4; ++tb)
#pragma unroll
                for (int i = 0; i < 4; ++i) { const int t = 16 * tb + 4 * fq + i; const float gv = bf2f(*((LAS const bf16_t*)(lds + S5_G + t * S5_HP) + n));
                    ((bf16_t*)(F.ws + OFF_MIX))[(size_t)(row0 + t) * D + 384 + n] = f2bf(gv / (1.f + __expf(-(acc[a][tb][i] + bg)))); } }
    }
}

__device__ __forceinline__ void phase_mixa(Frame& F, int l) {
    unsigned* ctr = F.ctl + CW_Q + 64 * (l * 4 + 0);
    for (;;) { const int u = queue_next(F, ctr); if (u >= 1280) break; if (u < 256) ssd_a_unit(F, l, u); else if (u < 512) s5_a_unit(F, l, u - 256); else attn_unit(F, l, u - 512); }
}
__device__ __forceinline__ void phase_mixb(Frame& F, int l) {
    unsigned* ctr = F.ctl + CW_Q + 64 * (l * 4 + 1);
    for (;;) { const int u = queue_next(F, ctr); if (u >= 384) break; if (u < 128) ssd_b_unit(F, l, u); else s5_b_unit(F, l, u - 128); }
}

struct Args { const float* in[35]; float* out; unsigned char* ws; int ph_lo, ph_hi, li, pad; };
__global__ void __launch_bounds__(NTHREADS, 2) mega(Args args) {
    extern __shared__ __attribute__((aligned(16))) unsigned char lds[];
    Frame F;
    F.lds = (LAS unsigned char*)lds;
    F.MISC = (volatile LAS unsigned*)(F.lds + MISC_OFF);
    F.tid = threadIdx.x; F.lane = F.tid & 63; F.wave = __builtin_amdgcn_readfirstlane(F.tid >> 6);
    F.G = gridDim.x; { const int bx = blockIdx.x; F.vcu = (F.G % 8 == 0) ? (bx % 8) * (F.G / 8) + bx / 8 : bx; }
    { const float* const* inp = (const float* const*)__builtin_amdgcn_kernarg_segment_ptr(); asm volatile("" : "+s"(inp)); F.in = inp; }
    F.out = args.out; F.ws = args.ws; F.ctl = (unsigned*)(args.ws + OFF_CTL);
    for (int u = F.tid; u < (LDS_BYTES - LDSCTL_OFF) / 4; u += NTHREADS) ((LAS unsigned*)(F.lds + LDSCTL_OFF))[u] = 0u;
    __syncthreads();
    XcdBarrier bar = xcd_barrier_post(F.ctl + CW_BAR + args.li * XCD_BAR_WORDS, F.MISC + 8);
    const int lo = args.ph_lo, hi = args.ph_hi;
    const float* modsb = (const float*)(F.ws + OFF_MODS);
    float* X = (float*)(F.ws + OFF_X);
    const int vcu0 = F.vcu;
#define IN(k) (lo <= (k) && (k) < hi)
#define REFRESH() do { int t_ = threadIdx.x; asm volatile("" : "+v"(t_)); F.tid = t_; F.lane = t_ & 63; \
        unsigned char* w_ = args.ws; asm volatile("" : "+s"(w_)); F.ws = w_; F.ctl = (unsigned*)(w_ + OFF_CTL); float* o_ = args.out; asm volatile("" : "+s"(o_)); F.out = o_; \
        const float* const* i_ = (const float* const*)__builtin_amdgcn_kernarg_segment_ptr(); asm volatile("" : "+s"(i_)); F.in = i_; \
        int g_ = gridDim.x, v_ = vcu0; asm volatile("" : "+s"(g_), "+s"(v_)); F.G = g_; F.vcu = v_; modsb = (const float*)(F.ws + OFF_MODS); X = (float*)(F.ws + OFF_X); } while (0)
#define SEAM(k) do { if (IN(k) && IN((k) + 1)) xcd_barrier(bar); } while (0)
    if (IN(PH_PRO)) phase_prologue(F);
    SEAM(PH_PRO);
    for (int l = 0; l < DEPTH; ++l) {
        const int pb = 1 + l * PH_PER_LAYER;
        if (IN(pb + PH_NORM1)) { REFRESH(); phase_norm(F, l, 0); }
        SEAM(pb + PH_NORM1);
        if (IN(pb + PH_G1)) { REFRESH();
            pg8::Gemm g{(const bf16_t*)(F.ws + OFF_H), (const bf16_t*)(F.ws + OFF_WIN) + (size_t)l * PNP * 1024, M, PNP, 1024}; pg8::StaticOrder S; S.init(M, PNP, F.G, (int)blockIdx.x);
            pg8::EpiProj E{(bf16_t*)(F.ws + OFF_PROJ), F.out + O_K, F.out + O_V, l};
            pg8::gemm_phase<pg8::EpiProj, pg8::StaticOrder, true, true>(F.lds, g, S, E);
        }
        SEAM(pb + PH_G1);
        if (IN(pb + PH_MIXA)) { REFRESH(); phase_mixa(F, l); }
        SEAM(pb + PH_MIXA);
        if (IN(pb + PH_MIXB)) { REFRESH(); phase_mixb(F, l); }
        SEAM(pb + PH_MIXB);
        if (IN(pb + PH_G3)) { REFRESH();
            pg8::Gemm g{(const bf16_t*)(F.ws + OFF_MIX), (const bf16_t*)(F.ws + OFF_WOUT) + (size_t)l * 1024 * 1024, M, D, 1024}; pg8::StaticOrder S; S.init(M, D, F.G, (int)blockIdx.x);
            pg8::EpiRes E{l == 0 ? F.in[0] : X, l == 0 ? F.in[1] - (size_t)MC * D : X, X, modsb + (size_t)l * 9 * 6144, 2};
            pg8::gemm_phase<pg8::EpiRes, pg8::StaticOrder, true, true>(F.lds, g, S, E);
        }
        SEAM(pb + PH_G3);
        if (IN(pb + PH_NORM2)) { REFRESH(); phase_norm(F, l, 1); }
        SEAM(pb + PH_NORM2);
        if (IN(pb + PH_G4)) { REFRESH();
            pg8::Gemm g{(const bf16_t*)(F.ws + OFF_H), (const bf16_t*)(F.ws + OFF_WFF1) + (size_t)l * DFF * 1024, M, DFF, 1024}; pg8::StaticOrder S; S.init(M, DFF, F.G, (int)blockIdx.x);
            pg8::EpiFF1 E{(bf16_t*)(F.ws + OFF_FFH)};
            pg8::gemm_phase<pg8::EpiFF1, pg8::StaticOrder, true, true>(F.lds, g, S, E);
        }
        SEAM(pb + PH_G4);
        if (IN(pb + PH_G5)) { REFRESH();
            pg8::Gemm g{(const bf16_t*)(F.ws + OFF_FFH), (const bf16_t*)(F.ws + OFF_WFF2) + (size_t)l * 1024 * DFF, M, D, DFF}; pg8::StaticOrder S; S.init(M, D, F.G, (int)blockIdx.x);
            pg8::EpiRes E{X, X, X, modsb + (size_t)l * 9 * 6144, 5};
            pg8::gemm_phase<pg8::EpiRes, pg8::StaticOrder, true, true>(F.lds, g, S, E);
        }
        SEAM(pb + PH_G5);
    }
    if (IN(PH_FINAL)) phase_final(F);
#undef IN
#undef SEAM
}
static void launch_mega(const Args& base, int lo, int hi, int li, hipStream_t stream) {
    Args a = base; a.ph_lo = lo; a.ph_hi = hi; a.li = li;
    hipLaunchKernelGGL(mega, dim3(256), dim3(NTHREADS), LDS_BYTES, stream, a);
}
extern "C" void kernel_launch(void* const* d_in, const int* in_sizes, int n_in, void* d_out, int out_size, void* d_ws, size_t ws_size, hipStream_t stream) {
    static int ready = 0;
    if (!ready) {
        if (n_in != 35 || out_size != (int)O_END || ws_size < WS_END) { fprintf(stderr, "kernel_launch: unexpected shapes n_in %d out %d ws %zu\n", n_in, out_size, ws_size); ready = -1; return; }
        if (hipFuncSetAttribute((const void*)mega, hipFuncAttributeMaxDynamicSharedMemorySize, LDS_BYTES) != hipSuccess) { fprintf(stderr, "kernel_launch: hipFuncSetAttribute failed\n"); ready = -1; return; }
        ready = 1;
    }
    if (ready < 0) return;
    Args a{}; for (int i = 0; i < 35; ++i) a.in[i] = (const float*)d_in[i]; a.out = (float*)d_out; a.ws = (unsigned char*)d_ws;
    (void)hipMemsetAsync((char*)d_ws + OFF_CTL, 0, CTL_ZERO_BYTES, stream);
    launch_mega(a, 0, PH_END, 0, stream);
}
```

```cpp
#include <hip/hip_runtime.h>
#include <stdint.h>
#include <stdio.h>

typedef unsigned short bf16_t;
typedef short bf16x8 __attribute__((ext_vector_type(8)));
typedef float f32x4 __attribute__((ext_vector_type(4)));

constexpr int D = 1024, DEPTH = 4;
constexpr int CB = 32, CL = 256, LB = 8, LL = 1024;
constexpr int MC = CB * CL;
constexpr int M = MC + LB * LL;
constexpr int NSEQ = CB + LB;
constexpr int IN_COLS = 2444;
constexpr int PN = 2432, PNP = 2560;
constexpr int PZ = 0, PX = 384, PU = 1024, PQ = 1280, PK = 1664, PV = 2048;
constexpr int DFF = 4096;
constexpr float EPS = 1e-6f;

constexpr size_t MiB = 1u << 20;
constexpr size_t OFF_CTL = 0, OFF_MODS = 1 * MiB, OFF_TAB = 2 * MiB, OFF_WIN = 8 * MiB, OFF_WOUT = 28 * MiB, OFF_WFF1 = 36 * MiB,
                 OFF_WFF2 = 68 * MiB, OFF_WGLU = 100 * MiB, OFF_DT = 101 * MiB, OFF_X = 102 * MiB, OFF_PROJ = 166 * MiB, OFF_MIX = 242 * MiB,
                 OFF_FFH = 166 * MiB, OFF_H = 294 * MiB, OFF_XBC = 294 * MiB, OFF_YSSD = 334 * MiB, OFF_YS5 = 358 * MiB, WS_END = 374 * MiB;
constexpr size_t TAB_ABAR = 0;
constexpr size_t TAB_BBAR = 256 * 1024;
constexpr size_t TAB_WDT = 2 * MiB;
constexpr size_t TAB_SSQ = 5 * MiB;
constexpr size_t OFF_HIN = 362 * MiB;
constexpr size_t OFF_YU = 294 * MiB;
constexpr size_t TAB_CD = 3 * MiB;
constexpr size_t OFF_CS = 334 * MiB;
constexpr size_t TAB_CC1 = 4 * MiB;
constexpr size_t TAB_BBT = 3 * MiB + 512 * 1024;
constexpr size_t OFF_E = 358 * MiB;

__device__ __forceinline__ float bf2f(bf16_t v) { return __uint_as_float((unsigned)v << 16); }
typedef float f32x2_t __attribute__((ext_vector_type(2))); typedef __bf16 bf16x2_t __attribute__((ext_vector_type(2)));
__device__ __forceinline__ unsigned cvtpk(float lo, float hi) { f32x2_t v = {lo, hi}; bf16x2_t b = __builtin_convertvector(v, bf16x2_t); return __builtin_bit_cast(unsigned, b); }
__device__ __forceinline__ bf16_t f2bf(float f) { return (bf16_t)(cvtpk(f, f) & 0xffffu); }
__device__ __forceinline__ float sigmoid_f(float x) { return __builtin_amdgcn_rcpf(1.f + __expf(-x)); }
__device__ __forceinline__ float silu_f(float x) { return x * sigmoid_f(x); }
__device__ __forceinline__ float softplus_f(float x) { return x > 20.f ? x : log1pf(__expf(x)); }
__device__ __forceinline__ float gelu_tanh_f(float x) { const float u = 1.5957691216057308f * (x + 0.044715f * x * x * x); return x * sigmoid_f(u); }
template <int CTRL> __device__ __forceinline__ float dppf(float x) { return __uint_as_float((unsigned)__builtin_amdgcn_update_dpp(0, (int)__float_as_uint(x), CTRL, 0xf, 0xf, true)); }
__device__ __forceinline__ float row16_sum(float x) { x += dppf<0xB1>(x); x += dppf<0x4E>(x); x += dppf<0x141>(x); x += dppf<0x140>(x); return x; }
__device__ __forceinline__ float row16_max(float x) { x = fmaxf(x, dppf<0xB1>(x)); x = fmaxf(x, dppf<0x4E>(x)); x = fmaxf(x, dppf<0x141>(x)); x = fmaxf(x, dppf<0x140>(x)); return x; }
__device__ __forceinline__ float xsum16(float x) { const auto r = __builtin_amdgcn_permlane16_swap(__float_as_uint(x), __float_as_uint(x), false, false); return __uint_as_float(r[0]) + __uint_as_float(r[1]); }
__device__ __forceinline__ float xsum32(float x) { const auto r = __builtin_amdgcn_permlane32_swap(__float_as_uint(x), __float_as_uint(x), false, false); return __uint_as_float(r[0]) + __uint_as_float(r[1]); }
__device__ __forceinline__ float xmax16(float x) { const auto r = __builtin_amdgcn_permlane16_swap(__float_as_uint(x), __float_as_uint(x), false, false); return fmaxf(__uint_as_float(r[0]), __uint_as_float(r[1])); }
__device__ __forceinline__ float xmax32(float x) { const auto r = __builtin_amdgcn_permlane32_swap(__float_as_uint(x), __float_as_uint(x), false, false); return fmaxf(__uint_as_float(r[0]), __uint_as_float(r[1])); }
__device__ __forceinline__ float rdlane(float x, int l) { return __uint_as_float((unsigned)__builtin_amdgcn_readlane((int)__float_as_uint(x), l)); }
__device__ __forceinline__ float wave_sum(float v) { return xsum32(xsum16(row16_sum(v))); }
__device__ __forceinline__ float wave_max(float v) { return xmax32(xmax16(row16_max(v))); }
__device__ __forceinline__ int mod_row(int row) { return row < MC ? 0 : 1 + ((row - MC) >> 10); }

struct P {
    const float* in[35];
    float* out;
    unsigned char* ws;
};
constexpr size_t O_YP = 0, O_YS = 8388608, O_K = 16777216, O_V = O_K + 12582912, O_SSD = O_V + 12582912, O_RE = O_SSD + 6291456, O_IM = O_RE + 262144, O_END = O_IM + 262144;


#define LAS __attribute__((address_space(3)))
struct SeqInfo { int start, L, b, ctx; };
__device__ __forceinline__ SeqInfo seq_info(int s) { SeqInfo q; if (s < CB) { q.start = s * CL; q.L = CL; q.b = s; q.ctx = 1; } else { q.start = MC + (s - CB) * LL; q.L = LL; q.b = s - CB; q.ctx = 0; } return q; }
__device__ __forceinline__ SeqInfo row_seq(int row) { return seq_info(row < MC ? (row >> 8) : CB + ((row - MC) >> 10)); }
namespace pg8 {
#define PG8_LAS __attribute__((address_space(3)))
typedef unsigned short bf16_t;
typedef short bf16x8 __attribute__((ext_vector_type(8)));
typedef float f32x4 __attribute__((ext_vector_type(4)));
typedef unsigned u32x4 __attribute__((ext_vector_type(4)));
constexpr int BM = 256, BK = 64, HALF = 128, HTB = HALF * BK * 2  , STAGE_BYTES = 8 * HTB, NXCD = 8, WGM = 8;

__host__ __device__ __forceinline__ int lds_byte(int r, int c) { const int st = (r >> 4) * 2 + (c >> 5), rr = r & 15, cc = c & 31, ob = rr * 64 + cc * 2; return st * 1024 + (ob ^ (((ob >> 9) & 1) << 5)); }
__host__ __device__ __forceinline__ void stage_rc(int b, int& R, int& C) { const int st = b / 1024, sb = b % 1024, swz = sb ^ (((sb >> 9) & 1) << 5); R = (st >> 1) * 16 + swz / 64; C = (st & 1) * 32 + (swz % 64) / 2; }
__host__ __device__ __forceinline__ int perm32(int rho) { const int n = rho >> 4, i = rho & 15; return 8 * (i >> 2) + 4 * n + (i & 3); }

struct Unit { int pm, pn; };
struct Gemm { const bf16_t* A; const bf16_t* Bt; int M, N, K; };

struct StaticOrder {
    int nM, nN, nwg, G, c;
    __host__ __device__ void init(int M, int N, int G_, int c_) { nM = M / BM; nN = N / BM; nwg = nM * nN; G = G_; c = c_; }
    __host__ __device__ bool next(int i, Unit& u) const {
        const long L = (long)i * G + c; if (L >= nwg) return false;
        int wgid = (int)L; { const int q = nwg / NXCD, r = nwg % NXCD, xcd = wgid % NXCD, off = wgid / NXCD; wgid = (xcd < r ? xcd * (q + 1) : r * (q + 1) + (xcd - r) * q) + off; }
        const int nig = WGM * nN, gid = wgid / nig, fm = gid * WGM, gsz = (nM - fm) < WGM ? (nM - fm) : WGM;
        u.pm = fm + ((wgid % nig) % gsz); u.pn = (wgid % nig) / gsz; return true;
    }
    __device__ __forceinline__ void a_ready(const Unit&) const {}
    __device__ __forceinline__ void done(const Unit&) const {}
};

__device__ __forceinline__ unsigned cvt_pk_bf16(float lo, float hi) { unsigned r; asm volatile("v_cvt_pk_bf16_f32 %0, %1, %2" : "=v"(r) : "v"(lo), "v"(hi)); return r; }
struct EpiProj {
    static constexpr bool PERM = true, AFTER_DRAIN = false;
    bf16_t* proj; float* ok; float* ov; int l;
    __device__ __forceinline__ void operator()(const f32x4 (&acc)[2][2][4][2], const Unit& u, int wr, int wc, int fr, int fq) const {
        const int row0 = u.pm * BM + wr * 64 + fr;
#pragma unroll
        for (int bj = 0; bj < 2; ++bj) {
            const int cb = u.pn * BM + bj * HALF;
            if (cb >= ::PN) continue;
            const int col = cb + wc * 32 + 8 * fq;
            const bool isk = (cb >= ::PK && cb < ::PV), isv = (cb >= ::PV);
#pragma unroll
            for (int ai = 0; ai < 2; ++ai)
#pragma unroll
                for (int m = 0; m < 4; ++m) {
                    const int row = row0 + ai * HALF + m * 16;
                    const f32x4 v0 = acc[ai][bj][m][0], v1 = acc[ai][bj][m][1];
                    u32x4 w; w.x = cvt_pk_bf16(v0[0], v0[1]); w.y = cvt_pk_bf16(v0[2], v0[3]); w.z = cvt_pk_bf16(v1[0], v1[1]); w.w = cvt_pk_bf16(v1[2], v1[3]);
                    *(u32x4*)(proj + (size_t)row * ::PN + col) = w;
                    if (u.pm < 32 && (isk || isv)) {
                        const int b = row >> 8, t = row & 255;
                        float* o = (isk ? ok : ov) + ((size_t)(b * 4 + l) * 256 + t) * 384 + (col - (isk ? ::PK : ::PV));
                        *(f32x4*)o = v0; *(f32x4*)(o + 4) = v1;
                    }
                }
        }
    }
};
struct EpiRes {
    static constexpr bool PERM = false, AFTER_DRAIN = false;
    const float* xin_c; const float* xin_l; float* xout; const float* mods; int chunk;
    __device__ __forceinline__ void operator()(const f32x4 (&acc)[2][2][4][2], const Unit& u, int wr, int wc, int fr, int fq) const {
        const int row0 = u.pm * BM + wr * 64 + fr, col0 = u.pn * BM + wc * 32 + 4 * fq;
        const int r = u.pm < 32 ? 0 : 1 + ((u.pm - 32) >> 2);
        const float* gate = mods + (size_t)r * 6144 + chunk * 1024;
        const float* xin = u.pm < 32 ? xin_c : xin_l;
#pragma unroll
        for (int bj = 0; bj < 2; ++bj)
#pragma unroll
            for (int n = 0; n < 2; ++n) {
                const int col = col0 + bj * HALF + n * 16;
                const f32x4 g = *(const f32x4*)(gate + col);
#pragma unroll
                for (int ai = 0; ai < 2; ++ai)
#pragma unroll
                    for (int m = 0; m < 4; ++m) {
                        const size_t off = (size_t)(row0 + ai * HALF + m * 16) * ::D + col;
                        const f32x4 xi = *(const f32x4*)(xin + off);
                        *(f32x4*)(xout + off) = xi + g * acc[ai][bj][m][n];
                    }
            }
    }
};
struct EpiFF1 {
    static constexpr bool PERM = true, AFTER_DRAIN = false;
    bf16_t* h;
    __device__ __forceinline__ void operator()(const f32x4 (&acc)[2][2][4][2], const Unit& u, int wr, int wc, int fr, int fq) const {
        const int row0 = u.pm * BM + wr * 64 + fr, col0 = u.pn * BM + wc * 32 + 8 * fq;
#pragma unroll
        for (int ai = 0; ai < 2; ++ai)
#pragma unroll
            for (int m = 0; m < 4; ++m) {
                bf16_t* rowp = h + (size_t)(row0 + ai * HALF + m * 16) * ::DFF + col0;
#pragma unroll
                for (int bj = 0; bj < 2; ++bj) {
                    f32x4 v0 = acc[ai][bj][m][0], v1 = acc[ai][bj][m][1];
#pragma unroll
                    for (int e = 0; e < 4; ++e) { const float a = fmaxf(v0[e], 0.f), b = fmaxf(v1[e], 0.f); v0[e] = a * a; v1[e] = b * b; }
                    u32x4 w; w.x = cvt_pk_bf16(v0[0], v0[1]); w.y = cvt_pk_bf16(v0[2], v0[3]); w.z = cvt_pk_bf16(v1[0], v1[1]); w.w = cvt_pk_bf16(v1[2], v1[3]);
                    *(u32x4*)(rowp + bj * HALF) = w;
                }
            }
    }
};
template <class Epi, class Sched, bool ALIGN_EPI = false, bool SP2 = false>
__device__ __forceinline__ void gemm_phase(PG8_LAS unsigned char* lds, const Gemm g, const Sched& S, const Epi& E) {
    int tid_ = threadIdx.x; asm volatile("" : "+v"(tid_));
    const int tid = tid_, wid = __builtin_amdgcn_readfirstlane(tid >> 6), lane = tid & 63, wr = wid >> 2, wc = wid & 3, fr = lane & 15, fq = lane >> 4;
    const int K = g.K, nt = K / BK;
    unsigned voffA[2], voffB[2];
#pragma unroll
    for (int i = 0; i < 2; ++i) { int R, C; stage_rc(tid * 16 + i * 8192, R, C); const int Rb = Epi::PERM ? ((R & ~31) + perm32(R & 31)) : R;
        voffA[i] = (unsigned)(R * K + C) * 2u; voffB[i] = (unsigned)(Rb * K + C) * 2u; }
    const size_t kstep = (size_t)(BK * 2);
    const size_t hstep = (size_t)HALF * K * 2;
    const size_t tstep = 2 * hstep;
    const unsigned ldsw = (unsigned)wid * 1024u;
    const int aoff = lds_byte(wr * 64 + fr, fq * 8), boff = lds_byte(wc * 32 + fr, fq * 8);
#define PG8_SA(b, h) (((b) * 2 + (h)) * HTB)
#define PG8_SB(b, h) ((4 + (b) * 2 + (h)) * HTB)
#define PG8_STAGE(bufoff, gbase, voff) do { _Pragma("unroll") for (int _i = 0; _i < 2; ++_i) \
        __builtin_amdgcn_global_load_lds((const unsigned*)((const char*)(gbase) + (voff)[_i]), (PG8_LAS unsigned*)(lds + (bufoff) + ldsw + _i * 8192), 16, 0, 0); } while (0)
#define PG8_LDA(dst, b, h) do { _Pragma("unroll") for (int m = 0; m < 4; ++m) _Pragma("unroll") for (int k = 0; k < 2; ++k) dst[m][k] = *(const PG8_LAS bf16x8*)(lds + PG8_SA(b, h) + aoff + m * 2048 + k * 1024); } while (0)
#define PG8_LDB(dst, b, h) do { _Pragma("unroll") for (int n = 0; n < 2; ++n) _Pragma("unroll") for (int k = 0; k < 2; ++k) dst[n][k] = *(const PG8_LAS bf16x8*)(lds + PG8_SB(b, h) + boff + n * 2048 + k * 1024); } while (0)
#define PG8_MMA(ai, bj, At, Bt) do { __builtin_amdgcn_s_setprio(1); _Pragma("unroll") for (int m = 0; m < 4; ++m) _Pragma("unroll") for (int n = 0; n < 2; ++n) _Pragma("unroll") for (int k = 0; k < 2; ++k) \
        acc[ai][bj][m][n] = __builtin_amdgcn_mfma_f32_16x16x32_bf16(Bt[n][k], At[m][k], acc[ai][bj][m][n], 0, 0, 0); __builtin_amdgcn_s_setprio(0); } while (0)
#define PG8_WAIT_V(n) asm volatile("s_waitcnt vmcnt(" #n ")" ::: "memory")
#define PG8_WAIT_L(n) asm volatile("s_waitcnt lgkmcnt(" #n ")" ::: "memory")
#define PG8_BAR __builtin_amdgcn_s_barrier()
#define PG8_SCHED __builtin_amdgcn_sched_barrier(0)
    Unit cur, nxt; int ui = 0;
    if (!S.next(0, cur)) return;
    f32x4 acc[2][2][4][2];
#pragma unroll
    for (int a = 0; a < 2; ++a)
#pragma unroll
        for (int b = 0; b < 2; ++b)
#pragma unroll
            for (int m = 0; m < 4; ++m)
#pragma unroll
                for (int n = 0; n < 2; ++n) acc[a][b][m][n] = (f32x4){0.f, 0.f, 0.f, 0.f};
    bf16x8 At[4][2], B0[2][2], B1[2][2];
    const char* cA = (const char*)g.A + (size_t)cur.pm * tstep; const char* cB = (const char*)g.Bt + (size_t)cur.pn * tstep;
    S.a_ready(cur);
    if constexpr (SP2) {
        PG8_STAGE(PG8_SB(0, 0), cB, voffB); PG8_STAGE(PG8_SB(0, 1), cB + hstep, voffB); PG8_STAGE(PG8_SA(0, 0), cA, voffA); PG8_STAGE(PG8_SA(0, 1), cA + hstep, voffA);
        if (wr == 1) PG8_BAR;
        PG8_WAIT_V(2); PG8_BAR;
        PG8_STAGE(PG8_SB(1, 0), cB + kstep, voffB); PG8_STAGE(PG8_SA(1, 0), cA + kstep, voffA); PG8_STAGE(PG8_SB(1, 1), cB + hstep + kstep, voffB);
        PG8_WAIT_V(6); PG8_BAR;
    } else {
        PG8_STAGE(PG8_SB(0, 0), cB, voffB); PG8_STAGE(PG8_SA(0, 0), cA, voffA); PG8_STAGE(PG8_SB(0, 1), cB + hstep, voffB); PG8_STAGE(PG8_SA(0, 1), cA + hstep, voffA);
        if (wr == 1) PG8_BAR;
        PG8_WAIT_V(4); PG8_BAR;
        PG8_STAGE(PG8_SB(1, 0), cB + kstep, voffB); PG8_STAGE(PG8_SA(1, 0), cA + kstep, voffA); PG8_STAGE(PG8_SB(1, 1), cB + hstep + kstep, voffB);
        PG8_WAIT_V(6); PG8_BAR;
    }
    for (;;) {
        const bool has_next = S.next(ui + 1, nxt);
        const char* nA = has_next ? (const char*)g.A + (size_t)nxt.pm * tstep : cA; const char* nB = has_next ? (const char*)g.Bt + (size_t)nxt.pn * tstep : cB;
        for (int t = 0; t < nt; t += 2) {
            const bool last = (t == nt - 2);
            const char* a1 = cA + (size_t)(t + 1) * kstep;
            const char* a2 = last ? nA : cA + (size_t)(t + 2) * kstep; const char* b2 = last ? nB : cB + (size_t)(t + 2) * kstep;
            const char* a3 = a2 + kstep; const char* b3 = b2 + kstep;
            if (last && has_next) S.a_ready(nxt);
            if constexpr (SP2) {
            PG8_LDB(B0, 0, 0); PG8_LDB(B1, 0, 1); PG8_SCHED; PG8_LDA(At, 0, 0); PG8_STAGE(PG8_SA(1, 1), a1 + hstep, voffA);
            PG8_WAIT_V(8); PG8_WAIT_L(0); PG8_BAR; PG8_MMA(0, 0, At, B0); PG8_MMA(0, 1, At, B1); PG8_BAR; PG8_SCHED;
            PG8_LDA(At, 0, 1); PG8_STAGE(PG8_SB(0, 0), b2, voffB); PG8_STAGE(PG8_SB(0, 1), b2 + hstep, voffB); PG8_STAGE(PG8_SA(0, 0), a2, voffA);
            PG8_WAIT_V(8); PG8_WAIT_L(0); PG8_BAR; PG8_MMA(1, 0, At, B0); PG8_MMA(1, 1, At, B1); PG8_BAR; PG8_SCHED;
            PG8_LDB(B0, 1, 0); PG8_LDB(B1, 1, 1); PG8_SCHED; PG8_LDA(At, 1, 0); PG8_STAGE(PG8_SA(0, 1), a2 + hstep, voffA);
            PG8_WAIT_V(8); PG8_WAIT_L(0); PG8_BAR; PG8_MMA(0, 0, At, B0); PG8_MMA(0, 1, At, B1); PG8_BAR; PG8_SCHED;
            PG8_LDA(At, 1, 1); PG8_STAGE(PG8_SB(1, 0), b3, voffB); PG8_STAGE(PG8_SB(1, 1), b3 + hstep, voffB); PG8_STAGE(PG8_SA(1, 0), a3, voffA);
            PG8_WAIT_V(8); PG8_WAIT_L(0); PG8_BAR; PG8_MMA(1, 0, At, B0); PG8_MMA(1, 1, At, B1); PG8_BAR; PG8_SCHED;
            } else {
            PG8_LDB(B0, 0, 0); PG8_SCHED; PG8_LDA(At, 0, 0); PG8_STAGE(PG8_SA(1, 1), a1 + hstep, voffA);
            PG8_WAIT_L(8); PG8_BAR; PG8_WAIT_L(0); PG8_MMA(0, 0, At, B0); PG8_BAR; PG8_SCHED;
            PG8_LDB(B1, 0, 1); PG8_STAGE(PG8_SB(0, 0), b2, voffB);
            PG8_BAR; PG8_WAIT_L(0); PG8_MMA(0, 1, At, B1); PG8_BAR;
            PG8_LDA(At, 0, 1); PG8_STAGE(PG8_SA(0, 0), a2, voffA);
            PG8_BAR; PG8_WAIT_L(0); PG8_MMA(1, 0, At, B0); PG8_BAR; PG8_SCHED;
            PG8_STAGE(PG8_SB(0, 1), b2 + hstep, voffB);
            PG8_WAIT_V(6); PG8_BAR; PG8_MMA(1, 1, At, B1); PG8_BAR;
            PG8_LDB(B0, 1, 0); PG8_SCHED; PG8_LDA(At, 1, 0); PG8_STAGE(PG8_SA(0, 1), a2 + hstep, voffA);
            PG8_WAIT_L(8); PG8_BAR; PG8_WAIT_L(0); PG8_MMA(0, 0, At, B0); PG8_BAR; PG8_SCHED;
            PG8_LDB(B1, 1, 1); PG8_STAGE(PG8_SB(1, 0), b3, voffB);
            PG8_BAR; PG8_WAIT_L(0); PG8_MMA(0, 1, At, B1); PG8_BAR;
            PG8_LDA(At, 1, 1); PG8_STAGE(PG8_SA(1, 0), a3, voffA);
            PG8_BAR; PG8_WAIT_L(0); PG8_MMA(1, 0, At, B0); PG8_BAR; PG8_SCHED;
            PG8_STAGE(PG8_SB(1, 1), b3 + hstep, voffB);
            PG8_WAIT_V(6); PG8_BAR; PG8_MMA(1, 1, At, B1); PG8_BAR;
            }
        }
        if constexpr (ALIGN_EPI) { if (wr == 0) PG8_BAR; }
        if constexpr (!Epi::AFTER_DRAIN) { E(acc, cur, wr, wc, fr, fq); S.done(cur); }
        if (!has_next) break;
#pragma unroll
        for (int a = 0; a < 2; ++a)
#pragma unroll
            for (int b = 0; b < 2; ++b)
#pragma unroll
                for (int m = 0; m < 4; ++m)
#pragma unroll
                    for (int n = 0; n < 2; ++n) acc[a][b][m][n] = (f32x4){0.f, 0.f, 0.f, 0.f};
        cur = nxt; cA = nA; cB = nB; ++ui;
        if constexpr (ALIGN_EPI) { if (wr == 1) PG8_BAR; }
    }
    PG8_WAIT_V(0);
    if constexpr (!ALIGN_EPI) { if (wr == 0) PG8_BAR; }
    PG8_BAR;
    if constexpr (Epi::AFTER_DRAIN) { E.fused(acc, cur, wr, wc, fr, fq, lds, wid, lane); S.done(cur); }
#undef PG8_SA
#undef PG8_SB
#undef PG8_STAGE
#undef PG8_LDA
#undef PG8_LDB
#undef PG8_MMA
#undef PG8_WAIT_V
#undef PG8_WAIT_L
#undef PG8_BAR
#undef PG8_SCHED
}
}

constexpr int NWAVES = 8, NTHREADS = 512;
constexpr int RING_BYTES = 131072, LDS_BYTES = 163840, LDSCTL_OFF = LDS_BYTES - 512, MISC_OFF = LDSCTL_OFF + 320;
#define GAS __attribute__((address_space(1)))
typedef unsigned v4u __attribute__((ext_vector_type(4)));
typedef GAS unsigned gu32;
#define LDS_WAIT() asm volatile("s_waitcnt lgkmcnt(0)" ::: "memory")
#define VM_WAIT() asm volatile("s_waitcnt vmcnt(0)" ::: "memory")
__device__ __forceinline__ unsigned pk2(float lo, float hi) { return cvtpk(lo, hi); }
constexpr int CW_BAR = 4096, CW_Q = 65536;
constexpr size_t CTL_ZERO_BYTES = 1 * MiB;

#define XB_TMO      128
#define XB_XCNT(j)  (256  + 64 * (j))
#define XB_XSUB(j)  (1280 + 64 * (j))
#define XB_XGEN(j)  (2304 + 64 * (j))
#define XB_TOP      3328
#define XB_TOPGEN   3392
#define XCD_BAR_WORDS 3456
#define XB_SPIN_CAP (1u << 18)

__device__ __forceinline__ unsigned xb_ld(unsigned* p)              { return __hip_atomic_load(p, __ATOMIC_RELAXED, __HIP_MEMORY_SCOPE_AGENT); }
__device__ __forceinline__ unsigned xb_add(unsigned* p, unsigned v) { return __hip_atomic_fetch_add(p, v, __ATOMIC_RELAXED, __HIP_MEMORY_SCOPE_AGENT); }
__device__ __forceinline__ unsigned xb_xcc_id() { return (unsigned)__builtin_amdgcn_s_getreg((3 << 11) | 20) & 0xFu; }
#define XB_SPIN(cond, bar) do { unsigned _sp = 0; while (cond) { __builtin_amdgcn_s_sleep(1); \
    if ((++_sp & 255u) == 0u) { if (xb_ld(&(bar)[XB_TMO])) break; if (_sp > XB_SPIN_CAP) { atomicAdd(&(bar)[XB_TMO], 1u); break; } } } } while (0)

struct XcdBarrier {
    unsigned* bar; unsigned x;
    volatile LAS unsigned* st;
};

__device__ __forceinline__ XcdBarrier xcd_barrier_post(unsigned* bar, volatile LAS unsigned* st) {
    XcdBarrier b; b.bar = bar; b.x = xb_xcc_id(); b.st = st;
    if (threadIdx.x == 0) (void)xb_add(&bar[XB_XCNT(b.x)], 1u);
    return b;
}
__device__ __forceinline__ void xcd_barrier_complete(unsigned* bar, unsigned x, unsigned& nloc, unsigned& nx) {
    const unsigned G = gridDim.x * gridDim.y * gridDim.z;
    unsigned sum, cnt, mine, sp = 0u;
    for (;;) {
        sum = 0u; cnt = 0u; mine = 0u;
#pragma unroll
        for (unsigned j = 0; j < 16; ++j) { const unsigned c = xb_ld(&bar[XB_XCNT(j)]); sum += c; cnt += (c > 0u) ? 1u : 0u; mine = (j == x) ? c : mine; }
        if (sum == G) break;
        __builtin_amdgcn_s_sleep(1);
        if ((++sp & 255u) == 0u) { if (xb_ld(&bar[XB_TMO])) break; if (sp > XB_SPIN_CAP) { atomicAdd(&bar[XB_TMO], 1u); break; } }
    }
    nloc = mine > 0u ? mine : 1u; nx = cnt > 0u ? cnt : 1u;
}

__device__ __forceinline__ void xcd_barrier(const XcdBarrier& b) {
    asm volatile("s_waitcnt vmcnt(0)" ::: "memory");
    __syncthreads();
    if (threadIdx.x == 0) {
        unsigned* bar = b.bar;
        __builtin_amdgcn_s_waitcnt(0);
        unsigned nloc = b.st[0], nx = b.st[1];
        if (nloc == 0u) { xcd_barrier_complete(bar, b.x, nloc, nx); b.st[0] = nloc; b.st[1] = nx; }
        const unsigned old = xb_add(&bar[XB_XSUB(b.x)], 1u);
        const unsigned gen = old / nloc;
        if (old + 1u == (gen + 1u) * nloc) {
            __builtin_amdgcn_fence(__ATOMIC_RELEASE, "agent");
            asm volatile("s_waitcnt vmcnt(0)" ::: "memory");
            const unsigned og = xb_add(&bar[XB_TOP], 1u);
            const unsigned tg = og / nx;
            if (og + 1u == (tg + 1u) * nx) xb_add(&bar[XB_TOPGEN], 1u);
            else XB_SPIN(xb_ld(&bar[XB_TOPGEN]) == tg, bar);
            __builtin_amdgcn_fence(__ATOMIC_ACQUIRE, "agent");
            xb_add(&bar[XB_XGEN(b.x)], 1u);
            asm volatile("s_waitcnt vmcnt(0)" ::: "memory");
        } else {
            XB_SPIN(xb_ld(&bar[XB_XGEN(b.x)]) == gen, bar);
            __builtin_amdgcn_fence(__ATOMIC_ACQUIRE, "agent");
            asm volatile("s_waitcnt vmcnt(0)" ::: "memory");
        }
    }
    __syncthreads();
}


struct Frame {
    LAS unsigned char* lds;
    volatile LAS unsigned* MISC;
    unsigned* ctl;
    int tid, lane, wave, vcu, G;
    const float* const* in; float* out; unsigned char* ws;
};
constexpr int PH_PRO = 0, PH_PER_LAYER = 8, PH_NORM1 = 0, PH_G1 = 1, PH_MIXA = 2, PH_MIXB = 3, PH_G3 = 4, PH_NORM2 = 5, PH_G4 = 6, PH_G5 = 7, PH_FINAL = 1 + DEPTH * PH_PER_LAYER, PH_END = PH_FINAL + 1;

__device__ __forceinline__ int queue_next(Frame& F, unsigned* ctr);
constexpr int TR_P = 144;
__device__ __forceinline__ void transpose_item(const float* W, int K, int Nsrc, int src_n0, bf16_t* WT, int dst_n0, int k0, LAS unsigned char* scr, int lane) {
    const int l16 = lane & 15, l4 = lane >> 4;
    f32x4 v[16];
#pragma unroll
    for (int i = 0; i < 16; ++i) v[i] = src_n0 >= 0 ? *(const f32x4*)(W + (size_t)(k0 + 4 * i + l4) * Nsrc + src_n0 + 4 * l16) : (f32x4){0.f, 0.f, 0.f, 0.f};
#pragma unroll
    for (int i = 0; i < 16; ++i)
#pragma unroll
        for (int e = 0; e < 4; ++e) *(LAS bf16_t*)(scr + (4 * l16 + e) * TR_P + (4 * i + l4) * 2) = f2bf(v[i][e]);
    LDS_WAIT(); asm volatile("" ::: "memory");
#pragma unroll
    for (int jn = 0; jn < 8; ++jn) { const int n = 8 * jn + (lane >> 3), c = lane & 7;
        *(v4u*)(WT + (size_t)(dst_n0 + n) * K + k0 + 8 * c) = *(LAS const v4u*)(scr + n * TR_P + c * 16); }
    LDS_WAIT(); asm volatile("" ::: "memory");
}
__device__ __forceinline__ void phase_prologue(Frame& F) {
    const float* const* in = F.in;
    for (int idx = F.vcu * NTHREADS + F.tid; idx < 8192; idx += F.G * NTHREADS) {
        const int pp = idx & 63, g = (idx >> 6) & 15, dir = (idx >> 10) & 1, l = idx >> 11;
        const float are = in[20][idx], aim = in[21][idx];
        const float dt = __expf(in[22][(l * 2 + dir) * 16 + g]);
        const float zr = are * dt, zi = aim * dt;
        const float e = expf(zr); float rev = zi * 0.15915494309189535f; rev -= rintf(rev);
        const float ar = e * cosf(rev * 6.283185307179586f), ai = e * sinf(rev * 6.283185307179586f);
        float* abar = (float*)(F.ws + OFF_TAB + TAB_ABAR);
        abar[idx * 2] = ar; abar[idx * 2 + 1] = ai;
        const float xr = ar - 1.f, xi = ai, den = are * are + aim * aim;
        const float fr = (xr * are + xi * aim) / den, fi = (xi * are - xr * aim) / den;
        for (int c = 0; c < 16; ++c) {
            const float br = in[23][((l * 16 + g) * 64 + pp) * 16 + c], bi = in[24][((l * 16 + g) * 64 + pp) * 16 + c];
            bf16_t* bbt = (bf16_t*)(F.ws + OFF_TAB + TAB_BBT) + ((size_t)(((l * 2 + dir) * 16 + g) * 2) * 64 + pp) * 16 + c;
            bbt[0] = f2bf(fr * br - fi * bi); bbt[64 * 16] = f2bf(fr * bi + fi * br);
        }
    }
    for (int i = F.vcu * NTHREADS + F.tid; i < 4 * 16 * 16 * 128; i += F.G * NTHREADS) {
        const int k = i & 127, c = (i >> 7) & 15, g = (i >> 11) & 15, l = i >> 15, ri = k >> 6, pp = k & 63;
        const size_t si = ((size_t)(l * 16 + g) * 16 + c) * 64 + pp;
        ((bf16_t*)(F.ws + OFF_TAB + TAB_CC1))[i] = f2bf(ri ? -in[26][si] : in[25][si]);
    }
    for (int i = F.vcu * NTHREADS + F.tid; i < 4 * 12 * 1024; i += F.G * NTHREADS) {
        const int k = i & 1023, j = (i >> 10) % 12, l = i / (12 * 1024);
        ((float*)(F.ws + OFF_TAB + TAB_WDT))[i] = in[13][((size_t)l * 1024 + k) * IN_COLS + 1024 + j];
    }
    constexpr int I_IN = 16 * (PNP / 64), I_OUT = 16 * 16, I_F1 = 16 * (DFF / 64), I_F2 = (DFF / 64) * 16, I_GLU = 4 * 4, I_L = I_IN + I_OUT + I_F1 + I_F2 + I_GLU, N_TR = DEPTH * I_L;
    constexpr int N_UNITS = 96 + (N_TR + 7) / 8;
    unsigned* ctr = F.ctl + CW_Q + 64 * 63;
    for (;;) {
        const int u = queue_next(F, ctr); if (u >= N_UNITS) break;
        if (u < 96) {
            LAS float* ssil = (LAS float*)F.lds;
            LAS float* part = (LAS float*)(F.lds + 9 * 1024 * 4);
            for (int i = F.tid; i < 9 * 1024; i += NTHREADS) { const int r = i >> 10, k = i & 1023; const float v = r == 0 ? in[8][k] : in[7][(r - 1) * 1024 + k]; ssil[i] = silu_f(v); }
            __syncthreads();
            const int l = u / 24, n0 = (u % 24) * 256;
            const float* w = in[9] + (size_t)l * 1024 * 6144 + n0 + 4 * F.lane;
            f32x4 acc[9];
#pragma unroll
            for (int r = 0; r < 9; ++r) acc[r] = (f32x4){0.f, 0.f, 0.f, 0.f};
            const int kb = F.wave * 128;
            for (int k = 0; k < 128; k += 4) {
                f32x4 wv[4];
#pragma unroll
                for (int e = 0; e < 4; ++e) wv[e] = *(const f32x4*)(w + (size_t)(kb + k + e) * 6144);
#pragma unroll
                for (int r = 0; r < 9; ++r) { const f32x4 sv = *(LAS const f32x4*)(ssil + r * 1024 + kb + k);
                    acc[r] += wv[0] * sv[0]; acc[r] += wv[1] * sv[1]; acc[r] += wv[2] * sv[2]; acc[r] += wv[3] * sv[3]; }
            }
#pragma unroll
            for (int r = 0; r < 9; ++r) *(LAS f32x4*)(part + (F.wave * 9 + r) * 256 + 4 * F.lane) = acc[r];
            __syncthreads();
            float* mods = (float*)(F.ws + OFF_MODS);
            for (int i = F.tid; i < 9 * 256; i += NTHREADS) { const int r = i >> 8, jn = i & 255; float sacc = in[10][l * 6144 + n0 + jn];
#pragma unroll
                for (int w8 = 0; w8 < 8; ++w8) sacc += part[(w8 * 9 + r) * 256 + jn];
                mods[(size_t)(l * 9 + r) * 6144 + n0 + jn] = sacc; }
        } else {
            const int it = (u - 96) * 8 + F.wave;
            if (it < N_TR) {
                LAS unsigned char* scr = F.lds + F.wave * (64 * TR_P);
                const int l = it / I_L; int r = it % I_L;
                if (r < I_IN) { const int nb = r % (PNP / 64), kb = r / (PNP / 64), n0 = nb * 64; const int src = n0 >= PN ? -1 : (n0 >= 1024 ? n0 + 12 : n0);
                    transpose_item(in[13] + (size_t)l * 1024 * IN_COLS, 1024, IN_COLS, src, (bf16_t*)(F.ws + OFF_WIN) + (size_t)l * PNP * 1024, n0, kb * 64, scr, F.lane); }
                else if ((r -= I_IN) < I_OUT) { const int nb = r % 16, kb = r / 16; transpose_item(in[31] + (size_t)l * 1024 * 1024, 1024, 1024, nb * 64, (bf16_t*)(F.ws + OFF_WOUT) + (size_t)l * 1024 * 1024, nb * 64, kb * 64, scr, F.lane); }
                else if ((r -= I_OUT) < I_F1) { const int nb = r % (DFF / 64), kb = r / (DFF / 64); transpose_item(in[32] + (size_t)l * 1024 * DFF, 1024, DFF, nb * 64, (bf16_t*)(F.ws + OFF_WFF1) + (size_t)l * DFF * 1024, nb * 64, kb * 64, scr, F.lane); }
                else if ((r -= I_F1) < I_F2) { const int nb = r % 16, kb = r / 16; transpose_item(in[33] + (size_t)l * DFF * 1024, DFF, 1024, nb * 64, (bf16_t*)(F.ws + OFF_WFF2) + (size_t)l * 1024 * DFF, nb * 64, kb * 64, scr, F.lane); }
                else { r -= I_F2; const int nb = r % 4, kb = r / 4; transpose_item(in[28] + (size_t)l * 65536, 256, 256, nb * 64, (bf16_t*)(F.ws + OFF_WGLU) + (size_t)l * 65536, nb * 64, kb * 64, scr, F.lane); }
            }
        }
    }
}
__device__ __forceinline__ void phase_norm(Frame& F, int l, int which) {
    const float* const* in = F.in; const int lane = F.lane;
    const float* gw = in[which ? 12 : 11] + l * D;
    for (int row = F.vcu * NWAVES + F.wave; row < M; row += F.G * NWAVES) {
        const float* xr = (l == 0 && which == 0) ? (row < MC ? in[0] + (size_t)row * D : in[1] + (size_t)(row - MC) * D) : (const float*)(F.ws + OFF_X) + (size_t)row * D;
        const float* mods = (const float*)(F.ws + OFF_MODS) + (size_t)(l * 9 + mod_row(row)) * 6144;
        const float* sh = mods + (which ? 3 : 0) * 1024; const float* sc = mods + (which ? 4 : 1) * 1024;
        f32x4 v[4]; float s = 0.f;
#pragma unroll
        for (int j = 0; j < 4; ++j) { v[j] = *(const f32x4*)(xr + 4 * lane + 256 * j); s += v[j].x * v[j].x + v[j].y * v[j].y + v[j].z * v[j].z + v[j].w * v[j].w; }
        const float rstd = rsqrtf(wave_sum(s) * (1.f / D) + EPS);
        bf16_t* h = (bf16_t*)(F.ws + OFF_H) + (size_t)row * D;
#pragma unroll
        for (int j = 0; j < 4; ++j) { const int c = 4 * lane + 256 * j; const f32x4 g = *(const f32x4*)(gw + c), a = *(const f32x4*)(sc + c), b = *(const f32x4*)(sh + c);
            v[j].x = v[j].x * rstd * g.x * (1.f + a.x) + b.x; v[j].y = v[j].y * rstd * g.y * (1.f + a.y) + b.y; v[j].z = v[j].z * rstd * g.z * (1.f + a.z) + b.z; v[j].w = v[j].w * rstd * g.w * (1.f + a.w) + b.w;
            uint2 o; o.x = pk2(v[j].x, v[j].y); o.y = pk2(v[j].z, v[j].w); *(uint2*)(h + c) = o; }
        if (which == 0) {
            const float* wdt = (const float*)(F.ws + OFF_TAB + TAB_WDT) + (size_t)l * 12 * 1024;
            float* dt = (float*)(F.ws + OFF_DT) + (size_t)row * 12;
            float mine = 0.f;
#pragma unroll
            for (int jj = 0; jj < 12; ++jj) { float a = 0.f;
#pragma unroll
                for (int j = 0; j < 4; ++j) { const f32x4 w = *(const f32x4*)(wdt + jj * 1024 + 4 * lane + 256 * j); a += v[j].x * w.x + v[j].y * w.y + v[j].z * w.z + v[j].w * w.w; }
                a = wave_sum(a); if (lane == jj) mine = a; }
            if (lane < 12) dt[lane] = mine;
        }
    }
}
__device__ __forceinline__ void phase_final(Frame& F) {
    const int lane = F.lane; const float* gw = F.in[34];
    for (int row = F.vcu * NWAVES + F.wave; row < M; row += F.G * NWAVES) {
        const float* xr = (const float*)(F.ws + OFF_X) + (size_t)row * D;
        f32x4 v[4]; float s = 0.f;
#pragma unroll
        for (int j = 0; j < 4; ++j) { v[j] = *(const f32x4*)(xr + 4 * lane + 256 * j); s += v[j].x * v[j].x + v[j].y * v[j].y + v[j].z * v[j].z + v[j].w * v[j].w; }
        const float rstd = rsqrtf(wave_sum(s) * (1.f / D) + EPS);
        float* o = F.out + (size_t)row * D;
#pragma unroll
        for (int j = 0; j < 4; ++j) { const int c = 4 * lane + 256 * j; const f32x4 g = *(const f32x4*)(gw + c); f32x4 r = {v[j].x * rstd * g.x, v[j].y * rstd * g.y, v[j].z * rstd * g.z, v[j].w * rstd * g.w}; *(f32x4*)(o + c) = r; }
    }
}


typedef short v4i16_t __attribute__((ext_vector_type(4)));
constexpr int AT_KP = 160;
constexpr int AT_TILE = 64 * AT_KP;
constexpr int AT_K0 = 0, AT_V0 = 2 * AT_TILE, AT_RPB = 4 * AT_TILE, AT_END = AT_RPB + 2048;
__device__ __forceinline__ int queue_next(Frame& F, unsigned* ctr) {
    __syncthreads();
    if (F.tid == 0) F.MISC[16] = atomicAdd(ctr, 1u);
    __syncthreads();
    { int t_ = F.tid; asm volatile("" : "+v"(t_)); F.tid = t_; F.lane = t_ & 63; }
    return (int)F.MISC[16];
}
__device__ __forceinline__ bf16x8 tr2(LAS const unsigned char* a, LAS const unsigned char* b) {
    const v4i16_t x = __builtin_amdgcn_ds_read_tr16_b64_v4i16((LAS v4i16_t*)a), y = __builtin_amdgcn_ds_read_tr16_b64_v4i16((LAS v4i16_t*)b);
    return (bf16x8){x[0], x[1], x[2], x[3], y[0], y[1], y[2], y[3]};
}
struct AttnState { f32x4 o[4]; float m, l; };
template <int NKB, bool MASKED>
__device__ __forceinline__ void attn_tile(AttnState& st, LAS const unsigned char* Kt, LAS const unsigned char* Vt, const bf16x8 (&qf)[2], int c0, int lane,
                                          LAS const float* rpbrow, const int (&dk)[2][4]) {
    const int fr = lane & 15, fq = lane >> 4;
    f32x4 s[NKB];
#pragma unroll
    for (int kb = 0; kb < NKB; ++kb) {
        s[kb] = (f32x4){0.f, 0.f, 0.f, 0.f};
#pragma unroll
        for (int ks = 0; ks < 2; ++ks) {
            const bf16x8 a = *(LAS const bf16x8*)(Kt + (c0 + 16 * kb + fr) * AT_KP + (32 * ks + 8 * fq) * 2);
            s[kb] = __builtin_amdgcn_mfma_f32_16x16x32_bf16(a, qf[ks], s[kb], 0, 0, 0);
        }
    }
    float mloc = -1e30f;
#pragma unroll
    for (int kb = 0; kb < NKB; ++kb)
#pragma unroll
        for (int i = 0; i < 4; ++i) {
            float t = s[kb][i] * 0.125f;
            if (MASKED) { const int d = dk[kb & 1][i]; t = d >= 0 ? t + rpbrow[d] : -1e30f; }
            s[kb][i] = t; mloc = fmaxf(mloc, t);
        }
    mloc = xmax32(xmax16(mloc));
    const float mn = fmaxf(st.m, mloc), alpha = __expf(st.m - mn);
    st.m = mn;
    float ls = 0.f;
#pragma unroll
    for (int kb = 0; kb < NKB; ++kb)
#pragma unroll
        for (int i = 0; i < 4; ++i) { const float pv = __expf(s[kb][i] - mn); s[kb][i] = pv; ls += pv; }
    st.l = st.l * alpha + ls;
#pragma unroll
    for (int db = 0; db < 4; ++db) st.o[db] = st.o[db] * alpha;
#pragma unroll
    for (int kk = 0; kk < NKB / 2; ++kk) {
        union { bf16x8 v; unsigned u[4]; } pf;
        pf.u[0] = pk2(s[2 * kk][0], s[2 * kk][1]); pf.u[1] = pk2(s[2 * kk][2], s[2 * kk][3]);
        pf.u[2] = pk2(s[2 * kk + 1][0], s[2 * kk + 1][1]); pf.u[3] = pk2(s[2 * kk + 1][2], s[2 * kk + 1][3]);
        LAS const unsigned char* va = Vt + (c0 + 32 * kk + 4 * fq + (fr >> 2)) * AT_KP + (4 * (fr & 3)) * 2;
#pragma unroll
        for (int db = 0; db < 4; ++db) {
            const bf16x8 vf = tr2(va + db * 32, va + 16 * AT_KP + db * 32);
            st.o[db] = __builtin_amdgcn_mfma_f32_16x16x32_bf16(vf, pf.v, st.o[db], 0, 0, 0);
        }
    }
}
__device__ __forceinline__ void attn_unit(Frame& F, int l, int unit) {
    const int tid = F.tid, lane = F.lane, w = F.wave, fr = lane & 15, fq = lane >> 4;
    const bf16_t* proj = (const bf16_t*)(F.ws + OFF_PROJ);
    LAS unsigned char* lds = F.lds;
    const bool nat = unit < 384;
    int b, h, qrow, r = 0, rs_w = 0, rs0 = 0, nlat = 0, c0 = 0;
    if (nat) { b = unit / 48; h = (unit / 8) % 6; const int rp = unit % 8; r = 2 * rp + (w >> 2); const int j = w & 3;
        qrow = MC + b * 1024 + r * 64 + 16 * j + fr;
        rs_w = min(max(r - 4, 0), 8); rs0 = min(max(2 * rp - 4, 0), 8); const int rs1 = min(max(2 * rp + 1 - 4, 0), 8); nlat = rs1 + 8 - rs0;
        c0 = j == 0 ? 0 : (j == 1 ? 8 : (j == 2 ? 24 : 32));
    } else { const int u = unit - 384; b = u / 12; h = (u / 2) % 6; const int qb = u % 2; qrow = b * 256 + qb * 128 + 16 * w + fr; }
    const int ntiles = nat ? nlat + 4 : 4;
    bf16x8 qf[2];
#pragma unroll
    for (int ks = 0; ks < 2; ++ks) qf[ks] = *(const bf16x8*)(proj + (size_t)qrow * PN + PQ + h * 64 + 32 * ks + 8 * fq);
    int dk[2][4];
    if (nat) {
        const int qc = (qrow - MC) & 63; const int cs = min(max(qc - 8, 0), 48);
#pragma unroll
        for (int kb = 0; kb < 2; ++kb)
#pragma unroll
            for (int i = 0; i < 4; ++i) { const int kc = c0 + 16 * kb + 4 * fq + i; dk[kb][i] = (kc >= cs && kc < cs + 16) ? kc - qc + 15 : -1; }
        const float* rpb = F.in[30] + (size_t)(l * 6 + h) * 465;
        for (int i = tid; i < 465; i += NTHREADS) ((LAS float*)(lds + AT_RPB))[i] = rpb[i];
    } else {
#pragma unroll
        for (int kb = 0; kb < 2; ++kb)
#pragma unroll
            for (int i = 0; i < 4; ++i) dk[kb][i] = 0;
    }
    AttnState st; st.m = -1e30f; st.l = 0.f;
#pragma unroll
    for (int db = 0; db < 4; ++db) st.o[db] = (f32x4){0.f, 0.f, 0.f, 0.f};
    const int skey = tid >> 3, sch = tid & 7;
    v4u rk = {0u, 0u, 0u, 0u}, rv = {0u, 0u, 0u, 0u}; f32x4 fk0 = {0.f, 0.f, 0.f, 0.f}, fk1 = fk0, fv0 = fk0, fv1 = fk0; bool isf = false;
#define AT_LOAD(ti_) do { const int ti__ = (ti_); \
        if (nat && ti__ >= nlat) { isf = true; const size_t off = ((size_t)(b * 4 + l) * 256 + (ti__ - nlat) * 64 + skey) * 384 + h * 64 + sch * 8; \
            fk0 = *(const f32x4*)(F.in[2] + off); fk1 = *(const f32x4*)(F.in[2] + off + 4); fv0 = *(const f32x4*)(F.in[3] + off); fv1 = *(const f32x4*)(F.in[3] + off + 4); \
        } else { isf = false; const int grow = nat ? MC + b * 1024 + (rs0 + ti__) * 64 + skey : b * 256 + ti__ * 64 + skey; \
            const bf16_t* pr = proj + (size_t)grow * PN + h * 64 + sch * 8; rk = *(const v4u*)(pr + PK); rv = *(const v4u*)(pr + PV); } } while (0)
#define AT_WRITE(buf_) do { const int buf__ = (buf_); \
        if (isf) { rk.x = pk2(fk0[0], fk0[1]); rk.y = pk2(fk0[2], fk0[3]); rk.z = pk2(fk1[0], fk1[1]); rk.w = pk2(fk1[2], fk1[3]); \
                   rv.x = pk2(fv0[0], fv0[1]); rv.y = pk2(fv0[2], fv0[3]); rv.z = pk2(fv1[0], fv1[1]); rv.w = pk2(fv1[2], fv1[3]); } \
        *(LAS v4u*)(lds + AT_K0 + buf__ * AT_TILE + skey * AT_KP + sch * 16) = rk; \
        *(LAS v4u*)(lds + AT_V0 + buf__ * AT_TILE + skey * AT_KP + sch * 16) = rv; } while (0)
    AT_LOAD(0); AT_WRITE(0);
    __syncthreads();
    for (int ti = 0; ti < ntiles; ++ti) {
        const int buf = ti & 1;
        if (ti + 1 < ntiles) AT_LOAD(ti + 1);
        LAS const unsigned char* Kt = lds + AT_K0 + buf * AT_TILE; LAS const unsigned char* Vt = lds + AT_V0 + buf * AT_TILE;
        if (nat && ti < nlat) {
            const int kr = rs0 + ti;
            if (kr >= rs_w && kr < rs_w + 8) attn_tile<2, true>(st, Kt, Vt, qf, c0, lane, (LAS const float*)(lds + AT_RPB) + (kr - r + 7) * 31, dk);
        } else attn_tile<4, false>(st, Kt, Vt, qf, 0, lane, (LAS const float*)(lds + AT_RPB), dk);
        if (ti + 1 < ntiles) AT_WRITE(buf ^ 1);
        __syncthreads();
    }
    const float lt = xsum32(xsum16(st.l));
    const float inv = 1.f / lt;
    bf16_t* mix = (bf16_t*)(F.ws + OFF_MIX) + (size_t)qrow * D + 640 + h * 64 + 4 * fq;
#pragma unroll
    for (int db = 0; db < 4; ++db) { uint2 o; o.x = pk2(st.o[db][0] * inv, st.o[db][1] * inv); o.y = pk2(st.o[db][2] * inv, st.o[db][3] * inv); *(uint2*)(mix + 16 * db) = o; }
}
__device__ __forceinline__ void phase_attn(Frame& F, int l, unsigned* ctr) {
    for (;;) { const int u = queue_next(F, ctr); if (u >= 768) break; attn_unit(F, l, u); }
}

constexpr int SS_P = 144;
constexpr int SS_IMG = 128 * SS_P;
constexpr int SS_HP = 144, SS_HIMG = 64 * SS_HP;
constexpr int SSA_B = 0, SSA_X = SS_IMG, SSA_TAB = 7 * SS_IMG;
constexpr int SSB_B = 0, SSB_C = SS_IMG, SSB_X = 2 * SS_IMG, SSB_H = 5 * SS_IMG, SSB_TAB = 5 * SS_IMG + 6 * SS_HIMG;
static_assert(SSB_TAB + 3 * 4 * 128 * 4 <= 163328 && SSA_TAB + 3 * 4 * 128 * 4 <= 163328, "SSD LDS map");
__device__ __forceinline__ void conv16(const bf16_t* proj, const float* cw, const float* cb, int seq_start, int seq_L, int t, int ch0, float (&v)[16]) {
#pragma unroll
    for (int e = 0; e < 16; e += 4) { const f32x4 b = *(const f32x4*)(cb + ch0 + e); v[e] = b[0]; v[e + 1] = b[1]; v[e + 2] = b[2]; v[e + 3] = b[3]; }
#pragma unroll
    for (int j = 0; j < 5; ++j) {
        const int tt = t + j - 2;
        if (tt >= 0 && tt < seq_L) {
            const bf16_t* src = proj + (size_t)(seq_start + tt) * PN + PX + ch0;
            const v4u r0 = *(const v4u*)src, r1 = *(const v4u*)(src + 8);
            const unsigned rr[8] = {r0[0], r0[1], r0[2], r0[3], r1[0], r1[1], r1[2], r1[3]};
#pragma unroll
            for (int e = 0; e < 16; e += 4) { const f32x4 w = *(const f32x4*)(cw + j * 640 + ch0 + e);
                v[e] += w[0] * __uint_as_float(rr[e / 2] << 16); v[e + 1] += w[1] * __uint_as_float(rr[e / 2] & 0xffff0000u);
                v[e + 2] += w[2] * __uint_as_float(rr[e / 2 + 1] << 16); v[e + 3] += w[3] * __uint_as_float(rr[e / 2 + 1] & 0xffff0000u); }
        }
    }
#pragma unroll
    for (int e = 0; e < 16; ++e) v[e] = silu_f(v[e]);
}
__device__ __forceinline__ void store16(LAS unsigned char* dst, const float (&v)[16], float sc) {
    v4u o0, o1;
    o0[0] = pk2(v[0] * sc, v[1] * sc); o0[1] = pk2(v[2] * sc, v[3] * sc); o0[2] = pk2(v[4] * sc, v[5] * sc); o0[3] = pk2(v[6] * sc, v[7] * sc);
    o1[0] = pk2(v[8] * sc, v[9] * sc); o1[1] = pk2(v[10] * sc, v[11] * sc); o1[2] = pk2(v[12] * sc, v[13] * sc); o1[3] = pk2(v[14] * sc, v[15] * sc);
    *(LAS v4u*)dst = o0; *(LAS v4u*)(dst + 16) = o1;
}
__device__ __forceinline__ void ssd_table(const float* dtraw  , float bias, float a, int dir, LAS float* tab, int lane) {
    const float d0 = softplus_f(dtraw[(2 * lane) * 12] + bias), d1 = softplus_f(dtraw[(2 * lane + 1) * 12] + bias);
    const float ps = d0 + d1; float x = ps;
    x += dppf<0x111>(x); x += dppf<0x112>(x); x += dppf<0x114>(x); x += dppf<0x118>(x);
    { const float t15 = rdlane(x, 15), t31 = rdlane(x, 31), t47 = rdlane(x, 47); const int rw = lane >> 4;
      x += (rw >= 1 ? t15 : 0.f) + (rw >= 2 ? t31 : 0.f) + (rw >= 3 ? t47 : 0.f); }
    tab[2 * lane] = d0; tab[2 * lane + 1] = d1;
    if (dir == 0) { const float ex = x - ps; tab[128 + 2 * lane] = a * (ex + d0); tab[128 + 2 * lane + 1] = a * (ex + ps); }
    else { const float tot = rdlane(x, 63); const float sx = tot - x; tab[128 + 2 * lane + 1] = a * (sx + d1); tab[128 + 2 * lane] = a * (sx + ps); }
}
__device__ __forceinline__ void ssd_a_unit(Frame& F, int l, int unit) {
    const int tid = F.tid, lane = F.lane, w = F.wave, fr = lane & 15, fq = lane >> 4;
    const int ci = unit >> 1, g = unit & 1, row0 = ci * 128;
    const SeqInfo q = row_seq(row0); const int t0 = row0 - q.start;
    const bf16_t* proj = (const bf16_t*)(F.ws + OFF_PROJ);
    const float* cw = F.in[14] + l * 5 * 640; const float* cb = F.in[15] + l * 640;
    LAS unsigned char* lds = F.lds; LAS float* tabs = (LAS float*)(lds + SSA_TAB);
    if (w < 6) { const int hh = w >> 1, dir = w & 1, h = 3 * g + hh;
        ssd_table((const float*)(F.ws + OFF_DT) + (size_t)row0 * 12 + dir * 6 + h, F.in[16][(l * 2 + dir) * 6 + h], -__expf(F.in[17][(l * 2 + dir) * 6 + h]), dir, tabs + (hh * 4 + dir * 2) * 128, lane); }
    const int t = tid >> 2, chq = tid & 3;
    { float v[16]; conv16(proj, cw, cb, q.start, q.L, t0 + t, 384 + g * 64 + chq * 16, v); store16(lds + SSA_B + t * SS_P + chq * 32, v, 1.f); }
    float xv[3][16];
#pragma unroll
    for (int hh = 0; hh < 3; ++hh) conv16(proj, cw, cb, q.start, q.L, t0 + t, (3 * g + hh) * 64 + chq * 16, xv[hh]);
    __syncthreads();
#pragma unroll
    for (int hh = 0; hh < 3; ++hh) { LAS const float* tb = tabs + hh * 4 * 128;
        const float wf = __expf(tb[128 + 127] - tb[128 + t]) * tb[t], wb = __expf(tb[384] - tb[384 + t]) * tb[256 + t];
        store16(lds + SSA_X + (2 * hh) * SS_IMG + t * SS_P + chq * 32, xv[hh], wf); store16(lds + SSA_X + (2 * hh + 1) * SS_IMG + t * SS_P + chq * 32, xv[hh], wb); }
    __syncthreads();
    const int dir = w >> 2, pb = w & 3;
    for (int hh = 0; hh < 3; ++hh) {
        const int h = 3 * g + hh;
        LAS const unsigned char* xa = lds + SSA_X + (2 * hh + dir) * SS_IMG + (4 * fq + (fr >> 2)) * SS_P + (16 * pb + 4 * (fr & 3)) * 2;
        LAS const unsigned char* ba = lds + SSA_B + (4 * fq + (fr >> 2)) * SS_P + (4 * (fr & 3)) * 2;
        f32x4 acc[4];
#pragma unroll
        for (int nb = 0; nb < 4; ++nb) acc[nb] = (f32x4){0.f, 0.f, 0.f, 0.f};
#pragma unroll
        for (int kk = 0; kk < 4; ++kk) {
            const bf16x8 af = tr2(xa + kk * 32 * SS_P, xa + (kk * 32 + 16) * SS_P);
#pragma unroll
            for (int nb = 0; nb < 4; ++nb) { const bf16x8 bfr = tr2(ba + kk * 32 * SS_P + nb * 32, ba + (kk * 32 + 16) * SS_P + nb * 32); acc[nb] = __builtin_amdgcn_mfma_f32_16x16x32_bf16(af, bfr, acc[nb], 0, 0, 0); }
        }
        float* cs = (float*)(F.ws + OFF_CS) + ((size_t)(ci * 6 + h) * 2 + dir) * 4096;
#pragma unroll
        for (int nb = 0; nb < 4; ++nb)
#pragma unroll
            for (int i = 0; i < 4; ++i) cs[(16 * pb + 4 * fq + i) * 64 + 16 * nb + fr] = acc[nb][i];
        if (tid == 0) { LAS const float* tb = tabs + hh * 4 * 128; float* cd = (float*)(F.ws + OFF_TAB + TAB_CD) + (size_t)(ci * 6 + h) * 2; cd[0] = __expf(tb[128 + 127]); cd[1] = __expf(tb[384]); }
    }
}
__device__ __forceinline__ void ssd_state_pass(Frame& F, int l) {
    const int tid = F.tid, p = tid >> 3, n0 = (tid & 7) * 8;
    const float* cdt = (const float*)(F.ws + OFF_TAB + TAB_CD); const float* csb = (const float*)(F.ws + OFF_CS);
    bf16_t* hin = (bf16_t*)(F.ws + OFF_HIN);
    for (int task = F.vcu; task < NSEQ * 12; task += F.G) {
        int s, hd; if (task < LB * 12) { s = CB + task / 12; hd = task % 12; } else { s = (task - LB * 12) / 12; hd = (task - LB * 12) % 12; }
        const int h = hd >> 1, dir = hd & 1;
        const SeqInfo q = seq_info(s); const int nch = q.L >> 7, ci0 = q.start >> 7;
        f32x4 s0 = {0.f, 0.f, 0.f, 0.f}, s1 = s0;
        if (!q.ctx) { const float* h0 = F.in[4] + ((((size_t)q.b * 4 + l) * 2 + dir) * 6 + h) * 4096 + p * 64 + n0; s0 = *(const f32x4*)h0; s1 = *(const f32x4*)(h0 + 4); }
        for (int k = 0; k < nch; ++k) {
            const int c = dir == 0 ? k : nch - 1 - k; const size_t ix = (size_t)((ci0 + c) * 6 + h) * 2 + dir;
            v4u o; o[0] = pk2(s0[0], s0[1]); o[1] = pk2(s0[2], s0[3]); o[2] = pk2(s1[0], s1[1]); o[3] = pk2(s1[2], s1[3]);
            *(v4u*)(hin + ix * 4096 + p * 64 + n0) = o;
            const float dcy = cdt[ix]; const float* cs = csb + ix * 4096 + p * 64 + n0;
            s0 = s0 * dcy + *(const f32x4*)cs; s1 = s1 * dcy + *(const f32x4*)(cs + 4);
        }
        if (q.ctx) { float* o4 = F.out + O_SSD + ((((size_t)q.b * 4 + l) * 2 + dir) * 6 + h) * 4096 + p * 64 + n0; *(f32x4*)o4 = s0; *(f32x4*)(o4 + 4) = s1; }
    }
}
__device__ __forceinline__ void ssd_b_unit(Frame& F, int l, int unit) {
    const int tid = F.tid, lane = F.lane, w = F.wave, fr = lane & 15, fq = lane >> 4;
    const int ci = unit >> 1, g = unit & 1, row0 = ci * 128;
    const SeqInfo q = row_seq(row0); const int t0 = row0 - q.start;
    const bf16_t* proj = (const bf16_t*)(F.ws + OFF_PROJ);
    const float* cw = F.in[14] + l * 5 * 640; const float* cb = F.in[15] + l * 640;
    LAS unsigned char* lds = F.lds; LAS float* tabs = (LAS float*)(lds + SSB_TAB);
    if (w < 6) { const int hh = w >> 1, dir = w & 1, h = 3 * g + hh;
        ssd_table((const float*)(F.ws + OFF_DT) + (size_t)row0 * 12 + dir * 6 + h, F.in[16][(l * 2 + dir) * 6 + h], -__expf(F.in[17][(l * 2 + dir) * 6 + h]), dir, tabs + (hh * 4 + dir * 2) * 128, lane); }
    {
        const bf16_t* hin = (const bf16_t*)(F.ws + OFF_HIN) + (size_t)((ci * 6 + 3 * g) * 2) * 4096 + (tid >> 3) * 64 + (tid & 7) * 8;
#pragma unroll
        for (int k = 0; k < 6; ++k) *(LAS v4u*)(lds + SSB_H + k * SS_HIMG + (tid >> 3) * SS_HP + (tid & 7) * 16) = *(const v4u*)(hin + (size_t)k * 4096);
    }
    { const int t = tid >> 2, chq = tid & 3; float v[16];
      conv16(proj, cw, cb, q.start, q.L, t0 + t, 384 + g * 64 + chq * 16, v); store16(lds + SSB_B + t * SS_P + chq * 32, v, 1.f);
      conv16(proj, cw, cb, q.start, q.L, t0 + t, 512 + g * 64 + chq * 16, v); store16(lds + SSB_C + t * SS_P + chq * 32, v, 1.f);
#pragma unroll
      for (int hh = 0; hh < 3; ++hh) { conv16(proj, cw, cb, q.start, q.L, t0 + t, (3 * g + hh) * 64 + chq * 16, v); store16(lds + SSB_X + hh * SS_IMG + t * SS_P + chq * 32, v, 1.f); } }
    __syncthreads();
    bf16x8 cf[2];
#pragma unroll
    for (int ks = 0; ks < 2; ++ks) cf[ks] = *(LAS const bf16x8*)(lds + SSB_C + (16 * w + fr) * SS_P + (32 * ks + 8 * fq) * 2);
    f32x4 gt[8];
#pragma unroll
    for (int sb = 0; sb < 8; ++sb) { gt[sb] = (f32x4){0.f, 0.f, 0.f, 0.f};
#pragma unroll
        for (int ks = 0; ks < 2; ++ks) { const bf16x8 bfr = *(LAS const bf16x8*)(lds + SSB_B + (16 * sb + fr) * SS_P + (32 * ks + 8 * fq) * 2); gt[sb] = __builtin_amdgcn_mfma_f32_16x16x32_bf16(bfr, cf[ks], gt[sb], 0, 0, 0); } }
    float ss[4] = {0.f, 0.f, 0.f, 0.f};
    bf16_t* yup = (bf16_t*)(F.ws + OFF_YU) + (size_t)(row0 + 16 * w + 4 * fq) * 384 + fr;
    for (int hh = 0; hh < 3; ++hh) {
        const int h = 3 * g + hh;
        LAS const float* tb = tabs + hh * 4 * 128;
        unsigned short zv[4][4];
#pragma unroll
        for (int i = 0; i < 4; ++i)
#pragma unroll
            for (int pb = 0; pb < 4; ++pb) zv[i][pb] = proj[(size_t)(row0 + 16 * w + 4 * fq + i) * PN + PZ + h * 64 + 16 * pb + fr];
        const float at = tb[128 + 16 * w + fr], bt = tb[384 + 16 * w + fr];
        f32x4 y[4];
#pragma unroll
        for (int pb = 0; pb < 4; ++pb) y[pb] = (f32x4){0.f, 0.f, 0.f, 0.f};
        LAS const unsigned char* xa = lds + SSB_X + hh * SS_IMG + (4 * fq + (fr >> 2)) * SS_P + (4 * (fr & 3)) * 2;
#pragma unroll
        for (int kk = 0; kk < 4; ++kk) {
            float mv[8];
#pragma unroll
            for (int half = 0; half < 2; ++half) { const int sb = 2 * kk + half; const int s0i = 16 * sb + 4 * fq;
                const f32x4 cumf = *(LAS const f32x4*)(tb + 128 + s0i), dtf = *(LAS const f32x4*)(tb + s0i), cumb = *(LAS const f32x4*)(tb + 384 + s0i), dtb = *(LAS const f32x4*)(tb + 256 + s0i);
#pragma unroll
                for (int i = 0; i < 4; ++i) { const int s = s0i + i, t = 16 * w + fr; float m = 0.f;
                    if (s <= t) m += __expf(at - cumf[i]) * dtf[i];
                    if (s >= t) m += __expf(bt - cumb[i]) * dtb[i];
                    mv[half * 4 + i] = m * gt[sb][i]; } }
            union { bf16x8 v; unsigned u[4]; } mf; mf.u[0] = pk2(mv[0], mv[1]); mf.u[1] = pk2(mv[2], mv[3]); mf.u[2] = pk2(mv[4], mv[5]); mf.u[3] = pk2(mv[6], mv[7]);
#pragma unroll
            for (int pb = 0; pb < 4; ++pb) { const bf16x8 xf = tr2(xa + kk * 32 * SS_P + pb * 32, xa + (kk * 32 + 16) * SS_P + pb * 32); y[pb] = __builtin_amdgcn_mfma_f32_16x16x32_bf16(mf.v, xf, y[pb], 0, 0, 0); }
        }
        f32x4 yf[4], yb[4];
#pragma unroll
        for (int pb = 0; pb < 4; ++pb) { yf[pb] = (f32x4){0.f, 0.f, 0.f, 0.f}; yb[pb] = yf[pb];
#pragma unroll
            for (int ks = 0; ks < 2; ++ks) {
                const bf16x8 hf = *(LAS const bf16x8*)(lds + SSB_H + (2 * hh) * SS_HIMG + (16 * pb + fr) * SS_HP + (32 * ks + 8 * fq) * 2);
                const bf16x8 hb = *(LAS const bf16x8*)(lds + SSB_H + (2 * hh + 1) * SS_HIMG + (16 * pb + fr) * SS_HP + (32 * ks + 8 * fq) * 2);
                yf[pb] = __builtin_amdgcn_mfma_f32_16x16x32_bf16(cf[ks], hf, yf[pb], 0, 0, 0);
                yb[pb] = __builtin_amdgcn_mfma_f32_16x16x32_bf16(cf[ks], hb, yb[pb], 0, 0, 0); } }
        const float dsk = F.in[18][l * 6 + h];
        const f32x4 cumf4 = *(LAS const f32x4*)(tb + 128 + 16 * w + 4 * fq), cumb4 = *(LAS const f32x4*)(tb + 384 + 16 * w + 4 * fq);
#pragma unroll
        for (int i = 0; i < 4; ++i) { const float ef = __expf(cumf4[i]), eb = __expf(cumb4[i]); const int tl = 16 * w + 4 * fq + i;
#pragma unroll
            for (int pb = 0; pb < 4; ++pb) { const float xv = bf2f(*(LAS const bf16_t*)(lds + SSB_X + hh * SS_IMG + tl * SS_P + (16 * pb + fr) * 2));
                const float yv = y[pb][i] + ef * yf[pb][i] + eb * yb[pb][i] + dsk * xv;
                const float gv = yv * silu_f(bf2f(zv[i][pb])); const bf16_t gb = f2bf(gv); const float gr = bf2f(gb); ss[i] += gr * gr;
                yup[(size_t)i * 384 + h * 64 + 16 * pb] = gb; } }
    }
#pragma unroll
    for (int i = 0; i < 4; ++i) { const float v = row16_sum(ss[i]);
        if (fr == 0) ((float*)(F.ws + OFF_TAB + TAB_SSQ))[(size_t)(row0 + 16 * w + 4 * fq + i) * 2 + g] = v; }
}
__device__ __forceinline__ void ssd_norm_panel(Frame& F, int l, int pm) {
    const float* nw = F.in[19] + l * 384; const float* ssq = (const float*)(F.ws + OFF_TAB + TAB_SSQ);
    const bf16_t* yu = (const bf16_t*)(F.ws + OFF_YU); bf16_t* mix = (bf16_t*)(F.ws + OFF_MIX);
    for (int i = F.tid; i < 256 * 48; i += NTHREADS) {
        const int row = pm * 256 + i / 48, c0 = (i % 48) * 8;
        const float rstd = rsqrtf((ssq[(size_t)row * 2] + ssq[(size_t)row * 2 + 1]) * (1.f / 384.f) + EPS);
        const v4u v = *(const v4u*)(yu + (size_t)row * 384 + c0); const f32x4 w0 = *(const f32x4*)(nw + c0), w1 = *(const f32x4*)(nw + c0 + 4);
        v4u o;
        o[0] = pk2(__uint_as_float(v[0] << 16) * rstd * w0[0], __uint_as_float(v[0] & 0xffff0000u) * rstd * w0[1]); o[1] = pk2(__uint_as_float(v[1] << 16) * rstd * w0[2], __uint_as_float(v[1] & 0xffff0000u) * rstd * w0[3]);
        o[2] = pk2(__uint_as_float(v[2] << 16) * rstd * w1[0], __uint_as_float(v[2] & 0xffff0000u) * rstd * w1[1]); o[3] = pk2(__uint_as_float(v[3] << 16) * rstd * w1[2], __uint_as_float(v[3] & 0xffff0000u) * rstd * w1[3]);
        *(v4u*)(mix + (size_t)row * D + c0) = o;
    }
    asm volatile("s_waitcnt vmcnt(0)" ::: "memory");
    __syncthreads();
}

constexpr int S5_HP = 272;
constexpr int S5_IMG = 64 * S5_HP;
constexpr int S5_GP = 528, S5_G = 4 * S5_IMG, S5_END = S5_G + 64 * S5_GP;
typedef float f32x16 __attribute__((ext_vector_type(16)));
typedef float f32x8 __attribute__((ext_vector_type(8)));
__device__ __forceinline__ float swap32sel(float x, int odd) {
    const auto r = __builtin_amdgcn_permlane32_swap(__float_as_uint(x), __float_as_uint(x), false, false);
    return __uint_as_float(odd ? r[1] : r[0]);
}
template <int DIR, bool FULL>
__device__ __forceinline__ void s5_dir(Frame& F, int l, int g, int p, int hi, const bf16x8 (&uf)[2], float& cr, float& ci, f32x16 (&hr)[2], f32x16 (&hq)[2]) {
    const float* ab = (const float*)(F.ws + OFF_TAB + TAB_ABAR) + (size_t)((((l * 2 + DIR) * 16 + g) * 64) + p) * 2;
    const float ar = ab[0], ai = ab[1];
    const float a2r = ar * ar - ai * ai, a2i = 2.f * ar * ai, a3r = a2r * ar - a2i * ai, a3i = a2r * ai + a2i * ar, a4r = a2r * a2r - a2i * a2i, a4i = 2.f * a2r * a2i;
    const bf16_t* bbt = (const bf16_t*)(F.ws + OFF_TAB + TAB_BBT) + ((size_t)(((l * 2 + DIR) * 16 + g) * 2) * 64 + p) * 16 + 8 * hi;
    const bf16x8 bre = *(const bf16x8*)bbt, bim = *(const bf16x8*)(bbt + 64 * 16);
    f32x16 xr[2], xi[2];
#pragma unroll
    for (int rb = 0; rb < 2; ++rb) {
        const f32x16 z = {0.f, 0.f, 0.f, 0.f, 0.f, 0.f, 0.f, 0.f, 0.f, 0.f, 0.f, 0.f, 0.f, 0.f, 0.f, 0.f};
        xr[rb] = __builtin_amdgcn_mfma_f32_32x32x16_bf16(uf[rb], bre, z, 0, 0, 0); xi[rb] = __builtin_amdgcn_mfma_f32_32x32x16_bf16(uf[rb], bim, z, 0, 0, 0);
    }
#pragma unroll
    for (int rb = 0; rb < 2; ++rb)
#pragma unroll
        for (int G4 = 0; G4 < 4; ++G4) {
            if (DIR == 0) {
#pragma unroll
                for (int e = 1; e < 4; ++e) { const int i = 4 * G4 + e; const float pr = xr[rb][i - 1], pi = xi[rb][i - 1]; xr[rb][i] += ar * pr - ai * pi; xi[rb][i] += ar * pi + ai * pr; }
            } else {
#pragma unroll
                for (int e = 2; e >= 0; --e) { const int i = 4 * G4 + e; const float pr = xr[rb][i + 1], pi = xi[rb][i + 1]; xr[rb][i] += ar * pr - ai * pi; xi[rb][i] += ar * pi + ai * pr; }
            }
        }
    f32x8 cinr = {0.f, 0.f, 0.f, 0.f, 0.f, 0.f, 0.f, 0.f}, cini = cinr;
#pragma unroll
    for (int kk = 0; kk < 16; ++kk) {
        const int k = DIR == 0 ? kk : 15 - kk, gi = k >> 1, rb = gi >> 2, il = 4 * (gi & 3) + (DIR == 0 ? 3 : 0), odd = k & 1;
        const bool first = DIR == 0 ? !odd : odd;
        if (first) { cinr[gi] = cr; cini[gi] = ci; } else { const bool own = (hi == odd); cinr[gi] = own ? cr : cinr[gi]; cini[gi] = own ? ci : cini[gi]; }
        const float nr = a4r * cr - a4i * ci + xr[rb][il], ni = a4r * ci + a4i * cr + xi[rb][il];
        cr = swap32sel(nr, odd); ci = swap32sel(ni, odd);
    }
    if (FULL) {
#pragma unroll
        for (int rb = 0; rb < 2; ++rb)
#pragma unroll
            for (int G4 = 0; G4 < 4; ++G4) {
                const int gi = rb * 4 + G4;
#pragma unroll
                for (int e = 0; e < 4; ++e) {
                    const int i = 4 * G4 + e, pw = DIR == 0 ? e + 1 : 4 - e;
                    const float pr = pw == 1 ? ar : (pw == 2 ? a2r : (pw == 3 ? a3r : a4r)), pi = pw == 1 ? ai : (pw == 2 ? a2i : (pw == 3 ? a3i : a4i));
                    hr[rb][i] += xr[rb][i] + pr * cinr[gi] - pi * cini[gi];
                    hq[rb][i] += xi[rb][i] + pr * cini[gi] + pi * cinr[gi];
                }
            }
    }
}
template <bool FULL>
__device__ __forceinline__ void s5_wave_unit(Frame& F, int l, int row0, int g, int ph, float& cfr, float& cfi, float& cbr, float& cbi, LAS unsigned char* himg) {
    const int lane = F.lane, r32 = lane & 31, hi = lane >> 5, p = 32 * ph + r32;
    const bf16_t* proj = (const bf16_t*)(F.ws + OFF_PROJ);
    bf16x8 uf[2];
#pragma unroll
    for (int rb = 0; rb < 2; ++rb) uf[rb] = *(const bf16x8*)(proj + (size_t)(row0 + 32 * rb + r32) * PN + PU + g * 16 + 8 * hi);
    f32x16 hr[2], hq[2];
#pragma unroll
    for (int rb = 0; rb < 2; ++rb) { hr[rb] = (f32x16){0.f, 0.f, 0.f, 0.f, 0.f, 0.f, 0.f, 0.f, 0.f, 0.f, 0.f, 0.f, 0.f, 0.f, 0.f, 0.f}; hq[rb] = hr[rb]; }
    s5_dir<0, FULL>(F, l, g, p, hi, uf, cfr, cfi, hr, hq);
    s5_dir<1, FULL>(F, l, g, p, hi, uf, cbr, cbi, hr, hq);
    if (FULL) {
#pragma unroll
        for (int rb = 0; rb < 2; ++rb)
#pragma unroll
            for (int i = 0; i < 16; ++i) { const int t = 32 * rb + 8 * (i >> 2) + 4 * hi + (i & 3);
                LAS bf16_t* d = (LAS bf16_t*)(himg + t * S5_HP) + p;
                const unsigned pk = pk2(hr[rb][i], hq[rb][i]); d[0] = (bf16_t)(pk & 0xffffu); d[64] = (bf16_t)(pk >> 16); }
    }
}
__device__ __forceinline__ void cpow64(float ar, float ai, float& or_, float& oi_) {
#pragma unroll
    for (int s = 0; s < 6; ++s) { const float nr = ar * ar - ai * ai, ni = 2.f * ar * ai; ar = nr; ai = ni; }
    or_ = ar; oi_ = ai;
}
__device__ __forceinline__ void s5_a_unit(Frame& F, int l, int cj) {
    const int w = F.wave, lane = F.lane, row0 = cj * 64;
    float* E = (float*)(F.ws + OFF_E);
    for (int it = w; it < 32; it += NWAVES) {
        const int g = it >> 1, ph = it & 1;
        float cfr = 0.f, cfi = 0.f, cbr = 0.f, cbi = 0.f;
        s5_wave_unit<false>(F, l, row0, g, ph, cfr, cfi, cbr, cbi, F.lds);
        if (lane < 32) { float2 v; v.x = cfr; v.y = cfi; *(float2*)(E + ((size_t)((cj * 2 + 0) * 16 + g) * 64 + 32 * ph + lane) * 2) = v;
                         v.x = cbr; v.y = cbi; *(float2*)(E + ((size_t)((cj * 2 + 1) * 16 + g) * 64 + 32 * ph + lane) * 2) = v; }
    }
}
__device__ __forceinline__ void s5_b_unit(Frame& F, int l, int cj) {
    const int w = F.wave, row0 = cj * 64;
    const SeqInfo q = row_seq(row0); const int j = (row0 - q.start) >> 6, nj = q.L >> 6, cj0 = cj - j;
    const bf16_t* proj = (const bf16_t*)(F.ws + OFF_PROJ);
    const float* E = (const float*)(F.ws + OFF_E);
    LAS unsigned char* lds = F.lds;
    for (int gi4 = 0; gi4 < 4; ++gi4) {
        {
            { int t_ = F.tid; asm volatile("" : "+v"(t_)); F.tid = t_; F.lane = t_ & 63; }
            const int lane = F.lane; const int g = 4 * gi4 + (w >> 1), ph = w & 1, p = 32 * ph + (lane & 31);
            const float* ab = (const float*)(F.ws + OFF_TAB + TAB_ABAR) + (size_t)((((l * 2 + 0) * 16 + g) * 64) + p) * 2;
            float a64r[2], a64i[2]; cpow64(ab[0], ab[1], a64r[0], a64i[0]); cpow64(ab[16 * 64 * 2], ab[16 * 64 * 2 + 1], a64r[1], a64i[1]);
            float cr[2] = {0.f, 0.f}, ci[2] = {0.f, 0.f};
#pragma unroll
            for (int dir = 0; dir < 2; ++dir) {
                if (!q.ctx) { const size_t o = (((size_t)q.b * 4 + l) * 2 + dir) * 1024 + g * 64 + p; cr[dir] = F.in[5][o]; ci[dir] = F.in[6][o]; }
                const int nprev = dir == 0 ? j : nj - 1 - j;
                for (int k = 0; k < nprev; ++k) { const int jj = dir == 0 ? k : nj - 1 - k;
                    const float2 e = *(const float2*)(E + ((size_t)(((cj0 + jj) * 2 + dir) * 16 + g) * 64 + p) * 2);
                    const float nr = a64r[dir] * cr[dir] - a64i[dir] * ci[dir] + e.x, ni = a64r[dir] * ci[dir] + a64i[dir] * cr[dir] + e.y; cr[dir] = nr; ci[dir] = ni; }
            }
            s5_wave_unit<true>(F, l, row0, g, ph, cr[0], ci[0], cr[1], ci[1], lds + (w >> 1) * S5_IMG);
            if (q.ctx && lane < 32) {
                if (j == nj - 1) { const size_t o = (((size_t)q.b * 4 + l) * 2 + 0) * 1024 + g * 64 + p; F.out[O_RE + o] = cr[0]; F.out[O_IM + o] = ci[0]; }
                if (j == 0) { const size_t o = (((size_t)q.b * 4 + l) * 2 + 1) * 1024 + g * 64 + p; F.out[O_RE + o] = cr[1]; F.out[O_IM + o] = ci[1]; }
            }
        }
        __syncthreads();
        int ln2 = F.tid; asm volatile("" : "+v"(ln2)); ln2 &= 63; const int fr = ln2 & 15, fq = ln2 >> 4;
#pragma unroll
        for (int tk = 0; tk < 2; ++tk) {
            const int task = 2 * w + tk, gsel = task >> 2, tb = task & 3, g = 4 * gi4 + gsel;
            LAS const unsigned char* hrow = lds + gsel * S5_IMG + (16 * tb + fr) * S5_HP + 16 * fq;
            const bf16_t* cc = (const bf16_t*)(F.ws + OFF_TAB + TAB_CC1) + ((size_t)(l * 16 + g) * 16 + fr) * 128 + 8 * fq;
            f32x4 y = {0.f, 0.f, 0.f, 0.f};
#pragma unroll
            for (int ks = 0; ks < 4; ++ks) { const bf16x8 a = *(LAS const bf16x8*)(hrow + ks * 64); const bf16x8 bfr = *(const bf16x8*)(cc + ks * 32); y = __builtin_amdgcn_mfma_f32_16x16x32_bf16(a, bfr, y, 0, 0, 0); }
            const float dsk = F.in[27][l * 256 + g * 16 + fr];
#pragma unroll
            for (int i = 0; i < 4; ++i) { const int t = 16 * tb + 4 * fq + i; const float u = bf2f(proj[(size_t)(row0 + t) * PN + PU + g * 16 + fr]);
                *((LAS bf16_t*)(lds + S5_G + t * S5_GP) + g * 16 + fr) = f2bf(gelu_tanh_f(y[i] + dsk * u)); }
        }
        __syncthreads();
    }
    {
        int ln3 = F.tid; asm volatile("" : "+v"(ln3)); ln3 &= 63; const int fr = ln3 & 15, fq = ln3 >> 4;
        f32x4 acc[2][4];
#pragma unroll
        for (int a = 0; a < 2; ++a)
#pragma unroll
            for (int tb = 0; tb < 4; ++tb) acc[a][tb] = (f32x4){0.f, 0.f, 0.f, 0.f};
        const bf16_t* wg = (const bf16_t*)(F.ws + OFF_WGLU) + (size_t)l * 65536 + (size_t)(32 * w + fr) * 256 + 8 * fq;
#pragma unroll
        for (int ks = 0; ks < 8; ++ks) {
            const bf16x8 b0 = *(const bf16x8*)(wg + ks * 32), b1 = *(const bf16x8*)(wg + 16 * 256 + ks * 32);
#pragma unroll
            for (int tb = 0; tb < 4; ++tb) { const bf16x8 a = *(LAS const bf16x8*)(lds + S5_G + (16 * tb + fr) * S5_GP + ks * 64 + 16 * fq);
                acc[0][tb] = __builtin_amdgcn_mfma_f32_16x16x32_bf16(a, b0, acc[0][tb], 0, 0, 0); acc[1][tb] = __builtin_amdgcn_mfma_f32_16x16x32_bf16(a, b1, acc[1][tb], 0, 0, 0); }
        }
#pragma unroll
        for (int a = 0; a < 2; ++a) { const int n = 32 * w + 16 * a + fr; const float bg = F.in[29][l * 256 + n];
#pragma unroll
            for (int tb = 0; tb < 4; ++tb)
#pragma unroll
                for (int i = 0; i < 4; ++i) { const int t = 16 * tb + 4 * fq + i; const float gv = bf2f(*((LAS const bf16_t*)(lds + S5_G + t * S5_GP) + n));
                    ((bf16_t*)(F.ws + OFF_MIX))[(size_t)(row0 + t) * D + 384 + n] = f2bf(gv * sigmoid_f(acc[a][tb][i] + bg)); } }
    }
}

__device__ __forceinline__ void phase_mixa(Frame& F, int l) {
    unsigned* ctr = F.ctl + CW_Q + 64 * (l * 4 + 0);
    for (;;) { const int u = queue_next(F, ctr); if (u >= 1280) break; if (u < 256) ssd_a_unit(F, l, u); else if (u < 512) s5_a_unit(F, l, u - 256); else attn_unit(F, l, u - 512); }
}
__device__ __forceinline__ void phase_mixb(Frame& F, int l) {
    unsigned* ctr = F.ctl + CW_Q + 64 * (l * 4 + 1);
    for (;;) { const int u = queue_next(F, ctr); if (u >= 512) break; if (u < 256) ssd_b_unit(F, l, u); else s5_b_unit(F, l, u - 256); }
}

struct Args { const float* in[35]; float* out; unsigned char* ws; int ph_lo, ph_hi, li, pad; };
__global__ void __launch_bounds__(NTHREADS, 2) mega(Args args) {
    extern __shared__ __attribute__((aligned(16))) unsigned char lds[];
    Frame F;
    F.lds = (LAS unsigned char*)lds;
    F.MISC = (volatile LAS unsigned*)(F.lds + MISC_OFF);
    F.tid = threadIdx.x; F.lane = F.tid & 63; F.wave = __builtin_amdgcn_readfirstlane(F.tid >> 6);
    F.G = gridDim.x; { const int bx = blockIdx.x; F.vcu = (F.G % 8 == 0) ? (bx % 8) * (F.G / 8) + bx / 8 : bx; }
    { const float* const* inp = (const float* const*)__builtin_amdgcn_kernarg_segment_ptr(); asm volatile("" : "+s"(inp)); F.in = inp; }
    F.out = args.out; F.ws = args.ws; F.ctl = (unsigned*)(args.ws + OFF_CTL);
    for (int u = F.tid; u < (LDS_BYTES - LDSCTL_OFF) / 4; u += NTHREADS) ((LAS unsigned*)(F.lds + LDSCTL_OFF))[u] = 0u;
    __syncthreads();
    XcdBarrier bar = xcd_barrier_post(F.ctl + CW_BAR + args.li * XCD_BAR_WORDS, F.MISC + 8);
    const int lo = args.ph_lo, hi = args.ph_hi;
    const float* modsb = (const float*)(F.ws + OFF_MODS);
    float* X = (float*)(F.ws + OFF_X);
    const int vcu0 = F.vcu;
#define IN(k) (lo <= (k) && (k) < hi)
#define REFRESH() do { int t_ = threadIdx.x; asm volatile("" : "+v"(t_)); F.tid = t_; F.lane = t_ & 63; \
        unsigned char* w_ = args.ws; asm volatile("" : "+s"(w_)); F.ws = w_; F.ctl = (unsigned*)(w_ + OFF_CTL); float* o_ = args.out; asm volatile("" : "+s"(o_)); F.out = o_; \
        const float* const* i_ = (const float* const*)__builtin_amdgcn_kernarg_segment_ptr(); asm volatile("" : "+s"(i_)); F.in = i_; \
        int g_ = gridDim.x, v_ = vcu0; asm volatile("" : "+s"(g_), "+s"(v_)); F.G = g_; F.vcu = v_; modsb = (const float*)(F.ws + OFF_MODS); X = (float*)(F.ws + OFF_X); } while (0)
#define SEAM(k) do { if (IN(k) && IN((k) + 1)) xcd_barrier(bar); } while (0)
    if (IN(PH_PRO)) phase_prologue(F);
    SEAM(PH_PRO);
    for (int l = 0; l < DEPTH; ++l) {
        const int pb = 1 + l * PH_PER_LAYER;
        if (IN(pb + PH_NORM1)) { REFRESH(); phase_norm(F, l, 0); }
        SEAM(pb + PH_NORM1);
        if (IN(pb + PH_G1)) { REFRESH();
            pg8::Gemm g{(const bf16_t*)(F.ws + OFF_H), (const bf16_t*)(F.ws + OFF_WIN) + (size_t)l * PNP * 1024, M, PNP, 1024}; pg8::StaticOrder S; S.init(M, PNP, F.G, (int)blockIdx.x);
            pg8::EpiProj E{(bf16_t*)(F.ws + OFF_PROJ), F.out + O_K, F.out + O_V, l};
            pg8::gemm_phase<pg8::EpiProj, pg8::StaticOrder, true, true>(F.lds, g, S, E);
        }
        SEAM(pb + PH_G1);
        if (IN(pb + PH_MIXA)) { REFRESH(); phase_mixa(F, l); }
        SEAM(pb + PH_MIXA);
        if (IN(pb + PH_MIXB)) { REFRESH(); ssd_state_pass(F, l); xcd_barrier(bar); REFRESH(); phase_mixb(F, l); }
        SEAM(pb + PH_MIXB);
        if (IN(pb + PH_G3)) { REFRESH();
            pg8::Gemm g{(const bf16_t*)(F.ws + OFF_MIX), (const bf16_t*)(F.ws + OFF_WOUT) + (size_t)l * 1024 * 1024, M, D, 1024}; pg8::StaticOrder S; S.init(M, D, F.G, (int)blockIdx.x);
            pg8::EpiRes E{l == 0 ? F.in[0] : X, l == 0 ? F.in[1] - (size_t)MC * D : X, X, modsb + (size_t)l * 9 * 6144, 2};
            { pg8::Unit u; for (int i = 0; S.next(i, u); ++i) ssd_norm_panel(F, l, u.pm); }
            pg8::gemm_phase<pg8::EpiRes, pg8::StaticOrder, true, true>(F.lds, g, S, E);
        }
        SEAM(pb + PH_G3);
        if (IN(pb + PH_NORM2)) { REFRESH(); phase_norm(F, l, 1); }
        SEAM(pb + PH_NORM2);
        if (IN(pb + PH_G4)) { REFRESH();
            pg8::Gemm g{(const bf16_t*)(F.ws + OFF_H), (const bf16_t*)(F.ws + OFF_WFF1) + (size_t)l * DFF * 1024, M, DFF, 1024}; pg8::StaticOrder S; S.init(M, DFF, F.G, (int)blockIdx.x);
            pg8::EpiFF1 E{(bf16_t*)(F.ws + OFF_FFH)};
            pg8::gemm_phase<pg8::EpiFF1, pg8::StaticOrder, true, true>(F.lds, g, S, E);
        }
        SEAM(pb + PH_G4);
        if (IN(pb + PH_G5)) { REFRESH();
            pg8::Gemm g{(const bf16_t*)(F.ws + OFF_FFH), (const bf16_t*)(F.ws + OFF_WFF2) + (size_t)l * 1024 * DFF, M, D, DFF}; pg8::StaticOrder S; S.init(M, D, F.G, (int)blockIdx.x);
            pg8::EpiRes E{X, X, X, modsb + (size_t)l * 9 * 6144, 5};
            pg8::gemm_phase<pg8::EpiRes, pg8::StaticOrder, true, true>(F.lds, g, S, E);
        }
        SEAM(pb + PH_G5);
    }
    if (IN(PH_FINAL)) phase_final(F);
#undef IN
#undef SEAM
}
static void launch_mega(const Args& base, int lo, int hi, int li, hipStream_t stream) {
    Args a = base; a.ph_lo = lo; a.ph_hi = hi; a.li = li;
    hipLaunchKernelGGL(mega, dim3(256), dim3(NTHREADS), LDS_BYTES, stream, a);
}
extern "C" void kernel_launch(void* const* d_in, const int* in_sizes, int n_in, void* d_out, int out_size, void* d_ws, size_t ws_size, hipStream_t stream) {
    static int ready = 0;
    if (!ready) {
        if (n_in != 35 || out_size != (int)O_END || ws_size < WS_END) { fprintf(stderr, "kernel_launch: unexpected shapes n_in %d out %d ws %zu\n", n_in, out_size, ws_size); ready = -1; return; }
        if (hipFuncSetAttribute((const void*)mega, hipFuncAttributeMaxDynamicSharedMemorySize, LDS_BYTES) != hipSuccess) { fprintf(stderr, "kernel_launch: hipFuncSetAttribute failed\n"); ready = -1; return; }
        ready = 1;
    }
    if (ready < 0) return;
    Args a{}; for (int i = 0; i < 35; ++i) a.in[i] = (const float*)d_in[i]; a.out = (float*)d_out; a.ws = (unsigned char*)d_ws;
    (void)hipMemsetAsync((char*)d_ws + OFF_CTL, 0, CTL_ZERO_BYTES, stream);
    launch_mega(a, 0, PH_END, 0, stream);
}
```

```cpp
#include <hip/hip_runtime.h>
#include <stdint.h>
#include <stdio.h>

typedef unsigned short bf16_t;
typedef short bf16x8 __attribute__((ext_vector_type(8)));
typedef float f32x4 __attribute__((ext_vector_type(4)));

constexpr int D = 1024, DEPTH = 4;
constexpr int CB = 32, CL = 256, LB = 8, LL = 1024;
constexpr int MC = CB * CL;
constexpr int M = MC + LB * LL;
constexpr int NSEQ = CB + LB;
constexpr int IN_COLS = 2444;
constexpr int PN = 2432, PNP = 2560;
constexpr int PZ = 0, PX = 384, PU = 1024, PQ = 1280, PK = 1664, PV = 2048;
constexpr int DFF = 4096;
constexpr float EPS = 1e-6f;

constexpr size_t MiB = 1u << 20;
constexpr size_t OFF_CTL = 0, OFF_MODS = 1 * MiB, OFF_TAB = 2 * MiB, OFF_WIN = 8 * MiB, OFF_WOUT = 28 * MiB, OFF_WFF1 = 36 * MiB,
                 OFF_WFF2 = 68 * MiB, OFF_WGLU = 100 * MiB, OFF_DT = 101 * MiB, OFF_X = 102 * MiB, OFF_PROJ = 166 * MiB, OFF_MIX = 242 * MiB,
                 OFF_FFH = 166 * MiB, OFF_H = 294 * MiB, OFF_XBC = 294 * MiB, OFF_YSSD = 334 * MiB, OFF_YS5 = 358 * MiB, WS_END = 374 * MiB;
constexpr size_t TAB_ABAR = 0;
constexpr size_t TAB_SQ1 = 256 * 1024;
constexpr size_t TAB_SQ2 = 1280 * 1024;
constexpr size_t TAB_B1 = 2304 * 1024;
constexpr size_t TAB_B2 = 4352 * 1024;
constexpr size_t TAB_SSQ = 5 * MiB;
constexpr size_t OFF_HIN = 362 * MiB;
constexpr size_t OFF_YU = 274 * MiB;
constexpr size_t TAB_CD = 3 * MiB;
constexpr size_t OFF_CS = 334 * MiB;
constexpr size_t TAB_CC1 = 4 * MiB;
constexpr size_t TAB_BBT = 3 * MiB + 512 * 1024;
constexpr size_t OFF_E = 358 * MiB;

__device__ __forceinline__ float bf2f(bf16_t v) { return __uint_as_float((unsigned)v << 16); }
typedef float f32x2_t __attribute__((ext_vector_type(2))); typedef __bf16 bf16x2_t __attribute__((ext_vector_type(2)));
__device__ __forceinline__ unsigned cvtpk(float lo, float hi) { f32x2_t v = {lo, hi}; bf16x2_t b = __builtin_convertvector(v, bf16x2_t); return __builtin_bit_cast(unsigned, b); }
__device__ __forceinline__ bf16_t f2bf(float f) { return (bf16_t)(cvtpk(f, f) & 0xffffu); }
__device__ __forceinline__ float sigmoid_f(float x) { return __builtin_amdgcn_rcpf(1.f + __expf(-x)); }
__device__ __forceinline__ float silu_f(float x) { return x * sigmoid_f(x); }
__device__ __forceinline__ float softplus_f(float x) { return x > 20.f ? x : log1pf(__expf(x)); }
__device__ __forceinline__ float gelu_tanh_f(float x) { const float u = 1.5957691216057308f * (x + 0.044715f * x * x * x); return x * sigmoid_f(u); }
template <int CTRL> __device__ __forceinline__ float dppf(float x) { return __uint_as_float((unsigned)__builtin_amdgcn_update_dpp(0, (int)__float_as_uint(x), CTRL, 0xf, 0xf, true)); }
__device__ __forceinline__ float row16_sum(float x) { x += dppf<0xB1>(x); x += dppf<0x4E>(x); x += dppf<0x141>(x); x += dppf<0x140>(x); return x; }
__device__ __forceinline__ float row16_max(float x) { x = fmaxf(x, dppf<0xB1>(x)); x = fmaxf(x, dppf<0x4E>(x)); x = fmaxf(x, dppf<0x141>(x)); x = fmaxf(x, dppf<0x140>(x)); return x; }
__device__ __forceinline__ float xsum16(float x) { const auto r = __builtin_amdgcn_permlane16_swap(__float_as_uint(x), __float_as_uint(x), false, false); return __uint_as_float(r[0]) + __uint_as_float(r[1]); }
__device__ __forceinline__ float xsum32(float x) { const auto r = __builtin_amdgcn_permlane32_swap(__float_as_uint(x), __float_as_uint(x), false, false); return __uint_as_float(r[0]) + __uint_as_float(r[1]); }
__device__ __forceinline__ float xmax16(float x) { const auto r = __builtin_amdgcn_permlane16_swap(__float_as_uint(x), __float_as_uint(x), false, false); return fmaxf(__uint_as_float(r[0]), __uint_as_float(r[1])); }
__device__ __forceinline__ float xmax32(float x) { const auto r = __builtin_amdgcn_permlane32_swap(__float_as_uint(x), __float_as_uint(x), false, false); return fmaxf(__uint_as_float(r[0]), __uint_as_float(r[1])); }
__device__ __forceinline__ float rdlane(float x, int l) { return __uint_as_float((unsigned)__builtin_amdgcn_readlane((int)__float_as_uint(x), l)); }
__device__ __forceinline__ float wave_sum(float v) { return xsum32(xsum16(row16_sum(v))); }
__device__ __forceinline__ float wave_max(float v) { return xmax32(xmax16(row16_max(v))); }
__device__ __forceinline__ int mod_row(int row) { return row < MC ? 0 : 1 + ((row - MC) >> 10); }

struct P {
    const float* in[35];
    float* out;
    unsigned char* ws;
};
constexpr size_t O_YP = 0, O_YS = 8388608, O_K = 16777216, O_V = O_K + 12582912, O_SSD = O_V + 12582912, O_RE = O_SSD + 6291456, O_IM = O_RE + 262144, O_END = O_IM + 262144;


#define LAS __attribute__((address_space(3)))
struct SeqInfo { int start, L, b, ctx; };
__device__ __forceinline__ SeqInfo seq_info(int s) { SeqInfo q; if (s < CB) { q.start = s * CL; q.L = CL; q.b = s; q.ctx = 1; } else { q.start = MC + (s - CB) * LL; q.L = LL; q.b = s - CB; q.ctx = 0; } return q; }
__device__ __forceinline__ SeqInfo row_seq(int row) { return seq_info(row < MC ? (row >> 8) : CB + ((row - MC) >> 10)); }
namespace pg8 {
#define PG8_LAS __attribute__((address_space(3)))
typedef unsigned short bf16_t;
typedef short bf16x8 __attribute__((ext_vector_type(8)));
typedef float f32x4 __attribute__((ext_vector_type(4)));
typedef unsigned u32x4 __attribute__((ext_vector_type(4)));
constexpr int BM = 256, BK = 64, HALF = 128, HTB = HALF * BK * 2  , STAGE_BYTES = 8 * HTB, NXCD = 8, WGM = 8;

__host__ __device__ __forceinline__ int lds_byte(int r, int c) { const int st = (r >> 4) * 2 + (c >> 5), rr = r & 15, cc = c & 31, ob = rr * 64 + cc * 2; return st * 1024 + (ob ^ (((ob >> 9) & 1) << 5)); }
__host__ __device__ __forceinline__ void stage_rc(int b, int& R, int& C) { const int st = b / 1024, sb = b % 1024, swz = sb ^ (((sb >> 9) & 1) << 5); R = (st >> 1) * 16 + swz / 64; C = (st & 1) * 32 + (swz % 64) / 2; }
__host__ __device__ __forceinline__ int perm32(int rho) { const int n = rho >> 4, i = rho & 15; return 8 * (i >> 2) + 4 * n + (i & 3); }

struct Unit { int pm, pn; };
struct Gemm { const bf16_t* A; const bf16_t* Bt; int M, N, K; };

struct StaticOrder {
    int nM, nN, nwg, G, c;
    __host__ __device__ void init(int M, int N, int G_, int c_) { nM = M / BM; nN = N / BM; nwg = nM * nN; G = G_; c = c_; }
    __host__ __device__ bool next(int i, Unit& u) const {
        const long L = (long)i * G + c; if (L >= nwg) return false;
        int wgid = (int)L; { const int q = nwg / NXCD, r = nwg % NXCD, xcd = wgid % NXCD, off = wgid / NXCD; wgid = (xcd < r ? xcd * (q + 1) : r * (q + 1) + (xcd - r) * q) + off; }
        const int nig = WGM * nN, gid = wgid / nig, fm = gid * WGM, gsz = (nM - fm) < WGM ? (nM - fm) : WGM;
        u.pm = fm + ((wgid % nig) % gsz); u.pn = (wgid % nig) / gsz; return true;
    }
    __device__ __forceinline__ void a_ready(const Unit&) const {}
    __device__ __forceinline__ void done(const Unit&) const {}
};

__device__ __forceinline__ unsigned cvt_pk_bf16(float lo, float hi) { unsigned r; asm volatile("v_cvt_pk_bf16_f32 %0, %1, %2" : "=v"(r) : "v"(lo), "v"(hi)); return r; }
__device__ __forceinline__ float row_rstd(const float* ssq, int row, int fq) {
    const f32x4 a = *(const f32x4*)(ssq + (size_t)row * 16 + 4 * fq);
    const float s = ::xsum32(::xsum16((a[0] + a[1]) + (a[2] + a[3])));
    return rsqrtf(s * (1.f / 1024.f) + ::EPS);
}
struct EpiProj {
    static constexpr bool PERM = true, AFTER_DRAIN = false; static constexpr int MID_T = 0;
    bf16_t* proj; float* ok; float* ov; float* dt; PG8_LAS const float* side; int l; mutable int slot;
    __device__ __forceinline__ void operator()(const f32x4 (&acc)[2][2][4][2], const Unit& u, int wr, int wc, int fr, int fq) const {
        const int row0 = u.pm * BM + wr * 64 + fr;
        PG8_LAS const float* rsp = side + slot * 256 + wr * 64 + fr; PG8_LAS const float* bsp = side + 1024 + slot * 256 + wc * 32 + 8 * fq; ++slot;
        float rs[2][4];
#pragma unroll
        for (int ai = 0; ai < 2; ++ai)
#pragma unroll
            for (int m = 0; m < 4; ++m) rs[ai][m] = rsp[ai * HALF + m * 16];
#pragma unroll
        for (int bj = 0; bj < 2; ++bj) {
            const int cb = u.pn * BM + bj * HALF;
            if (cb > ::PN) continue;
            const int col = cb + wc * 32 + 8 * fq;
            const f32x4 b0 = *(PG8_LAS const f32x4*)(bsp + bj * HALF), b1 = *(PG8_LAS const f32x4*)(bsp + bj * HALF + 4);
            const bool isk = (cb >= ::PK && cb < ::PV), isv = (cb >= ::PV && cb < ::PN), isdt = (cb == ::PN);
#pragma unroll
            for (int ai = 0; ai < 2; ++ai)
#pragma unroll
                for (int m = 0; m < 4; ++m) {
                    const int row = row0 + ai * HALF + m * 16;
                    const f32x4 v0 = acc[ai][bj][m][0] * rs[ai][m] + b0, v1 = acc[ai][bj][m][1] * rs[ai][m] + b1;
                    if (isdt) { if (wc == 0 && fq < 2) { float* d = dt + (size_t)row * 12 + 8 * fq; *(f32x4*)d = v0; if (fq == 0) *(f32x4*)(d + 4) = v1; } continue; }
                    u32x4 w; w.x = cvt_pk_bf16(v0[0], v0[1]); w.y = cvt_pk_bf16(v0[2], v0[3]); w.z = cvt_pk_bf16(v1[0], v1[1]); w.w = cvt_pk_bf16(v1[2], v1[3]);
                    *(u32x4*)(proj + (size_t)row * ::PN + col) = w;
                    if (u.pm < 32 && (isk || isv)) {
                        const int b = row >> 8, t = row & 255;
                        float* o = (isk ? ok : ov) + ((size_t)(b * 4 + l) * 256 + t) * 384 + (col - (isk ? ::PK : ::PV));
                        *(f32x4*)o = v0; *(f32x4*)(o + 4) = v1;
                    }
                }
        }
    }
};
template <int MID>
struct EpiRes {
    static constexpr bool PERM = true, AFTER_DRAIN = false; static constexpr int MID_T = MID;
    const float* xin_c; const float* xin_l; float* xout; const float* gate; const float* nw; const float* sc; bf16_t* xs; float* ssq;
    PG8_LAS const float* side;
    __device__ __forceinline__ void mid(f32x4 (&acc)[2][2][4][2], const Unit& u, int wr, int fr) const {
#pragma unroll
        for (int ai = 0; ai < 2; ++ai)
#pragma unroll
            for (int m = 0; m < 4; ++m) { const float sc_ = side[ai * HALF + wr * 64 + m * 16 + fr];
#pragma unroll
                for (int bj = 0; bj < 2; ++bj)
#pragma unroll
                    for (int n = 0; n < 2; ++n) acc[ai][bj][m][n] = acc[ai][bj][m][n] * sc_; }
    }
    __device__ __forceinline__ void operator()(const f32x4 (&acc)[2][2][4][2], const Unit& u, int wr, int wc, int fr, int fq) const {
        const int row0 = u.pm * BM + wr * 64 + fr, col0 = u.pn * BM + wc * 32 + 8 * fq;
        const int r = u.pm < 32 ? 0 : 1 + ((u.pm - 32) >> 2);
        const float* gt = gate + (size_t)r * 6144; const float* sr = sc + (size_t)r * 6144;
        const float* xin = u.pm < 32 ? xin_c : xin_l;
        float sq[2][4];
#pragma unroll
        for (int ai = 0; ai < 2; ++ai)
#pragma unroll
            for (int m = 0; m < 4; ++m) sq[ai][m] = 0.f;
#pragma unroll
        for (int bj = 0; bj < 2; ++bj) {
            const int col = col0 + bj * HALF;
            const f32x4 g0 = *(const f32x4*)(gt + col), g1 = *(const f32x4*)(gt + col + 4);
            f32x4 gs0 = {0.f, 0.f, 0.f, 0.f}, gs1 = gs0;
            if (xs) { gs0 = *(const f32x4*)(nw + col) * (*(const f32x4*)(sr + col) + 1.f); gs1 = *(const f32x4*)(nw + col + 4) * (*(const f32x4*)(sr + col + 4) + 1.f); }
#pragma unroll
            for (int ai = 0; ai < 2; ++ai)
#pragma unroll
                for (int m = 0; m < 4; ++m) {
                    const size_t off = (size_t)(row0 + ai * HALF + m * 16) * ::D + col;
                    const f32x4 x0 = *(const f32x4*)(xin + off) + g0 * acc[ai][bj][m][0], x1 = *(const f32x4*)(xin + off + 4) + g1 * acc[ai][bj][m][1];
                    *(f32x4*)(xout + off) = x0; *(f32x4*)(xout + off + 4) = x1;
                    if (xs) { sq[ai][m] += ((x0[0] * x0[0] + x0[1] * x0[1]) + (x0[2] * x0[2] + x0[3] * x0[3])) + ((x1[0] * x1[0] + x1[1] * x1[1]) + (x1[2] * x1[2] + x1[3] * x1[3]));
                        const f32x4 h0 = x0 * gs0, h1 = x1 * gs1; u32x4 o; o.x = cvt_pk_bf16(h0[0], h0[1]); o.y = cvt_pk_bf16(h0[2], h0[3]); o.z = cvt_pk_bf16(h1[0], h1[1]); o.w = cvt_pk_bf16(h1[2], h1[3]);
                        *(u32x4*)(xs + off) = o; }
                }
        }
        if (xs) {
#pragma unroll
            for (int ai = 0; ai < 2; ++ai)
#pragma unroll
                for (int m = 0; m < 4; ++m) { const float t = ::xsum32(::xsum16(sq[ai][m])); if (fq == 0) ssq[(size_t)(row0 + ai * HALF + m * 16) * 16 + u.pn * 4 + wc] = t; }
        }
    }
};
struct EpiFF1 {
    static constexpr bool PERM = true, AFTER_DRAIN = false; static constexpr int MID_T = 0;
    bf16_t* h; PG8_LAS const float* side; mutable int slot;
    __device__ __forceinline__ void operator()(const f32x4 (&acc)[2][2][4][2], const Unit& u, int wr, int wc, int fr, int fq) const {
        const int row0 = u.pm * BM + wr * 64 + fr, col0 = u.pn * BM + wc * 32 + 8 * fq;
        PG8_LAS const float* rsp = side + slot * 256 + wr * 64 + fr; PG8_LAS const float* bsp = side + 1024 + slot * 256 + wc * 32 + 8 * fq; ++slot;
        f32x4 bv[2][2];
#pragma unroll
        for (int bj = 0; bj < 2; ++bj) { bv[bj][0] = *(PG8_LAS const f32x4*)(bsp + bj * HALF); bv[bj][1] = *(PG8_LAS const f32x4*)(bsp + bj * HALF + 4); }
#pragma unroll
        for (int ai = 0; ai < 2; ++ai)
#pragma unroll
            for (int m = 0; m < 4; ++m) {
                const int row = row0 + ai * HALF + m * 16; const float rs = rsp[ai * HALF + m * 16];
                bf16_t* rowp = h + (size_t)row * ::DFF + col0;
#pragma unroll
                for (int bj = 0; bj < 2; ++bj) {
                    f32x4 v0 = acc[ai][bj][m][0] * rs + bv[bj][0], v1 = acc[ai][bj][m][1] * rs + bv[bj][1];
#pragma unroll
                    for (int e = 0; e < 4; ++e) { const float a = fmaxf(v0[e], 0.f), b = fmaxf(v1[e], 0.f); v0[e] = a * a; v1[e] = b * b; }
                    u32x4 w; w.x = cvt_pk_bf16(v0[0], v0[1]); w.y = cvt_pk_bf16(v0[2], v0[3]); w.z = cvt_pk_bf16(v1[0], v1[1]); w.w = cvt_pk_bf16(v1[2], v1[3]);
                    *(u32x4*)(rowp + bj * HALF) = w;
                }
            }
    }
};
template <class Epi, class Sched, bool ALIGN_EPI = false, bool SP2 = false>
__device__ __forceinline__ void gemm_phase(PG8_LAS unsigned char* lds, const Gemm g, const Sched& S, const Epi& E) {
    int tid_ = threadIdx.x; asm volatile("" : "+v"(tid_));
    const int tid = tid_, wid = __builtin_amdgcn_readfirstlane(tid >> 6), lane = tid & 63, wr = wid >> 2, wc = wid & 3, fr = lane & 15, fq = lane >> 4;
    const int K = g.K, nt = K / BK;
    unsigned voffA[2], voffB[2];
#pragma unroll
    for (int i = 0; i < 2; ++i) { int R, C; stage_rc(tid * 16 + i * 8192, R, C); const int Rb = Epi::PERM ? ((R & ~31) + perm32(R & 31)) : R;
        voffA[i] = (unsigned)(R * K + C) * 2u; voffB[i] = (unsigned)(Rb * K + C) * 2u; }
    const size_t kstep = (size_t)(BK * 2);
    const size_t hstep = (size_t)HALF * K * 2;
    const size_t tstep = 2 * hstep;
    const unsigned ldsw = (unsigned)wid * 1024u;
    const int aoff = lds_byte(wr * 64 + fr, fq * 8), boff = lds_byte(wc * 32 + fr, fq * 8);
#define PG8_SA(b, h) (((b) * 2 + (h)) * HTB)
#define PG8_SB(b, h) ((4 + (b) * 2 + (h)) * HTB)
#define PG8_STAGE(bufoff, gbase, voff) do { _Pragma("unroll") for (int _i = 0; _i < 2; ++_i) \
        __builtin_amdgcn_global_load_lds((const unsigned*)((const char*)(gbase) + (voff)[_i]), (PG8_LAS unsigned*)(lds + (bufoff) + ldsw + _i * 8192), 16, 0, 0); } while (0)
#define PG8_LDA(dst, b, h) do { _Pragma("unroll") for (int m = 0; m < 4; ++m) _Pragma("unroll") for (int k = 0; k < 2; ++k) dst[m][k] = *(const PG8_LAS bf16x8*)(lds + PG8_SA(b, h) + aoff + m * 2048 + k * 1024); } while (0)
#define PG8_LDB(dst, b, h) do { _Pragma("unroll") for (int n = 0; n < 2; ++n) _Pragma("unroll") for (int k = 0; k < 2; ++k) dst[n][k] = *(const PG8_LAS bf16x8*)(lds + PG8_SB(b, h) + boff + n * 2048 + k * 1024); } while (0)
#define PG8_MMA(ai, bj, At, Bt) do { __builtin_amdgcn_s_setprio(1); _Pragma("unroll") for (int m = 0; m < 4; ++m) _Pragma("unroll") for (int n = 0; n < 2; ++n) _Pragma("unroll") for (int k = 0; k < 2; ++k) \
        acc[ai][bj][m][n] = __builtin_amdgcn_mfma_f32_16x16x32_bf16(Bt[n][k], At[m][k], acc[ai][bj][m][n], 0, 0, 0); __builtin_amdgcn_s_setprio(0); } while (0)
#define PG8_WAIT_V(n) asm volatile("s_waitcnt vmcnt(" #n ")" ::: "memory")
#define PG8_WAIT_L(n) asm volatile("s_waitcnt lgkmcnt(" #n ")" ::: "memory")
#define PG8_BAR __builtin_amdgcn_s_barrier()
#define PG8_SCHED __builtin_amdgcn_sched_barrier(0)
    Unit cur, nxt; int ui = 0;
    if (!S.next(0, cur)) return;
    f32x4 acc[2][2][4][2];
#pragma unroll
    for (int a = 0; a < 2; ++a)
#pragma unroll
        for (int b = 0; b < 2; ++b)
#pragma unroll
            for (int m = 0; m < 4; ++m)
#pragma unroll
                for (int n = 0; n < 2; ++n) acc[a][b][m][n] = (f32x4){0.f, 0.f, 0.f, 0.f};
    bf16x8 At[4][2], B0[2][2], B1[2][2];
    const char* cA = (const char*)g.A + (size_t)cur.pm * tstep; const char* cB = (const char*)g.Bt + (size_t)cur.pn * tstep;
    S.a_ready(cur);
    if constexpr (SP2) {
        PG8_STAGE(PG8_SB(0, 0), cB, voffB); PG8_STAGE(PG8_SB(0, 1), cB + hstep, voffB); PG8_STAGE(PG8_SA(0, 0), cA, voffA); PG8_STAGE(PG8_SA(0, 1), cA + hstep, voffA);
        if (wr == 1) PG8_BAR;
        PG8_WAIT_V(2); PG8_BAR;
        PG8_STAGE(PG8_SB(1, 0), cB + kstep, voffB); PG8_STAGE(PG8_SA(1, 0), cA + kstep, voffA); PG8_STAGE(PG8_SB(1, 1), cB + hstep + kstep, voffB);
        PG8_WAIT_V(6); PG8_BAR;
    } else {
        PG8_STAGE(PG8_SB(0, 0), cB, voffB); PG8_STAGE(PG8_SA(0, 0), cA, voffA); PG8_STAGE(PG8_SB(0, 1), cB + hstep, voffB); PG8_STAGE(PG8_SA(0, 1), cA + hstep, voffA);
        if (wr == 1) PG8_BAR;
        PG8_WAIT_V(4); PG8_BAR;
        PG8_STAGE(PG8_SB(1, 0), cB + kstep, voffB); PG8_STAGE(PG8_SA(1, 0), cA + kstep, voffA); PG8_STAGE(PG8_SB(1, 1), cB + hstep + kstep, voffB);
        PG8_WAIT_V(6); PG8_BAR;
    }
    for (;;) {
        const bool has_next = S.next(ui + 1, nxt);
        const char* nA = has_next ? (const char*)g.A + (size_t)nxt.pm * tstep : cA; const char* nB = has_next ? (const char*)g.Bt + (size_t)nxt.pn * tstep : cB;
        for (int t = 0; t < nt; t += 2) {
            if constexpr (Epi::MID_T > 0) { if (t == Epi::MID_T) E.mid(acc, cur, wr, fr); }
            const bool last = (t == nt - 2);
            const char* a1 = cA + (size_t)(t + 1) * kstep;
            const char* a2 = last ? nA : cA + (size_t)(t + 2) * kstep; const char* b2 = last ? nB : cB + (size_t)(t + 2) * kstep;
            const char* a3 = a2 + kstep; const char* b3 = b2 + kstep;
            if (last && has_next) S.a_ready(nxt);
            if constexpr (SP2) {
            PG8_LDB(B0, 0, 0); PG8_LDB(B1, 0, 1); PG8_SCHED; PG8_LDA(At, 0, 0); PG8_STAGE(PG8_SA(1, 1), a1 + hstep, voffA);
            PG8_WAIT_V(8); PG8_WAIT_L(0); PG8_BAR; PG8_MMA(0, 0, At, B0); PG8_MMA(0, 1, At, B1); PG8_BAR; PG8_SCHED;
            PG8_LDA(At, 0, 1); PG8_STAGE(PG8_SB(0, 0), b2, voffB); PG8_STAGE(PG8_SB(0, 1), b2 + hstep, voffB); PG8_STAGE(PG8_SA(0, 0), a2, voffA);
            PG8_WAIT_V(8); PG8_WAIT_L(0); PG8_BAR; PG8_MMA(1, 0, At, B0); PG8_MMA(1, 1, At, B1); PG8_BAR; PG8_SCHED;
            PG8_LDB(B0, 1, 0); PG8_LDB(B1, 1, 1); PG8_SCHED; PG8_LDA(At, 1, 0); PG8_STAGE(PG8_SA(0, 1), a2 + hstep, voffA);
            PG8_WAIT_V(8); PG8_WAIT_L(0); PG8_BAR; PG8_MMA(0, 0, At, B0); PG8_MMA(0, 1, At, B1); PG8_BAR; PG8_SCHED;
            PG8_LDA(At, 1, 1); PG8_STAGE(PG8_SB(1, 0), b3, voffB); PG8_STAGE(PG8_SB(1, 1), b3 + hstep, voffB); PG8_STAGE(PG8_SA(1, 0), a3, voffA);
            PG8_WAIT_V(8); PG8_WAIT_L(0); PG8_BAR; PG8_MMA(1, 0, At, B0); PG8_MMA(1, 1, At, B1); PG8_BAR; PG8_SCHED;
            } else {
            PG8_LDB(B0, 0, 0); PG8_SCHED; PG8_LDA(At, 0, 0); PG8_STAGE(PG8_SA(1, 1), a1 + hstep, voffA);
            PG8_WAIT_L(8); PG8_BAR; PG8_WAIT_L(0); PG8_MMA(0, 0, At, B0); PG8_BAR; PG8_SCHED;
            PG8_LDB(B1, 0, 1); PG8_STAGE(PG8_SB(0, 0), b2, voffB);
            PG8_BAR; PG8_WAIT_L(0); PG8_MMA(0, 1, At, B1); PG8_BAR;
            PG8_LDA(At, 0, 1); PG8_STAGE(PG8_SA(0, 0), a2, voffA);
            PG8_BAR; PG8_WAIT_L(0); PG8_MMA(1, 0, At, B0); PG8_BAR; PG8_SCHED;
            PG8_STAGE(PG8_SB(0, 1), b2 + hstep, voffB);
            PG8_WAIT_V(6); PG8_BAR; PG8_MMA(1, 1, At, B1); PG8_BAR;
            PG8_LDB(B0, 1, 0); PG8_SCHED; PG8_LDA(At, 1, 0); PG8_STAGE(PG8_SA(0, 1), a2 + hstep, voffA);
            PG8_WAIT_L(8); PG8_BAR; PG8_WAIT_L(0); PG8_MMA(0, 0, At, B0); PG8_BAR; PG8_SCHED;
            PG8_LDB(B1, 1, 1); PG8_STAGE(PG8_SB(1, 0), b3, voffB);
            PG8_BAR; PG8_WAIT_L(0); PG8_MMA(0, 1, At, B1); PG8_BAR;
            PG8_LDA(At, 1, 1); PG8_STAGE(PG8_SA(1, 0), a3, voffA);
            PG8_BAR; PG8_WAIT_L(0); PG8_MMA(1, 0, At, B0); PG8_BAR; PG8_SCHED;
            PG8_STAGE(PG8_SB(1, 1), b3 + hstep, voffB);
            PG8_WAIT_V(6); PG8_BAR; PG8_MMA(1, 1, At, B1); PG8_BAR;
            }
        }
        if constexpr (ALIGN_EPI) { if (wr == 0) PG8_BAR; }
        if constexpr (!Epi::AFTER_DRAIN) { E(acc, cur, wr, wc, fr, fq); S.done(cur); }
        if (!has_next) break;
#pragma unroll
        for (int a = 0; a < 2; ++a)
#pragma unroll
            for (int b = 0; b < 2; ++b)
#pragma unroll
                for (int m = 0; m < 4; ++m)
#pragma unroll
                    for (int n = 0; n < 2; ++n) acc[a][b][m][n] = (f32x4){0.f, 0.f, 0.f, 0.f};
        cur = nxt; cA = nA; cB = nB; ++ui;
        if constexpr (ALIGN_EPI) { if (wr == 1) PG8_BAR; }
    }
    PG8_WAIT_V(0);
    if constexpr (!ALIGN_EPI) { if (wr == 0) PG8_BAR; }
    PG8_BAR;
    if constexpr (Epi::AFTER_DRAIN) { E.fused(acc, cur, wr, wc, fr, fq, lds, wid, lane); S.done(cur); }
#undef PG8_SA
#undef PG8_SB
#undef PG8_STAGE
#undef PG8_LDA
#undef PG8_LDB
#undef PG8_MMA
#undef PG8_WAIT_V
#undef PG8_WAIT_L
#undef PG8_BAR
#undef PG8_SCHED
}
}

constexpr int NWAVES = 8, NTHREADS = 512;
constexpr int RING_BYTES = 131072, LDS_BYTES = 163840, LDSCTL_OFF = LDS_BYTES - 512, MISC_OFF = LDSCTL_OFF + 320;
#define GAS __attribute__((address_space(1)))
typedef unsigned v4u __attribute__((ext_vector_type(4)));
typedef GAS unsigned gu32;
#define LDS_WAIT() asm volatile("s_waitcnt lgkmcnt(0)" ::: "memory")
#define VM_WAIT() asm volatile("s_waitcnt vmcnt(0)" ::: "memory")
__device__ __forceinline__ unsigned pk2(float lo, float hi) { return cvtpk(lo, hi); }
constexpr int CW_BAR = 4096, CW_Q = 65536;
constexpr size_t CTL_ZERO_BYTES = 1 * MiB;

#define XB_TMO      128
#define XB_XCNT(j)  (256  + 64 * (j))
#define XB_XSUB(j)  (1280 + 64 * (j))
#define XB_XGEN(j)  (2304 + 64 * (j))
#define XB_TOP      3328
#define XB_TOPGEN   3392
#define XCD_BAR_WORDS 3456
#define XB_SPIN_CAP (1u << 18)

__device__ __forceinline__ unsigned xb_ld(unsigned* p)              { return __hip_atomic_load(p, __ATOMIC_RELAXED, __HIP_MEMORY_SCOPE_AGENT); }
__device__ __forceinline__ unsigned xb_add(unsigned* p, unsigned v) { return __hip_atomic_fetch_add(p, v, __ATOMIC_RELAXED, __HIP_MEMORY_SCOPE_AGENT); }
__device__ __forceinline__ unsigned xb_xcc_id() { return (unsigned)__builtin_amdgcn_s_getreg((3 << 11) | 20) & 0xFu; }
#define XB_SPIN(cond, bar) do { unsigned _sp = 0; while (cond) { __builtin_amdgcn_s_sleep(1); \
    if ((++_sp & 255u) == 0u) { if (xb_ld(&(bar)[XB_TMO])) break; if (_sp > XB_SPIN_CAP) { atomicAdd(&(bar)[XB_TMO], 1u); break; } } } } while (0)

struct XcdBarrier {
    unsigned* bar; unsigned x;
    volatile LAS unsigned* st;
};

__device__ __forceinline__ XcdBarrier xcd_barrier_post(unsigned* bar, volatile LAS unsigned* st) {
    XcdBarrier b; b.bar = bar; b.x = xb_xcc_id(); b.st = st;
    if (threadIdx.x == 0) (void)xb_add(&bar[XB_XCNT(b.x)], 1u);
    return b;
}
__device__ __forceinline__ void xcd_barrier_complete(unsigned* bar, unsigned x, unsigned& nloc, unsigned& nx) {
    const unsigned G = gridDim.x * gridDim.y * gridDim.z;
    unsigned sum, cnt, mine, sp = 0u;
    for (;;) {
        sum = 0u; cnt = 0u; mine = 0u;
#pragma unroll
        for (unsigned j = 0; j < 16; ++j) { const unsigned c = xb_ld(&bar[XB_XCNT(j)]); sum += c; cnt += (c > 0u) ? 1u : 0u; mine = (j == x) ? c : mine; }
        if (sum == G) break;
        __builtin_amdgcn_s_sleep(1);
        if ((++sp & 255u) == 0u) { if (xb_ld(&bar[XB_TMO])) break; if (sp > XB_SPIN_CAP) { atomicAdd(&bar[XB_TMO], 1u); break; } }
    }
    nloc = mine > 0u ? mine : 1u; nx = cnt > 0u ? cnt : 1u;
}

__device__ __forceinline__ void xcd_barrier(const XcdBarrier& b) {
    asm volatile("s_waitcnt vmcnt(0)" ::: "memory");
    __syncthreads();
    if (threadIdx.x == 0) {
        unsigned* bar = b.bar;
        __builtin_amdgcn_s_waitcnt(0);
        unsigned nloc = b.st[0], nx = b.st[1];
        if (nloc == 0u) { xcd_barrier_complete(bar, b.x, nloc, nx); b.st[0] = nloc; b.st[1] = nx; }
        const unsigned old = xb_add(&bar[XB_XSUB(b.x)], 1u);
        const unsigned gen = old / nloc;
        if (old + 1u == (gen + 1u) * nloc) {
            __builtin_amdgcn_fence(__ATOMIC_RELEASE, "agent");
            asm volatile("s_waitcnt vmcnt(0)" ::: "memory");
            const unsigned og = xb_add(&bar[XB_TOP], 1u);
            const unsigned tg = og / nx;
            if (og + 1u == (tg + 1u) * nx) xb_add(&bar[XB_TOPGEN], 1u);
            else XB_SPIN(xb_ld(&bar[XB_TOPGEN]) == tg, bar);
            __builtin_amdgcn_fence(__ATOMIC_ACQUIRE, "agent");
            xb_add(&bar[XB_XGEN(b.x)], 1u);
            asm volatile("s_waitcnt vmcnt(0)" ::: "memory");
        } else {
            XB_SPIN(xb_ld(&bar[XB_XGEN(b.x)]) == gen, bar);
            __builtin_amdgcn_fence(__ATOMIC_ACQUIRE, "agent");
            asm volatile("s_waitcnt vmcnt(0)" ::: "memory");
        }
    }
    __syncthreads();
}


struct Frame {
    LAS unsigned char* lds;
    volatile LAS unsigned* MISC;
    unsigned* ctl;
    int tid, lane, wave, vcu, G;
    const float* const* in; float* out; unsigned char* ws;
};
constexpr int PH_PRO = 0, PH_PRE = 1, PH_L0 = 2, PH_PER_LAYER = 6, PH_G1 = 0, PH_MIXA = 1, PH_MIXB = 2, PH_G3 = 3, PH_G4 = 4, PH_G5 = 5, PH_FINAL = PH_L0 + DEPTH * PH_PER_LAYER, PH_END = PH_FINAL + 1;

__device__ __forceinline__ int queue_next(Frame& F, unsigned* ctr);
constexpr int TR_P = 144;
__device__ __forceinline__ void transpose_item(const float* W, int K, int Nsrc, int src_n0, bf16_t* WT, int dst_n0, int k0, LAS unsigned char* scr, int lane, int nvalid = 64) {
    const int l16 = lane & 15, l4 = lane >> 4;
    f32x4 v[16];
#pragma unroll
    for (int i = 0; i < 16; ++i) v[i] = (src_n0 >= 0 && 4 * l16 < nvalid) ? *(const f32x4*)(W + (size_t)(k0 + 4 * i + l4) * Nsrc + src_n0 + 4 * l16) : (f32x4){0.f, 0.f, 0.f, 0.f};
#pragma unroll
    for (int i = 0; i < 16; ++i)
#pragma unroll
        for (int e = 0; e < 4; ++e) *(LAS bf16_t*)(scr + (4 * l16 + e) * TR_P + (4 * i + l4) * 2) = f2bf(v[i][e]);
    LDS_WAIT(); asm volatile("" ::: "memory");
#pragma unroll
    for (int jn = 0; jn < 8; ++jn) { const int n = 8 * jn + (lane >> 3), c = lane & 7;
        *(v4u*)(WT + (size_t)(dst_n0 + n) * K + k0 + 8 * c) = *(LAS const v4u*)(scr + n * TR_P + c * 16); }
    LDS_WAIT(); asm volatile("" ::: "memory");
}
__device__ __forceinline__ void phase_prologue(Frame& F) {
    const float* const* in = F.in;
    for (int idx = F.vcu * NTHREADS + F.tid; idx < 8192; idx += F.G * NTHREADS) {
        const int pp = idx & 63, g = (idx >> 6) & 15, dir = (idx >> 10) & 1, l = idx >> 11;
        const float are = in[20][idx], aim = in[21][idx];
        const float dt = __expf(in[22][(l * 2 + dir) * 16 + g]);
        const float zr = are * dt, zi = aim * dt;
        const float e = expf(zr); float rev = zi * 0.15915494309189535f; rev -= rintf(rev);
        const float ar = e * cosf(rev * 6.283185307179586f), ai = e * sinf(rev * 6.283185307179586f);
        float* abar = (float*)(F.ws + OFF_TAB + TAB_ABAR);
        abar[idx * 2] = ar; abar[idx * 2 + 1] = ai;
        const float xr = ar - 1.f, xi = ai, den = are * are + aim * aim;
        const float fr = (xr * are + xi * aim) / den, fi = (xi * are - xr * aim) / den;
        for (int c = 0; c < 16; ++c) {
            const float br = in[23][((l * 16 + g) * 64 + pp) * 16 + c], bi = in[24][((l * 16 + g) * 64 + pp) * 16 + c];
            bf16_t* bbt = (bf16_t*)(F.ws + OFF_TAB + TAB_BBT) + ((size_t)(((l * 2 + dir) * 16 + g) * 2) * 64 + pp) * 16 + c;
            bbt[0] = f2bf(fr * br - fi * bi); bbt[64 * 16] = f2bf(fr * bi + fi * br);
        }
    }
    for (int i = F.vcu * NTHREADS + F.tid; i < 4 * 16 * 16 * 128; i += F.G * NTHREADS) {
        const int k = i & 127, c = (i >> 7) & 15, g = (i >> 11) & 15, l = i >> 15, ri = k >> 6, pp = k & 63;
        const size_t si = ((size_t)(l * 16 + g) * 16 + c) * 64 + pp;
        ((bf16_t*)(F.ws + OFF_TAB + TAB_CC1))[i] = f2bf(ri ? -in[26][si] : in[25][si]);
    }
    constexpr int I_IN = 16 * (PNP / 64), I_OUT = 16 * 16, I_F1 = 16 * (DFF / 64), I_F2 = (DFF / 64) * 16, I_GLU = 4 * 4, I_L = I_IN + I_OUT + I_F1 + I_F2 + I_GLU, N_TR = DEPTH * I_L;
    constexpr int N_UNITS = 96 + (N_TR + 7) / 8;
    unsigned* ctr = F.ctl + CW_Q + 64 * 63;
    for (;;) {
        const int u = queue_next(F, ctr); if (u >= N_UNITS) break;
        if (u < 96) {
            LAS float* ssil = (LAS float*)F.lds;
            LAS float* part = (LAS float*)(F.lds + 9 * 1024 * 4);
            for (int i = F.tid; i < 9 * 1024; i += NTHREADS) { const int r = i >> 10, k = i & 1023; const float v = r == 0 ? in[8][k] : in[7][(r - 1) * 1024 + k]; ssil[i] = silu_f(v); }
            __syncthreads();
            const int l = u / 24, n0 = (u % 24) * 256;
            const float* w = in[9] + (size_t)l * 1024 * 6144 + n0 + 4 * F.lane;
            f32x4 acc[9];
#pragma unroll
            for (int r = 0; r < 9; ++r) acc[r] = (f32x4){0.f, 0.f, 0.f, 0.f};
            const int kb = F.wave * 128;
            for (int k = 0; k < 128; k += 4) {
                f32x4 wv[4];
#pragma unroll
                for (int e = 0; e < 4; ++e) wv[e] = *(const f32x4*)(w + (size_t)(kb + k + e) * 6144);
#pragma unroll
                for (int r = 0; r < 9; ++r) { const f32x4 sv = *(LAS const f32x4*)(ssil + r * 1024 + kb + k);
                    acc[r] += wv[0] * sv[0]; acc[r] += wv[1] * sv[1]; acc[r] += wv[2] * sv[2]; acc[r] += wv[3] * sv[3]; }
            }
#pragma unroll
            for (int r = 0; r < 9; ++r) *(LAS f32x4*)(part + (F.wave * 9 + r) * 256 + 4 * F.lane) = acc[r];
            __syncthreads();
            float* mods = (float*)(F.ws + OFF_MODS);
            for (int i = F.tid; i < 9 * 256; i += NTHREADS) { const int r = i >> 8, jn = i & 255; float sacc = in[10][l * 6144 + n0 + jn];
#pragma unroll
                for (int w8 = 0; w8 < 8; ++w8) sacc += part[(w8 * 9 + r) * 256 + jn];
                mods[(size_t)(l * 9 + r) * 6144 + n0 + jn] = sacc; }
        } else {
            const int it = (u - 96) * 8 + F.wave;
            if (it < N_TR) {
                LAS unsigned char* scr = F.lds + F.wave * (64 * TR_P);
                const int l = it / I_L; int r = it % I_L;
                if (r < I_IN) { const int nb = r % (PNP / 64), kb = r / (PNP / 64), n0 = nb * 64; const int src = n0 > PN ? -1 : (n0 == PN ? 1024 : (n0 >= 1024 ? n0 + 12 : n0));
                    transpose_item(in[13] + (size_t)l * 1024 * IN_COLS, 1024, IN_COLS, src, (bf16_t*)(F.ws + OFF_WIN) + (size_t)l * PNP * 1024, n0, kb * 64, scr, F.lane, n0 == PN ? 12 : 64); }
                else if ((r -= I_IN) < I_OUT) { const int nb = r % 16, kb = r / 16; transpose_item(in[31] + (size_t)l * 1024 * 1024, 1024, 1024, nb * 64, (bf16_t*)(F.ws + OFF_WOUT) + (size_t)l * 1024 * 1024, nb * 64, kb * 64, scr, F.lane); }
                else if ((r -= I_OUT) < I_F1) { const int nb = r % (DFF / 64), kb = r / (DFF / 64); transpose_item(in[32] + (size_t)l * 1024 * DFF, 1024, DFF, nb * 64, (bf16_t*)(F.ws + OFF_WFF1) + (size_t)l * DFF * 1024, nb * 64, kb * 64, scr, F.lane); }
                else if ((r -= I_F1) < I_F2) { const int nb = r % 16, kb = r / 16; transpose_item(in[33] + (size_t)l * DFF * 1024, DFF, 1024, nb * 64, (bf16_t*)(F.ws + OFF_WFF2) + (size_t)l * 1024 * DFF, nb * 64, kb * 64, scr, F.lane); }
                else { r -= I_F2; const int nb = r % 4, kb = r / 4; transpose_item(in[28] + (size_t)l * 65536, 256, 256, nb * 64, (bf16_t*)(F.ws + OFF_WGLU) + (size_t)l * 65536, nb * 64, kb * 64, scr, F.lane); }
            }
        }
    }
}
__device__ __forceinline__ void phase_pre(Frame& F) {
    const float* const* in = F.in; const int lane = F.lane;
    for (int row = F.vcu * NWAVES + F.wave; row < M; row += F.G * NWAVES) {
        const float* xr = row < MC ? in[0] + (size_t)row * D : in[1] + (size_t)(row - MC) * D;
        const float* sc = (const float*)(F.ws + OFF_MODS) + (size_t)mod_row(row) * 6144 + 1024; const float* gw = in[11];
        bf16_t* h = (bf16_t*)(F.ws + OFF_H) + (size_t)row * D;
        float s = 0.f;
#pragma unroll
        for (int j = 0; j < 4; ++j) { const int c = 4 * lane + 256 * j; const f32x4 v = *(const f32x4*)(xr + c), g = *(const f32x4*)(gw + c), a = *(const f32x4*)(sc + c);
            s += v.x * v.x + v.y * v.y + v.z * v.z + v.w * v.w;
            uint2 o; o.x = pk2(v.x * g.x * (1.f + a.x), v.y * g.y * (1.f + a.y)); o.y = pk2(v.z * g.z * (1.f + a.z), v.w * g.w * (1.f + a.w)); *(uint2*)(h + c) = o; }
        s = wave_sum(s);
        if (lane < 16) ((float*)(F.ws + OFF_TAB + TAB_SQ1))[(size_t)row * 16 + lane] = lane == 0 ? s : 0.f;
    }
    const int fr = lane & 15, fq = lane >> 4, w = F.wave;
    LAS float* red = (LAS float*)F.lds;
    for (int task = F.vcu; task < DEPTH * 104; task += F.G) {
        const int l = task / 104, t = task % 104, which = t >= 40, n0 = (which ? t - 40 : t) * 64;
        const float* mods = (const float*)(F.ws + OFF_MODS) + (size_t)l * 9 * 6144 + (which ? 3 : 0) * 1024;
        const bf16_t* wt = which ? (const bf16_t*)(F.ws + OFF_WFF1) + (size_t)l * DFF * 1024 : (const bf16_t*)(F.ws + OFF_WIN) + (size_t)l * PNP * 1024;
        float* bo = (float*)(F.ws + OFF_TAB + (which ? TAB_B2 : TAB_B1)) + (size_t)l * 9 * (which ? DFF : PNP);
        f32x4 acc[4];
#pragma unroll
        for (int nb = 0; nb < 4; ++nb) acc[nb] = (f32x4){0.f, 0.f, 0.f, 0.f};
#pragma unroll
        for (int ks = 0; ks < 4; ++ks) {
            const int k0 = 128 * w + 32 * ks + 8 * fq;
            union { bf16x8 v; unsigned u[4]; } af; af.u[0] = af.u[1] = af.u[2] = af.u[3] = 0u;
            if (fr < 9) { const f32x4 a0 = *(const f32x4*)(mods + (size_t)fr * 6144 + k0), a1 = *(const f32x4*)(mods + (size_t)fr * 6144 + k0 + 4);
                af.u[0] = pk2(a0[0], a0[1]); af.u[1] = pk2(a0[2], a0[3]); af.u[2] = pk2(a1[0], a1[1]); af.u[3] = pk2(a1[2], a1[3]); }
#pragma unroll
            for (int nb = 0; nb < 4; ++nb) { const bf16x8 bfr = *(const bf16x8*)(wt + (size_t)(n0 + 16 * nb + fr) * 1024 + k0); acc[nb] = __builtin_amdgcn_mfma_f32_16x16x32_bf16(af.v, bfr, acc[nb], 0, 0, 0); }
        }
        __syncthreads();
#pragma unroll
        for (int nb = 0; nb < 4; ++nb) *(LAS f32x4*)(red + ((w * 4 + nb) * 64 + lane) * 4) = acc[nb];
        __syncthreads();
        for (int i = F.tid; i < 1024; i += NTHREADS) { float sacc = 0.f;
#pragma unroll
            for (int w8 = 0; w8 < 8; ++w8) sacc += red[w8 * 1024 + i];
            const int nb = i >> 8, ln = (i >> 2) & 63, e = i & 3, r = 4 * (ln >> 4) + e;
            if (r < 9) bo[(size_t)r * (which ? DFF : PNP) + n0 + 16 * nb + (ln & 15)] = sacc; }
    }
}
constexpr int EPI_SIDE_OFF = RING_BYTES;
template <class Sched>
__device__ __forceinline__ void epi_side_fill(Frame& F, const Sched& S, const float* ssq, const float* bias, int ldb) {
    LAS float* side = (LAS float*)(F.lds + EPI_SIDE_OFF);
    pg8::Unit u;
    for (int i = 0; i < 4 && S.next(i, u); ++i) {
        if (F.tid < 256) { const f32x4* p = (const f32x4*)(ssq + (size_t)(u.pm * 256 + F.tid) * 16); const f32x4 a = p[0], b = p[1], c = p[2], d = p[3];
            const float sm = ((a[0] + a[1]) + (a[2] + a[3])) + ((b[0] + b[1]) + (b[2] + b[3])) + ((c[0] + c[1]) + (c[2] + c[3])) + ((d[0] + d[1]) + (d[2] + d[3]));
            side[i * 256 + F.tid] = rsqrtf(sm * (1.f / 1024.f) + EPS); }
        else { const int r = u.pm < 32 ? 0 : 1 + ((u.pm - 32) >> 2); side[1024 + i * 256 + F.tid - 256] = bias[(size_t)r * ldb + u.pn * 256 + F.tid - 256]; }
    }
    __syncthreads();
}
__device__ __forceinline__ void phase_final(Frame& F) {
    const int lane = F.lane; const float* gw = F.in[34];
    for (int row = F.vcu * NWAVES + F.wave; row < M; row += F.G * NWAVES) {
        const float* xr = (const float*)(F.ws + OFF_X) + (size_t)row * D;
        f32x4 v[4]; float s = 0.f;
#pragma unroll
        for (int j = 0; j < 4; ++j) { v[j] = *(const f32x4*)(xr + 4 * lane + 256 * j); s += v[j].x * v[j].x + v[j].y * v[j].y + v[j].z * v[j].z + v[j].w * v[j].w; }
        const float rstd = rsqrtf(wave_sum(s) * (1.f / D) + EPS);
        float* o = F.out + (size_t)row * D;
#pragma unroll
        for (int j = 0; j < 4; ++j) { const int c = 4 * lane + 256 * j; const f32x4 g = *(const f32x4*)(gw + c); f32x4 r = {v[j].x * rstd * g.x, v[j].y * rstd * g.y, v[j].z * rstd * g.z, v[j].w * rstd * g.w}; *(f32x4*)(o + c) = r; }
    }
}


typedef short v4i16_t __attribute__((ext_vector_type(4)));
constexpr int AT_KP = 160;
constexpr int AT_TILE = 64 * AT_KP;
constexpr int AT_K0 = 0, AT_V0 = 2 * AT_TILE, AT_RPB = 4 * AT_TILE, AT_END = AT_RPB + 2048;
__device__ __forceinline__ int queue_next(Frame& F, unsigned* ctr) {
    __syncthreads();
    if (F.tid == 0) F.MISC[16] = atomicAdd(ctr, 1u);
    __syncthreads();
    { int t_ = F.tid; asm volatile("" : "+v"(t_)); F.tid = t_; F.lane = t_ & 63; }
    return (int)F.MISC[16];
}
__device__ __forceinline__ bf16x8 tr2(LAS const unsigned char* a, LAS const unsigned char* b) {
    const v4i16_t x = __builtin_amdgcn_ds_read_tr16_b64_v4i16((LAS v4i16_t*)a), y = __builtin_amdgcn_ds_read_tr16_b64_v4i16((LAS v4i16_t*)b);
    return (bf16x8){x[0], x[1], x[2], x[3], y[0], y[1], y[2], y[3]};
}
struct AttnState { f32x4 o[4]; float m, l; };
template <int NKB, bool MASKED>
__device__ __forceinline__ void attn_tile(AttnState& st, LAS const unsigned char* Kt, LAS const unsigned char* Vt, const bf16x8 (&qf)[2], int c0, int lane,
                                          LAS const float* rpbrow, const int (&dk)[2][4]) {
    const int fr = lane & 15, fq = lane >> 4;
    f32x4 s[NKB];
#pragma unroll
    for (int kb = 0; kb < NKB; ++kb) {
        s[kb] = (f32x4){0.f, 0.f, 0.f, 0.f};
#pragma unroll
        for (int ks = 0; ks < 2; ++ks) {
            const bf16x8 a = *(LAS const bf16x8*)(Kt + (c0 + 16 * kb + fr) * AT_KP + (32 * ks + 8 * fq) * 2);
            s[kb] = __builtin_amdgcn_mfma_f32_16x16x32_bf16(a, qf[ks], s[kb], 0, 0, 0);
        }
    }
    float mloc = -1e30f;
#pragma unroll
    for (int kb = 0; kb < NKB; ++kb)
#pragma unroll
        for (int i = 0; i < 4; ++i) {
            float t = s[kb][i] * 0.125f;
            if (MASKED) { const int d = dk[kb & 1][i]; t = d >= 0 ? t + rpbrow[d] : -1e30f; }
            s[kb][i] = t; mloc = fmaxf(mloc, t);
        }
    mloc = xmax32(xmax16(mloc));
    const float mn = fmaxf(st.m, mloc), alpha = __expf(st.m - mn);
    st.m = mn;
    float ls = 0.f;
#pragma unroll
    for (int kb = 0; kb < NKB; ++kb)
#pragma unroll
        for (int i = 0; i < 4; ++i) { const float pv = __expf(s[kb][i] - mn); s[kb][i] = pv; ls += pv; }
    st.l = st.l * alpha + ls;
#pragma unroll
    for (int db = 0; db < 4; ++db) st.o[db] = st.o[db] * alpha;
#pragma unroll
    for (int kk = 0; kk < NKB / 2; ++kk) {
        union { bf16x8 v; unsigned u[4]; } pf;
        pf.u[0] = pk2(s[2 * kk][0], s[2 * kk][1]); pf.u[1] = pk2(s[2 * kk][2], s[2 * kk][3]);
        pf.u[2] = pk2(s[2 * kk + 1][0], s[2 * kk + 1][1]); pf.u[3] = pk2(s[2 * kk + 1][2], s[2 * kk + 1][3]);
        LAS const unsigned char* va = Vt + (c0 + 32 * kk + 4 * fq + (fr >> 2)) * AT_KP + (4 * (fr & 3)) * 2;
#pragma unroll
        for (int db = 0; db < 4; ++db) {
            const bf16x8 vf = tr2(va + db * 32, va + 16 * AT_KP + db * 32);
            st.o[db] = __builtin_amdgcn_mfma_f32_16x16x32_bf16(vf, pf.v, st.o[db], 0, 0, 0);
        }
    }
}
__device__ __forceinline__ void attn_unit(Frame& F, int l, int unit) {
    const int tid = F.tid, lane = F.lane, w = F.wave, fr = lane & 15, fq = lane >> 4;
    const bf16_t* proj = (const bf16_t*)(F.ws + OFF_PROJ);
    LAS unsigned char* lds = F.lds;
    const bool nat = unit < 384;
    int b, h, qrow, r = 0, rs_w = 0, rs0 = 0, nlat = 0, c0 = 0;
    if (nat) { b = unit / 48; h = (unit / 8) % 6; const int rp = unit % 8; r = 2 * rp + (w >> 2); const int j = w & 3;
        qrow = MC + b * 1024 + r * 64 + 16 * j + fr;
        rs_w = min(max(r - 4, 0), 8); rs0 = min(max(2 * rp - 4, 0), 8); const int rs1 = min(max(2 * rp + 1 - 4, 0), 8); nlat = rs1 + 8 - rs0;
        c0 = j == 0 ? 0 : (j == 1 ? 8 : (j == 2 ? 24 : 32));
    } else { const int u = unit - 384; b = u / 12; h = (u / 2) % 6; const int qb = u % 2; qrow = b * 256 + qb * 128 + 16 * w + fr; }
    const int ntiles = nat ? nlat + 4 : 4;
    bf16x8 qf[2];
#pragma unroll
    for (int ks = 0; ks < 2; ++ks) qf[ks] = *(const bf16x8*)(proj + (size_t)qrow * PN + PQ + h * 64 + 32 * ks + 8 * fq);
    int dk[2][4];
    if (nat) {
        const int qc = (qrow - MC) & 63; const int cs = min(max(qc - 8, 0), 48);
#pragma unroll
        for (int kb = 0; kb < 2; ++kb)
#pragma unroll
            for (int i = 0; i < 4; ++i) { const int kc = c0 + 16 * kb + 4 * fq + i; dk[kb][i] = (kc >= cs && kc < cs + 16) ? kc - qc + 15 : -1; }
        const float* rpb = F.in[30] + (size_t)(l * 6 + h) * 465;
        for (int i = tid; i < 465; i += NTHREADS) ((LAS float*)(lds + AT_RPB))[i] = rpb[i];
    } else {
#pragma unroll
        for (int kb = 0; kb < 2; ++kb)
#pragma unroll
            for (int i = 0; i < 4; ++i) dk[kb][i] = 0;
    }
    AttnState st; st.m = -1e30f; st.l = 0.f;
#pragma unroll
    for (int db = 0; db < 4; ++db) st.o[db] = (f32x4){0.f, 0.f, 0.f, 0.f};
    const int skey = tid >> 3, sch = tid & 7;
    v4u rk = {0u, 0u, 0u, 0u}, rv = {0u, 0u, 0u, 0u}; f32x4 fk0 = {0.f, 0.f, 0.f, 0.f}, fk1 = fk0, fv0 = fk0, fv1 = fk0; bool isf = false;
#define AT_LOAD(ti_) do { const int ti__ = (ti_); \
        if (nat && ti__ >= nlat) { isf = true; const size_t off = ((size_t)(b * 4 + l) * 256 + (ti__ - nlat) * 64 + skey) * 384 + h * 64 + sch * 8; \
            fk0 = *(const f32x4*)(F.in[2] + off); fk1 = *(const f32x4*)(F.in[2] + off + 4); fv0 = *(const f32x4*)(F.in[3] + off); fv1 = *(const f32x4*)(F.in[3] + off + 4); \
        } else { isf = false; const int grow = nat ? MC + b * 1024 + (rs0 + ti__) * 64 + skey : b * 256 + ti__ * 64 + skey; \
            const bf16_t* pr = proj + (size_t)grow * PN + h * 64 + sch * 8; rk = *(const v4u*)(pr + PK); rv = *(const v4u*)(pr + PV); } } while (0)
#define AT_WRITE(buf_) do { const int buf__ = (buf_); \
        if (isf) { rk.x = pk2(fk0[0], fk0[1]); rk.y = pk2(fk0[2], fk0[3]); rk.z = pk2(fk1[0], fk1[1]); rk.w = pk2(fk1[2], fk1[3]); \
                   rv.x = pk2(fv0[0], fv0[1]); rv.y = pk2(fv0[2], fv0[3]); rv.z = pk2(fv1[0], fv1[1]); rv.w = pk2(fv1[2], fv1[3]); } \
        *(LAS v4u*)(lds + AT_K0 + buf__ * AT_TILE + skey * AT_KP + sch * 16) = rk; \
        *(LAS v4u*)(lds + AT_V0 + buf__ * AT_TILE + skey * AT_KP + sch * 16) = rv; } while (0)
    AT_LOAD(0); AT_WRITE(0);
    __syncthreads();
    for (int ti = 0; ti < ntiles; ++ti) {
        const int buf = ti & 1;
        if (ti + 1 < ntiles) AT_LOAD(ti + 1);
        LAS const unsigned char* Kt = lds + AT_K0 + buf * AT_TILE; LAS const unsigned char* Vt = lds + AT_V0 + buf * AT_TILE;
        if (nat && ti < nlat) {
            const int kr = rs0 + ti;
            if (kr >= rs_w && kr < rs_w + 8) attn_tile<2, true>(st, Kt, Vt, qf, c0, lane, (LAS const float*)(lds + AT_RPB) + (kr - r + 7) * 31, dk);
        } else attn_tile<4, false>(st, Kt, Vt, qf, 0, lane, (LAS const float*)(lds + AT_RPB), dk);
        if (ti + 1 < ntiles) AT_WRITE(buf ^ 1);
        __syncthreads();
    }
    const float lt = xsum32(xsum16(st.l));
    const float inv = 1.f / lt;
    bf16_t* mix = (bf16_t*)(F.ws + OFF_MIX) + (size_t)qrow * D + 640 + h * 64 + 4 * fq;
#pragma unroll
    for (int db = 0; db < 4; ++db) { uint2 o; o.x = pk2(st.o[db][0] * inv, st.o[db][1] * inv); o.y = pk2(st.o[db][2] * inv, st.o[db][3] * inv); *(uint2*)(mix + 16 * db) = o; }
}
__device__ __forceinline__ void phase_attn(Frame& F, int l, unsigned* ctr) {
    for (;;) { const int u = queue_next(F, ctr); if (u >= 768) break; attn_unit(F, l, u); }
}

constexpr int SS_P = 144;
constexpr int SS_IMG = 128 * SS_P;
constexpr int SS_HP = 144, SS_HIMG = 64 * SS_HP;
constexpr int SSA_B = 0, SSA_X = SS_IMG, SSA_TAB = 7 * SS_IMG;
constexpr int SSB_B = 0, SSB_C = SS_IMG, SSB_X = 2 * SS_IMG, SSB_H = 5 * SS_IMG, SSB_TAB = 5 * SS_IMG + 6 * SS_HIMG;
static_assert(SSB_TAB + 3 * 4 * 128 * 4 <= 163328 && SSA_TAB + 3 * 4 * 128 * 4 <= 163328, "SSD LDS map");
__device__ __forceinline__ void conv16(const bf16_t* proj, const float* cw, const float* cb, int seq_start, int seq_L, int t, int ch0, float (&v)[16]) {
#pragma unroll
    for (int e = 0; e < 16; e += 4) { const f32x4 b = *(const f32x4*)(cb + ch0 + e); v[e] = b[0]; v[e + 1] = b[1]; v[e + 2] = b[2]; v[e + 3] = b[3]; }
#pragma unroll
    for (int j = 0; j < 5; ++j) {
        const int tt = t + j - 2;
        if (tt >= 0 && tt < seq_L) {
            const bf16_t* src = proj + (size_t)(seq_start + tt) * PN + PX + ch0;
            const v4u r0 = *(const v4u*)src, r1 = *(const v4u*)(src + 8);
            const unsigned rr[8] = {r0[0], r0[1], r0[2], r0[3], r1[0], r1[1], r1[2], r1[3]};
#pragma unroll
            for (int e = 0; e < 16; e += 4) { const f32x4 w = *(const f32x4*)(cw + j * 640 + ch0 + e);
                v[e] += w[0] * __uint_as_float(rr[e / 2] << 16); v[e + 1] += w[1] * __uint_as_float(rr[e / 2] & 0xffff0000u);
                v[e + 2] += w[2] * __uint_as_float(rr[e / 2 + 1] << 16); v[e + 3] += w[3] * __uint_as_float(rr[e / 2 + 1] & 0xffff0000u); }
        }
    }
#pragma unroll
    for (int e = 0; e < 16; ++e) v[e] = silu_f(v[e]);
}
__device__ __forceinline__ void store16(LAS unsigned char* dst, const float (&v)[16], float sc) {
    v4u o0, o1;
    o0[0] = pk2(v[0] * sc, v[1] * sc); o0[1] = pk2(v[2] * sc, v[3] * sc); o0[2] = pk2(v[4] * sc, v[5] * sc); o0[3] = pk2(v[6] * sc, v[7] * sc);
    o1[0] = pk2(v[8] * sc, v[9] * sc); o1[1] = pk2(v[10] * sc, v[11] * sc); o1[2] = pk2(v[12] * sc, v[13] * sc); o1[3] = pk2(v[14] * sc, v[15] * sc);
    *(LAS v4u*)dst = o0; *(LAS v4u*)(dst + 16) = o1;
}
__device__ __forceinline__ void ssd_table(const float* dtraw  , float bias, float a, int dir, LAS float* tab, int lane) {
    const float d0 = softplus_f(dtraw[(2 * lane) * 12] + bias), d1 = softplus_f(dtraw[(2 * lane + 1) * 12] + bias);
    const float ps = d0 + d1; float x = ps;
    x += dppf<0x111>(x); x += dppf<0x112>(x); x += dppf<0x114>(x); x += dppf<0x118>(x);
    { const float t15 = rdlane(x, 15), t31 = rdlane(x, 31), t47 = rdlane(x, 47); const int rw = lane >> 4;
      x += (rw >= 1 ? t15 : 0.f) + (rw >= 2 ? t31 : 0.f) + (rw >= 3 ? t47 : 0.f); }
    tab[2 * lane] = d0; tab[2 * lane + 1] = d1;
    if (dir == 0) { const float ex = x - ps; tab[128 + 2 * lane] = a * (ex + d0); tab[128 + 2 * lane + 1] = a * (ex + ps); }
    else { const float tot = rdlane(x, 63); const float sx = tot - x; tab[128 + 2 * lane + 1] = a * (sx + d1); tab[128 + 2 * lane] = a * (sx + ps); }
}
__device__ __forceinline__ void ssd_a_unit(Frame& F, int l, int unit) {
    const int tid = F.tid, lane = F.lane, w = F.wave, fr = lane & 15, fq = lane >> 4;
    const int ci = unit >> 1, g = unit & 1, row0 = ci * 128;
    const SeqInfo q = row_seq(row0); const int t0 = row0 - q.start;
    const bf16_t* proj = (const bf16_t*)(F.ws + OFF_PROJ);
    const float* cw = F.in[14] + l * 5 * 640; const float* cb = F.in[15] + l * 640;
    LAS unsigned char* lds = F.lds; LAS float* tabs = (LAS float*)(lds + SSA_TAB);
    if (w < 6) { const int hh = w >> 1, dir = w & 1, h = 3 * g + hh;
        ssd_table((const float*)(F.ws + OFF_DT) + (size_t)row0 * 12 + dir * 6 + h, F.in[16][(l * 2 + dir) * 6 + h], -__expf(F.in[17][(l * 2 + dir) * 6 + h]), dir, tabs + (hh * 4 + dir * 2) * 128, lane); }
    const int t = tid >> 2, chq = tid & 3;
    { float v[16]; conv16(proj, cw, cb, q.start, q.L, t0 + t, 384 + g * 64 + chq * 16, v); store16(lds + SSA_B + t * SS_P + chq * 32, v, 1.f); }
    float xv[3][16];
#pragma unroll
    for (int hh = 0; hh < 3; ++hh) conv16(proj, cw, cb, q.start, q.L, t0 + t, (3 * g + hh) * 64 + chq * 16, xv[hh]);
    __syncthreads();
#pragma unroll
    for (int hh = 0; hh < 3; ++hh) { LAS const float* tb = tabs + hh * 4 * 128;
        const float wf = __expf(tb[128 + 127] - tb[128 + t]) * tb[t], wb = __expf(tb[384] - tb[384 + t]) * tb[256 + t];
        store16(lds + SSA_X + (2 * hh) * SS_IMG + t * SS_P + chq * 32, xv[hh], wf); store16(lds + SSA_X + (2 * hh + 1) * SS_IMG + t * SS_P + chq * 32, xv[hh], wb); }
    __syncthreads();
    const int dir = w >> 2, pb = w & 3;
    for (int hh = 0; hh < 3; ++hh) {
        const int h = 3 * g + hh;
        LAS const unsigned char* xa = lds + SSA_X + (2 * hh + dir) * SS_IMG + (4 * fq + (fr >> 2)) * SS_P + (16 * pb + 4 * (fr & 3)) * 2;
        LAS const unsigned char* ba = lds + SSA_B + (4 * fq + (fr >> 2)) * SS_P + (4 * (fr & 3)) * 2;
        f32x4 acc[4];
#pragma unroll
        for (int nb = 0; nb < 4; ++nb) acc[nb] = (f32x4){0.f, 0.f, 0.f, 0.f};
#pragma unroll
        for (int kk = 0; kk < 4; ++kk) {
            const bf16x8 af = tr2(xa + kk * 32 * SS_P, xa + (kk * 32 + 16) * SS_P);
#pragma unroll
            for (int nb = 0; nb < 4; ++nb) { const bf16x8 bfr = tr2(ba + kk * 32 * SS_P + nb * 32, ba + (kk * 32 + 16) * SS_P + nb * 32); acc[nb] = __builtin_amdgcn_mfma_f32_16x16x32_bf16(af, bfr, acc[nb], 0, 0, 0); }
        }
        float* cs = (float*)(F.ws + OFF_CS) + ((size_t)(ci * 6 + h) * 2 + dir) * 4096;
#pragma unroll
        for (int nb = 0; nb < 4; ++nb)
#pragma unroll
            for (int i = 0; i < 4; ++i) cs[(16 * pb + 4 * fq + i) * 64 + 16 * nb + fr] = acc[nb][i];
        if (tid == 0) { LAS const float* tb = tabs + hh * 4 * 128; float* cd = (float*)(F.ws + OFF_TAB + TAB_CD) + (size_t)(ci * 6 + h) * 2; cd[0] = __expf(tb[128 + 127]); cd[1] = __expf(tb[384]); }
    }
}
__device__ __forceinline__ void ssd_state_pass(Frame& F, int l) {
    const int tid = F.tid, p = tid >> 3, n0 = (tid & 7) * 8;
    const float* cdt = (const float*)(F.ws + OFF_TAB + TAB_CD); const float* csb = (const float*)(F.ws + OFF_CS);
    bf16_t* hin = (bf16_t*)(F.ws + OFF_HIN);
    for (int task = F.vcu; task < NSEQ * 12; task += F.G) {
        int s, hd; if (task < LB * 12) { s = CB + task / 12; hd = task % 12; } else { s = (task - LB * 12) / 12; hd = (task - LB * 12) % 12; }
        const int h = hd >> 1, dir = hd & 1;
        const SeqInfo q = seq_info(s); const int nch = q.L >> 7, ci0 = q.start >> 7;
        f32x4 s0 = {0.f, 0.f, 0.f, 0.f}, s1 = s0;
        if (!q.ctx) { const float* h0 = F.in[4] + ((((size_t)q.b * 4 + l) * 2 + dir) * 6 + h) * 4096 + p * 64 + n0; s0 = *(const f32x4*)h0; s1 = *(const f32x4*)(h0 + 4); }
        for (int k = 0; k < nch; ++k) {
            const int c = dir == 0 ? k : nch - 1 - k; const size_t ix = (size_t)((ci0 + c) * 6 + h) * 2 + dir;
            v4u o; o[0] = pk2(s0[0], s0[1]); o[1] = pk2(s0[2], s0[3]); o[2] = pk2(s1[0], s1[1]); o[3] = pk2(s1[2], s1[3]);
            *(v4u*)(hin + ix * 4096 + p * 64 + n0) = o;
            const float dcy = cdt[ix]; const float* cs = csb + ix * 4096 + p * 64 + n0;
            s0 = s0 * dcy + *(const f32x4*)cs; s1 = s1 * dcy + *(const f32x4*)(cs + 4);
        }
        if (q.ctx) { float* o4 = F.out + O_SSD + ((((size_t)q.b * 4 + l) * 2 + dir) * 6 + h) * 4096 + p * 64 + n0; *(f32x4*)o4 = s0; *(f32x4*)(o4 + 4) = s1; }
    }
}
__device__ __forceinline__ void ssd_b_unit(Frame& F, int l, int unit) {
    const int tid = F.tid, lane = F.lane, w = F.wave, fr = lane & 15, fq = lane >> 4;
    const int ci = unit >> 1, g = unit & 1, row0 = ci * 128;
    const SeqInfo q = row_seq(row0); const int t0 = row0 - q.start;
    const bf16_t* proj = (const bf16_t*)(F.ws + OFF_PROJ);
    const float* cw = F.in[14] + l * 5 * 640; const float* cb = F.in[15] + l * 640;
    LAS unsigned char* lds = F.lds; LAS float* tabs = (LAS float*)(lds + SSB_TAB);
    if (w < 6) { const int hh = w >> 1, dir = w & 1, h = 3 * g + hh;
        ssd_table((const float*)(F.ws + OFF_DT) + (size_t)row0 * 12 + dir * 6 + h, F.in[16][(l * 2 + dir) * 6 + h], -__expf(F.in[17][(l * 2 + dir) * 6 + h]), dir, tabs + (hh * 4 + dir * 2) * 128, lane); }
    {
        const bf16_t* hin = (const bf16_t*)(F.ws + OFF_HIN) + (size_t)((ci * 6 + 3 * g) * 2) * 4096 + (tid >> 3) * 64 + (tid & 7) * 8;
#pragma unroll
        for (int k = 0; k < 6; ++k) *(LAS v4u*)(lds + SSB_H + k * SS_HIMG + (tid >> 3) * SS_HP + (tid & 7) * 16) = *(const v4u*)(hin + (size_t)k * 4096);
    }
    { const int t = tid >> 2, chq = tid & 3; float v[16];
      conv16(proj, cw, cb, q.start, q.L, t0 + t, 384 + g * 64 + chq * 16, v); store16(lds + SSB_B + t * SS_P + chq * 32, v, 1.f);
      conv16(proj, cw, cb, q.start, q.L, t0 + t, 512 + g * 64 + chq * 16, v); store16(lds + SSB_C + t * SS_P + chq * 32, v, 1.f);
#pragma unroll
      for (int hh = 0; hh < 3; ++hh) { conv16(proj, cw, cb, q.start, q.L, t0 + t, (3 * g + hh) * 64 + chq * 16, v); store16(lds + SSB_X + hh * SS_IMG + t * SS_P + chq * 32, v, 1.f); } }
    __syncthreads();
    bf16x8 cf[2];
#pragma unroll
    for (int ks = 0; ks < 2; ++ks) cf[ks] = *(LAS const bf16x8*)(lds + SSB_C + (16 * w + fr) * SS_P + (32 * ks + 8 * fq) * 2);
    f32x4 gt[8];
#pragma unroll
    for (int sb = 0; sb < 8; ++sb) { gt[sb] = (f32x4){0.f, 0.f, 0.f, 0.f};
#pragma unroll
        for (int ks = 0; ks < 2; ++ks) { const bf16x8 bfr = *(LAS const bf16x8*)(lds + SSB_B + (16 * sb + fr) * SS_P + (32 * ks + 8 * fq) * 2); gt[sb] = __builtin_amdgcn_mfma_f32_16x16x32_bf16(bfr, cf[ks], gt[sb], 0, 0, 0); } }
    float ss[4] = {0.f, 0.f, 0.f, 0.f};
    bf16_t* yup = (bf16_t*)(F.ws + OFF_MIX) + (size_t)(row0 + 16 * w + 4 * fq) * D + fr;
    for (int hh = 0; hh < 3; ++hh) {
        const int h = 3 * g + hh;
        LAS const float* tb = tabs + hh * 4 * 128;
        unsigned short zv[4][4];
#pragma unroll
        for (int i = 0; i < 4; ++i)
#pragma unroll
            for (int pb = 0; pb < 4; ++pb) zv[i][pb] = proj[(size_t)(row0 + 16 * w + 4 * fq + i) * PN + PZ + h * 64 + 16 * pb + fr];
        const float at = tb[128 + 16 * w + fr], bt = tb[384 + 16 * w + fr];
        f32x4 y[4];
#pragma unroll
        for (int pb = 0; pb < 4; ++pb) y[pb] = (f32x4){0.f, 0.f, 0.f, 0.f};
        LAS const unsigned char* xa = lds + SSB_X + hh * SS_IMG + (4 * fq + (fr >> 2)) * SS_P + (4 * (fr & 3)) * 2;
#pragma unroll
        for (int kk = 0; kk < 4; ++kk) {
            float mv[8];
#pragma unroll
            for (int half = 0; half < 2; ++half) { const int sb = 2 * kk + half; const int s0i = 16 * sb + 4 * fq;
                const f32x4 cumf = *(LAS const f32x4*)(tb + 128 + s0i), dtf = *(LAS const f32x4*)(tb + s0i), cumb = *(LAS const f32x4*)(tb + 384 + s0i), dtb = *(LAS const f32x4*)(tb + 256 + s0i);
#pragma unroll
                for (int i = 0; i < 4; ++i) { const int s = s0i + i, t = 16 * w + fr; float m = 0.f;
                    if (s <= t) m += __expf(at - cumf[i]) * dtf[i];
                    if (s >= t) m += __expf(bt - cumb[i]) * dtb[i];
                    mv[half * 4 + i] = m * gt[sb][i]; } }
            union { bf16x8 v; unsigned u[4]; } mf; mf.u[0] = pk2(mv[0], mv[1]); mf.u[1] = pk2(mv[2], mv[3]); mf.u[2] = pk2(mv[4], mv[5]); mf.u[3] = pk2(mv[6], mv[7]);
#pragma unroll
            for (int pb = 0; pb < 4; ++pb) { const bf16x8 xf = tr2(xa + kk * 32 * SS_P + pb * 32, xa + (kk * 32 + 16) * SS_P + pb * 32); y[pb] = __builtin_amdgcn_mfma_f32_16x16x32_bf16(mf.v, xf, y[pb], 0, 0, 0); }
        }
        f32x4 yf[4], yb[4];
#pragma unroll
        for (int pb = 0; pb < 4; ++pb) { yf[pb] = (f32x4){0.f, 0.f, 0.f, 0.f}; yb[pb] = yf[pb];
#pragma unroll
            for (int ks = 0; ks < 2; ++ks) {
                const bf16x8 hf = *(LAS const bf16x8*)(lds + SSB_H + (2 * hh) * SS_HIMG + (16 * pb + fr) * SS_HP + (32 * ks + 8 * fq) * 2);
                const bf16x8 hb = *(LAS const bf16x8*)(lds + SSB_H + (2 * hh + 1) * SS_HIMG + (16 * pb + fr) * SS_HP + (32 * ks + 8 * fq) * 2);
                yf[pb] = __builtin_amdgcn_mfma_f32_16x16x32_bf16(cf[ks], hf, yf[pb], 0, 0, 0);
                yb[pb] = __builtin_amdgcn_mfma_f32_16x16x32_bf16(cf[ks], hb, yb[pb], 0, 0, 0); } }
        const float dsk = F.in[18][l * 6 + h];
        float nwv[4];
#pragma unroll
        for (int pb = 0; pb < 4; ++pb) nwv[pb] = F.in[19][l * 384 + h * 64 + 16 * pb + fr];
        const f32x4 cumf4 = *(LAS const f32x4*)(tb + 128 + 16 * w + 4 * fq), cumb4 = *(LAS const f32x4*)(tb + 384 + 16 * w + 4 * fq);
#pragma unroll
        for (int i = 0; i < 4; ++i) { const float ef = __expf(cumf4[i]), eb = __expf(cumb4[i]); const int tl = 16 * w + 4 * fq + i;
#pragma unroll
            for (int pb = 0; pb < 4; ++pb) { const float xv = bf2f(*(LAS const bf16_t*)(lds + SSB_X + hh * SS_IMG + tl * SS_P + (16 * pb + fr) * 2));
                const float yv = y[pb][i] + ef * yf[pb][i] + eb * yb[pb][i] + dsk * xv;
                const float gv = yv * silu_f(bf2f(zv[i][pb])); ss[i] += gv * gv;
                yup[(size_t)i * D + h * 64 + 16 * pb] = f2bf(gv * nwv[pb]); } }
    }
#pragma unroll
    for (int i = 0; i < 4; ++i) { const float v = row16_sum(ss[i]);
        if (fr == 0) ((float*)(F.ws + OFF_TAB + TAB_SSQ))[(size_t)(row0 + 16 * w + 4 * fq + i) * 2 + g] = v; }
}
__device__ __forceinline__ void ssd_norm_panel(Frame& F, int l, int pm) {
    const float* nw = F.in[19] + l * 384; const float* ssq = (const float*)(F.ws + OFF_TAB + TAB_SSQ);
    const bf16_t* yu = (const bf16_t*)(F.ws + OFF_YU); bf16_t* mix = (bf16_t*)(F.ws + OFF_MIX);
    for (int i = F.tid; i < 256 * 48; i += NTHREADS) {
        const int row = pm * 256 + i / 48, c0 = (i % 48) * 8;
        const float rstd = rsqrtf((ssq[(size_t)row * 2] + ssq[(size_t)row * 2 + 1]) * (1.f / 384.f) + EPS);
        const v4u v = *(const v4u*)(yu + (size_t)row * 384 + c0); const f32x4 w0 = *(const f32x4*)(nw + c0), w1 = *(const f32x4*)(nw + c0 + 4);
        v4u o;
        o[0] = pk2(__uint_as_float(v[0] << 16) * rstd * w0[0], __uint_as_float(v[0] & 0xffff0000u) * rstd * w0[1]); o[1] = pk2(__uint_as_float(v[1] << 16) * rstd * w0[2], __uint_as_float(v[1] & 0xffff0000u) * rstd * w0[3]);
        o[2] = pk2(__uint_as_float(v[2] << 16) * rstd * w1[0], __uint_as_float(v[2] & 0xffff0000u) * rstd * w1[1]); o[3] = pk2(__uint_as_float(v[3] << 16) * rstd * w1[2], __uint_as_float(v[3] & 0xffff0000u) * rstd * w1[3]);
        *(v4u*)(mix + (size_t)row * D + c0) = o;
    }
    asm volatile("s_waitcnt vmcnt(0)" ::: "memory");
    __syncthreads();
}

constexpr int S5_HP = 272;
constexpr int S5_IMG = 64 * S5_HP;
constexpr int S5_GP = 528, S5_G = 4 * S5_IMG, S5_END = S5_G + 64 * S5_GP;
typedef float f32x16 __attribute__((ext_vector_type(16)));
typedef float f32x8 __attribute__((ext_vector_type(8)));
__device__ __forceinline__ float swap32sel(float x, int odd) {
    const auto r = __builtin_amdgcn_permlane32_swap(__float_as_uint(x), __float_as_uint(x), false, false);
    return __uint_as_float(odd ? r[1] : r[0]);
}
template <int DIR, bool FULL>
__device__ __forceinline__ void s5_dir(Frame& F, int l, int g, int p, int hi, const bf16x8 (&uf)[2], float& cr, float& ci, f32x16 (&hr)[2], f32x16 (&hq)[2]) {
    const float* ab = (const float*)(F.ws + OFF_TAB + TAB_ABAR) + (size_t)((((l * 2 + DIR) * 16 + g) * 64) + p) * 2;
    const float ar = ab[0], ai = ab[1];
    const float a2r = ar * ar - ai * ai, a2i = 2.f * ar * ai, a3r = a2r * ar - a2i * ai, a3i = a2r * ai + a2i * ar, a4r = a2r * a2r - a2i * a2i, a4i = 2.f * a2r * a2i;
    const bf16_t* bbt = (const bf16_t*)(F.ws + OFF_TAB + TAB_BBT) + ((size_t)(((l * 2 + DIR) * 16 + g) * 2) * 64 + p) * 16 + 8 * hi;
    const bf16x8 bre = *(const bf16x8*)bbt, bim = *(const bf16x8*)(bbt + 64 * 16);
    f32x16 xr[2], xi[2];
#pragma unroll
    for (int rb = 0; rb < 2; ++rb) {
        const f32x16 z = {0.f, 0.f, 0.f, 0.f, 0.f, 0.f, 0.f, 0.f, 0.f, 0.f, 0.f, 0.f, 0.f, 0.f, 0.f, 0.f};
        xr[rb] = __builtin_amdgcn_mfma_f32_32x32x16_bf16(uf[rb], bre, z, 0, 0, 0); xi[rb] = __builtin_amdgcn_mfma_f32_32x32x16_bf16(uf[rb], bim, z, 0, 0, 0);
    }
#pragma unroll
    for (int rb = 0; rb < 2; ++rb)
#pragma unroll
        for (int G4 = 0; G4 < 4; ++G4) {
            if (DIR == 0) {
#pragma unroll
                for (int e = 1; e < 4; ++e) { const int i = 4 * G4 + e; const float pr = xr[rb][i - 1], pi = xi[rb][i - 1]; xr[rb][i] += ar * pr - ai * pi; xi[rb][i] += ar * pi + ai * pr; }
            } else {
#pragma unroll
                for (int e = 2; e >= 0; --e) { const int i = 4 * G4 + e; const float pr = xr[rb][i + 1], pi = xi[rb][i + 1]; xr[rb][i] += ar * pr - ai * pi; xi[rb][i] += ar * pi + ai * pr; }
            }
        }
    f32x8 cinr = {0.f, 0.f, 0.f, 0.f, 0.f, 0.f, 0.f, 0.f}, cini = cinr;
#pragma unroll
    for (int kk = 0; kk < 16; ++kk) {
        const int k = DIR == 0 ? kk : 15 - kk, gi = k >> 1, rb = gi >> 2, il = 4 * (gi & 3) + (DIR == 0 ? 3 : 0), odd = k & 1;
        const bool first = DIR == 0 ? !odd : odd;
        if (first) { cinr[gi] = cr; cini[gi] = ci; } else { const bool own = (hi == odd); cinr[gi] = own ? cr : cinr[gi]; cini[gi] = own ? ci : cini[gi]; }
        const float nr = a4r * cr - a4i * ci + xr[rb][il], ni = a4r * ci + a4i * cr + xi[rb][il];
        cr = swap32sel(nr, odd); ci = swap32sel(ni, odd);
    }
    if (FULL) {
#pragma unroll
        for (int rb = 0; rb < 2; ++rb)
#pragma unroll
            for (int G4 = 0; G4 < 4; ++G4) {
                const int gi = rb * 4 + G4;
#pragma unroll
                for (int e = 0; e < 4; ++e) {
                    const int i = 4 * G4 + e, pw = DIR == 0 ? e + 1 : 4 - e;
                    const float pr = pw == 1 ? ar : (pw == 2 ? a2r : (pw == 3 ? a3r : a4r)), pi = pw == 1 ? ai : (pw == 2 ? a2i : (pw == 3 ? a3i : a4i));
                    hr[rb][i] += xr[rb][i] + pr * cinr[gi] - pi * cini[gi];
                    hq[rb][i] += xi[rb][i] + pr * cini[gi] + pi * cinr[gi];
                }
            }
    }
}
template <bool FULL>
__device__ __forceinline__ void s5_wave_unit(Frame& F, int l, int row0, int g, int ph, float& cfr, float& cfi, float& cbr, float& cbi, LAS unsigned char* himg) {
    const int lane = F.lane, r32 = lane & 31, hi = lane >> 5, p = 32 * ph + r32;
    const bf16_t* proj = (const bf16_t*)(F.ws + OFF_PROJ);
    bf16x8 uf[2];
#pragma unroll
    for (int rb = 0; rb < 2; ++rb) uf[rb] = *(const bf16x8*)(proj + (size_t)(row0 + 32 * rb + r32) * PN + PU + g * 16 + 8 * hi);
    f32x16 hr[2], hq[2];
#pragma unroll
    for (int rb = 0; rb < 2; ++rb) { hr[rb] = (f32x16){0.f, 0.f, 0.f, 0.f, 0.f, 0.f, 0.f, 0.f, 0.f, 0.f, 0.f, 0.f, 0.f, 0.f, 0.f, 0.f}; hq[rb] = hr[rb]; }
    s5_dir<0, FULL>(F, l, g, p, hi, uf, cfr, cfi, hr, hq);
    s5_dir<1, FULL>(F, l, g, p, hi, uf, cbr, cbi, hr, hq);
    if (FULL) {
#pragma unroll
        for (int rb = 0; rb < 2; ++rb)
#pragma unroll
            for (int i = 0; i < 16; ++i) { const int t = 32 * rb + 8 * (i >> 2) + 4 * hi + (i & 3);
                LAS bf16_t* d = (LAS bf16_t*)(himg + t * S5_HP) + p;
                const unsigned pk = pk2(hr[rb][i], hq[rb][i]); d[0] = (bf16_t)(pk & 0xffffu); d[64] = (bf16_t)(pk >> 16); }
    }
}
__device__ __forceinline__ void cpow64(float ar, float ai, float& or_, float& oi_) {
#pragma unroll
    for (int s = 0; s < 6; ++s) { const float nr = ar * ar - ai * ai, ni = 2.f * ar * ai; ar = nr; ai = ni; }
    or_ = ar; oi_ = ai;
}
__device__ __forceinline__ void s5_a_unit(Frame& F, int l, int cj) {
    const int w = F.wave, lane = F.lane, row0 = cj * 64;
    float* E = (float*)(F.ws + OFF_E);
    for (int it = w; it < 32; it += NWAVES) {
        const int g = it >> 1, ph = it & 1;
        float cfr = 0.f, cfi = 0.f, cbr = 0.f, cbi = 0.f;
        s5_wave_unit<false>(F, l, row0, g, ph, cfr, cfi, cbr, cbi, F.lds);
        if (lane < 32) { float2 v; v.x = cfr; v.y = cfi; *(float2*)(E + ((size_t)((cj * 2 + 0) * 16 + g) * 64 + 32 * ph + lane) * 2) = v;
                         v.x = cbr; v.y = cbi; *(float2*)(E + ((size_t)((cj * 2 + 1) * 16 + g) * 64 + 32 * ph + lane) * 2) = v; }
    }
}
__device__ __forceinline__ void s5_b_unit(Frame& F, int l, int cj) {
    const int w = F.wave, row0 = cj * 64;
    const SeqInfo q = row_seq(row0); const int j = (row0 - q.start) >> 6, nj = q.L >> 6, cj0 = cj - j;
    const bf16_t* proj = (const bf16_t*)(F.ws + OFF_PROJ);
    const float* E = (const float*)(F.ws + OFF_E);
    LAS unsigned char* lds = F.lds;
    for (int gi4 = 0; gi4 < 4; ++gi4) {
        {
            { int t_ = F.tid; asm volatile("" : "+v"(t_)); F.tid = t_; F.lane = t_ & 63; }
            const int lane = F.lane; const int g = 4 * gi4 + (w >> 1), ph = w & 1, p = 32 * ph + (lane & 31);
            const float* ab = (const float*)(F.ws + OFF_TAB + TAB_ABAR) + (size_t)((((l * 2 + 0) * 16 + g) * 64) + p) * 2;
            float a64r[2], a64i[2]; cpow64(ab[0], ab[1], a64r[0], a64i[0]); cpow64(ab[16 * 64 * 2], ab[16 * 64 * 2 + 1], a64r[1], a64i[1]);
            float cr[2] = {0.f, 0.f}, ci[2] = {0.f, 0.f};
#pragma unroll
            for (int dir = 0; dir < 2; ++dir) {
                if (!q.ctx) { const size_t o = (((size_t)q.b * 4 + l) * 2 + dir) * 1024 + g * 64 + p; cr[dir] = F.in[5][o]; ci[dir] = F.in[6][o]; }
                const int nprev = dir == 0 ? j : nj - 1 - j;
                for (int k = 0; k < nprev; ++k) { const int jj = dir == 0 ? k : nj - 1 - k;
                    const float2 e = *(const float2*)(E + ((size_t)(((cj0 + jj) * 2 + dir) * 16 + g) * 64 + p) * 2);
                    const float nr = a64r[dir] * cr[dir] - a64i[dir] * ci[dir] + e.x, ni = a64r[dir] * ci[dir] + a64i[dir] * cr[dir] + e.y; cr[dir] = nr; ci[dir] = ni; }
            }
            s5_wave_unit<true>(F, l, row0, g, ph, cr[0], ci[0], cr[1], ci[1], lds + (w >> 1) * S5_IMG);
            if (q.ctx && lane < 32) {
                if (j == nj - 1) { const size_t o = (((size_t)q.b * 4 + l) * 2 + 0) * 1024 + g * 64 + p; F.out[O_RE + o] = cr[0]; F.out[O_IM + o] = ci[0]; }
                if (j == 0) { const size_t o = (((size_t)q.b * 4 + l) * 2 + 1) * 1024 + g * 64 + p; F.out[O_RE + o] = cr[1]; F.out[O_IM + o] = ci[1]; }
            }
        }
        __syncthreads();
        int ln2 = F.tid; asm volatile("" : "+v"(ln2)); ln2 &= 63; const int fr = ln2 & 15, fq = ln2 >> 4;
#pragma unroll
        for (int tk = 0; tk < 2; ++tk) {
            const int task = 2 * w + tk, gsel = task >> 2, tb = task & 3, g = 4 * gi4 + gsel;
            LAS const unsigned char* hrow = lds + gsel * S5_IMG + (16 * tb + fr) * S5_HP + 16 * fq;
            const bf16_t* cc = (const bf16_t*)(F.ws + OFF_TAB + TAB_CC1) + ((size_t)(l * 16 + g) * 16 + fr) * 128 + 8 * fq;
            f32x4 y = {0.f, 0.f, 0.f, 0.f};
#pragma unroll
            for (int ks = 0; ks < 4; ++ks) { const bf16x8 a = *(LAS const bf16x8*)(hrow + ks * 64); const bf16x8 bfr = *(const bf16x8*)(cc + ks * 32); y = __builtin_amdgcn_mfma_f32_16x16x32_bf16(a, bfr, y, 0, 0, 0); }
            const float dsk = F.in[27][l * 256 + g * 16 + fr];
#pragma unroll
            for (int i = 0; i < 4; ++i) { const int t = 16 * tb + 4 * fq + i; const float u = bf2f(proj[(size_t)(row0 + t) * PN + PU + g * 16 + fr]);
                *((LAS bf16_t*)(lds + S5_G + t * S5_GP) + g * 16 + fr) = f2bf(gelu_tanh_f(y[i] + dsk * u)); }
        }
        __syncthreads();
    }
    {
        int ln3 = F.tid; asm volatile("" : "+v"(ln3)); ln3 &= 63; const int fr = ln3 & 15, fq = ln3 >> 4;
        f32x4 acc[2][4];
#pragma unroll
        for (int a = 0; a < 2; ++a)
#pragma unroll
            for (int tb = 0; tb < 4; ++tb) acc[a][tb] = (f32x4){0.f, 0.f, 0.f, 0.f};
        const bf16_t* wg = (const bf16_t*)(F.ws + OFF_WGLU) + (size_t)l * 65536 + (size_t)(32 * w + fr) * 256 + 8 * fq;
#pragma unroll
        for (int ks = 0; ks < 8; ++ks) {
            const bf16x8 b0 = *(const bf16x8*)(wg + ks * 32), b1 = *(const bf16x8*)(wg + 16 * 256 + ks * 32);
#pragma unroll
            for (int tb = 0; tb < 4; ++tb) { const bf16x8 a = *(LAS const bf16x8*)(lds + S5_G + (16 * tb + fr) * S5_GP + ks * 64 + 16 * fq);
                acc[0][tb] = __builtin_amdgcn_mfma_f32_16x16x32_bf16(a, b0, acc[0][tb], 0, 0, 0); acc[1][tb] = __builtin_amdgcn_mfma_f32_16x16x32_bf16(a, b1, acc[1][tb], 0, 0, 0); }
        }
#pragma unroll
        for (int a = 0; a < 2; ++a) { const int n = 32 * w + 16 * a + fr; const float bg = F.in[29][l * 256 + n];
#pragma unroll
            for (int tb = 0; tb < 4; ++tb)
#pragma unroll
                for (int i = 0; i < 4; ++i) { const int t = 16 * tb + 4 * fq + i; const float gv = bf2f(*((LAS const bf16_t*)(lds + S5_G + t * S5_GP) + n));
                    ((bf16_t*)(F.ws + OFF_MIX))[(size_t)(row0 + t) * D + 384 + n] = f2bf(gv * sigmoid_f(acc[a][tb][i] + bg)); } }
    }
}

__device__ __forceinline__ void phase_mixa(Frame& F, int l) {
    unsigned* ctr = F.ctl + CW_Q + 64 * (l * 4 + 0);
    for (;;) { const int u = queue_next(F, ctr); if (u >= 1280) break; if (u < 256) ssd_a_unit(F, l, u); else if (u < 512) s5_a_unit(F, l, u - 256); else attn_unit(F, l, u - 512); }
}
__device__ __forceinline__ void phase_mixb(Frame& F, int l) {
    unsigned* ctr = F.ctl + CW_Q + 64 * (l * 4 + 1);
    for (;;) { const int u = queue_next(F, ctr); if (u >= 512) break; if (u < 256) ssd_b_unit(F, l, u); else s5_b_unit(F, l, u - 256); }
}

struct Args { const float* in[35]; float* out; unsigned char* ws; int ph_lo, ph_hi, li, pad; };
#ifdef MK_PHASE_RANGE
#define IN(k) (lo <= (k) && (k) < hi)
#else
#define IN(k) true
#endif
#define REFRESH() do { int t_ = threadIdx.x; asm volatile("" : "+v"(t_)); F.tid = t_; F.lane = t_ & 63; \
        unsigned char* w_ = args.ws; asm volatile("" : "+s"(w_)); F.ws = w_; F.ctl = (unsigned*)(w_ + OFF_CTL); float* o_ = args.out; asm volatile("" : "+s"(o_)); F.out = o_; \
        const float* const* i_ = (const float* const*)__builtin_amdgcn_kernarg_segment_ptr(); asm volatile("" : "+s"(i_)); F.in = i_; \
        int g_ = gridDim.x, v_ = vcu0; asm volatile("" : "+s"(g_), "+s"(v_)); F.G = g_; F.vcu = v_; modsb = (const float*)(F.ws + OFF_MODS); X = (float*)(F.ws + OFF_X); } while (0)
#define SEAM(k) do { if (IN(k) && IN((k) + 1) && (k) + 1 < PH_END) xcd_barrier(bar); } while (0)
template <int l>
__device__ __forceinline__ void layer_body(Frame& F, const Args& args, const XcdBarrier& bar, const int vcu0) {
    const int lo = args.ph_lo, hi = args.ph_hi; (void)lo; (void)hi;
    const float* modsb = (const float*)(F.ws + OFF_MODS);
    float* X = (float*)(F.ws + OFF_X);
        const int pb = PH_L0 + l * PH_PER_LAYER;
        if (IN(pb + PH_G1)) { REFRESH();
            pg8::Gemm g{(const bf16_t*)(F.ws + OFF_H), (const bf16_t*)(F.ws + OFF_WIN) + (size_t)l * PNP * 1024, M, PNP, 1024}; pg8::StaticOrder S; S.init(M, PNP, F.G, (int)blockIdx.x);
            epi_side_fill(F, S, (const float*)(F.ws + OFF_TAB + TAB_SQ1), (const float*)(F.ws + OFF_TAB + TAB_B1) + (size_t)l * 9 * PNP, PNP);
            pg8::EpiProj E{(bf16_t*)(F.ws + OFF_PROJ), F.out + O_K, F.out + O_V, (float*)(F.ws + OFF_DT), (LAS const float*)(F.lds + EPI_SIDE_OFF), l, 0};
            pg8::gemm_phase<pg8::EpiProj, pg8::StaticOrder, true, true>(F.lds, g, S, E);
        }
        SEAM(pb + PH_G1);
        if (IN(pb + PH_MIXA)) { REFRESH(); phase_mixa(F, l); }
        SEAM(pb + PH_MIXA);
        if (IN(pb + PH_MIXB)) { REFRESH(); ssd_state_pass(F, l); xcd_barrier(bar); REFRESH(); phase_mixb(F, l); }
        SEAM(pb + PH_MIXB);
        if (IN(pb + PH_G3)) { REFRESH();
            pg8::Gemm g{(const bf16_t*)(F.ws + OFF_MIX), (const bf16_t*)(F.ws + OFF_WOUT) + (size_t)l * 1024 * 1024, M, D, 1024}; pg8::StaticOrder S; S.init(M, D, F.G, (int)blockIdx.x);
            pg8::EpiRes<6> E{l == 0 ? F.in[0] : X, l == 0 ? F.in[1] - (size_t)MC * D : X, X, modsb + (size_t)l * 9 * 6144 + 2 * 1024, F.in[12] + l * D, modsb + (size_t)l * 9 * 6144 + 4 * 1024,
                          (bf16_t*)(F.ws + OFF_H), (float*)(F.ws + OFF_TAB + TAB_SQ2), (LAS const float*)(F.lds + EPI_SIDE_OFF)};
            { pg8::Unit u; if (S.next(0, u) && F.tid < 256) { const float* q2 = (const float*)(F.ws + OFF_TAB + TAB_SSQ) + (size_t)(u.pm * 256 + F.tid) * 2;
                ((LAS float*)(F.lds + EPI_SIDE_OFF))[F.tid] = rsqrtf((q2[0] + q2[1]) * (1.f / 384.f) + EPS); } __syncthreads(); }
            pg8::gemm_phase<pg8::EpiRes<6>, pg8::StaticOrder, true, true>(F.lds, g, S, E);
        }
        SEAM(pb + PH_G3);
        if (IN(pb + PH_G4)) { REFRESH();
            pg8::Gemm g{(const bf16_t*)(F.ws + OFF_H), (const bf16_t*)(F.ws + OFF_WFF1) + (size_t)l * DFF * 1024, M, DFF, 1024}; pg8::StaticOrder S; S.init(M, DFF, F.G, (int)blockIdx.x);
            epi_side_fill(F, S, (const float*)(F.ws + OFF_TAB + TAB_SQ2), (const float*)(F.ws + OFF_TAB + TAB_B2) + (size_t)l * 9 * DFF, DFF);
            pg8::EpiFF1 E{(bf16_t*)(F.ws + OFF_FFH), (LAS const float*)(F.lds + EPI_SIDE_OFF), 0};
            pg8::gemm_phase<pg8::EpiFF1, pg8::StaticOrder, true, true>(F.lds, g, S, E);
        }
        SEAM(pb + PH_G4);
        if (IN(pb + PH_G5)) { REFRESH();
            pg8::Gemm g{(const bf16_t*)(F.ws + OFF_FFH), (const bf16_t*)(F.ws + OFF_WFF2) + (size_t)l * 1024 * DFF, M, D, DFF}; pg8::StaticOrder S; S.init(M, D, F.G, (int)blockIdx.x);
            const int ln = l + 1 < DEPTH ? l + 1 : l;
            pg8::EpiRes<0> E{X, X, X, modsb + (size_t)l * 9 * 6144 + 5 * 1024, F.in[11] + ln * D, modsb + (size_t)ln * 9 * 6144 + 1 * 1024,
                          l + 1 < DEPTH ? (bf16_t*)(F.ws + OFF_H) : (bf16_t*)nullptr, (float*)(F.ws + OFF_TAB + TAB_SQ1), (LAS const float*)(F.lds + EPI_SIDE_OFF)};
            pg8::gemm_phase<pg8::EpiRes<0>, pg8::StaticOrder, true, true>(F.lds, g, S, E);
        }
        SEAM(pb + PH_G5);
    }
__global__ void __launch_bounds__(NTHREADS, 2) mega(Args args) {
    extern __shared__ __attribute__((aligned(16))) unsigned char lds[];
    Frame F;
    F.lds = (LAS unsigned char*)lds;
    F.MISC = (volatile LAS unsigned*)(F.lds + MISC_OFF);
    F.tid = threadIdx.x; F.lane = F.tid & 63; F.wave = __builtin_amdgcn_readfirstlane(F.tid >> 6);
    F.G = gridDim.x; { const int bx = blockIdx.x; F.vcu = (F.G % 8 == 0) ? (bx % 8) * (F.G / 8) + bx / 8 : bx; }
    { const float* const* inp = (const float* const*)__builtin_amdgcn_kernarg_segment_ptr(); asm volatile("" : "+s"(inp)); F.in = inp; }
    F.out = args.out; F.ws = args.ws; F.ctl = (unsigned*)(args.ws + OFF_CTL);
    for (int u = F.tid; u < (LDS_BYTES - LDSCTL_OFF) / 4; u += NTHREADS) ((LAS unsigned*)(F.lds + LDSCTL_OFF))[u] = 0u;
    __syncthreads();
    XcdBarrier bar = xcd_barrier_post(F.ctl + CW_BAR + args.li * XCD_BAR_WORDS, F.MISC + 8);
    const int lo = args.ph_lo, hi = args.ph_hi; (void)lo; (void)hi;
    const float* modsb = (const float*)(F.ws + OFF_MODS);
    float* X = (float*)(F.ws + OFF_X);
    const int vcu0 = F.vcu;
    if (IN(PH_PRO)) phase_prologue(F);
    SEAM(PH_PRO);
    if (IN(PH_PRE)) { REFRESH(); phase_pre(F); }
    SEAM(PH_PRE);
    layer_body<0>(F, args, bar, vcu0); layer_body<1>(F, args, bar, vcu0); layer_body<2>(F, args, bar, vcu0); layer_body<3>(F, args, bar, vcu0);
    if (IN(PH_FINAL)) phase_final(F);
#undef IN
#undef SEAM
}
static void launch_mega(const Args& base, int lo, int hi, int li, hipStream_t stream) {
    Args a = base; a.ph_lo = lo; a.ph_hi = hi; a.li = li;
    hipLaunchKernelGGL(mega, dim3(256), dim3(NTHREADS), LDS_BYTES, stream, a);
}
extern "C" void kernel_launch(void* const* d_in, const int* in_sizes, int n_in, void* d_out, int out_size, void* d_ws, size_t ws_size, hipStream_t stream) {
    static int ready = 0;
    if (!ready) {
        if (n_in != 35 || out_size != (int)O_END || ws_size < WS_END) { fprintf(stderr, "kernel_launch: unexpected shapes n_in %d out %d ws %zu\n", n_in, out_size, ws_size); ready = -1; return; }
        if (hipFuncSetAttribute((const void*)mega, hipFuncAttributeMaxDynamicSharedMemorySize, LDS_BYTES) != hipSuccess) { fprintf(stderr, "kernel_launch: hipFuncSetAttribute failed\n"); ready = -1; return; }
        ready = 1;
    }
    if (ready < 0) return;
    Args a{}; for (int i = 0; i < 35; ++i) a.in[i] = (const float*)d_in[i]; a.out = (float*)d_out; a.ws = (unsigned char*)d_ws;
    (void)hipMemsetAsync((char*)d_ws + OFF_CTL, 0, CTL_ZERO_BYTES, stream);
    launch_mega(a, 0, PH_END, 0, stream);
}
```

```cpp
#include <hip/hip_runtime.h>
#include <stdint.h>
#include <stdio.h>

typedef unsigned short bf16_t;
typedef short bf16x8 __attribute__((ext_vector_type(8)));
typedef float f32x4 __attribute__((ext_vector_type(4)));

constexpr int D = 1024, DEPTH = 4;
constexpr int CB = 32, CL = 256, LB = 8, LL = 1024;
constexpr int MC = CB * CL;
constexpr int M = MC + LB * LL;
constexpr int NSEQ = CB + LB;
constexpr int IN_COLS = 2444;
constexpr int PN = 2432, PNP = 2560;
constexpr int PZ = 0, PX = 384, PU = 1024, PQ = 1280, PK = 1664, PV = 2048;
constexpr int DFF = 4096;
constexpr float EPS = 1e-6f;

constexpr size_t MiB = 1u << 20;
constexpr size_t OFF_CTL = 0, OFF_MODS = 1 * MiB, OFF_TAB = 2 * MiB, OFF_WIN = 8 * MiB, OFF_WOUT = 28 * MiB, OFF_WFF1 = 36 * MiB,
                 OFF_WFF2 = 68 * MiB, OFF_WGLU = 100 * MiB, OFF_DT = 101 * MiB, OFF_X = 102 * MiB, OFF_PROJ = 166 * MiB, OFF_MIX = 242 * MiB,
                 OFF_FFH = 166 * MiB, OFF_H = 294 * MiB, OFF_XBC = 294 * MiB, OFF_YSSD = 334 * MiB, OFF_YS5 = 358 * MiB, WS_END = 374 * MiB;
constexpr size_t TAB_ABAR = 0;
constexpr size_t TAB_SQ1 = 256 * 1024;
constexpr size_t TAB_SQ2 = 1280 * 1024;
constexpr size_t TAB_B1 = 2304 * 1024;
constexpr size_t TAB_B2 = 4352 * 1024;
constexpr size_t TAB_SSQ = 5 * MiB;
constexpr size_t OFF_HIN = 362 * MiB;
constexpr size_t OFF_YU = 274 * MiB;
constexpr size_t TAB_CD = 3 * MiB;
constexpr size_t OFF_CS = 334 * MiB;
constexpr size_t TAB_CC1 = 4 * MiB;
constexpr size_t TAB_BBT = 3 * MiB + 512 * 1024;
constexpr size_t OFF_E = 358 * MiB;

__device__ __forceinline__ float bf2f(bf16_t v) { return __uint_as_float((unsigned)v << 16); }
typedef float f32x2_t __attribute__((ext_vector_type(2))); typedef __bf16 bf16x2_t __attribute__((ext_vector_type(2)));
__device__ __forceinline__ unsigned cvtpk(float lo, float hi) { f32x2_t v = {lo, hi}; bf16x2_t b = __builtin_convertvector(v, bf16x2_t); return __builtin_bit_cast(unsigned, b); }
__device__ __forceinline__ bf16_t f2bf(float f) { return (bf16_t)(cvtpk(f, f) & 0xffffu); }
__device__ __forceinline__ float sigmoid_f(float x) { return __builtin_amdgcn_rcpf(1.f + __expf(-x)); }
__device__ __forceinline__ float silu_f(float x) { return x * sigmoid_f(x); }
__device__ __forceinline__ float softplus_f(float x) { return x > 20.f ? x : log1pf(__expf(x)); }
__device__ __forceinline__ float gelu_tanh_f(float x) { const float u = 1.5957691216057308f * (x + 0.044715f * x * x * x); return x * sigmoid_f(u); }
template <int CTRL> __device__ __forceinline__ float dppf(float x) { return __uint_as_float((unsigned)__builtin_amdgcn_update_dpp(0, (int)__float_as_uint(x), CTRL, 0xf, 0xf, true)); }
__device__ __forceinline__ float row16_sum(float x) { x += dppf<0xB1>(x); x += dppf<0x4E>(x); x += dppf<0x141>(x); x += dppf<0x140>(x); return x; }
__device__ __forceinline__ float row16_max(float x) { x = fmaxf(x, dppf<0xB1>(x)); x = fmaxf(x, dppf<0x4E>(x)); x = fmaxf(x, dppf<0x141>(x)); x = fmaxf(x, dppf<0x140>(x)); return x; }
__device__ __forceinline__ float xsum16(float x) { const auto r = __builtin_amdgcn_permlane16_swap(__float_as_uint(x), __float_as_uint(x), false, false); return __uint_as_float(r[0]) + __uint_as_float(r[1]); }
__device__ __forceinline__ float xsum32(float x) { const auto r = __builtin_amdgcn_permlane32_swap(__float_as_uint(x), __float_as_uint(x), false, false); return __uint_as_float(r[0]) + __uint_as_float(r[1]); }
__device__ __forceinline__ float xmax16(float x) { const auto r = __builtin_amdgcn_permlane16_swap(__float_as_uint(x), __float_as_uint(x), false, false); return fmaxf(__uint_as_float(r[0]), __uint_as_float(r[1])); }
__device__ __forceinline__ float xmax32(float x) { const auto r = __builtin_amdgcn_permlane32_swap(__float_as_uint(x), __float_as_uint(x), false, false); return fmaxf(__uint_as_float(r[0]), __uint_as_float(r[1])); }
__device__ __forceinline__ float rdlane(float x, int l) { return __uint_as_float((unsigned)__builtin_amdgcn_readlane((int)__float_as_uint(x), l)); }
__device__ __forceinline__ float wave_sum(float v) { return xsum32(xsum16(row16_sum(v))); }
__device__ __forceinline__ float wave_max(float v) { return xmax32(xmax16(row16_max(v))); }
__device__ __forceinline__ int mod_row(int row) { return row < MC ? 0 : 1 + ((row - MC) >> 10); }

struct P {
    const float* in[35];
    float* out;
    unsigned char* ws;
};
constexpr size_t O_YP = 0, O_YS = 8388608, O_K = 16777216, O_V = O_K + 12582912, O_SSD = O_V + 12582912, O_RE = O_SSD + 6291456, O_IM = O_RE + 262144, O_END = O_IM + 262144;


#define LAS __attribute__((address_space(3)))
struct SeqInfo { int start, L, b, ctx; };
__device__ __forceinline__ SeqInfo seq_info(int s) { SeqInfo q; if (s < CB) { q.start = s * CL; q.L = CL; q.b = s; q.ctx = 1; } else { q.start = MC + (s - CB) * LL; q.L = LL; q.b = s - CB; q.ctx = 0; } return q; }
__device__ __forceinline__ SeqInfo row_seq(int row) { return seq_info(row < MC ? (row >> 8) : CB + ((row - MC) >> 10)); }
namespace pg8 {
#define PG8_LAS __attribute__((address_space(3)))
typedef unsigned short bf16_t;
typedef short bf16x8 __attribute__((ext_vector_type(8)));
typedef float f32x4 __attribute__((ext_vector_type(4)));
typedef unsigned u32x4 __attribute__((ext_vector_type(4)));
constexpr int BM = 256, BK = 64, HALF = 128, HTB = HALF * BK * 2  , STAGE_BYTES = 8 * HTB, NXCD = 8, WGM = 8;

__host__ __device__ __forceinline__ int lds_byte(int r, int c) { const int st = (r >> 4) * 2 + (c >> 5), rr = r & 15, cc = c & 31, ob = rr * 64 + cc * 2; return st * 1024 + (ob ^ (((ob >> 9) & 1) << 5)); }
__host__ __device__ __forceinline__ void stage_rc(int b, int& R, int& C) { const int st = b / 1024, sb = b % 1024, swz = sb ^ (((sb >> 9) & 1) << 5); R = (st >> 1) * 16 + swz / 64; C = (st & 1) * 32 + (swz % 64) / 2; }
__host__ __device__ __forceinline__ int perm32(int rho) { const int n = rho >> 4, i = rho & 15; return 8 * (i >> 2) + 4 * n + (i & 3); }

struct Unit { int pm, pn; };
struct Gemm { const bf16_t* A; const bf16_t* Bt; int M, N, K; };

struct StaticOrder {
    int nM, nN, nwg, G, c;
    __host__ __device__ void init(int M, int N, int G_, int c_) { nM = M / BM; nN = N / BM; nwg = nM * nN; G = G_; c = c_; }
    __host__ __device__ bool next(int i, Unit& u) const {
        const long L = (long)i * G + c; if (L >= nwg) return false;
        int wgid = (int)L; { const int q = nwg / NXCD, r = nwg % NXCD, xcd = wgid % NXCD, off = wgid / NXCD; wgid = (xcd < r ? xcd * (q + 1) : r * (q + 1) + (xcd - r) * q) + off; }
        const int nig = WGM * nN, gid = wgid / nig, fm = gid * WGM, gsz = (nM - fm) < WGM ? (nM - fm) : WGM;
        u.pm = fm + ((wgid % nig) % gsz); u.pn = (wgid % nig) / gsz; return true;
    }
    __device__ __forceinline__ void a_ready(const Unit&) const {}
    __device__ __forceinline__ void done(const Unit&) const {}
};

__device__ __forceinline__ unsigned cvt_pk_bf16(float lo, float hi) { unsigned r; asm volatile("v_cvt_pk_bf16_f32 %0, %1, %2" : "=v"(r) : "v"(lo), "v"(hi)); return r; }
__device__ __forceinline__ float row_rstd(const float* ssq, int row, int fq) {
    const f32x4 a = *(const f32x4*)(ssq + (size_t)row * 16 + 4 * fq);
    const float s = ::xsum32(::xsum16((a[0] + a[1]) + (a[2] + a[3])));
    return rsqrtf(s * (1.f / 1024.f) + ::EPS);
}
struct EpiProj {
    static constexpr bool PERM = true, AFTER_DRAIN = false; static constexpr int MID_T = 0;
    bf16_t* proj; float* ok; float* ov; float* dt; PG8_LAS const float* side; int l; mutable int slot;
    __device__ __forceinline__ void operator()(const f32x4 (&acc)[2][2][4][2], const Unit& u, int wr, int wc, int fr, int fq) const {
        const int row0 = u.pm * BM + wr * 64 + fr;
        PG8_LAS const float* rsp = side + slot * 256 + wr * 64 + fr; PG8_LAS const float* bsp = side + 1024 + slot * 256 + wc * 32 + 8 * fq; ++slot;
        float rs[2][4];
#pragma unroll
        for (int ai = 0; ai < 2; ++ai)
#pragma unroll
            for (int m = 0; m < 4; ++m) rs[ai][m] = rsp[ai * HALF + m * 16];
#pragma unroll
        for (int bj = 0; bj < 2; ++bj) {
            const int cb = u.pn * BM + bj * HALF;
            if (cb > ::PN) continue;
            const int col = cb + wc * 32 + 8 * fq;
            const f32x4 b0 = *(PG8_LAS const f32x4*)(bsp + bj * HALF), b1 = *(PG8_LAS const f32x4*)(bsp + bj * HALF + 4);
            const bool isk = (cb >= ::PK && cb < ::PV), isv = (cb >= ::PV && cb < ::PN), isdt = (cb == ::PN);
#pragma unroll
            for (int ai = 0; ai < 2; ++ai)
#pragma unroll
                for (int m = 0; m < 4; ++m) {
                    const int row = row0 + ai * HALF + m * 16;
                    const f32x4 v0 = acc[ai][bj][m][0] * rs[ai][m] + b0, v1 = acc[ai][bj][m][1] * rs[ai][m] + b1;
                    if (isdt) { if (wc == 0 && fq < 2) { float* d = dt + (size_t)row * 12 + 8 * fq; *(f32x4*)d = v0; if (fq == 0) *(f32x4*)(d + 4) = v1; } continue; }
                    u32x4 w; w.x = cvt_pk_bf16(v0[0], v0[1]); w.y = cvt_pk_bf16(v0[2], v0[3]); w.z = cvt_pk_bf16(v1[0], v1[1]); w.w = cvt_pk_bf16(v1[2], v1[3]);
                    *(u32x4*)(proj + (size_t)row * ::PN + col) = w;
                    if (u.pm < 32 && (isk || isv)) {
                        const int b = row >> 8, t = row & 255;
                        float* o = (isk ? ok : ov) + ((size_t)(b * 4 + l) * 256 + t) * 384 + (col - (isk ? ::PK : ::PV));
                        *(f32x4*)o = v0; *(f32x4*)(o + 4) = v1;
                    }
                }
        }
    }
};
template <int MID, bool XF32>
struct EpiRes {
    static constexpr bool PERM = true, AFTER_DRAIN = false; static constexpr int MID_T = MID;
    const void* xin_c; const void* xin_l; bf16_t* xout; const float* gate;
    const float* nw; const float* sc; bf16_t* xs; float* ssq;
    PG8_LAS const float* side;
    __device__ __forceinline__ void mid(f32x4 (&acc)[2][2][4][2], const Unit& u, int wr, int fr) const {
#pragma unroll
        for (int ai = 0; ai < 2; ++ai)
#pragma unroll
            for (int m = 0; m < 4; ++m) { const float sc_ = side[ai * HALF + wr * 64 + m * 16 + fr];
#pragma unroll
                for (int bj = 0; bj < 2; ++bj)
#pragma unroll
                    for (int n = 0; n < 2; ++n) acc[ai][bj][m][n] = acc[ai][bj][m][n] * sc_; }
    }
    __device__ __forceinline__ void operator()(const f32x4 (&acc)[2][2][4][2], const Unit& u, int wr, int wc, int fr, int fq) const {
        const int row0 = u.pm * BM + wr * 64 + fr, col0 = u.pn * BM + wc * 32 + 8 * fq;
        const int r = u.pm < 32 ? 0 : 1 + ((u.pm - 32) >> 2);
        const float* gt = gate + (size_t)r * 6144; const float* sr = sc + (size_t)r * 6144;
        const void* xin = u.pm < 32 ? xin_c : xin_l;
        float sq[2][4];
#pragma unroll
        for (int ai = 0; ai < 2; ++ai)
#pragma unroll
            for (int m = 0; m < 4; ++m) sq[ai][m] = 0.f;
#pragma unroll
        for (int bj = 0; bj < 2; ++bj) {
            const int col = col0 + bj * HALF;
            const f32x4 g0 = *(const f32x4*)(gt + col), g1 = *(const f32x4*)(gt + col + 4);
            f32x4 gs0 = {0.f, 0.f, 0.f, 0.f}, gs1 = gs0;
            if (xs) { gs0 = *(const f32x4*)(nw + col) * (*(const f32x4*)(sr + col) + 1.f); gs1 = *(const f32x4*)(nw + col + 4) * (*(const f32x4*)(sr + col + 4) + 1.f); }
#pragma unroll
            for (int ai = 0; ai < 2; ++ai)
#pragma unroll
                for (int m = 0; m < 4; ++m) {
                    const size_t off = (size_t)(row0 + ai * HALF + m * 16) * ::D + col;
                    f32x4 xi0, xi1;
                    if (XF32) { xi0 = *(const f32x4*)((const float*)xin + off); xi1 = *(const f32x4*)((const float*)xin + off + 4); }
                    else { const u32x4 xr = *(const u32x4*)((const bf16_t*)xin + off);
                        xi0 = (f32x4){__uint_as_float(xr.x << 16), __uint_as_float(xr.x & 0xffff0000u), __uint_as_float(xr.y << 16), __uint_as_float(xr.y & 0xffff0000u)};
                        xi1 = (f32x4){__uint_as_float(xr.z << 16), __uint_as_float(xr.z & 0xffff0000u), __uint_as_float(xr.w << 16), __uint_as_float(xr.w & 0xffff0000u)}; }
                    const f32x4 x0 = xi0 + g0 * acc[ai][bj][m][0], x1 = xi1 + g1 * acc[ai][bj][m][1];
                    { u32x4 xo; xo.x = cvt_pk_bf16(x0[0], x0[1]); xo.y = cvt_pk_bf16(x0[2], x0[3]); xo.z = cvt_pk_bf16(x1[0], x1[1]); xo.w = cvt_pk_bf16(x1[2], x1[3]); *(u32x4*)(xout + off) = xo; }
                    if (xs) { sq[ai][m] += ((x0[0] * x0[0] + x0[1] * x0[1]) + (x0[2] * x0[2] + x0[3] * x0[3])) + ((x1[0] * x1[0] + x1[1] * x1[1]) + (x1[2] * x1[2] + x1[3] * x1[3]));
                        const f32x4 h0 = x0 * gs0, h1 = x1 * gs1; u32x4 o; o.x = cvt_pk_bf16(h0[0], h0[1]); o.y = cvt_pk_bf16(h0[2], h0[3]); o.z = cvt_pk_bf16(h1[0], h1[1]); o.w = cvt_pk_bf16(h1[2], h1[3]);
                        *(u32x4*)(xs + off) = o; }
                }
        }
        if (xs) {
#pragma unroll
            for (int ai = 0; ai < 2; ++ai)
#pragma unroll
                for (int m = 0; m < 4; ++m) { const float t = ::xsum32(::xsum16(sq[ai][m])); if (fq == 0) ssq[(size_t)(row0 + ai * HALF + m * 16) * 16 + u.pn * 4 + wc] = t; }
        }
    }
};
struct EpiFF1 {
    static constexpr bool PERM = true, AFTER_DRAIN = false; static constexpr int MID_T = 0;
    bf16_t* h; PG8_LAS const float* side; mutable int slot;
    __device__ __forceinline__ void operator()(const f32x4 (&acc)[2][2][4][2], const Unit& u, int wr, int wc, int fr, int fq) const {
        const int row0 = u.pm * BM + wr * 64 + fr, col0 = u.pn * BM + wc * 32 + 8 * fq;
        PG8_LAS const float* rsp = side + slot * 256 + wr * 64 + fr; PG8_LAS const float* bsp = side + 1024 + slot * 256 + wc * 32 + 8 * fq; ++slot;
        f32x4 bv[2][2];
#pragma unroll
        for (int bj = 0; bj < 2; ++bj) { bv[bj][0] = *(PG8_LAS const f32x4*)(bsp + bj * HALF); bv[bj][1] = *(PG8_LAS const f32x4*)(bsp + bj * HALF + 4); }
#pragma unroll
        for (int ai = 0; ai < 2; ++ai)
#pragma unroll
            for (int m = 0; m < 4; ++m) {
                const int row = row0 + ai * HALF + m * 16; const float rs = rsp[ai * HALF + m * 16];
                bf16_t* rowp = h + (size_t)row * ::DFF + col0;
#pragma unroll
                for (int bj = 0; bj < 2; ++bj) {
                    f32x4 v0 = acc[ai][bj][m][0] * rs + bv[bj][0], v1 = acc[ai][bj][m][1] * rs + bv[bj][1];
#pragma unroll
                    for (int e = 0; e < 4; ++e) { const float a = fmaxf(v0[e], 0.f), b = fmaxf(v1[e], 0.f); v0[e] = a * a; v1[e] = b * b; }
                    u32x4 w; w.x = cvt_pk_bf16(v0[0], v0[1]); w.y = cvt_pk_bf16(v0[2], v0[3]); w.z = cvt_pk_bf16(v1[0], v1[1]); w.w = cvt_pk_bf16(v1[2], v1[3]);
                    *(u32x4*)(rowp + bj * HALF) = w;
                }
            }
    }
};
template <class Epi, class Sched, bool ALIGN_EPI = false, bool SP2 = false>
__device__ __forceinline__ void gemm_phase(PG8_LAS unsigned char* lds, const Gemm g, const Sched& S, const Epi& E) {
    int tid_ = threadIdx.x; asm volatile("" : "+v"(tid_));
    const int tid = tid_, wid = __builtin_amdgcn_readfirstlane(tid >> 6), lane = tid & 63, wr = wid >> 2, wc = wid & 3, fr = lane & 15, fq = lane >> 4;
    const int K = g.K, nt = K / BK;
    unsigned voffA[2], voffB[2];
#pragma unroll
    for (int i = 0; i < 2; ++i) { int R, C; stage_rc(tid * 16 + i * 8192, R, C); const int Rb = Epi::PERM ? ((R & ~31) + perm32(R & 31)) : R;
        voffA[i] = (unsigned)(R * K + C) * 2u; voffB[i] = (unsigned)(Rb * K + C) * 2u; }
    const size_t kstep = (size_t)(BK * 2);
    const size_t hstep = (size_t)HALF * K * 2;
    const size_t tstep = 2 * hstep;
    const unsigned ldsw = (unsigned)wid * 1024u;
    const int aoff = lds_byte(wr * 64 + fr, fq * 8), boff = lds_byte(wc * 32 + fr, fq * 8);
#define PG8_SA(b, h) (((b) * 2 + (h)) * HTB)
#define PG8_SB(b, h) ((4 + (b) * 2 + (h)) * HTB)
#define PG8_STAGE(bufoff, gbase, voff) do { _Pragma("unroll") for (int _i = 0; _i < 2; ++_i) \
        __builtin_amdgcn_global_load_lds((const unsigned*)((const char*)(gbase) + (voff)[_i]), (PG8_LAS unsigned*)(lds + (bufoff) + ldsw + _i * 8192), 16, 0, 0); } while (0)
#define PG8_LDA(dst, b, h) do { _Pragma("unroll") for (int m = 0; m < 4; ++m) _Pragma("unroll") for (int k = 0; k < 2; ++k) dst[m][k] = *(const PG8_LAS bf16x8*)(lds + PG8_SA(b, h) + aoff + m * 2048 + k * 1024); } while (0)
#define PG8_LDB(dst, b, h) do { _Pragma("unroll") for (int n = 0; n < 2; ++n) _Pragma("unroll") for (int k = 0; k < 2; ++k) dst[n][k] = *(const PG8_LAS bf16x8*)(lds + PG8_SB(b, h) + boff + n * 2048 + k * 1024); } while (0)
#define PG8_MMA(ai, bj, At, Bt) do { __builtin_amdgcn_s_setprio(1); _Pragma("unroll") for (int m = 0; m < 4; ++m) _Pragma("unroll") for (int n = 0; n < 2; ++n) _Pragma("unroll") for (int k = 0; k < 2; ++k) \
        acc[ai][bj][m][n] = __builtin_amdgcn_mfma_f32_16x16x32_bf16(Bt[n][k], At[m][k], acc[ai][bj][m][n], 0, 0, 0); __builtin_amdgcn_s_setprio(0); } while (0)
#define PG8_WAIT_V(n) asm volatile("s_waitcnt vmcnt(" #n ")" ::: "memory")
#define PG8_WAIT_L(n) asm volatile("s_waitcnt lgkmcnt(" #n ")" ::: "memory")
#define PG8_BAR __builtin_amdgcn_s_barrier()
#define PG8_SCHED __builtin_amdgcn_sched_barrier(0)
    Unit cur, nxt; int ui = 0;
    if (!S.next(0, cur)) return;
    f32x4 acc[2][2][4][2];
#pragma unroll
    for (int a = 0; a < 2; ++a)
#pragma unroll
        for (int b = 0; b < 2; ++b)
#pragma unroll
            for (int m = 0; m < 4; ++m)
#pragma unroll
                for (int n = 0; n < 2; ++n) acc[a][b][m][n] = (f32x4){0.f, 0.f, 0.f, 0.f};
    bf16x8 At[4][2], B0[2][2], B1[2][2];
    const char* cA = (const char*)g.A + (size_t)cur.pm * tstep; const char* cB = (const char*)g.Bt + (size_t)cur.pn * tstep;
    S.a_ready(cur);
    if constexpr (SP2) {
        PG8_STAGE(PG8_SB(0, 0), cB, voffB); PG8_STAGE(PG8_SB(0, 1), cB + hstep, voffB); PG8_STAGE(PG8_SA(0, 0), cA, voffA); PG8_STAGE(PG8_SA(0, 1), cA + hstep, voffA);
        if (wr == 1) PG8_BAR;
        PG8_WAIT_V(2); PG8_BAR;
        PG8_STAGE(PG8_SB(1, 0), cB + kstep, voffB); PG8_STAGE(PG8_SA(1, 0), cA + kstep, voffA); PG8_STAGE(PG8_SB(1, 1), cB + hstep + kstep, voffB);
        PG8_WAIT_V(6); PG8_BAR;
    } else {
        PG8_STAGE(PG8_SB(0, 0), cB, voffB); PG8_STAGE(PG8_SA(0, 0), cA, voffA); PG8_STAGE(PG8_SB(0, 1), cB + hstep, voffB); PG8_STAGE(PG8_SA(0, 1), cA + hstep, voffA);
        if (wr == 1) PG8_BAR;
        PG8_WAIT_V(4); PG8_BAR;
        PG8_STAGE(PG8_SB(1, 0), cB + kstep, voffB); PG8_STAGE(PG8_SA(1, 0), cA + kstep, voffA); PG8_STAGE(PG8_SB(1, 1), cB + hstep + kstep, voffB);
        PG8_WAIT_V(6); PG8_BAR;
    }
    for (;;) {
        const bool has_next = S.next(ui + 1, nxt);
        const char* nA = has_next ? (const char*)g.A + (size_t)nxt.pm * tstep : cA; const char* nB = has_next ? (const char*)g.Bt + (size_t)nxt.pn * tstep : cB;
        for (int t = 0; t < nt; t += 2) {
            if constexpr (Epi::MID_T > 0) { if (t == Epi::MID_T) E.mid(acc, cur, wr, fr); }
            const bool last = (t == nt - 2);
            const char* a1 = cA + (size_t)(t + 1) * kstep;
            const char* a2 = last ? nA : cA + (size_t)(t + 2) * kstep; const char* b2 = last ? nB : cB + (size_t)(t + 2) * kstep;
            const char* a3 = a2 + kstep; const char* b3 = b2 + kstep;
            if (last && has_next) S.a_ready(nxt);
            if constexpr (SP2) {
            PG8_LDB(B0, 0, 0); PG8_LDB(B1, 0, 1); PG8_SCHED; PG8_LDA(At, 0, 0); PG8_STAGE(PG8_SA(1, 1), a1 + hstep, voffA);
            PG8_WAIT_V(8); PG8_WAIT_L(0); PG8_BAR; PG8_MMA(0, 0, At, B0); PG8_MMA(0, 1, At, B1); PG8_BAR; PG8_SCHED;
            PG8_LDA(At, 0, 1); PG8_STAGE(PG8_SB(0, 0), b2, voffB); PG8_STAGE(PG8_SB(0, 1), b2 + hstep, voffB); PG8_STAGE(PG8_SA(0, 0), a2, voffA);
            PG8_WAIT_V(8); PG8_WAIT_L(0); PG8_BAR; PG8_MMA(1, 0, At, B0); PG8_MMA(1, 1, At, B1); PG8_BAR; PG8_SCHED;
            PG8_LDB(B0, 1, 0); PG8_LDB(B1, 1, 1); PG8_SCHED; PG8_LDA(At, 1, 0); PG8_STAGE(PG8_SA(0, 1), a2 + hstep, voffA);
            PG8_WAIT_V(8); PG8_WAIT_L(0); PG8_BAR; PG8_MMA(0, 0, At, B0); PG8_MMA(0, 1, At, B1); PG8_BAR; PG8_SCHED;
            PG8_LDA(At, 1, 1); PG8_STAGE(PG8_SB(1, 0), b3, voffB); PG8_STAGE(PG8_SB(1, 1), b3 + hstep, voffB); PG8_STAGE(PG8_SA(1, 0), a3, voffA);
            PG8_WAIT_V(8); PG8_WAIT_L(0); PG8_BAR; PG8_MMA(1, 0, At, B0); PG8_MMA(1, 1, At, B1); PG8_BAR; PG8_SCHED;
            } else {
            PG8_LDB(B0, 0, 0); PG8_SCHED; PG8_LDA(At, 0, 0); PG8_STAGE(PG8_SA(1, 1), a1 + hstep, voffA);
            PG8_WAIT_L(8); PG8_BAR; PG8_WAIT_L(0); PG8_MMA(0, 0, At, B0); PG8_BAR; PG8_SCHED;
            PG8_LDB(B1, 0, 1); PG8_STAGE(PG8_SB(0, 0), b2, voffB);
            PG8_BAR; PG8_WAIT_L(0); PG8_MMA(0, 1, At, B1); PG8_BAR;
            PG8_LDA(At, 0, 1); PG8_STAGE(PG8_SA(0, 0), a2, voffA);
            PG8_BAR; PG8_WAIT_L(0); PG8_MMA(1, 0, At, B0); PG8_BAR; PG8_SCHED;
            PG8_STAGE(PG8_SB(0, 1), b2 + hstep, voffB);
            PG8_WAIT_V(6); PG8_BAR; PG8_MMA(1, 1, At, B1); PG8_BAR;
            PG8_LDB(B0, 1, 0); PG8_SCHED; PG8_LDA(At, 1, 0); PG8_STAGE(PG8_SA(0, 1), a2 + hstep, voffA);
            PG8_WAIT_L(8); PG8_BAR; PG8_WAIT_L(0); PG8_MMA(0, 0, At, B0); PG8_BAR; PG8_SCHED;
            PG8_LDB(B1, 1, 1); PG8_STAGE(PG8_SB(1, 0), b3, voffB);
            PG8_BAR; PG8_WAIT_L(0); PG8_MMA(0, 1, At, B1); PG8_BAR;
            PG8_LDA(At, 1, 1); PG8_STAGE(PG8_SA(1, 0), a3, voffA);
            PG8_BAR; PG8_WAIT_L(0); PG8_MMA(1, 0, At, B0); PG8_BAR; PG8_SCHED;
            PG8_STAGE(PG8_SB(1, 1), b3 + hstep, voffB);
            PG8_WAIT_V(6); PG8_BAR; PG8_MMA(1, 1, At, B1); PG8_BAR;
            }
        }
        if constexpr (ALIGN_EPI) { if (wr == 0) PG8_BAR; }
        if constexpr (!Epi::AFTER_DRAIN) { E(acc, cur, wr, wc, fr, fq); S.done(cur); }
        if (!has_next) break;
#pragma unroll
        for (int a = 0; a < 2; ++a)
#pragma unroll
            for (int b = 0; b < 2; ++b)
#pragma unroll
                for (int m = 0; m < 4; ++m)
#pragma unroll
                    for (int n = 0; n < 2; ++n) acc[a][b][m][n] = (f32x4){0.f, 0.f, 0.f, 0.f};
        cur = nxt; cA = nA; cB = nB; ++ui;
        if constexpr (ALIGN_EPI) { if (wr == 1) PG8_BAR; }
    }
    PG8_WAIT_V(0);
    if constexpr (!ALIGN_EPI) { if (wr == 0) PG8_BAR; }
    PG8_BAR;
    if constexpr (Epi::AFTER_DRAIN) { E.fused(acc, cur, wr, wc, fr, fq, lds, wid, lane); S.done(cur); }
#undef PG8_SA
#undef PG8_SB
#undef PG8_STAGE
#undef PG8_LDA
#undef PG8_LDB
#undef PG8_MMA
#undef PG8_WAIT_V
#undef PG8_WAIT_L
#undef PG8_BAR
#undef PG8_SCHED
}
}

constexpr int NWAVES = 8, NTHREADS = 512;
constexpr int RING_BYTES = 131072, LDS_BYTES = 163840, LDSCTL_OFF = LDS_BYTES - 512, MISC_OFF = LDSCTL_OFF + 320;
#define GAS __attribute__((address_space(1)))
typedef unsigned v4u __attribute__((ext_vector_type(4)));
typedef GAS unsigned gu32;
#define LDS_WAIT() asm volatile("s_waitcnt lgkmcnt(0)" ::: "memory")
#define VM_WAIT() asm volatile("s_waitcnt vmcnt(0)" ::: "memory")
__device__ __forceinline__ unsigned pk2(float lo, float hi) { return cvtpk(lo, hi); }
constexpr int CW_BAR = 4096, CW_Q = 65536;
constexpr size_t CTL_ZERO_BYTES = 1 * MiB;

#define XB_TMO      128
#define XB_XCNT(j)  (256  + 64 * (j))
#define XB_XSUB(j)  (1280 + 64 * (j))
#define XB_XGEN(j)  (2304 + 64 * (j))
#define XB_TOP      3328
#define XB_TOPGEN   3392
#define XCD_BAR_WORDS 3456
#define XB_SPIN_CAP (1u << 18)

__device__ __forceinline__ unsigned xb_ld(unsigned* p)              { return __hip_atomic_load(p, __ATOMIC_RELAXED, __HIP_MEMORY_SCOPE_AGENT); }
__device__ __forceinline__ unsigned xb_add(unsigned* p, unsigned v) { return __hip_atomic_fetch_add(p, v, __ATOMIC_RELAXED, __HIP_MEMORY_SCOPE_AGENT); }
__device__ __forceinline__ unsigned xb_xcc_id() { return (unsigned)__builtin_amdgcn_s_getreg((3 << 11) | 20) & 0xFu; }
#define XB_SPIN(cond, bar) do { unsigned _sp = 0; while (cond) { __builtin_amdgcn_s_sleep(1); \
    if ((++_sp & 255u) == 0u) { if (xb_ld(&(bar)[XB_TMO])) break; if (_sp > XB_SPIN_CAP) { atomicAdd(&(bar)[XB_TMO], 1u); break; } } } } while (0)

struct XcdBarrier {
    unsigned* bar; unsigned x;
    volatile LAS unsigned* st;
};

__device__ __forceinline__ XcdBarrier xcd_barrier_post(unsigned* bar, volatile LAS unsigned* st) {
    XcdBarrier b; b.bar = bar; b.x = xb_xcc_id(); b.st = st;
    if (threadIdx.x == 0) (void)xb_add(&bar[XB_XCNT(b.x)], 1u);
    return b;
}
__device__ __forceinline__ void xcd_barrier_complete(unsigned* bar, unsigned x, unsigned& nloc, unsigned& nx) {
    const unsigned G = gridDim.x * gridDim.y * gridDim.z;
    unsigned sum, cnt, mine, sp = 0u;
    for (;;) {
        sum = 0u; cnt = 0u; mine = 0u;
#pragma unroll
        for (unsigned j = 0; j < 16; ++j) { const unsigned c = xb_ld(&bar[XB_XCNT(j)]); sum += c; cnt += (c > 0u) ? 1u : 0u; mine = (j == x) ? c : mine; }
        if (sum == G) break;
        __builtin_amdgcn_s_sleep(1);
        if ((++sp & 255u) == 0u) { if (xb_ld(&bar[XB_TMO])) break; if (sp > XB_SPIN_CAP) { atomicAdd(&bar[XB_TMO], 1u); break; } }
    }
    nloc = mine > 0u ? mine : 1u; nx = cnt > 0u ? cnt : 1u;
}

__device__ __forceinline__ void xcd_barrier(const XcdBarrier& b) {
    asm volatile("s_waitcnt vmcnt(0)" ::: "memory");
    __syncthreads();
    if (threadIdx.x == 0) {
        unsigned* bar = b.bar;
        __builtin_amdgcn_s_waitcnt(0);
        unsigned nloc = b.st[0], nx = b.st[1];
        if (nloc == 0u) { xcd_barrier_complete(bar, b.x, nloc, nx); b.st[0] = nloc; b.st[1] = nx; }
        const unsigned old = xb_add(&bar[XB_XSUB(b.x)], 1u);
        const unsigned gen = old / nloc;
        if (old + 1u == (gen + 1u) * nloc) {
            __builtin_amdgcn_fence(__ATOMIC_RELEASE, "agent");
            asm volatile("s_waitcnt vmcnt(0)" ::: "memory");
            const unsigned og = xb_add(&bar[XB_TOP], 1u);
            const unsigned tg = og / nx;
            if (og + 1u == (tg + 1u) * nx) xb_add(&bar[XB_TOPGEN], 1u);
            else XB_SPIN(xb_ld(&bar[XB_TOPGEN]) == tg, bar);
            __builtin_amdgcn_fence(__ATOMIC_ACQUIRE, "agent");
            xb_add(&bar[XB_XGEN(b.x)], 1u);
            asm volatile("s_waitcnt vmcnt(0)" ::: "memory");
        } else {
            XB_SPIN(xb_ld(&bar[XB_XGEN(b.x)]) == gen, bar);
            __builtin_amdgcn_fence(__ATOMIC_ACQUIRE, "agent");
            asm volatile("s_waitcnt vmcnt(0)" ::: "memory");
        }
    }
    __syncthreads();
}


struct Frame {
    LAS unsigned char* lds;
    volatile LAS unsigned* MISC;
    unsigned* ctl;
    int tid, lane, wave, vcu, G;
    const float* const* in; float* out; unsigned char* ws;
};
constexpr int PH_PRO = 0, PH_PRE = 1, PH_L0 = 2, PH_PER_LAYER = 6, PH_G1 = 0, PH_MIXA = 1, PH_MIXB = 2, PH_G3 = 3, PH_G4 = 4, PH_G5 = 5, PH_FINAL = PH_L0 + DEPTH * PH_PER_LAYER, PH_END = PH_FINAL + 1;

__device__ __forceinline__ int queue_next(Frame& F, unsigned* ctr);
constexpr int TR_P = 144;
__device__ __forceinline__ void transpose_item(const float* W, int K, int Nsrc, int src_n0, bf16_t* WT, int dst_n0, int k0, LAS unsigned char* scr, int lane, int nvalid = 64) {
    const int l16 = lane & 15, l4 = lane >> 4;
    f32x4 v[16];
#pragma unroll
    for (int i = 0; i < 16; ++i) v[i] = (src_n0 >= 0 && 4 * l16 < nvalid) ? *(const f32x4*)(W + (size_t)(k0 + 4 * i + l4) * Nsrc + src_n0 + 4 * l16) : (f32x4){0.f, 0.f, 0.f, 0.f};
#pragma unroll
    for (int i = 0; i < 16; ++i)
#pragma unroll
        for (int e = 0; e < 4; ++e) *(LAS bf16_t*)(scr + (4 * l16 + e) * TR_P + (4 * i + l4) * 2) = f2bf(v[i][e]);
    LDS_WAIT(); asm volatile("" ::: "memory");
#pragma unroll
    for (int jn = 0; jn < 8; ++jn) { const int n = 8 * jn + (lane >> 3), c = lane & 7;
        *(v4u*)(WT + (size_t)(dst_n0 + n) * K + k0 + 8 * c) = *(LAS const v4u*)(scr + n * TR_P + c * 16); }
    LDS_WAIT(); asm volatile("" ::: "memory");
}
__device__ __forceinline__ void phase_prologue(Frame& F) {
    const float* const* in = F.in;
    for (int idx = F.vcu * NTHREADS + F.tid; idx < 8192; idx += F.G * NTHREADS) {
        const int pp = idx & 63, g = (idx >> 6) & 15, dir = (idx >> 10) & 1, l = idx >> 11;
        const float are = in[20][idx], aim = in[21][idx];
        const float dt = __expf(in[22][(l * 2 + dir) * 16 + g]);
        const float zr = are * dt, zi = aim * dt;
        const float e = expf(zr); float rev = zi * 0.15915494309189535f; rev -= rintf(rev);
        const float ar = e * cosf(rev * 6.283185307179586f), ai = e * sinf(rev * 6.283185307179586f);
        float* abar = (float*)(F.ws + OFF_TAB + TAB_ABAR);
        abar[idx * 2] = ar; abar[idx * 2 + 1] = ai;
        const float xr = ar - 1.f, xi = ai, den = are * are + aim * aim;
        const float fr = (xr * are + xi * aim) / den, fi = (xi * are - xr * aim) / den;
        for (int c = 0; c < 16; ++c) {
            const float br = in[23][((l * 16 + g) * 64 + pp) * 16 + c], bi = in[24][((l * 16 + g) * 64 + pp) * 16 + c];
            bf16_t* bbt = (bf16_t*)(F.ws + OFF_TAB + TAB_BBT) + ((size_t)(((l * 2 + dir) * 16 + g) * 2) * 64 + pp) * 16 + c;
            bbt[0] = f2bf(fr * br - fi * bi); bbt[64 * 16] = f2bf(fr * bi + fi * br);
        }
    }
    for (int i = F.vcu * NTHREADS + F.tid; i < 4 * 16 * 16 * 128; i += F.G * NTHREADS) {
        const int k = i & 127, c = (i >> 7) & 15, g = (i >> 11) & 15, l = i >> 15, ri = k >> 6, pp = k & 63;
        const size_t si = ((size_t)(l * 16 + g) * 16 + c) * 64 + pp;
        ((bf16_t*)(F.ws + OFF_TAB + TAB_CC1))[i] = f2bf(ri ? -in[26][si] : in[25][si]);
    }
    constexpr int I_IN = 16 * (PNP / 64), I_OUT = 16 * 16, I_F1 = 16 * (DFF / 64), I_F2 = (DFF / 64) * 16, I_GLU = 4 * 4, I_L = I_IN + I_OUT + I_F1 + I_F2 + I_GLU, N_TR = DEPTH * I_L;
    constexpr int N_UNITS = 96 + (N_TR + 7) / 8;
    unsigned* ctr = F.ctl + CW_Q + 64 * 63;
    for (;;) {
        const int u = queue_next(F, ctr); if (u >= N_UNITS) break;
        if (u < 96) {
            LAS float* ssil = (LAS float*)F.lds;
            LAS float* part = (LAS float*)(F.lds + 9 * 1024 * 4);
            for (int i = F.tid; i < 9 * 1024; i += NTHREADS) { const int r = i >> 10, k = i & 1023; const float v = r == 0 ? in[8][k] : in[7][(r - 1) * 1024 + k]; ssil[i] = silu_f(v); }
            __syncthreads();
            const int l = u / 24, n0 = (u % 24) * 256;
            const float* w = in[9] + (size_t)l * 1024 * 6144 + n0 + 4 * F.lane;
            f32x4 acc[9];
#pragma unroll
            for (int r = 0; r < 9; ++r) acc[r] = (f32x4){0.f, 0.f, 0.f, 0.f};
            const int kb = F.wave * 128;
            for (int k = 0; k < 128; k += 4) {
                f32x4 wv[4];
#pragma unroll
                for (int e = 0; e < 4; ++e) wv[e] = *(const f32x4*)(w + (size_t)(kb + k + e) * 6144);
#pragma unroll
                for (int r = 0; r < 9; ++r) { const f32x4 sv = *(LAS const f32x4*)(ssil + r * 1024 + kb + k);
                    acc[r] += wv[0] * sv[0]; acc[r] += wv[1] * sv[1]; acc[r] += wv[2] * sv[2]; acc[r] += wv[3] * sv[3]; }
            }
#pragma unroll
            for (int r = 0; r < 9; ++r) *(LAS f32x4*)(part + (F.wave * 9 + r) * 256 + 4 * F.lane) = acc[r];
            __syncthreads();
            float* mods = (float*)(F.ws + OFF_MODS);
            for (int i = F.tid; i < 9 * 256; i += NTHREADS) { const int r = i >> 8, jn = i & 255; float sacc = in[10][l * 6144 + n0 + jn];
#pragma unroll
                for (int w8 = 0; w8 < 8; ++w8) sacc += part[(w8 * 9 + r) * 256 + jn];
                mods[(size_t)(l * 9 + r) * 6144 + n0 + jn] = sacc; }
        } else {
            const int it = (u - 96) * 8 + F.wave;
            if (it < N_TR) {
                LAS unsigned char* scr = F.lds + F.wave * (64 * TR_P);
                const int l = it / I_L; int r = it % I_L;
                if (r < I_IN) { const int nb = r % (PNP / 64), kb = r / (PNP / 64), n0 = nb * 64; const int src = n0 > PN ? -1 : (n0 == PN ? 1024 : (n0 >= 1024 ? n0 + 12 : n0));
                    transpose_item(in[13] + (size_t)l * 1024 * IN_COLS, 1024, IN_COLS, src, (bf16_t*)(F.ws + OFF_WIN) + (size_t)l * PNP * 1024, n0, kb * 64, scr, F.lane, n0 == PN ? 12 : 64); }
                else if ((r -= I_IN) < I_OUT) { const int nb = r % 16, kb = r / 16; transpose_item(in[31] + (size_t)l * 1024 * 1024, 1024, 1024, nb * 64, (bf16_t*)(F.ws + OFF_WOUT) + (size_t)l * 1024 * 1024, nb * 64, kb * 64, scr, F.lane); }
                else if ((r -= I_OUT) < I_F1) { const int nb = r % (DFF / 64), kb = r / (DFF / 64); transpose_item(in[32] + (size_t)l * 1024 * DFF, 1024, DFF, nb * 64, (bf16_t*)(F.ws + OFF_WFF1) + (size_t)l * DFF * 1024, nb * 64, kb * 64, scr, F.lane); }
                else if ((r -= I_F1) < I_F2) { const int nb = r % 16, kb = r / 16; transpose_item(in[33] + (size_t)l * DFF * 1024, DFF, 1024, nb * 64, (bf16_t*)(F.ws + OFF_WFF2) + (size_t)l * 1024 * DFF, nb * 64, kb * 64, scr, F.lane); }
                else { r -= I_F2; const int nb = r % 4, kb = r / 4; transpose_item(in[28] + (size_t)l * 65536, 256, 256, nb * 64, (bf16_t*)(F.ws + OFF_WGLU) + (size_t)l * 65536, nb * 64, kb * 64, scr, F.lane); }
            }
        }
    }
}
__device__ __forceinline__ void phase_pre(Frame& F) {
    const float* const* in = F.in; const int lane = F.lane;
    for (int row = F.vcu * NWAVES + F.wave; row < M; row += F.G * NWAVES) {
        const float* xr = row < MC ? in[0] + (size_t)row * D : in[1] + (size_t)(row - MC) * D;
        const float* sc = (const float*)(F.ws + OFF_MODS) + (size_t)mod_row(row) * 6144 + 1024; const float* gw = in[11];
        bf16_t* h = (bf16_t*)(F.ws + OFF_H) + (size_t)row * D;
        float s = 0.f;
#pragma unroll
        for (int j = 0; j < 4; ++j) { const int c = 4 * lane + 256 * j; const f32x4 v = *(const f32x4*)(xr + c), g = *(const f32x4*)(gw + c), a = *(const f32x4*)(sc + c);
            s += v.x * v.x + v.y * v.y + v.z * v.z + v.w * v.w;
            uint2 o; o.x = pk2(v.x * g.x * (1.f + a.x), v.y * g.y * (1.f + a.y)); o.y = pk2(v.z * g.z * (1.f + a.z), v.w * g.w * (1.f + a.w)); *(uint2*)(h + c) = o; }
        s = wave_sum(s);
        if (lane < 16) ((float*)(F.ws + OFF_TAB + TAB_SQ1))[(size_t)row * 16 + lane] = lane == 0 ? s : 0.f;
    }
    const int fr = lane & 15, fq = lane >> 4, w = F.wave;
    LAS float* red = (LAS float*)F.lds;
    for (int task = F.vcu; task < DEPTH * 104; task += F.G) {
        const int l = task / 104, t = task % 104, which = t >= 40, n0 = (which ? t - 40 : t) * 64;
        const float* mods = (const float*)(F.ws + OFF_MODS) + (size_t)l * 9 * 6144 + (which ? 3 : 0) * 1024;
        const bf16_t* wt = which ? (const bf16_t*)(F.ws + OFF_WFF1) + (size_t)l * DFF * 1024 : (const bf16_t*)(F.ws + OFF_WIN) + (size_t)l * PNP * 1024;
        float* bo = (float*)(F.ws + OFF_TAB + (which ? TAB_B2 : TAB_B1)) + (size_t)l * 9 * (which ? DFF : PNP);
        f32x4 acc[4];
#pragma unroll
        for (int nb = 0; nb < 4; ++nb) acc[nb] = (f32x4){0.f, 0.f, 0.f, 0.f};
#pragma unroll
        for (int ks = 0; ks < 4; ++ks) {
            const int k0 = 128 * w + 32 * ks + 8 * fq;
            union { bf16x8 v; unsigned u[4]; } af; af.u[0] = af.u[1] = af.u[2] = af.u[3] = 0u;
            if (fr < 9) { const f32x4 a0 = *(const f32x4*)(mods + (size_t)fr * 6144 + k0), a1 = *(const f32x4*)(mods + (size_t)fr * 6144 + k0 + 4);
                af.u[0] = pk2(a0[0], a0[1]); af.u[1] = pk2(a0[2], a0[3]); af.u[2] = pk2(a1[0], a1[1]); af.u[3] = pk2(a1[2], a1[3]); }
#pragma unroll
            for (int nb = 0; nb < 4; ++nb) { const bf16x8 bfr = *(const bf16x8*)(wt + (size_t)(n0 + 16 * nb + fr) * 1024 + k0); acc[nb] = __builtin_amdgcn_mfma_f32_16x16x32_bf16(af.v, bfr, acc[nb], 0, 0, 0); }
        }
        __syncthreads();
#pragma unroll
        for (int nb = 0; nb < 4; ++nb) *(LAS f32x4*)(red + ((w * 4 + nb) * 64 + lane) * 4) = acc[nb];
        __syncthreads();
        for (int i = F.tid; i < 1024; i += NTHREADS) { float sacc = 0.f;
#pragma unroll
            for (int w8 = 0; w8 < 8; ++w8) sacc += red[w8 * 1024 + i];
            const int nb = i >> 8, ln = (i >> 2) & 63, e = i & 3, r = 4 * (ln >> 4) + e;
            if (r < 9) bo[(size_t)r * (which ? DFF : PNP) + n0 + 16 * nb + (ln & 15)] = sacc; }
    }
}
constexpr int EPI_SIDE_OFF = RING_BYTES;
template <class Sched>
__device__ __forceinline__ void epi_side_fill(Frame& F, const Sched& S, const float* ssq, const float* bias, int ldb) {
    LAS float* side = (LAS float*)(F.lds + EPI_SIDE_OFF);
    pg8::Unit u;
    for (int i = 0; i < 4 && S.next(i, u); ++i) {
        if (F.tid < 256) { const f32x4* p = (const f32x4*)(ssq + (size_t)(u.pm * 256 + F.tid) * 16); const f32x4 a = p[0], b = p[1], c = p[2], d = p[3];
            const float sm = ((a[0] + a[1]) + (a[2] + a[3])) + ((b[0] + b[1]) + (b[2] + b[3])) + ((c[0] + c[1]) + (c[2] + c[3])) + ((d[0] + d[1]) + (d[2] + d[3]));
            side[i * 256 + F.tid] = rsqrtf(sm * (1.f / 1024.f) + EPS); }
        else { const int r = u.pm < 32 ? 0 : 1 + ((u.pm - 32) >> 2); side[1024 + i * 256 + F.tid - 256] = bias[(size_t)r * ldb + u.pn * 256 + F.tid - 256]; }
    }
    __syncthreads();
}
__device__ __forceinline__ void phase_final(Frame& F) {
    const int lane = F.lane; const float* gw = F.in[34];
    for (int row = F.vcu * NWAVES + F.wave; row < M; row += F.G * NWAVES) {
        const bf16_t* xr = (const bf16_t*)(F.ws + OFF_X) + (size_t)row * D;
        f32x4 v[4]; float s = 0.f;
#pragma unroll
        for (int j = 0; j < 4; ++j) { const uint2 q = *(const uint2*)(xr + 4 * lane + 256 * j); v[j] = (f32x4){__uint_as_float(q.x << 16), __uint_as_float(q.x & 0xffff0000u), __uint_as_float(q.y << 16), __uint_as_float(q.y & 0xffff0000u)};
            s += v[j].x * v[j].x + v[j].y * v[j].y + v[j].z * v[j].z + v[j].w * v[j].w; }
        const float rstd = rsqrtf(wave_sum(s) * (1.f / D) + EPS);
        float* o = F.out + (size_t)row * D;
#pragma unroll
        for (int j = 0; j < 4; ++j) { const int c = 4 * lane + 256 * j; const f32x4 g = *(const f32x4*)(gw + c); f32x4 r = {v[j].x * rstd * g.x, v[j].y * rstd * g.y, v[j].z * rstd * g.z, v[j].w * rstd * g.w}; *(f32x4*)(o + c) = r; }
    }
}


typedef short v4i16_t __attribute__((ext_vector_type(4)));
constexpr int AT_KP = 160;
constexpr int AT_TILE = 128 * AT_KP;
constexpr int AT_K0 = 0, AT_V0 = 2 * AT_TILE, AT_RPB = 4 * AT_TILE, AT_END = AT_RPB + 2048;
__device__ __forceinline__ int queue_next(Frame& F, unsigned* ctr) {
    __syncthreads();
    if (F.tid == 0) F.MISC[16] = atomicAdd(ctr, 1u);
    __syncthreads();
    { int t_ = F.tid; asm volatile("" : "+v"(t_)); F.tid = t_; F.lane = t_ & 63; }
    return (int)F.MISC[16];
}
__device__ __forceinline__ bf16x8 tr2(LAS const unsigned char* a, LAS const unsigned char* b) {
    const v4i16_t x = __builtin_amdgcn_ds_read_tr16_b64_v4i16((LAS v4i16_t*)a), y = __builtin_amdgcn_ds_read_tr16_b64_v4i16((LAS v4i16_t*)b);
    return (bf16x8){x[0], x[1], x[2], x[3], y[0], y[1], y[2], y[3]};
}
struct AttnState { f32x4 o[4]; float m, l; };
template <int NKB, bool MASKED>
__device__ __forceinline__ void attn_tile(AttnState& st, LAS const unsigned char* Kt, LAS const unsigned char* Vt, const bf16x8 (&qf)[2], int c0, int lane,
                                          LAS const float* rpbrow, const int (&dk)[2][4]) {
    const int fr = lane & 15, fq = lane >> 4;
    f32x4 s[NKB];
#pragma unroll
    for (int kb = 0; kb < NKB; ++kb) {
        s[kb] = (f32x4){0.f, 0.f, 0.f, 0.f};
#pragma unroll
        for (int ks = 0; ks < 2; ++ks) {
            const bf16x8 a = *(LAS const bf16x8*)(Kt + (c0 + 16 * kb + fr) * AT_KP + (32 * ks + 8 * fq) * 2);
            s[kb] = __builtin_amdgcn_mfma_f32_16x16x32_bf16(a, qf[ks], s[kb], 0, 0, 0);
        }
    }
    float mloc = -1e30f;
#pragma unroll
    for (int kb = 0; kb < NKB; ++kb)
#pragma unroll
        for (int i = 0; i < 4; ++i) {
            float t = s[kb][i] * 0.125f;
            if (MASKED) { const int d = dk[kb & 1][i]; t = d >= 0 ? t + rpbrow[d] : -1e30f; }
            s[kb][i] = t; mloc = fmaxf(mloc, t);
        }
    mloc = xmax32(xmax16(mloc));
    const float mn = fmaxf(st.m, mloc), alpha = __expf(st.m - mn);
    st.m = mn;
    float ls = 0.f;
#pragma unroll
    for (int kb = 0; kb < NKB; ++kb)
#pragma unroll
        for (int i = 0; i < 4; ++i) { const float pv = __expf(s[kb][i] - mn); s[kb][i] = pv; ls += pv; }
    st.l = st.l * alpha + ls;
#pragma unroll
    for (int db = 0; db < 4; ++db) st.o[db] = st.o[db] * alpha;
#pragma unroll
    for (int kk = 0; kk < NKB / 2; ++kk) {
        union { bf16x8 v; unsigned u[4]; } pf;
        pf.u[0] = pk2(s[2 * kk][0], s[2 * kk][1]); pf.u[1] = pk2(s[2 * kk][2], s[2 * kk][3]);
        pf.u[2] = pk2(s[2 * kk + 1][0], s[2 * kk + 1][1]); pf.u[3] = pk2(s[2 * kk + 1][2], s[2 * kk + 1][3]);
        LAS const unsigned char* va = Vt + (c0 + 32 * kk + 4 * fq + (fr >> 2)) * AT_KP + (4 * (fr & 3)) * 2;
#pragma unroll
        for (int db = 0; db < 4; ++db) {
            const bf16x8 vf = tr2(va + db * 32, va + 16 * AT_KP + db * 32);
            st.o[db] = __builtin_amdgcn_mfma_f32_16x16x32_bf16(vf, pf.v, st.o[db], 0, 0, 0);
        }
    }
}
__device__ __forceinline__ void attn_unit(Frame& F, int l, int unit) {
    const int tid = F.tid, lane = F.lane, w = F.wave, fr = lane & 15, fq = lane >> 4;
    const bf16_t* proj = (const bf16_t*)(F.ws + OFF_PROJ);
    LAS unsigned char* lds = F.lds;
    const bool nat = unit < 384;
    int b, h, qrow, r = 0, rs_w = 0, rs0 = 0, nlat = 0, c0 = 0;
    if (nat) { b = unit / 48; h = (unit / 8) % 6; const int rp = unit % 8; r = 2 * rp + (w >> 2); const int j = w & 3;
        qrow = MC + b * 1024 + r * 64 + 16 * j + fr;
        rs_w = min(max(r - 4, 0), 8); rs0 = min(max(2 * rp - 4, 0), 8); const int rs1 = min(max(2 * rp + 1 - 4, 0), 8); nlat = rs1 + 8 - rs0;
        c0 = j == 0 ? 0 : (j == 1 ? 8 : (j == 2 ? 24 : 32));
    } else { const int u = unit - 384; b = u / 12; h = (u / 2) % 6; const int qb = u % 2; qrow = b * 256 + qb * 128 + 16 * w + fr; }
    const int nlt = (nlat + 1) >> 1;
    const int ntiles = nat ? nlt + 2 : 2;
    bf16x8 qf[2];
#pragma unroll
    for (int ks = 0; ks < 2; ++ks) qf[ks] = *(const bf16x8*)(proj + (size_t)qrow * PN + PQ + h * 64 + 32 * ks + 8 * fq);
    int dk[2][4];
    if (nat) {
        const int qc = (qrow - MC) & 63; const int cs = min(max(qc - 8, 0), 48);
#pragma unroll
        for (int kb = 0; kb < 2; ++kb)
#pragma unroll
            for (int i = 0; i < 4; ++i) { const int kc = c0 + 16 * kb + 4 * fq + i; dk[kb][i] = (kc >= cs && kc < cs + 16) ? kc - qc + 15 : -1; }
        const float* rpb = F.in[30] + (size_t)(l * 6 + h) * 465;
        for (int i = tid; i < 465; i += NTHREADS) ((LAS float*)(lds + AT_RPB))[i] = rpb[i];
    } else {
#pragma unroll
        for (int kb = 0; kb < 2; ++kb)
#pragma unroll
            for (int i = 0; i < 4; ++i) dk[kb][i] = 0;
    }
    AttnState st; st.m = -1e30f; st.l = 0.f;
#pragma unroll
    for (int db = 0; db < 4; ++db) st.o[db] = (f32x4){0.f, 0.f, 0.f, 0.f};
    const int skey = tid >> 2, sch = (tid & 3) * 2;
    v4u rk[2] = {{0u, 0u, 0u, 0u}, {0u, 0u, 0u, 0u}}, rv[2] = {{0u, 0u, 0u, 0u}, {0u, 0u, 0u, 0u}}; f32x4 fk[4], fv[4]; bool isf = false;
#pragma unroll
    for (int e = 0; e < 4; ++e) { fk[e] = (f32x4){0.f, 0.f, 0.f, 0.f}; fv[e] = fk[e]; }
#define AT_LOAD(ti_) do { const int ti__ = (ti_); \
        if (nat && ti__ >= nlt) { isf = true; const size_t off = ((size_t)(b * 4 + l) * 256 + (ti__ - nlt) * 128 + skey) * 384 + h * 64 + sch * 8; \
            _Pragma("unroll") for (int e = 0; e < 4; ++e) { fk[e] = *(const f32x4*)(F.in[2] + off + 4 * e); fv[e] = *(const f32x4*)(F.in[3] + off + 4 * e); } \
        } else { isf = false; const int grow = nat ? MC + b * 1024 + min(rs0 + 2 * ti__ + (skey >> 6), 15) * 64 + (skey & 63) : b * 256 + ti__ * 128 + skey; \
            const bf16_t* pr = proj + (size_t)grow * PN + h * 64 + sch * 8; rk[0] = *(const v4u*)(pr + PK); rk[1] = *(const v4u*)(pr + PK + 8); rv[0] = *(const v4u*)(pr + PV); rv[1] = *(const v4u*)(pr + PV + 8); } } while (0)
#define AT_WRITE(buf_) do { const int buf__ = (buf_); \
        if (isf) { _Pragma("unroll") for (int e = 0; e < 2; ++e) { rk[e].x = pk2(fk[2 * e][0], fk[2 * e][1]); rk[e].y = pk2(fk[2 * e][2], fk[2 * e][3]); rk[e].z = pk2(fk[2 * e + 1][0], fk[2 * e + 1][1]); rk[e].w = pk2(fk[2 * e + 1][2], fk[2 * e + 1][3]); \
                   rv[e].x = pk2(fv[2 * e][0], fv[2 * e][1]); rv[e].y = pk2(fv[2 * e][2], fv[2 * e][3]); rv[e].z = pk2(fv[2 * e + 1][0], fv[2 * e + 1][1]); rv[e].w = pk2(fv[2 * e + 1][2], fv[2 * e + 1][3]); } } \
        *(LAS v4u*)(lds + AT_K0 + buf__ * AT_TILE + skey * AT_KP + sch * 16) = rk[0]; *(LAS v4u*)(lds + AT_K0 + buf__ * AT_TILE + skey * AT_KP + sch * 16 + 16) = rk[1]; \
        *(LAS v4u*)(lds + AT_V0 + buf__ * AT_TILE + skey * AT_KP + sch * 16) = rv[0]; *(LAS v4u*)(lds + AT_V0 + buf__ * AT_TILE + skey * AT_KP + sch * 16 + 16) = rv[1]; } while (0)
    AT_LOAD(0); AT_WRITE(0);
    __syncthreads();
    for (int ti = 0; ti < ntiles; ++ti) {
        const int buf = ti & 1;
        if (ti + 1 < ntiles) AT_LOAD(ti + 1);
        LAS const unsigned char* Kt = lds + AT_K0 + buf * AT_TILE; LAS const unsigned char* Vt = lds + AT_V0 + buf * AT_TILE;
        if (nat && ti < nlt) {
#pragma unroll
            for (int sub = 0; sub < 2; ++sub) { const int kr = rs0 + 2 * ti + sub;
                if (kr >= rs_w && kr < rs_w + 8) attn_tile<2, true>(st, Kt, Vt, qf, 64 * sub + c0, lane, (LAS const float*)(lds + AT_RPB) + (kr - r + 7) * 31, dk); }
        } else attn_tile<8, false>(st, Kt, Vt, qf, 0, lane, (LAS const float*)(lds + AT_RPB), dk);
        if (ti + 1 < ntiles) AT_WRITE(buf ^ 1);
        __syncthreads();
    }
    const float lt = xsum32(xsum16(st.l));
    const float inv = 1.f / lt;
    bf16_t* mix = (bf16_t*)(F.ws + OFF_MIX) + (size_t)qrow * D + 640 + h * 64 + 4 * fq;
#pragma unroll
    for (int db = 0; db < 4; ++db) { uint2 o; o.x = pk2(st.o[db][0] * inv, st.o[db][1] * inv); o.y = pk2(st.o[db][2] * inv, st.o[db][3] * inv); *(uint2*)(mix + 16 * db) = o; }
}
__device__ __forceinline__ void phase_attn(Frame& F, int l, unsigned* ctr) {
    for (;;) { const int u = queue_next(F, ctr); if (u >= 768) break; attn_unit(F, l, u); }
}

constexpr int SS_P = 144;
constexpr int SS_IMG = 128 * SS_P;
constexpr int SS_HP = 144, SS_HIMG = 64 * SS_HP;
constexpr int SSA_B = 0, SSA_X = SS_IMG, SSA_TAB = 7 * SS_IMG;
constexpr int SSB_B = 0, SSB_C = SS_IMG, SSB_X = 2 * SS_IMG, SSB_H = 5 * SS_IMG, SSB_TAB = 5 * SS_IMG + 6 * SS_HIMG;
static_assert(SSB_TAB + 3 * 4 * 128 * 4 <= 163328 && SSA_TAB + 3 * 4 * 128 * 4 <= 163328, "SSD LDS map");
__device__ __forceinline__ void conv16(const bf16_t* proj, const float* cw, const float* cb, int seq_start, int seq_L, int t, int ch0, float (&v)[16]) {
#pragma unroll
    for (int e = 0; e < 16; e += 4) { const f32x4 b = *(const f32x4*)(cb + ch0 + e); v[e] = b[0]; v[e + 1] = b[1]; v[e + 2] = b[2]; v[e + 3] = b[3]; }
#pragma unroll
    for (int j = 0; j < 5; ++j) {
        const int tt = t + j - 2;
        if (tt >= 0 && tt < seq_L) {
            const bf16_t* src = proj + (size_t)(seq_start + tt) * PN + PX + ch0;
            const v4u r0 = *(const v4u*)src, r1 = *(const v4u*)(src + 8);
            const unsigned rr[8] = {r0[0], r0[1], r0[2], r0[3], r1[0], r1[1], r1[2], r1[3]};
#pragma unroll
            for (int e = 0; e < 16; e += 4) { const f32x4 w = *(const f32x4*)(cw + j * 640 + ch0 + e);
                v[e] += w[0] * __uint_as_float(rr[e / 2] << 16); v[e + 1] += w[1] * __uint_as_float(rr[e / 2] & 0xffff0000u);
                v[e + 2] += w[2] * __uint_as_float(rr[e / 2 + 1] << 16); v[e + 3] += w[3] * __uint_as_float(rr[e / 2 + 1] & 0xffff0000u); }
        }
    }
#pragma unroll
    for (int e = 0; e < 16; ++e) v[e] = silu_f(v[e]);
}
__device__ __forceinline__ void store16(LAS unsigned char* dst, const float (&v)[16], float sc) {
    v4u o0, o1;
    o0[0] = pk2(v[0] * sc, v[1] * sc); o0[1] = pk2(v[2] * sc, v[3] * sc); o0[2] = pk2(v[4] * sc, v[5] * sc); o0[3] = pk2(v[6] * sc, v[7] * sc);
    o1[0] = pk2(v[8] * sc, v[9] * sc); o1[1] = pk2(v[10] * sc, v[11] * sc); o1[2] = pk2(v[12] * sc, v[13] * sc); o1[3] = pk2(v[14] * sc, v[15] * sc);
    *(LAS v4u*)dst = o0; *(LAS v4u*)(dst + 16) = o1;
}
__device__ __forceinline__ void ssd_table(const float* dtraw  , float bias, float a, int dir, LAS float* tab, int lane) {
    const float d0 = softplus_f(dtraw[(2 * lane) * 12] + bias), d1 = softplus_f(dtraw[(2 * lane + 1) * 12] + bias);
    const float ps = d0 + d1; float x = ps;
    x += dppf<0x111>(x); x += dppf<0x112>(x); x += dppf<0x114>(x); x += dppf<0x118>(x);
    { const float t15 = rdlane(x, 15), t31 = rdlane(x, 31), t47 = rdlane(x, 47); const int rw = lane >> 4;
      x += (rw >= 1 ? t15 : 0.f) + (rw >= 2 ? t31 : 0.f) + (rw >= 3 ? t47 : 0.f); }
    tab[2 * lane] = d0; tab[2 * lane + 1] = d1;
    if (dir == 0) { const float ex = x - ps; tab[128 + 2 * lane] = a * (ex + d0); tab[128 + 2 * lane + 1] = a * (ex + ps); }
    else { const float tot = rdlane(x, 63); const float sx = tot - x; tab[128 + 2 * lane + 1] = a * (sx + d1); tab[128 + 2 * lane] = a * (sx + ps); }
}
__device__ __forceinline__ void ssd_a_unit(Frame& F, int l, int unit) {
    const int tid = F.tid, lane = F.lane, w = F.wave, fr = lane & 15, fq = lane >> 4;
    const int ci = unit >> 1, g = unit & 1, row0 = ci * 128;
    const SeqInfo q = row_seq(row0); const int t0 = row0 - q.start;
    const bf16_t* proj = (const bf16_t*)(F.ws + OFF_PROJ);
    const float* cw = F.in[14] + l * 5 * 640; const float* cb = F.in[15] + l * 640;
    LAS unsigned char* lds = F.lds; LAS float* tabs = (LAS float*)(lds + SSA_TAB);
    if (w < 6) { const int hh = w >> 1, dir = w & 1, h = 3 * g + hh;
        ssd_table((const float*)(F.ws + OFF_DT) + (size_t)row0 * 12 + dir * 6 + h, F.in[16][(l * 2 + dir) * 6 + h], -__expf(F.in[17][(l * 2 + dir) * 6 + h]), dir, tabs + (hh * 4 + dir * 2) * 128, lane); }
    const int t = tid >> 2, chq = tid & 3;
    { float v[16]; conv16(proj, cw, cb, q.start, q.L, t0 + t, 384 + g * 64 + chq * 16, v); store16(lds + SSA_B + t * SS_P + chq * 32, v, 1.f); }
    float xv[3][16];
#pragma unroll
    for (int hh = 0; hh < 3; ++hh) conv16(proj, cw, cb, q.start, q.L, t0 + t, (3 * g + hh) * 64 + chq * 16, xv[hh]);
    __syncthreads();
#pragma unroll
    for (int hh = 0; hh < 3; ++hh) { LAS const float* tb = tabs + hh * 4 * 128;
        const float wf = __expf(tb[128 + 127] - tb[128 + t]) * tb[t], wb = __expf(tb[384] - tb[384 + t]) * tb[256 + t];
        store16(lds + SSA_X + (2 * hh) * SS_IMG + t * SS_P + chq * 32, xv[hh], wf); store16(lds + SSA_X + (2 * hh + 1) * SS_IMG + t * SS_P + chq * 32, xv[hh], wb); }
    __syncthreads();
    const int dir = w >> 2, pb = w & 3;
    for (int hh = 0; hh < 3; ++hh) {
        const int h = 3 * g + hh;
        LAS const unsigned char* xa = lds + SSA_X + (2 * hh + dir) * SS_IMG + (4 * fq + (fr >> 2)) * SS_P + (16 * pb + 4 * (fr & 3)) * 2;
        LAS const unsigned char* ba = lds + SSA_B + (4 * fq + (fr >> 2)) * SS_P + (4 * (fr & 3)) * 2;
        f32x4 acc[4];
#pragma unroll
        for (int nb = 0; nb < 4; ++nb) acc[nb] = (f32x4){0.f, 0.f, 0.f, 0.f};
#pragma unroll
        for (int kk = 0; kk < 4; ++kk) {
            const bf16x8 af = tr2(xa + kk * 32 * SS_P, xa + (kk * 32 + 16) * SS_P);
#pragma unroll
            for (int nb = 0; nb < 4; ++nb) { const bf16x8 bfr = tr2(ba + kk * 32 * SS_P + nb * 32, ba + (kk * 32 + 16) * SS_P + nb * 32); acc[nb] = __builtin_amdgcn_mfma_f32_16x16x32_bf16(af, bfr, acc[nb], 0, 0, 0); }
        }
        float* cs = (float*)(F.ws + OFF_CS) + ((size_t)(ci * 6 + h) * 2 + dir) * 4096;
#pragma unroll
        for (int nb = 0; nb < 4; ++nb)
#pragma unroll
            for (int i = 0; i < 4; ++i) cs[(16 * pb + 4 * fq + i) * 64 + 16 * nb + fr] = acc[nb][i];
        if (tid == 0) { LAS const float* tb = tabs + hh * 4 * 128; float* cd = (float*)(F.ws + OFF_TAB + TAB_CD) + (size_t)(ci * 6 + h) * 2; cd[0] = __expf(tb[128 + 127]); cd[1] = __expf(tb[384]); }
    }
}
__device__ __forceinline__ void ssd_state_pass(Frame& F, int l) {
    const int tid = F.tid, p = tid >> 3, n0 = (tid & 7) * 8;
    const float* cdt = (const float*)(F.ws + OFF_TAB + TAB_CD); const float* csb = (const float*)(F.ws + OFF_CS);
    bf16_t* hin = (bf16_t*)(F.ws + OFF_HIN);
    for (int task = F.vcu; task < NSEQ * 12; task += F.G) {
        int s, hd; if (task < LB * 12) { s = CB + task / 12; hd = task % 12; } else { s = (task - LB * 12) / 12; hd = (task - LB * 12) % 12; }
        const int h = hd >> 1, dir = hd & 1;
        const SeqInfo q = seq_info(s); const int nch = q.L >> 7, ci0 = q.start >> 7;
        f32x4 s0 = {0.f, 0.f, 0.f, 0.f}, s1 = s0;
        if (!q.ctx) { const float* h0 = F.in[4] + ((((size_t)q.b * 4 + l) * 2 + dir) * 6 + h) * 4096 + p * 64 + n0; s0 = *(const f32x4*)h0; s1 = *(const f32x4*)(h0 + 4); }
        for (int k = 0; k < nch; ++k) {
            const int c = dir == 0 ? k : nch - 1 - k; const size_t ix = (size_t)((ci0 + c) * 6 + h) * 2 + dir;
            v4u o; o[0] = pk2(s0[0], s0[1]); o[1] = pk2(s0[2], s0[3]); o[2] = pk2(s1[0], s1[1]); o[3] = pk2(s1[2], s1[3]);
            *(v4u*)(hin + ix * 4096 + p * 64 + n0) = o;
            const float dcy = cdt[ix]; const float* cs = csb + ix * 4096 + p * 64 + n0;
            s0 = s0 * dcy + *(const f32x4*)cs; s1 = s1 * dcy + *(const f32x4*)(cs + 4);
        }
        if (q.ctx) { float* o4 = F.out + O_SSD + ((((size_t)q.b * 4 + l) * 2 + dir) * 6 + h) * 4096 + p * 64 + n0; *(f32x4*)o4 = s0; *(f32x4*)(o4 + 4) = s1; }
    }
}
__device__ __forceinline__ void ssd_b_unit(Frame& F, int l, int unit) {
    const int tid = F.tid, lane = F.lane, w = F.wave, fr = lane & 15, fq = lane >> 4;
    const int ci = unit >> 1, g = unit & 1, row0 = ci * 128;
    const SeqInfo q = row_seq(row0); const int t0 = row0 - q.start;
    const bf16_t* proj = (const bf16_t*)(F.ws + OFF_PROJ);
    const float* cw = F.in[14] + l * 5 * 640; const float* cb = F.in[15] + l * 640;
    LAS unsigned char* lds = F.lds; LAS float* tabs = (LAS float*)(lds + SSB_TAB);
    if (w < 6) { const int hh = w >> 1, dir = w & 1, h = 3 * g + hh;
        ssd_table((const float*)(F.ws + OFF_DT) + (size_t)row0 * 12 + dir * 6 + h, F.in[16][(l * 2 + dir) * 6 + h], -__expf(F.in[17][(l * 2 + dir) * 6 + h]), dir, tabs + (hh * 4 + dir * 2) * 128, lane); }
    {
        const bf16_t* hin = (const bf16_t*)(F.ws + OFF_HIN) + (size_t)((ci * 6 + 3 * g) * 2) * 4096 + (tid >> 3) * 64 + (tid & 7) * 8;
#pragma unroll
        for (int k = 0; k < 6; ++k) *(LAS v4u*)(lds + SSB_H + k * SS_HIMG + (tid >> 3) * SS_HP + (tid & 7) * 16) = *(const v4u*)(hin + (size_t)k * 4096);
    }
    { const int t = tid >> 2, chq = tid & 3; float v[16];
      conv16(proj, cw, cb, q.start, q.L, t0 + t, 384 + g * 64 + chq * 16, v); store16(lds + SSB_B + t * SS_P + chq * 32, v, 1.f);
      conv16(proj, cw, cb, q.start, q.L, t0 + t, 512 + g * 64 + chq * 16, v); store16(lds + SSB_C + t * SS_P + chq * 32, v, 1.f);
#pragma unroll
      for (int hh = 0; hh < 3; ++hh) { conv16(proj, cw, cb, q.start, q.L, t0 + t, (3 * g + hh) * 64 + chq * 16, v); store16(lds + SSB_X + hh * SS_IMG + t * SS_P + chq * 32, v, 1.f); } }
    __syncthreads();
    bf16x8 cf[2];
#pragma unroll
    for (int ks = 0; ks < 2; ++ks) cf[ks] = *(LAS const bf16x8*)(lds + SSB_C + (16 * w + fr) * SS_P + (32 * ks + 8 * fq) * 2);
    f32x4 gt[8];
#pragma unroll
    for (int sb = 0; sb < 8; ++sb) { gt[sb] = (f32x4){0.f, 0.f, 0.f, 0.f};
#pragma unroll
        for (int ks = 0; ks < 2; ++ks) { const bf16x8 bfr = *(LAS const bf16x8*)(lds + SSB_B + (16 * sb + fr) * SS_P + (32 * ks + 8 * fq) * 2); gt[sb] = __builtin_amdgcn_mfma_f32_16x16x32_bf16(bfr, cf[ks], gt[sb], 0, 0, 0); } }
    float ss[4] = {0.f, 0.f, 0.f, 0.f};
    bf16_t* yup = (bf16_t*)(F.ws + OFF_MIX) + (size_t)(row0 + 16 * w + 4 * fq) * D + fr;
    for (int hh = 0; hh < 3; ++hh) {
        const int h = 3 * g + hh;
        LAS const float* tb = tabs + hh * 4 * 128;
        unsigned short zv[4][4];
#pragma unroll
        for (int i = 0; i < 4; ++i)
#pragma unroll
            for (int pb = 0; pb < 4; ++pb) zv[i][pb] = proj[(size_t)(row0 + 16 * w + 4 * fq + i) * PN + PZ + h * 64 + 16 * pb + fr];
        const float at = tb[128 + 16 * w + fr], bt = tb[384 + 16 * w + fr];
        f32x4 y[4];
#pragma unroll
        for (int pb = 0; pb < 4; ++pb) y[pb] = (f32x4){0.f, 0.f, 0.f, 0.f};
        LAS const unsigned char* xa = lds + SSB_X + hh * SS_IMG + (4 * fq + (fr >> 2)) * SS_P + (4 * (fr & 3)) * 2;
#pragma unroll
        for (int kk = 0; kk < 4; ++kk) {
            float mv[8];
#pragma unroll
            for (int half = 0; half < 2; ++half) { const int sb = 2 * kk + half; const int s0i = 16 * sb + 4 * fq;
                const f32x4 cumf = *(LAS const f32x4*)(tb + 128 + s0i), dtf = *(LAS const f32x4*)(tb + s0i), cumb = *(LAS const f32x4*)(tb + 384 + s0i), dtb = *(LAS const f32x4*)(tb + 256 + s0i);
#pragma unroll
                for (int i = 0; i < 4; ++i) { const int s = s0i + i, t = 16 * w + fr; float m = 0.f;
                    if (s <= t) m += __expf(at - cumf[i]) * dtf[i];
                    if (s >= t) m += __expf(bt - cumb[i]) * dtb[i];
                    mv[half * 4 + i] = m * gt[sb][i]; } }
            union { bf16x8 v; unsigned u[4]; } mf; mf.u[0] = pk2(mv[0], mv[1]); mf.u[1] = pk2(mv[2], mv[3]); mf.u[2] = pk2(mv[4], mv[5]); mf.u[3] = pk2(mv[6], mv[7]);
#pragma unroll
            for (int pb = 0; pb < 4; ++pb) { const bf16x8 xf = tr2(xa + kk * 32 * SS_P + pb * 32, xa + (kk * 32 + 16) * SS_P + pb * 32); y[pb] = __builtin_amdgcn_mfma_f32_16x16x32_bf16(mf.v, xf, y[pb], 0, 0, 0); }
        }
        f32x4 yf[4], yb[4];
#pragma unroll
        for (int pb = 0; pb < 4; ++pb) { yf[pb] = (f32x4){0.f, 0.f, 0.f, 0.f}; yb[pb] = yf[pb];
#pragma unroll
            for (int ks = 0; ks < 2; ++ks) {
                const bf16x8 hf = *(LAS const bf16x8*)(lds + SSB_H + (2 * hh) * SS_HIMG + (16 * pb + fr) * SS_HP + (32 * ks + 8 * fq) * 2);
                const bf16x8 hb = *(LAS const bf16x8*)(lds + SSB_H + (2 * hh + 1) * SS_HIMG + (16 * pb + fr) * SS_HP + (32 * ks + 8 * fq) * 2);
                yf[pb] = __builtin_amdgcn_mfma_f32_16x16x32_bf16(cf[ks], hf, yf[pb], 0, 0, 0);
                yb[pb] = __builtin_amdgcn_mfma_f32_16x16x32_bf16(cf[ks], hb, yb[pb], 0, 0, 0); } }
        const float dsk = F.in[18][l * 6 + h];
        float nwv[4];
#pragma unroll
        for (int pb = 0; pb < 4; ++pb) nwv[pb] = F.in[19][l * 384 + h * 64 + 16 * pb + fr];
        const f32x4 cumf4 = *(LAS const f32x4*)(tb + 128 + 16 * w + 4 * fq), cumb4 = *(LAS const f32x4*)(tb + 384 + 16 * w + 4 * fq);
#pragma unroll
        for (int i = 0; i < 4; ++i) { const float ef = __expf(cumf4[i]), eb = __expf(cumb4[i]); const int tl = 16 * w + 4 * fq + i;
#pragma unroll
            for (int pb = 0; pb < 4; ++pb) { const float xv = bf2f(*(LAS const bf16_t*)(lds + SSB_X + hh * SS_IMG + tl * SS_P + (16 * pb + fr) * 2));
                const float yv = y[pb][i] + ef * yf[pb][i] + eb * yb[pb][i] + dsk * xv;
                const float gv = yv * silu_f(bf2f(zv[i][pb])); ss[i] += gv * gv;
                yup[(size_t)i * D + h * 64 + 16 * pb] = f2bf(gv * nwv[pb]); } }
    }
#pragma unroll
    for (int i = 0; i < 4; ++i) { const float v = row16_sum(ss[i]);
        if (fr == 0) ((float*)(F.ws + OFF_TAB + TAB_SSQ))[(size_t)(row0 + 16 * w + 4 * fq + i) * 2 + g] = v; }
}
__device__ __forceinline__ void ssd_norm_panel(Frame& F, int l, int pm) {
    const float* nw = F.in[19] + l * 384; const float* ssq = (const float*)(F.ws + OFF_TAB + TAB_SSQ);
    const bf16_t* yu = (const bf16_t*)(F.ws + OFF_YU); bf16_t* mix = (bf16_t*)(F.ws + OFF_MIX);
    for (int i = F.tid; i < 256 * 48; i += NTHREADS) {
        const int row = pm * 256 + i / 48, c0 = (i % 48) * 8;
        const float rstd = rsqrtf((ssq[(size_t)row * 2] + ssq[(size_t)row * 2 + 1]) * (1.f / 384.f) + EPS);
        const v4u v = *(const v4u*)(yu + (size_t)row * 384 + c0); const f32x4 w0 = *(const f32x4*)(nw + c0), w1 = *(const f32x4*)(nw + c0 + 4);
        v4u o;
        o[0] = pk2(__uint_as_float(v[0] << 16) * rstd * w0[0], __uint_as_float(v[0] & 0xffff0000u) * rstd * w0[1]); o[1] = pk2(__uint_as_float(v[1] << 16) * rstd * w0[2], __uint_as_float(v[1] & 0xffff0000u) * rstd * w0[3]);
        o[2] = pk2(__uint_as_float(v[2] << 16) * rstd * w1[0], __uint_as_float(v[2] & 0xffff0000u) * rstd * w1[1]); o[3] = pk2(__uint_as_float(v[3] << 16) * rstd * w1[2], __uint_as_float(v[3] & 0xffff0000u) * rstd * w1[3]);
        *(v4u*)(mix + (size_t)row * D + c0) = o;
    }
    asm volatile("s_waitcnt vmcnt(0)" ::: "memory");
    __syncthreads();
}

constexpr int S5_HP = 272;
constexpr int S5_IMG = 64 * S5_HP;
constexpr int S5_GP = 528, S5_G = 4 * S5_IMG, S5_END = S5_G + 64 * S5_GP;
typedef float f32x16 __attribute__((ext_vector_type(16)));
typedef float f32x8 __attribute__((ext_vector_type(8)));
__device__ __forceinline__ float swap32sel(float x, int odd) {
    const auto r = __builtin_amdgcn_permlane32_swap(__float_as_uint(x), __float_as_uint(x), false, false);
    return __uint_as_float(odd ? r[1] : r[0]);
}
template <int DIR, bool FULL>
__device__ __forceinline__ void s5_dir(Frame& F, int l, int g, int p, int hi, const bf16x8 (&uf)[2], float& cr, float& ci, f32x16 (&hr)[2], f32x16 (&hq)[2]) {
    const float* ab = (const float*)(F.ws + OFF_TAB + TAB_ABAR) + (size_t)((((l * 2 + DIR) * 16 + g) * 64) + p) * 2;
    const float ar = ab[0], ai = ab[1];
    const float a2r = ar * ar - ai * ai, a2i = 2.f * ar * ai, a3r = a2r * ar - a2i * ai, a3i = a2r * ai + a2i * ar, a4r = a2r * a2r - a2i * a2i, a4i = 2.f * a2r * a2i;
    const bf16_t* bbt = (const bf16_t*)(F.ws + OFF_TAB + TAB_BBT) + ((size_t)(((l * 2 + DIR) * 16 + g) * 2) * 64 + p) * 16 + 8 * hi;
    const bf16x8 bre = *(const bf16x8*)bbt, bim = *(const bf16x8*)(bbt + 64 * 16);
    f32x16 xr[2], xi[2];
#pragma unroll
    for (int rb = 0; rb < 2; ++rb) {
        const f32x16 z = {0.f, 0.f, 0.f, 0.f, 0.f, 0.f, 0.f, 0.f, 0.f, 0.f, 0.f, 0.f, 0.f, 0.f, 0.f, 0.f};
        xr[rb] = __builtin_amdgcn_mfma_f32_32x32x16_bf16(uf[rb], bre, z, 0, 0, 0); xi[rb] = __builtin_amdgcn_mfma_f32_32x32x16_bf16(uf[rb], bim, z, 0, 0, 0);
    }
#pragma unroll
    for (int rb = 0; rb < 2; ++rb)
#pragma unroll
        for (int G4 = 0; G4 < 4; ++G4) {
            if (DIR == 0) {
#pragma unroll
                for (int e = 1; e < 4; ++e) { const int i = 4 * G4 + e; const float pr = xr[rb][i - 1], pi = xi[rb][i - 1]; xr[rb][i] += ar * pr - ai * pi; xi[rb][i] += ar * pi + ai * pr; }
            } else {
#pragma unroll
                for (int e = 2; e >= 0; --e) { const int i = 4 * G4 + e; const float pr = xr[rb][i + 1], pi = xi[rb][i + 1]; xr[rb][i] += ar * pr - ai * pi; xi[rb][i] += ar * pi + ai * pr; }
            }
        }
    f32x8 cinr = {0.f, 0.f, 0.f, 0.f, 0.f, 0.f, 0.f, 0.f}, cini = cinr;
#pragma unroll
    for (int kk = 0; kk < 16; ++kk) {
        const int k = DIR == 0 ? kk : 15 - kk, gi = k >> 1, rb = gi >> 2, il = 4 * (gi & 3) + (DIR == 0 ? 3 : 0), odd = k & 1;
        const bool first = DIR == 0 ? !odd : odd;
        if (first) { cinr[gi] = cr; cini[gi] = ci; } else { const bool own = (hi == odd); cinr[gi] = own ? cr : cinr[gi]; cini[gi] = own ? ci : cini[gi]; }
        const float nr = a4r * cr - a4i * ci + xr[rb][il], ni = a4r * ci + a4i * cr + xi[rb][il];
        cr = swap32sel(nr, odd); ci = swap32sel(ni, odd);
    }
    if (FULL) {
#pragma unroll
        for (int rb = 0; rb < 2; ++rb)
#pragma unroll
            for (int G4 = 0; G4 < 4; ++G4) {
                const int gi = rb * 4 + G4;
#pragma unroll
                for (int e = 0; e < 4; ++e) {
                    const int i = 4 * G4 + e, pw = DIR == 0 ? e + 1 : 4 - e;
                    const float pr = pw == 1 ? ar : (pw == 2 ? a2r : (pw == 3 ? a3r : a4r)), pi = pw == 1 ? ai : (pw == 2 ? a2i : (pw == 3 ? a3i : a4i));
                    hr[rb][i] += xr[rb][i] + pr * cinr[gi] - pi * cini[gi];
                    hq[rb][i] += xi[rb][i] + pr * cini[gi] + pi * cinr[gi];
                }
            }
    }
}
template <bool FULL>
__device__ __forceinline__ void s5_wave_unit(Frame& F, int l, int row0, int g, int ph, float& cfr, float& cfi, float& cbr, float& cbi, LAS unsigned char* himg) {
    const int lane = F.lane, r32 = lane & 31, hi = lane >> 5, p = 32 * ph + r32;
    const bf16_t* proj = (const bf16_t*)(F.ws + OFF_PROJ);
    bf16x8 uf[2];
#pragma unroll
    for (int rb = 0; rb < 2; ++rb) uf[rb] = *(const bf16x8*)(proj + (size_t)(row0 + 32 * rb + r32) * PN + PU + g * 16 + 8 * hi);
    f32x16 hr[2], hq[2];
#pragma unroll
    for (int rb = 0; rb < 2; ++rb) { hr[rb] = (f32x16){0.f, 0.f, 0.f, 0.f, 0.f, 0.f, 0.f, 0.f, 0.f, 0.f, 0.f, 0.f, 0.f, 0.f, 0.f, 0.f}; hq[rb] = hr[rb]; }
    s5_dir<0, FULL>(F, l, g, p, hi, uf, cfr, cfi, hr, hq);
    s5_dir<1, FULL>(F, l, g, p, hi, uf, cbr, cbi, hr, hq);
    if (FULL) {
#pragma unroll
        for (int rb = 0; rb < 2; ++rb)
#pragma unroll
            for (int i = 0; i < 16; ++i) { const int t = 32 * rb + 8 * (i >> 2) + 4 * hi + (i & 3);
                LAS bf16_t* d = (LAS bf16_t*)(himg + t * S5_HP) + p;
                const unsigned pk = pk2(hr[rb][i], hq[rb][i]); d[0] = (bf16_t)(pk & 0xffffu); d[64] = (bf16_t)(pk >> 16); }
    }
}
__device__ __forceinline__ void cpow64(float ar, float ai, float& or_, float& oi_) {
#pragma unroll
    for (int s = 0; s < 6; ++s) { const float nr = ar * ar - ai * ai, ni = 2.f * ar * ai; ar = nr; ai = ni; }
    or_ = ar; oi_ = ai;
}
__device__ __forceinline__ void s5_a_unit(Frame& F, int l, int cj) {
    const int w = F.wave, lane = F.lane, row0 = cj * 64;
    float* E = (float*)(F.ws + OFF_E);
    for (int it = w; it < 32; it += NWAVES) {
        const int g = it >> 1, ph = it & 1;
        float cfr = 0.f, cfi = 0.f, cbr = 0.f, cbi = 0.f;
        s5_wave_unit<false>(F, l, row0, g, ph, cfr, cfi, cbr, cbi, F.lds);
        if (lane < 32) { float2 v; v.x = cfr; v.y = cfi; *(float2*)(E + ((size_t)((cj * 2 + 0) * 16 + g) * 64 + 32 * ph + lane) * 2) = v;
                         v.x = cbr; v.y = cbi; *(float2*)(E + ((size_t)((cj * 2 + 1) * 16 + g) * 64 + 32 * ph + lane) * 2) = v; }
    }
}
__device__ __forceinline__ void s5_b_unit(Frame& F, int l, int cj) {
    const int w = F.wave, row0 = cj * 64;
    const SeqInfo q = row_seq(row0); const int j = (row0 - q.start) >> 6, nj = q.L >> 6, cj0 = cj - j;
    const bf16_t* proj = (const bf16_t*)(F.ws + OFF_PROJ);
    const float* E = (const float*)(F.ws + OFF_E);
    LAS unsigned char* lds = F.lds;
    for (int gi4 = 0; gi4 < 4; ++gi4) {
        {
            { int t_ = F.tid; asm volatile("" : "+v"(t_)); F.tid = t_; F.lane = t_ & 63; }
            const int lane = F.lane; const int g = 4 * gi4 + (w >> 1), ph = w & 1, p = 32 * ph + (lane & 31);
            const float* ab = (const float*)(F.ws + OFF_TAB + TAB_ABAR) + (size_t)((((l * 2 + 0) * 16 + g) * 64) + p) * 2;
            float a64r[2], a64i[2]; cpow64(ab[0], ab[1], a64r[0], a64i[0]); cpow64(ab[16 * 64 * 2], ab[16 * 64 * 2 + 1], a64r[1], a64i[1]);
            float cr[2] = {0.f, 0.f}, ci[2] = {0.f, 0.f};
#pragma unroll
            for (int dir = 0; dir < 2; ++dir) {
                if (!q.ctx) { const size_t o = (((size_t)q.b * 4 + l) * 2 + dir) * 1024 + g * 64 + p; cr[dir] = F.in[5][o]; ci[dir] = F.in[6][o]; }
                const int nprev = dir == 0 ? j : nj - 1 - j;
                for (int k = 0; k < nprev; ++k) { const int jj = dir == 0 ? k : nj - 1 - k;
                    const float2 e = *(const float2*)(E + ((size_t)(((cj0 + jj) * 2 + dir) * 16 + g) * 64 + p) * 2);
                    const float nr = a64r[dir] * cr[dir] - a64i[dir] * ci[dir] + e.x, ni = a64r[dir] * ci[dir] + a64i[dir] * cr[dir] + e.y; cr[dir] = nr; ci[dir] = ni; }
            }
            s5_wave_unit<true>(F, l, row0, g, ph, cr[0], ci[0], cr[1], ci[1], lds + (w >> 1) * S5_IMG);
            if (q.ctx && lane < 32) {
                if (j == nj - 1) { const size_t o = (((size_t)q.b * 4 + l) * 2 + 0) * 1024 + g * 64 + p; F.out[O_RE + o] = cr[0]; F.out[O_IM + o] = ci[0]; }
                if (j == 0) { const size_t o = (((size_t)q.b * 4 + l) * 2 + 1) * 1024 + g * 64 + p; F.out[O_RE + o] = cr[1]; F.out[O_IM + o] = ci[1]; }
            }
        }
        __syncthreads();
        int ln2 = F.tid; asm volatile("" : "+v"(ln2)); ln2 &= 63; const int fr = ln2 & 15, fq = ln2 >> 4;
#pragma unroll
        for (int tk = 0; tk < 2; ++tk) {
            const int task = 2 * w + tk, gsel = task >> 2, tb = task & 3, g = 4 * gi4 + gsel;
            LAS const unsigned char* hrow = lds + gsel * S5_IMG + (16 * tb + fr) * S5_HP + 16 * fq;
            const bf16_t* cc = (const bf16_t*)(F.ws + OFF_TAB + TAB_CC1) + ((size_t)(l * 16 + g) * 16 + fr) * 128 + 8 * fq;
            f32x4 y = {0.f, 0.f, 0.f, 0.f};
#pragma unroll
            for (int ks = 0; ks < 4; ++ks) { const bf16x8 a = *(LAS const bf16x8*)(hrow + ks * 64); const bf16x8 bfr = *(const bf16x8*)(cc + ks * 32); y = __builtin_amdgcn_mfma_f32_16x16x32_bf16(a, bfr, y, 0, 0, 0); }
            const float dsk = F.in[27][l * 256 + g * 16 + fr];
#pragma unroll
            for (int i = 0; i < 4; ++i) { const int t = 16 * tb + 4 * fq + i; const float u = bf2f(proj[(size_t)(row0 + t) * PN + PU + g * 16 + fr]);
                *((LAS bf16_t*)(lds + S5_G + t * S5_GP) + g * 16 + fr) = f2bf(gelu_tanh_f(y[i] + dsk * u)); }
        }
        __syncthreads();
    }
    {
        int ln3 = F.tid; asm volatile("" : "+v"(ln3)); ln3 &= 63; const int fr = ln3 & 15, fq = ln3 >> 4;
        f32x4 acc[2][4];
#pragma unroll
        for (int a = 0; a < 2; ++a)
#pragma unroll
            for (int tb = 0; tb < 4; ++tb) acc[a][tb] = (f32x4){0.f, 0.f, 0.f, 0.f};
        const bf16_t* wg = (const bf16_t*)(F.ws + OFF_WGLU) + (size_t)l * 65536 + (size_t)(32 * w + fr) * 256 + 8 * fq;
#pragma unroll
        for (int ks = 0; ks < 8; ++ks) {
            const bf16x8 b0 = *(const bf16x8*)(wg + ks * 32), b1 = *(const bf16x8*)(wg + 16 * 256 + ks * 32);
#pragma unroll
            for (int tb = 0; tb < 4; ++tb) { const bf16x8 a = *(LAS const bf16x8*)(lds + S5_G + (16 * tb + fr) * S5_GP + ks * 64 + 16 * fq);
                acc[0][tb] = __builtin_amdgcn_mfma_f32_16x16x32_bf16(a, b0, acc[0][tb], 0, 0, 0); acc[1][tb] = __builtin_amdgcn_mfma_f32_16x16x32_bf16(a, b1, acc[1][tb], 0, 0, 0); }
        }
#pragma unroll
        for (int a = 0; a < 2; ++a) { const int n = 32 * w + 16 * a + fr; const float bg = F.in[29][l * 256 + n];
#pragma unroll
            for (int tb = 0; tb < 4; ++tb)
#pragma unroll
                for (int i = 0; i < 4; ++i) { const int t = 16 * tb + 4 * fq + i; const float gv = bf2f(*((LAS const bf16_t*)(lds + S5_G + t * S5_GP) + n));
                    ((bf16_t*)(F.ws + OFF_MIX))[(size_t)(row0 + t) * D + 384 + n] = f2bf(gv * sigmoid_f(acc[a][tb][i] + bg)); } }
    }
}

__device__ __forceinline__ void phase_mixa(Frame& F, int l) {
    unsigned* ctr = F.ctl + CW_Q + 64 * (l * 4 + 0);
    for (;;) { const int u = queue_next(F, ctr); if (u >= 1280) break; if (u < 256) ssd_a_unit(F, l, u); else if (u < 512) s5_a_unit(F, l, u - 256); else attn_unit(F, l, u - 512); }
}
__device__ __forceinline__ void phase_mixb(Frame& F, int l) {
    unsigned* ctr = F.ctl + CW_Q + 64 * (l * 4 + 1);
    for (;;) { const int u = queue_next(F, ctr); if (u >= 512) break; if (u < 256) ssd_b_unit(F, l, u); else s5_b_unit(F, l, u - 256); }
}

struct Args { const float* in[35]; float* out; unsigned char* ws; int ph_lo, ph_hi, li, pad; };
#ifdef MK_PHASE_RANGE
#define IN(k) (lo <= (k) && (k) < hi)
#else
#define IN(k) true
#endif
#define REFRESH() do { int t_ = threadIdx.x; asm volatile("" : "+v"(t_)); F.tid = t_; F.lane = t_ & 63; \
        unsigned char* w_ = args.ws; asm volatile("" : "+s"(w_)); F.ws = w_; F.ctl = (unsigned*)(w_ + OFF_CTL); float* o_ = args.out; asm volatile("" : "+s"(o_)); F.out = o_; \
        const float* const* i_ = (const float* const*)__builtin_amdgcn_kernarg_segment_ptr(); asm volatile("" : "+s"(i_)); F.in = i_; \
        int g_ = gridDim.x, v_ = vcu0; asm volatile("" : "+s"(g_), "+s"(v_)); F.G = g_; F.vcu = v_; modsb = (const float*)(F.ws + OFF_MODS); XB = (bf16_t*)(F.ws + OFF_X); } while (0)
#define SEAM(k) do { if (IN(k) && IN((k) + 1) && (k) + 1 < PH_END) xcd_barrier(bar); } while (0)
template <int l>
__device__ __forceinline__ void layer_body(Frame& F, const Args& args, const XcdBarrier& bar, const int vcu0) {
    const int lo = args.ph_lo, hi = args.ph_hi; (void)lo; (void)hi;
    const float* modsb = (const float*)(F.ws + OFF_MODS);
    bf16_t* XB = (bf16_t*)(F.ws + OFF_X);
        const int pb = PH_L0 + l * PH_PER_LAYER;
        if (IN(pb + PH_G1)) { REFRESH();
            pg8::Gemm g{(const bf16_t*)(F.ws + OFF_H), (const bf16_t*)(F.ws + OFF_WIN) + (size_t)l * PNP * 1024, M, PNP, 1024}; pg8::StaticOrder S; S.init(M, PNP, F.G, (int)blockIdx.x);
            epi_side_fill(F, S, (const float*)(F.ws + OFF_TAB + TAB_SQ1), (const float*)(F.ws + OFF_TAB + TAB_B1) + (size_t)l * 9 * PNP, PNP);
            pg8::EpiProj E{(bf16_t*)(F.ws + OFF_PROJ), F.out + O_K, F.out + O_V, (float*)(F.ws + OFF_DT), (LAS const float*)(F.lds + EPI_SIDE_OFF), l, 0};
            pg8::gemm_phase<pg8::EpiProj, pg8::StaticOrder, true, true>(F.lds, g, S, E);
        }
        SEAM(pb + PH_G1);
        if (IN(pb + PH_MIXA)) { REFRESH(); phase_mixa(F, l); }
        SEAM(pb + PH_MIXA);
        if (IN(pb + PH_MIXB)) { REFRESH(); ssd_state_pass(F, l); xcd_barrier(bar); REFRESH(); phase_mixb(F, l); }
        SEAM(pb + PH_MIXB);
        if (IN(pb + PH_G3)) { REFRESH();
            pg8::Gemm g{(const bf16_t*)(F.ws + OFF_MIX), (const bf16_t*)(F.ws + OFF_WOUT) + (size_t)l * 1024 * 1024, M, D, 1024}; pg8::StaticOrder S; S.init(M, D, F.G, (int)blockIdx.x);
            { pg8::Unit u; if (S.next(0, u) && F.tid < 256) { const float* q2 = (const float*)(F.ws + OFF_TAB + TAB_SSQ) + (size_t)(u.pm * 256 + F.tid) * 2;
                ((LAS float*)(F.lds + EPI_SIDE_OFF))[F.tid] = rsqrtf((q2[0] + q2[1]) * (1.f / 384.f) + EPS); } __syncthreads(); }
            typedef pg8::EpiRes<6, l == 0> Epi3;
            Epi3 E{l == 0 ? (const void*)F.in[0] : (const void*)XB, l == 0 ? (const void*)(F.in[1] - (size_t)MC * D) : (const void*)XB, XB, modsb + (size_t)l * 9 * 6144 + 2 * 1024, F.in[12] + l * D, modsb + (size_t)l * 9 * 6144 + 4 * 1024,
                   (bf16_t*)(F.ws + OFF_H), (float*)(F.ws + OFF_TAB + TAB_SQ2), (LAS const float*)(F.lds + EPI_SIDE_OFF)};
            pg8::gemm_phase<Epi3, pg8::StaticOrder, true, true>(F.lds, g, S, E);
        }
        SEAM(pb + PH_G3);
        if (IN(pb + PH_G4)) { REFRESH();
            pg8::Gemm g{(const bf16_t*)(F.ws + OFF_H), (const bf16_t*)(F.ws + OFF_WFF1) + (size_t)l * DFF * 1024, M, DFF, 1024}; pg8::StaticOrder S; S.init(M, DFF, F.G, (int)blockIdx.x);
            epi_side_fill(F, S, (const float*)(F.ws + OFF_TAB + TAB_SQ2), (const float*)(F.ws + OFF_TAB + TAB_B2) + (size_t)l * 9 * DFF, DFF);
            pg8::EpiFF1 E{(bf16_t*)(F.ws + OFF_FFH), (LAS const float*)(F.lds + EPI_SIDE_OFF), 0};
            pg8::gemm_phase<pg8::EpiFF1, pg8::StaticOrder, true, true>(F.lds, g, S, E);
        }
        SEAM(pb + PH_G4);
        if (IN(pb + PH_G5)) { REFRESH();
            pg8::Gemm g{(const bf16_t*)(F.ws + OFF_FFH), (const bf16_t*)(F.ws + OFF_WFF2) + (size_t)l * 1024 * DFF, M, D, DFF}; pg8::StaticOrder S; S.init(M, D, F.G, (int)blockIdx.x);
            const int ln = l + 1 < DEPTH ? l + 1 : l;
            typedef pg8::EpiRes<0, false> Epi5;
            Epi5 E{(const void*)XB, (const void*)XB, XB, modsb + (size_t)l * 9 * 6144 + 5 * 1024, F.in[11] + ln * D, modsb + (size_t)ln * 9 * 6144 + 1 * 1024,
                   l + 1 < DEPTH ? (bf16_t*)(F.ws + OFF_H) : (bf16_t*)nullptr, (float*)(F.ws + OFF_TAB + TAB_SQ1), (LAS const float*)(F.lds + EPI_SIDE_OFF)};
            pg8::gemm_phase<Epi5, pg8::StaticOrder, true, true>(F.lds, g, S, E);
        }
        SEAM(pb + PH_G5);
    }
__global__ void __launch_bounds__(NTHREADS, 2) mega(Args args) {
    extern __shared__ __attribute__((aligned(16))) unsigned char lds[];
    Frame F;
    F.lds = (LAS unsigned char*)lds;
    F.MISC = (volatile LAS unsigned*)(F.lds + MISC_OFF);
    F.tid = threadIdx.x; F.lane = F.tid & 63; F.wave = __builtin_amdgcn_readfirstlane(F.tid >> 6);
    F.G = gridDim.x; { const int bx = blockIdx.x; F.vcu = (F.G % 8 == 0) ? (bx % 8) * (F.G / 8) + bx / 8 : bx; }
    { const float* const* inp = (const float* const*)__builtin_amdgcn_kernarg_segment_ptr(); asm volatile("" : "+s"(inp)); F.in = inp; }
    F.out = args.out; F.ws = args.ws; F.ctl = (unsigned*)(args.ws + OFF_CTL);
    for (int u = F.tid; u < (LDS_BYTES - LDSCTL_OFF) / 4; u += NTHREADS) ((LAS unsigned*)(F.lds + LDSCTL_OFF))[u] = 0u;
    __syncthreads();
    XcdBarrier bar = xcd_barrier_post(F.ctl + CW_BAR + args.li * XCD_BAR_WORDS, F.MISC + 8);
    const int lo = args.ph_lo, hi = args.ph_hi; (void)lo; (void)hi;
    const float* modsb = (const float*)(F.ws + OFF_MODS);
    bf16_t* XB = (bf16_t*)(F.ws + OFF_X);
    const int vcu0 = F.vcu;
    if (IN(PH_PRO)) phase_prologue(F);
    SEAM(PH_PRO);
    if (IN(PH_PRE)) { REFRESH(); phase_pre(F); }
    SEAM(PH_PRE);
    layer_body<0>(F, args, bar, vcu0); layer_body<1>(F, args, bar, vcu0); layer_body<2>(F, args, bar, vcu0); layer_body<3>(F, args, bar, vcu0);
    if (IN(PH_FINAL)) phase_final(F);
#undef IN
#undef SEAM
}
static void launch_mega(const Args& base, int lo, int hi, int li, hipStream_t stream) {
    Args a = base; a.ph_lo = lo; a.ph_hi = hi; a.li = li;
    hipLaunchKernelGGL(mega, dim3(256), dim3(NTHREADS), LDS_BYTES, stream, a);
}
extern "C" void kernel_launch(void* const* d_in, const int* in_sizes, int n_in, void* d_out, int out_size, void* d_ws, size_t ws_size, hipStream_t stream) {
    static int ready = 0;
    if (!ready) {
        if (n_in != 35 || out_size != (int)O_END || ws_size < WS_END) { fprintf(stderr, "kernel_launch: unexpected shapes n_in %d out %d ws %zu\n", n_in, out_size, ws_size); ready = -1; return; }
        if (hipFuncSetAttribute((const void*)mega, hipFuncAttributeMaxDynamicSharedMemorySize, LDS_BYTES) != hipSuccess) { fprintf(stderr, "kernel_launch: hipFuncSetAttribute failed\n"); ready = -1; return; }
        ready = 1;
    }
    if (ready < 0) return;
    Args a{}; for (int i = 0; i < 35; ++i) a.in[i] = (const float*)d_in[i]; a.out = (float*)d_out; a.ws = (unsigned char*)d_ws;
    (void)hipMemsetAsync((char*)d_ws + OFF_CTL, 0, CTL_ZERO_BYTES, stream);
    launch_mega(a, 0, PH_END, 0, stream);
}
```

```cpp
#include <hip/hip_runtime.h>
#include <stdint.h>
#include <stdio.h>

typedef unsigned short bf16_t;
typedef short bf16x8 __attribute__((ext_vector_type(8)));
typedef float f32x4 __attribute__((ext_vector_type(4)));

constexpr int D = 1024, DEPTH = 4;
constexpr int CB = 32, CL = 256, LB = 8, LL = 1024;
constexpr int MC = CB * CL;
constexpr int M = MC + LB * LL;
constexpr int NSEQ = CB + LB;
constexpr int IN_COLS = 2444;
constexpr int PN = 2432, PNP = 2560;
constexpr int PZ = 0, PX = 384, PU = 1024, PQ = 1280, PK = 1664, PV = 2048;
constexpr int DFF = 4096;
constexpr float EPS = 1e-6f;

constexpr size_t MiB = 1u << 20;
constexpr size_t OFF_CTL = 0, OFF_MODS = 1 * MiB, OFF_TAB = 2 * MiB, OFF_WIN = 8 * MiB, OFF_WOUT = 28 * MiB, OFF_WFF1 = 36 * MiB,
                 OFF_WFF2 = 68 * MiB, OFF_WGLU = 100 * MiB, OFF_DT = 101 * MiB, OFF_X = 102 * MiB, OFF_PROJ = 166 * MiB, OFF_MIX = 242 * MiB,
                 OFF_FFH = 166 * MiB, OFF_H = 294 * MiB, OFF_XBC = 294 * MiB, OFF_YSSD = 334 * MiB, OFF_YS5 = 358 * MiB, WS_END = 374 * MiB;
constexpr size_t TAB_ABAR = 0;
constexpr size_t TAB_SQ1 = 256 * 1024;
constexpr size_t TAB_SQ2 = 1280 * 1024;
constexpr size_t TAB_B1 = 2304 * 1024;
constexpr size_t TAB_B2 = 4352 * 1024;
constexpr size_t TAB_SSQ = 5 * MiB;
constexpr size_t OFF_CK = 134 * MiB, OFF_CV = 140 * MiB;
constexpr size_t OFF_H5 = 326 * MiB;
constexpr size_t OFF_HIN = 362 * MiB;
constexpr size_t OFF_YU = 274 * MiB;
constexpr size_t TAB_CD = 3 * MiB;
constexpr size_t OFF_CS = 334 * MiB;
constexpr size_t TAB_CC1 = 4 * MiB;
constexpr size_t TAB_BBT = 3 * MiB + 512 * 1024;
constexpr size_t OFF_E = 358 * MiB;

__device__ __forceinline__ float bf2f(bf16_t v) { return __uint_as_float((unsigned)v << 16); }
typedef float f32x2_t __attribute__((ext_vector_type(2))); typedef __bf16 bf16x2_t __attribute__((ext_vector_type(2)));
__device__ __forceinline__ unsigned cvtpk(float lo, float hi) { f32x2_t v = {lo, hi}; bf16x2_t b = __builtin_convertvector(v, bf16x2_t); return __builtin_bit_cast(unsigned, b); }
__device__ __forceinline__ bf16_t f2bf(float f) { return (bf16_t)(cvtpk(f, f) & 0xffffu); }
__device__ __forceinline__ float sigmoid_f(float x) { return __builtin_amdgcn_rcpf(1.f + __expf(-x)); }
__device__ __forceinline__ float silu_f(float x) { return x * sigmoid_f(x); }
__device__ __forceinline__ float softplus_f(float x) { return x > 20.f ? x : log1pf(__expf(x)); }
__device__ __forceinline__ float gelu_tanh_f(float x) { const float u = 1.5957691216057308f * (x + 0.044715f * x * x * x); return x * sigmoid_f(u); }
template <int CTRL> __device__ __forceinline__ float dppf(float x) { return __uint_as_float((unsigned)__builtin_amdgcn_update_dpp(0, (int)__float_as_uint(x), CTRL, 0xf, 0xf, true)); }
__device__ __forceinline__ float row16_sum(float x) { x += dppf<0xB1>(x); x += dppf<0x4E>(x); x += dppf<0x141>(x); x += dppf<0x140>(x); return x; }
__device__ __forceinline__ float row16_max(float x) { x = fmaxf(x, dppf<0xB1>(x)); x = fmaxf(x, dppf<0x4E>(x)); x = fmaxf(x, dppf<0x141>(x)); x = fmaxf(x, dppf<0x140>(x)); return x; }
__device__ __forceinline__ float xsum16(float x) { const auto r = __builtin_amdgcn_permlane16_swap(__float_as_uint(x), __float_as_uint(x), false, false); return __uint_as_float(r[0]) + __uint_as_float(r[1]); }
__device__ __forceinline__ float xsum32(float x) { const auto r = __builtin_amdgcn_permlane32_swap(__float_as_uint(x), __float_as_uint(x), false, false); return __uint_as_float(r[0]) + __uint_as_float(r[1]); }
__device__ __forceinline__ float xmax16(float x) { const auto r = __builtin_amdgcn_permlane16_swap(__float_as_uint(x), __float_as_uint(x), false, false); return fmaxf(__uint_as_float(r[0]), __uint_as_float(r[1])); }
__device__ __forceinline__ float xmax32(float x) { const auto r = __builtin_amdgcn_permlane32_swap(__float_as_uint(x), __float_as_uint(x), false, false); return fmaxf(__uint_as_float(r[0]), __uint_as_float(r[1])); }
__device__ __forceinline__ float rdlane(float x, int l) { return __uint_as_float((unsigned)__builtin_amdgcn_readlane((int)__float_as_uint(x), l)); }
__device__ __forceinline__ float wave_sum(float v) { return xsum32(xsum16(row16_sum(v))); }
__device__ __forceinline__ float wave_max(float v) { return xmax32(xmax16(row16_max(v))); }
__device__ __forceinline__ int mod_row(int row) { return row < MC ? 0 : 1 + ((row - MC) >> 10); }

struct P {
    const float* in[35];
    float* out;
    unsigned char* ws;
};
constexpr size_t O_YP = 0, O_YS = 8388608, O_K = 16777216, O_V = O_K + 12582912, O_SSD = O_V + 12582912, O_RE = O_SSD + 6291456, O_IM = O_RE + 262144, O_END = O_IM + 262144;


#define LAS __attribute__((address_space(3)))
struct SeqInfo { int start, L, b, ctx; };
__device__ __forceinline__ SeqInfo seq_info(int s) { SeqInfo q; if (s < CB) { q.start = s * CL; q.L = CL; q.b = s; q.ctx = 1; } else { q.start = MC + (s - CB) * LL; q.L = LL; q.b = s - CB; q.ctx = 0; } return q; }
__device__ __forceinline__ SeqInfo row_seq(int row) { return seq_info(row < MC ? (row >> 8) : CB + ((row - MC) >> 10)); }
namespace pg8 {
#define PG8_LAS __attribute__((address_space(3)))
typedef unsigned short bf16_t;
typedef short bf16x8 __attribute__((ext_vector_type(8)));
typedef float f32x4 __attribute__((ext_vector_type(4)));
typedef unsigned u32x4 __attribute__((ext_vector_type(4)));
constexpr int BM = 256, BK = 64, HALF = 128, HTB = HALF * BK * 2  , STAGE_BYTES = 8 * HTB, NXCD = 8, WGM = 8;

__host__ __device__ __forceinline__ int lds_byte(int r, int c) { const int st = (r >> 4) * 2 + (c >> 5), rr = r & 15, cc = c & 31, ob = rr * 64 + cc * 2; return st * 1024 + (ob ^ (((ob >> 9) & 1) << 5)); }
__host__ __device__ __forceinline__ void stage_rc(int b, int& R, int& C) { const int st = b / 1024, sb = b % 1024, swz = sb ^ (((sb >> 9) & 1) << 5); R = (st >> 1) * 16 + swz / 64; C = (st & 1) * 32 + (swz % 64) / 2; }
__host__ __device__ __forceinline__ int perm32(int rho) { const int n = rho >> 4, i = rho & 15; return 8 * (i >> 2) + 4 * n + (i & 3); }

struct Unit { int pm, pn; };
struct Gemm { const bf16_t* A; const bf16_t* Bt; int M, N, K; };

struct StaticOrder {
    int nM, nN, nwg, G, c;
    __host__ __device__ void init(int M, int N, int G_, int c_) { nM = M / BM; nN = N / BM; nwg = nM * nN; G = G_; c = c_; }
    __host__ __device__ bool next(int i, Unit& u) const {
        const long L = (long)i * G + c; if (L >= nwg) return false;
        int wgid = (int)L; { const int q = nwg / NXCD, r = nwg % NXCD, xcd = wgid % NXCD, off = wgid / NXCD; wgid = (xcd < r ? xcd * (q + 1) : r * (q + 1) + (xcd - r) * q) + off; }
        const int nig = WGM * nN, gid = wgid / nig, fm = gid * WGM, gsz = (nM - fm) < WGM ? (nM - fm) : WGM;
        u.pm = fm + ((wgid % nig) % gsz); u.pn = (wgid % nig) / gsz; return true;
    }
    __device__ __forceinline__ void a_ready(const Unit&) const {}
    __device__ __forceinline__ void done(const Unit&) const {}
};

__device__ __forceinline__ unsigned cvt_pk_bf16(float lo, float hi) { unsigned r; asm volatile("v_cvt_pk_bf16_f32 %0, %1, %2" : "=v"(r) : "v"(lo), "v"(hi)); return r; }
__device__ __forceinline__ float row_rstd(const float* ssq, int row, int fq) {
    const f32x4 a = *(const f32x4*)(ssq + (size_t)row * 16 + 4 * fq);
    const float s = ::xsum32(::xsum16((a[0] + a[1]) + (a[2] + a[3])));
    return rsqrtf(s * (1.f / 1024.f) + ::EPS);
}
struct EpiProj {
    static constexpr bool PERM = true, AFTER_DRAIN = false; static constexpr int MID_T = 0;
    bf16_t* proj; float* ok; float* ov; float* dt; PG8_LAS const float* side; int l; mutable int slot;
    __device__ __forceinline__ void operator()(const f32x4 (&acc)[2][2][4][2], const Unit& u, int wr, int wc, int fr, int fq) const {
        const int row0 = u.pm * BM + wr * 64 + fr;
        PG8_LAS const float* rsp = side + slot * 256 + wr * 64 + fr; PG8_LAS const float* bsp = side + 1024 + slot * 256 + wc * 32 + 8 * fq; ++slot;
        float rs[2][4];
#pragma unroll
        for (int ai = 0; ai < 2; ++ai)
#pragma unroll
            for (int m = 0; m < 4; ++m) rs[ai][m] = rsp[ai * HALF + m * 16];
#pragma unroll
        for (int bj = 0; bj < 2; ++bj) {
            const int cb = u.pn * BM + bj * HALF;
            if (cb > ::PN) continue;
            const int col = cb + wc * 32 + 8 * fq;
            const f32x4 b0 = *(PG8_LAS const f32x4*)(bsp + bj * HALF), b1 = *(PG8_LAS const f32x4*)(bsp + bj * HALF + 4);
            const bool isk = (cb >= ::PK && cb < ::PV), isv = (cb >= ::PV && cb < ::PN), isdt = (cb == ::PN);
#pragma unroll
            for (int ai = 0; ai < 2; ++ai)
#pragma unroll
                for (int m = 0; m < 4; ++m) {
                    const int row = row0 + ai * HALF + m * 16;
                    const f32x4 v0 = acc[ai][bj][m][0] * rs[ai][m] + b0, v1 = acc[ai][bj][m][1] * rs[ai][m] + b1;
                    if (isdt) { if (wc == 0 && fq < 2) { float* d = dt + (size_t)row * 12 + 8 * fq; *(f32x4*)d = v0; if (fq == 0) *(f32x4*)(d + 4) = v1; } continue; }
                    u32x4 w; w.x = cvt_pk_bf16(v0[0], v0[1]); w.y = cvt_pk_bf16(v0[2], v0[3]); w.z = cvt_pk_bf16(v1[0], v1[1]); w.w = cvt_pk_bf16(v1[2], v1[3]);
                    *(u32x4*)(proj + (size_t)row * ::PN + col) = w;
                    if (u.pm < 32 && (isk || isv)) {
                        const int b = row >> 8, t = row & 255;
                        float* o = (isk ? ok : ov) + ((size_t)(b * 4 + l) * 256 + t) * 384 + (col - (isk ? ::PK : ::PV));
                        *(f32x4*)o = v0; *(f32x4*)(o + 4) = v1;
                    }
                }
        }
    }
};
template <int MID, bool XF32>
struct EpiRes {
    static constexpr bool PERM = true, AFTER_DRAIN = false; static constexpr int MID_T = MID;
    const void* xin_c; const void* xin_l; bf16_t* xout; const float* gate;
    const float* nw; const float* sc; bf16_t* xs; float* ssq;
    PG8_LAS const float* side;
    __device__ __forceinline__ void mid(f32x4 (&acc)[2][2][4][2], const Unit& u, int wr, int fr) const {
#pragma unroll
        for (int ai = 0; ai < 2; ++ai)
#pragma unroll
            for (int m = 0; m < 4; ++m) { const float sc_ = side[ai * HALF + wr * 64 + m * 16 + fr];
#pragma unroll
                for (int bj = 0; bj < 2; ++bj)
#pragma unroll
                    for (int n = 0; n < 2; ++n) acc[ai][bj][m][n] = acc[ai][bj][m][n] * sc_; }
    }
    __device__ __forceinline__ void operator()(const f32x4 (&acc)[2][2][4][2], const Unit& u, int wr, int wc, int fr, int fq) const {
        const int row0 = u.pm * BM + wr * 64 + fr, col0 = u.pn * BM + wc * 32 + 8 * fq;
        const int r = u.pm < 32 ? 0 : 1 + ((u.pm - 32) >> 2);
        const float* gt = gate + (size_t)r * 6144; const float* sr = sc + (size_t)r * 6144;
        const void* xin = u.pm < 32 ? xin_c : xin_l;
        float sq[2][4];
#pragma unroll
        for (int ai = 0; ai < 2; ++ai)
#pragma unroll
            for (int m = 0; m < 4; ++m) sq[ai][m] = 0.f;
#pragma unroll
        for (int bj = 0; bj < 2; ++bj) {
            const int col = col0 + bj * HALF;
            const f32x4 g0 = *(const f32x4*)(gt + col), g1 = *(const f32x4*)(gt + col + 4);
            f32x4 gs0 = {0.f, 0.f, 0.f, 0.f}, gs1 = gs0;
            if (xs) { gs0 = *(const f32x4*)(nw + col) * (*(const f32x4*)(sr + col) + 1.f); gs1 = *(const f32x4*)(nw + col + 4) * (*(const f32x4*)(sr + col + 4) + 1.f); }
#pragma unroll
            for (int ai = 0; ai < 2; ++ai)
#pragma unroll
                for (int m = 0; m < 4; ++m) {
                    const size_t off = (size_t)(row0 + ai * HALF + m * 16) * ::D + col;
                    f32x4 xi0, xi1;
                    if (XF32) { xi0 = *(const f32x4*)((const float*)xin + off); xi1 = *(const f32x4*)((const float*)xin + off + 4); }
                    else { const u32x4 xr = *(const u32x4*)((const bf16_t*)xin + off);
                        xi0 = (f32x4){__uint_as_float(xr.x << 16), __uint_as_float(xr.x & 0xffff0000u), __uint_as_float(xr.y << 16), __uint_as_float(xr.y & 0xffff0000u)};
                        xi1 = (f32x4){__uint_as_float(xr.z << 16), __uint_as_float(xr.z & 0xffff0000u), __uint_as_float(xr.w << 16), __uint_as_float(xr.w & 0xffff0000u)}; }
                    const f32x4 x0 = xi0 + g0 * acc[ai][bj][m][0], x1 = xi1 + g1 * acc[ai][bj][m][1];
                    { u32x4 xo; xo.x = cvt_pk_bf16(x0[0], x0[1]); xo.y = cvt_pk_bf16(x0[2], x0[3]); xo.z = cvt_pk_bf16(x1[0], x1[1]); xo.w = cvt_pk_bf16(x1[2], x1[3]); *(u32x4*)(xout + off) = xo; }
                    if (xs) { sq[ai][m] += ((x0[0] * x0[0] + x0[1] * x0[1]) + (x0[2] * x0[2] + x0[3] * x0[3])) + ((x1[0] * x1[0] + x1[1] * x1[1]) + (x1[2] * x1[2] + x1[3] * x1[3]));
                        const f32x4 h0 = x0 * gs0, h1 = x1 * gs1; u32x4 o; o.x = cvt_pk_bf16(h0[0], h0[1]); o.y = cvt_pk_bf16(h0[2], h0[3]); o.z = cvt_pk_bf16(h1[0], h1[1]); o.w = cvt_pk_bf16(h1[2], h1[3]);
                        *(u32x4*)(xs + off) = o; }
                }
        }
        if (xs) {
#pragma unroll
            for (int ai = 0; ai < 2; ++ai)
#pragma unroll
                for (int m = 0; m < 4; ++m) { const float t = ::xsum32(::xsum16(sq[ai][m])); if (fq == 0) ssq[(size_t)(row0 + ai * HALF + m * 16) * 16 + u.pn * 4 + wc] = t; }
        }
    }
};
struct EpiFF1 {
    static constexpr bool PERM = true, AFTER_DRAIN = false; static constexpr int MID_T = 0;
    bf16_t* h; PG8_LAS const float* side; mutable int slot;
    __device__ __forceinline__ void operator()(const f32x4 (&acc)[2][2][4][2], const Unit& u, int wr, int wc, int fr, int fq) const {
        const int row0 = u.pm * BM + wr * 64 + fr, col0 = u.pn * BM + wc * 32 + 8 * fq;
        PG8_LAS const float* rsp = side + slot * 256 + wr * 64 + fr; PG8_LAS const float* bsp = side + 1024 + slot * 256 + wc * 32 + 8 * fq; ++slot;
        f32x4 bv[2][2];
#pragma unroll
        for (int bj = 0; bj < 2; ++bj) { bv[bj][0] = *(PG8_LAS const f32x4*)(bsp + bj * HALF); bv[bj][1] = *(PG8_LAS const f32x4*)(bsp + bj * HALF + 4); }
#pragma unroll
        for (int ai = 0; ai < 2; ++ai)
#pragma unroll
            for (int m = 0; m < 4; ++m) {
                const int row = row0 + ai * HALF + m * 16; const float rs = rsp[ai * HALF + m * 16];
                bf16_t* rowp = h + (size_t)row * ::DFF + col0;
#pragma unroll
                for (int bj = 0; bj < 2; ++bj) {
                    f32x4 v0 = acc[ai][bj][m][0] * rs + bv[bj][0], v1 = acc[ai][bj][m][1] * rs + bv[bj][1];
#pragma unroll
                    for (int e = 0; e < 4; ++e) { const float a = fmaxf(v0[e], 0.f), b = fmaxf(v1[e], 0.f); v0[e] = a * a; v1[e] = b * b; }
                    u32x4 w; w.x = cvt_pk_bf16(v0[0], v0[1]); w.y = cvt_pk_bf16(v0[2], v0[3]); w.z = cvt_pk_bf16(v1[0], v1[1]); w.w = cvt_pk_bf16(v1[2], v1[3]);
                    *(u32x4*)(rowp + bj * HALF) = w;
                }
            }
    }
};
template <class Epi, class Sched, bool ALIGN_EPI = false, bool SP2 = false>
__device__ __forceinline__ void gemm_phase(PG8_LAS unsigned char* lds, const Gemm g, const Sched& S, const Epi& E) {
    int tid_ = threadIdx.x; asm volatile("" : "+v"(tid_));
    const int tid = tid_, wid = __builtin_amdgcn_readfirstlane(tid >> 6), lane = tid & 63, wr = wid >> 2, wc = wid & 3, fr = lane & 15, fq = lane >> 4;
    const int K = g.K, nt = K / BK;
    unsigned voffA[2], voffB[2];
#pragma unroll
    for (int i = 0; i < 2; ++i) { int R, C; stage_rc(tid * 16 + i * 8192, R, C); const int Rb = Epi::PERM ? ((R & ~31) + perm32(R & 31)) : R;
        voffA[i] = (unsigned)(R * K + C) * 2u; voffB[i] = (unsigned)(Rb * K + C) * 2u; }
    const size_t kstep = (size_t)(BK * 2);
    const size_t hstep = (size_t)HALF * K * 2;
    const size_t tstep = 2 * hstep;
    const unsigned ldsw = (unsigned)wid * 1024u;
    const int aoff = lds_byte(wr * 64 + fr, fq * 8), boff = lds_byte(wc * 32 + fr, fq * 8);
#define PG8_SA(b, h) (((b) * 2 + (h)) * HTB)
#define PG8_SB(b, h) ((4 + (b) * 2 + (h)) * HTB)
#define PG8_STAGE(bufoff, gbase, voff) do { _Pragma("unroll") for (int _i = 0; _i < 2; ++_i) \
        __builtin_amdgcn_global_load_lds((const unsigned*)((const char*)(gbase) + (voff)[_i]), (PG8_LAS unsigned*)(lds + (bufoff) + ldsw + _i * 8192), 16, 0, 0); } while (0)
#define PG8_LDA(dst, b, h) do { _Pragma("unroll") for (int m = 0; m < 4; ++m) _Pragma("unroll") for (int k = 0; k < 2; ++k) dst[m][k] = *(const PG8_LAS bf16x8*)(lds + PG8_SA(b, h) + aoff + m * 2048 + k * 1024); } while (0)
#define PG8_LDB(dst, b, h) do { _Pragma("unroll") for (int n = 0; n < 2; ++n) _Pragma("unroll") for (int k = 0; k < 2; ++k) dst[n][k] = *(const PG8_LAS bf16x8*)(lds + PG8_SB(b, h) + boff + n * 2048 + k * 1024); } while (0)
#define PG8_MMA(ai, bj, At, Bt) do { __builtin_amdgcn_s_setprio(1); _Pragma("unroll") for (int m = 0; m < 4; ++m) _Pragma("unroll") for (int n = 0; n < 2; ++n) _Pragma("unroll") for (int k = 0; k < 2; ++k) \
        acc[ai][bj][m][n] = __builtin_amdgcn_mfma_f32_16x16x32_bf16(Bt[n][k], At[m][k], acc[ai][bj][m][n], 0, 0, 0); __builtin_amdgcn_s_setprio(0); } while (0)
#define PG8_WAIT_V(n) asm volatile("s_waitcnt vmcnt(" #n ")" ::: "memory")
#define PG8_WAIT_L(n) asm volatile("s_waitcnt lgkmcnt(" #n ")" ::: "memory")
#define PG8_BAR __builtin_amdgcn_s_barrier()
#define PG8_SCHED __builtin_amdgcn_sched_barrier(0)
    Unit cur, nxt; int ui = 0;
    if (!S.next(0, cur)) return;
    f32x4 acc[2][2][4][2];
#pragma unroll
    for (int a = 0; a < 2; ++a)
#pragma unroll
        for (int b = 0; b < 2; ++b)
#pragma unroll
            for (int m = 0; m < 4; ++m)
#pragma unroll
                for (int n = 0; n < 2; ++n) acc[a][b][m][n] = (f32x4){0.f, 0.f, 0.f, 0.f};
    bf16x8 At[4][2], B0[2][2], B1[2][2];
    const char* cA = (const char*)g.A + (size_t)cur.pm * tstep; const char* cB = (const char*)g.Bt + (size_t)cur.pn * tstep;
    S.a_ready(cur);
    if constexpr (SP2) {
        PG8_STAGE(PG8_SB(0, 0), cB, voffB); PG8_STAGE(PG8_SB(0, 1), cB + hstep, voffB); PG8_STAGE(PG8_SA(0, 0), cA, voffA); PG8_STAGE(PG8_SA(0, 1), cA + hstep, voffA);
        if (wr == 1) PG8_BAR;
        PG8_WAIT_V(2); PG8_BAR;
        PG8_STAGE(PG8_SB(1, 0), cB + kstep, voffB); PG8_STAGE(PG8_SA(1, 0), cA + kstep, voffA); PG8_STAGE(PG8_SB(1, 1), cB + hstep + kstep, voffB);
        PG8_WAIT_V(6); PG8_BAR;
    } else {
        PG8_STAGE(PG8_SB(0, 0), cB, voffB); PG8_STAGE(PG8_SA(0, 0), cA, voffA); PG8_STAGE(PG8_SB(0, 1), cB + hstep, voffB); PG8_STAGE(PG8_SA(0, 1), cA + hstep, voffA);
        if (wr == 1) PG8_BAR;
        PG8_WAIT_V(4); PG8_BAR;
        PG8_STAGE(PG8_SB(1, 0), cB + kstep, voffB); PG8_STAGE(PG8_SA(1, 0), cA + kstep, voffA); PG8_STAGE(PG8_SB(1, 1), cB + hstep + kstep, voffB);
        PG8_WAIT_V(6); PG8_BAR;
    }
    for (;;) {
        const bool has_next = S.next(ui + 1, nxt);
        const char* nA = has_next ? (const char*)g.A + (size_t)nxt.pm * tstep : cA; const char* nB = has_next ? (const char*)g.Bt + (size_t)nxt.pn * tstep : cB;
        for (int t = 0; t < nt; t += 2) {
            if constexpr (Epi::MID_T > 0) { if (t == Epi::MID_T) E.mid(acc, cur, wr, fr); }
            const bool last = (t == nt - 2);
            const char* a1 = cA + (size_t)(t + 1) * kstep;
            const char* a2 = last ? nA : cA + (size_t)(t + 2) * kstep; const char* b2 = last ? nB : cB + (size_t)(t + 2) * kstep;
            const char* a3 = a2 + kstep; const char* b3 = b2 + kstep;
            if (last && has_next) S.a_ready(nxt);
            if constexpr (SP2) {
            PG8_LDB(B0, 0, 0); PG8_LDB(B1, 0, 1); PG8_SCHED; PG8_LDA(At, 0, 0); PG8_STAGE(PG8_SA(1, 1), a1 + hstep, voffA);
            PG8_WAIT_V(8); PG8_WAIT_L(0); PG8_BAR; PG8_MMA(0, 0, At, B0); PG8_MMA(0, 1, At, B1); PG8_BAR; PG8_SCHED;
            PG8_LDA(At, 0, 1); PG8_STAGE(PG8_SB(0, 0), b2, voffB); PG8_STAGE(PG8_SB(0, 1), b2 + hstep, voffB); PG8_STAGE(PG8_SA(0, 0), a2, voffA);
            PG8_WAIT_V(8); PG8_WAIT_L(0); PG8_BAR; PG8_MMA(1, 0, At, B0); PG8_MMA(1, 1, At, B1); PG8_BAR; PG8_SCHED;
            PG8_LDB(B0, 1, 0); PG8_LDB(B1, 1, 1); PG8_SCHED; PG8_LDA(At, 1, 0); PG8_STAGE(PG8_SA(0, 1), a2 + hstep, voffA);
            PG8_WAIT_V(8); PG8_WAIT_L(0); PG8_BAR; PG8_MMA(0, 0, At, B0); PG8_MMA(0, 1, At, B1); PG8_BAR; PG8_SCHED;
            PG8_LDA(At, 1, 1); PG8_STAGE(PG8_SB(1, 0), b3, voffB); PG8_STAGE(PG8_SB(1, 1), b3 + hstep, voffB); PG8_STAGE(PG8_SA(1, 0), a3, voffA);
            PG8_WAIT_V(8); PG8_WAIT_L(0); PG8_BAR; PG8_MMA(1, 0, At, B0); PG8_MMA(1, 1, At, B1); PG8_BAR; PG8_SCHED;
            } else {
            PG8_LDB(B0, 0, 0); PG8_SCHED; PG8_LDA(At, 0, 0); PG8_STAGE(PG8_SA(1, 1), a1 + hstep, voffA);
            PG8_WAIT_L(8); PG8_BAR; PG8_WAIT_L(0); PG8_MMA(0, 0, At, B0); PG8_BAR; PG8_SCHED;
            PG8_LDB(B1, 0, 1); PG8_STAGE(PG8_SB(0, 0), b2, voffB);
            PG8_BAR; PG8_WAIT_L(0); PG8_MMA(0, 1, At, B1); PG8_BAR;
            PG8_LDA(At, 0, 1); PG8_STAGE(PG8_SA(0, 0), a2, voffA);
            PG8_BAR; PG8_WAIT_L(0); PG8_MMA(1, 0, At, B0); PG8_BAR; PG8_SCHED;
            PG8_STAGE(PG8_SB(0, 1), b2 + hstep, voffB);
            PG8_WAIT_V(6); PG8_BAR; PG8_MMA(1, 1, At, B1); PG8_BAR;
            PG8_LDB(B0, 1, 0); PG8_SCHED; PG8_LDA(At, 1, 0); PG8_STAGE(PG8_SA(0, 1), a2 + hstep, voffA);
            PG8_WAIT_L(8); PG8_BAR; PG8_WAIT_L(0); PG8_MMA(0, 0, At, B0); PG8_BAR; PG8_SCHED;
            PG8_LDB(B1, 1, 1); PG8_STAGE(PG8_SB(1, 0), b3, voffB);
            PG8_BAR; PG8_WAIT_L(0); PG8_MMA(0, 1, At, B1); PG8_BAR;
            PG8_LDA(At, 1, 1); PG8_STAGE(PG8_SA(1, 0), a3, voffA);
            PG8_BAR; PG8_WAIT_L(0); PG8_MMA(1, 0, At, B0); PG8_BAR; PG8_SCHED;
            PG8_STAGE(PG8_SB(1, 1), b3 + hstep, voffB);
            PG8_WAIT_V(6); PG8_BAR; PG8_MMA(1, 1, At, B1); PG8_BAR;
            }
        }
        if constexpr (ALIGN_EPI) { if (wr == 0) PG8_BAR; }
        if constexpr (!Epi::AFTER_DRAIN) { E(acc, cur, wr, wc, fr, fq); S.done(cur); }
        if (!has_next) break;
#pragma unroll
        for (int a = 0; a < 2; ++a)
#pragma unroll
            for (int b = 0; b < 2; ++b)
#pragma unroll
                for (int m = 0; m < 4; ++m)
#pragma unroll
                    for (int n = 0; n < 2; ++n) acc[a][b][m][n] = (f32x4){0.f, 0.f, 0.f, 0.f};
        cur = nxt; cA = nA; cB = nB; ++ui;
        if constexpr (ALIGN_EPI) { if (wr == 1) PG8_BAR; }
    }
    PG8_WAIT_V(0);
    if constexpr (!ALIGN_EPI) { if (wr == 0) PG8_BAR; }
    PG8_BAR;
    if constexpr (Epi::AFTER_DRAIN) { E.fused(acc, cur, wr, wc, fr, fq, lds, wid, lane); S.done(cur); }
#undef PG8_SA
#undef PG8_SB
#undef PG8_STAGE
#undef PG8_LDA
#undef PG8_LDB
#undef PG8_MMA
#undef PG8_WAIT_V
#undef PG8_WAIT_L
#undef PG8_BAR
#undef PG8_SCHED
}
}

constexpr int NWAVES = 8, NTHREADS = 512;
constexpr int RING_BYTES = 131072, LDS_BYTES = 163840, LDSCTL_OFF = LDS_BYTES - 512, MISC_OFF = LDSCTL_OFF + 320;
#define GAS __attribute__((address_space(1)))
typedef unsigned v4u __attribute__((ext_vector_type(4)));
typedef GAS unsigned gu32;
#define LDS_WAIT() asm volatile("s_waitcnt lgkmcnt(0)" ::: "memory")
#define VM_WAIT() asm volatile("s_waitcnt vmcnt(0)" ::: "memory")
__device__ __forceinline__ unsigned pk2(float lo, float hi) { return cvtpk(lo, hi); }
constexpr int CW_BAR = 4096, CW_Q = 65536;
constexpr size_t CTL_ZERO_BYTES = 1 * MiB;

#define XB_TMO      128
#define XB_XCNT(j)  (256  + 64 * (j))
#define XB_XSUB(j)  (1280 + 64 * (j))
#define XB_XGEN(j)  (2304 + 64 * (j))
#define XB_TOP      3328
#define XB_TOPGEN   3392
#define XCD_BAR_WORDS 3456
#define XB_SPIN_CAP (1u << 18)

__device__ __forceinline__ unsigned xb_ld(unsigned* p)              { return __hip_atomic_load(p, __ATOMIC_RELAXED, __HIP_MEMORY_SCOPE_AGENT); }
__device__ __forceinline__ unsigned xb_add(unsigned* p, unsigned v) { return __hip_atomic_fetch_add(p, v, __ATOMIC_RELAXED, __HIP_MEMORY_SCOPE_AGENT); }
__device__ __forceinline__ unsigned xb_xcc_id() { return (unsigned)__builtin_amdgcn_s_getreg((3 << 11) | 20) & 0xFu; }
#define XB_SPIN(cond, bar) do { unsigned _sp = 0; while (cond) { __builtin_amdgcn_s_sleep(1); \
    if ((++_sp & 255u) == 0u) { if (xb_ld(&(bar)[XB_TMO])) break; if (_sp > XB_SPIN_CAP) { atomicAdd(&(bar)[XB_TMO], 1u); break; } } } } while (0)

struct XcdBarrier {
    unsigned* bar; unsigned x;
    volatile LAS unsigned* st;
};

__device__ __forceinline__ XcdBarrier xcd_barrier_post(unsigned* bar, volatile LAS unsigned* st) {
    XcdBarrier b; b.bar = bar; b.x = xb_xcc_id(); b.st = st;
    if (threadIdx.x == 0) (void)xb_add(&bar[XB_XCNT(b.x)], 1u);
    return b;
}
__device__ __forceinline__ void xcd_barrier_complete(unsigned* bar, unsigned x, unsigned& nloc, unsigned& nx) {
    const unsigned G = gridDim.x * gridDim.y * gridDim.z;
    unsigned sum, cnt, mine, sp = 0u;
    for (;;) {
        sum = 0u; cnt = 0u; mine = 0u;
#pragma unroll
        for (unsigned j = 0; j < 16; ++j) { const unsigned c = xb_ld(&bar[XB_XCNT(j)]); sum += c; cnt += (c > 0u) ? 1u : 0u; mine = (j == x) ? c : mine; }
        if (sum == G) break;
        __builtin_amdgcn_s_sleep(1);
        if ((++sp & 255u) == 0u) { if (xb_ld(&bar[XB_TMO])) break; if (sp > XB_SPIN_CAP) { atomicAdd(&bar[XB_TMO], 1u); break; } }
    }
    nloc = mine > 0u ? mine : 1u; nx = cnt > 0u ? cnt : 1u;
}

__device__ __forceinline__ void xcd_barrier(const XcdBarrier& b) {
    asm volatile("s_waitcnt vmcnt(0)" ::: "memory");
    __syncthreads();
    if (threadIdx.x == 0) {
        unsigned* bar = b.bar;
        __builtin_amdgcn_s_waitcnt(0);
        unsigned nloc = b.st[0], nx = b.st[1];
        if (nloc == 0u) { xcd_barrier_complete(bar, b.x, nloc, nx); b.st[0] = nloc; b.st[1] = nx; }
        const unsigned old = xb_add(&bar[XB_XSUB(b.x)], 1u);
        const unsigned gen = old / nloc;
        if (old + 1u == (gen + 1u) * nloc) {
            __builtin_amdgcn_fence(__ATOMIC_RELEASE, "agent");
            asm volatile("s_waitcnt vmcnt(0)" ::: "memory");
            const unsigned og = xb_add(&bar[XB_TOP], 1u);
            const unsigned tg = og / nx;
            if (og + 1u == (tg + 1u) * nx) xb_add(&bar[XB_TOPGEN], 1u);
            else XB_SPIN(xb_ld(&bar[XB_TOPGEN]) == tg, bar);
            __builtin_amdgcn_fence(__ATOMIC_ACQUIRE, "agent");
            xb_add(&bar[XB_XGEN(b.x)], 1u);
            asm volatile("s_waitcnt vmcnt(0)" ::: "memory");
        } else {
            XB_SPIN(xb_ld(&bar[XB_XGEN(b.x)]) == gen, bar);
            __builtin_amdgcn_fence(__ATOMIC_ACQUIRE, "agent");
            asm volatile("s_waitcnt vmcnt(0)" ::: "memory");
        }
    }
    __syncthreads();
}


struct Frame {
    LAS unsigned char* lds;
    volatile LAS unsigned* MISC;
    unsigned* ctl;
    int tid, lane, wave, vcu, G;
    const float* const* in; float* out; unsigned char* ws;
};
constexpr int PH_PRO = 0, PH_PRE = 1, PH_L0 = 2, PH_PER_LAYER = 6, PH_G1 = 0, PH_MIXA = 1, PH_MIXB = 2, PH_G3 = 3, PH_G4 = 4, PH_G5 = 5, PH_FINAL = PH_L0 + DEPTH * PH_PER_LAYER, PH_END = PH_FINAL + 1;

__device__ __forceinline__ int queue_next(Frame& F, unsigned* ctr);
constexpr int TR_P = 144;
__device__ __forceinline__ void transpose_item(const float* W, int K, int Nsrc, int src_n0, bf16_t* WT, int dst_n0, int k0, LAS unsigned char* scr, int lane, int nvalid = 64) {
    const int l16 = lane & 15, l4 = lane >> 4;
    f32x4 v[16];
#pragma unroll
    for (int i = 0; i < 16; ++i) v[i] = (src_n0 >= 0 && 4 * l16 < nvalid) ? *(const f32x4*)(W + (size_t)(k0 + 4 * i + l4) * Nsrc + src_n0 + 4 * l16) : (f32x4){0.f, 0.f, 0.f, 0.f};
#pragma unroll
    for (int i = 0; i < 16; ++i)
#pragma unroll
        for (int e = 0; e < 4; ++e) *(LAS bf16_t*)(scr + (4 * l16 + e) * TR_P + (4 * i + l4) * 2) = f2bf(v[i][e]);
    LDS_WAIT(); asm volatile("" ::: "memory");
#pragma unroll
    for (int jn = 0; jn < 8; ++jn) { const int n = 8 * jn + (lane >> 3), c = lane & 7;
        *(v4u*)(WT + (size_t)(dst_n0 + n) * K + k0 + 8 * c) = *(LAS const v4u*)(scr + n * TR_P + c * 16); }
    LDS_WAIT(); asm volatile("" ::: "memory");
}
__device__ __forceinline__ void phase_prologue(Frame& F) {
    const float* const* in = F.in;
    for (int idx = F.vcu * NTHREADS + F.tid; idx < 8192; idx += F.G * NTHREADS) {
        const int pp = idx & 63, g = (idx >> 6) & 15, dir = (idx >> 10) & 1, l = idx >> 11;
        const float are = in[20][idx], aim = in[21][idx];
        const float dt = __expf(in[22][(l * 2 + dir) * 16 + g]);
        const float zr = are * dt, zi = aim * dt;
        const float e = expf(zr); float rev = zi * 0.15915494309189535f; rev -= rintf(rev);
        const float ar = e * cosf(rev * 6.283185307179586f), ai = e * sinf(rev * 6.283185307179586f);
        float* abar = (float*)(F.ws + OFF_TAB + TAB_ABAR);
        abar[idx * 2] = ar; abar[idx * 2 + 1] = ai;
        const float xr = ar - 1.f, xi = ai, den = are * are + aim * aim;
        const float fr = (xr * are + xi * aim) / den, fi = (xi * are - xr * aim) / den;
        for (int c = 0; c < 16; ++c) {
            const float br = in[23][((l * 16 + g) * 64 + pp) * 16 + c], bi = in[24][((l * 16 + g) * 64 + pp) * 16 + c];
            bf16_t* bbt = (bf16_t*)(F.ws + OFF_TAB + TAB_BBT) + ((size_t)(((l * 2 + dir) * 16 + g) * 2) * 64 + pp) * 16 + c;
            bbt[0] = f2bf(fr * br - fi * bi); bbt[64 * 16] = f2bf(fr * bi + fi * br);
        }
    }
    for (int i = F.vcu * NTHREADS + F.tid; i < 4 * 16 * 16 * 128; i += F.G * NTHREADS) {
        const int k = i & 127, c = (i >> 7) & 15, g = (i >> 11) & 15, l = i >> 15, ri = k >> 6, pp = k & 63;
        const size_t si = ((size_t)(l * 16 + g) * 16 + c) * 64 + pp;
        ((bf16_t*)(F.ws + OFF_TAB + TAB_CC1))[i] = f2bf(ri ? -in[26][si] : in[25][si]);
    }
    for (int i = F.vcu * NTHREADS + F.tid; i < 2 * 3145728 / 8; i += F.G * NTHREADS) {
        const int which = i >= 3145728 / 8; const size_t e = (size_t)(which ? i - 3145728 / 8 : i) * 8;
        const float* src = in[which ? 3 : 2] + e; const f32x4 a = *(const f32x4*)src, b = *(const f32x4*)(src + 4);
        v4u o; o[0] = pk2(a[0], a[1]); o[1] = pk2(a[2], a[3]); o[2] = pk2(b[0], b[1]); o[3] = pk2(b[2], b[3]);
        *(v4u*)((bf16_t*)(F.ws + (which ? OFF_CV : OFF_CK)) + e) = o;
    }
    constexpr int I_IN = 16 * (PNP / 64), I_OUT = 16 * 16, I_F1 = 16 * (DFF / 64), I_F2 = (DFF / 64) * 16, I_GLU = 4 * 4, I_L = I_IN + I_OUT + I_F1 + I_F2 + I_GLU, N_TR = DEPTH * I_L;
    constexpr int N_UNITS = 96 + (N_TR + 7) / 8;
    unsigned* ctr = F.ctl + CW_Q + 64 * 63;
    for (;;) {
        const int u = queue_next(F, ctr); if (u >= N_UNITS) break;
        if (u < 96) {
            LAS float* ssil = (LAS float*)F.lds;
            LAS float* part = (LAS float*)(F.lds + 9 * 1024 * 4);
            for (int i = F.tid; i < 9 * 1024; i += NTHREADS) { const int r = i >> 10, k = i & 1023; const float v = r == 0 ? in[8][k] : in[7][(r - 1) * 1024 + k]; ssil[i] = silu_f(v); }
            __syncthreads();
            const int l = u / 24, n0 = (u % 24) * 256;
            const float* w = in[9] + (size_t)l * 1024 * 6144 + n0 + 4 * F.lane;
            f32x4 acc[9];
#pragma unroll
            for (int r = 0; r < 9; ++r) acc[r] = (f32x4){0.f, 0.f, 0.f, 0.f};
            const int kb = F.wave * 128;
            for (int k = 0; k < 128; k += 4) {
                f32x4 wv[4];
#pragma unroll
                for (int e = 0; e < 4; ++e) wv[e] = *(const f32x4*)(w + (size_t)(kb + k + e) * 6144);
#pragma unroll
                for (int r = 0; r < 9; ++r) { const f32x4 sv = *(LAS const f32x4*)(ssil + r * 1024 + kb + k);
                    acc[r] += wv[0] * sv[0]; acc[r] += wv[1] * sv[1]; acc[r] += wv[2] * sv[2]; acc[r] += wv[3] * sv[3]; }
            }
#pragma unroll
            for (int r = 0; r < 9; ++r) *(LAS f32x4*)(part + (F.wave * 9 + r) * 256 + 4 * F.lane) = acc[r];
            __syncthreads();
            float* mods = (float*)(F.ws + OFF_MODS);
            for (int i = F.tid; i < 9 * 256; i += NTHREADS) { const int r = i >> 8, jn = i & 255; float sacc = in[10][l * 6144 + n0 + jn];
#pragma unroll
                for (int w8 = 0; w8 < 8; ++w8) sacc += part[(w8 * 9 + r) * 256 + jn];
                mods[(size_t)(l * 9 + r) * 6144 + n0 + jn] = sacc; }
        } else {
            const int it = (u - 96) * 8 + F.wave;
            if (it < N_TR) {
                LAS unsigned char* scr = F.lds + F.wave * (64 * TR_P);
                const int l = it / I_L; int r = it % I_L;
                if (r < I_IN) { const int nb = r % (PNP / 64), kb = r / (PNP / 64), n0 = nb * 64; const int src = n0 > PN ? -1 : (n0 == PN ? 1024 : (n0 >= 1024 ? n0 + 12 : n0));
                    transpose_item(in[13] + (size_t)l * 1024 * IN_COLS, 1024, IN_COLS, src, (bf16_t*)(F.ws + OFF_WIN) + (size_t)l * PNP * 1024, n0, kb * 64, scr, F.lane, n0 == PN ? 12 : 64); }
                else if ((r -= I_IN) < I_OUT) { const int nb = r % 16, kb = r / 16; transpose_item(in[31] + (size_t)l * 1024 * 1024, 1024, 1024, nb * 64, (bf16_t*)(F.ws + OFF_WOUT) + (size_t)l * 1024 * 1024, nb * 64, kb * 64, scr, F.lane); }
                else if ((r -= I_OUT) < I_F1) { const int nb = r % (DFF / 64), kb = r / (DFF / 64); transpose_item(in[32] + (size_t)l * 1024 * DFF, 1024, DFF, nb * 64, (bf16_t*)(F.ws + OFF_WFF1) + (size_t)l * DFF * 1024, nb * 64, kb * 64, scr, F.lane); }
                else if ((r -= I_F1) < I_F2) { const int nb = r % 16, kb = r / 16; transpose_item(in[33] + (size_t)l * DFF * 1024, DFF, 1024, nb * 64, (bf16_t*)(F.ws + OFF_WFF2) + (size_t)l * 1024 * DFF, nb * 64, kb * 64, scr, F.lane); }
                else { r -= I_F2; const int nb = r % 4, kb = r / 4; transpose_item(in[28] + (size_t)l * 65536, 256, 256, nb * 64, (bf16_t*)(F.ws + OFF_WGLU) + (size_t)l * 65536, nb * 64, kb * 64, scr, F.lane); }
            }
        }
    }
}
__device__ __forceinline__ void phase_pre(Frame& F) {
    const float* const* in = F.in; const int lane = F.lane;
    for (int row = F.vcu * NWAVES + F.wave; row < M; row += F.G * NWAVES) {
        const float* xr = row < MC ? in[0] + (size_t)row * D : in[1] + (size_t)(row - MC) * D;
        const float* sc = (const float*)(F.ws + OFF_MODS) + (size_t)mod_row(row) * 6144 + 1024; const float* gw = in[11];
        bf16_t* h = (bf16_t*)(F.ws + OFF_H) + (size_t)row * D;
        float s = 0.f;
#pragma unroll
        for (int j = 0; j < 4; ++j) { const int c = 4 * lane + 256 * j; const f32x4 v = *(const f32x4*)(xr + c), g = *(const f32x4*)(gw + c), a = *(const f32x4*)(sc + c);
            s += v.x * v.x + v.y * v.y + v.z * v.z + v.w * v.w;
            uint2 o; o.x = pk2(v.x * g.x * (1.f + a.x), v.y * g.y * (1.f + a.y)); o.y = pk2(v.z * g.z * (1.f + a.z), v.w * g.w * (1.f + a.w)); *(uint2*)(h + c) = o; }
        s = wave_sum(s);
        if (lane < 16) ((float*)(F.ws + OFF_TAB + TAB_SQ1))[(size_t)row * 16 + lane] = lane == 0 ? s : 0.f;
    }
    const int fr = lane & 15, fq = lane >> 4, w = F.wave;
    LAS float* red = (LAS float*)F.lds;
    for (int task = F.vcu; task < DEPTH * 104; task += F.G) {
        const int l = task / 104, t = task % 104, which = t >= 40, n0 = (which ? t - 40 : t) * 64;
        const float* mods = (const float*)(F.ws + OFF_MODS) + (size_t)l * 9 * 6144 + (which ? 3 : 0) * 1024;
        const bf16_t* wt = which ? (const bf16_t*)(F.ws + OFF_WFF1) + (size_t)l * DFF * 1024 : (const bf16_t*)(F.ws + OFF_WIN) + (size_t)l * PNP * 1024;
        float* bo = (float*)(F.ws + OFF_TAB + (which ? TAB_B2 : TAB_B1)) + (size_t)l * 9 * (which ? DFF : PNP);
        f32x4 acc[4];
#pragma unroll
        for (int nb = 0; nb < 4; ++nb) acc[nb] = (f32x4){0.f, 0.f, 0.f, 0.f};
#pragma unroll
        for (int ks = 0; ks < 4; ++ks) {
            const int k0 = 128 * w + 32 * ks + 8 * fq;
            union { bf16x8 v; unsigned u[4]; } af; af.u[0] = af.u[1] = af.u[2] = af.u[3] = 0u;
            if (fr < 9) { const f32x4 a0 = *(const f32x4*)(mods + (size_t)fr * 6144 + k0), a1 = *(const f32x4*)(mods + (size_t)fr * 6144 + k0 + 4);
                af.u[0] = pk2(a0[0], a0[1]); af.u[1] = pk2(a0[2], a0[3]); af.u[2] = pk2(a1[0], a1[1]); af.u[3] = pk2(a1[2], a1[3]); }
#pragma unroll
            for (int nb = 0; nb < 4; ++nb) { const bf16x8 bfr = *(const bf16x8*)(wt + (size_t)(n0 + 16 * nb + fr) * 1024 + k0); acc[nb] = __builtin_amdgcn_mfma_f32_16x16x32_bf16(af.v, bfr, acc[nb], 0, 0, 0); }
        }
        __syncthreads();
#pragma unroll
        for (int nb = 0; nb < 4; ++nb) *(LAS f32x4*)(red + ((w * 4 + nb) * 64 + lane) * 4) = acc[nb];
        __syncthreads();
        for (int i = F.tid; i < 1024; i += NTHREADS) { float sacc = 0.f;
#pragma unroll
            for (int w8 = 0; w8 < 8; ++w8) sacc += red[w8 * 1024 + i];
            const int nb = i >> 8, ln = (i >> 2) & 63, e = i & 3, r = 4 * (ln >> 4) + e;
            if (r < 9) bo[(size_t)r * (which ? DFF : PNP) + n0 + 16 * nb + (ln & 15)] = sacc; }
    }
}
constexpr int EPI_SIDE_OFF = RING_BYTES;
template <class Sched>
__device__ __forceinline__ void epi_side_fill(Frame& F, const Sched& S, const float* ssq, const float* bias, int ldb) {
    LAS float* side = (LAS float*)(F.lds + EPI_SIDE_OFF);
    pg8::Unit u;
    for (int i = 0; i < 4 && S.next(i, u); ++i) {
        if (F.tid < 256) { const f32x4* p = (const f32x4*)(ssq + (size_t)(u.pm * 256 + F.tid) * 16); const f32x4 a = p[0], b = p[1], c = p[2], d = p[3];
            const float sm = ((a[0] + a[1]) + (a[2] + a[3])) + ((b[0] + b[1]) + (b[2] + b[3])) + ((c[0] + c[1]) + (c[2] + c[3])) + ((d[0] + d[1]) + (d[2] + d[3]));
            side[i * 256 + F.tid] = rsqrtf(sm * (1.f / 1024.f) + EPS); }
        else { const int r = u.pm < 32 ? 0 : 1 + ((u.pm - 32) >> 2); side[1024 + i * 256 + F.tid - 256] = bias[(size_t)r * ldb + u.pn * 256 + F.tid - 256]; }
    }
    __syncthreads();
}
__device__ __forceinline__ void phase_final(Frame& F) {
    const int lane = F.lane; const float* gw = F.in[34];
    for (int row = F.vcu * NWAVES + F.wave; row < M; row += F.G * NWAVES) {
        const bf16_t* xr = (const bf16_t*)(F.ws + OFF_X) + (size_t)row * D;
        f32x4 v[4]; float s = 0.f;
#pragma unroll
        for (int j = 0; j < 4; ++j) { const uint2 q = *(const uint2*)(xr + 4 * lane + 256 * j); v[j] = (f32x4){__uint_as_float(q.x << 16), __uint_as_float(q.x & 0xffff0000u), __uint_as_float(q.y << 16), __uint_as_float(q.y & 0xffff0000u)};
            s += v[j].x * v[j].x + v[j].y * v[j].y + v[j].z * v[j].z + v[j].w * v[j].w; }
        const float rstd = rsqrtf(wave_sum(s) * (1.f / D) + EPS);
        float* o = F.out + (size_t)row * D;
#pragma unroll
        for (int j = 0; j < 4; ++j) { const int c = 4 * lane + 256 * j; const f32x4 g = *(const f32x4*)(gw + c); f32x4 r = {v[j].x * rstd * g.x, v[j].y * rstd * g.y, v[j].z * rstd * g.z, v[j].w * rstd * g.w}; *(f32x4*)(o + c) = r; }
    }
}


typedef short v4i16_t __attribute__((ext_vector_type(4)));
constexpr int AT_KP = 160;
constexpr int AT_TILE = 128 * AT_KP;
constexpr int AT_K0 = 0, AT_V0 = 2 * AT_TILE, AT_RPB = 4 * AT_TILE, AT_END = AT_RPB + 2048;
__device__ __forceinline__ int queue_next(Frame& F, unsigned* ctr) {
    int t_ = threadIdx.x; asm volatile("" : "+v"(t_));
    unsigned slot = MISC_OFF + 64; asm volatile("" : "+v"(slot));
    volatile LAS unsigned* bw = (volatile LAS unsigned*)(F.lds + slot);
    __syncthreads();
    if (t_ == 0) *bw = atomicAdd(ctr, 1u);
    __syncthreads();
    F.tid = t_; F.lane = t_ & 63;
    return (int)*bw;
}
__device__ __forceinline__ bf16x8 tr2(LAS const unsigned char* a, LAS const unsigned char* b) {
    const v4i16_t x = __builtin_amdgcn_ds_read_tr16_b64_v4i16((LAS v4i16_t*)a), y = __builtin_amdgcn_ds_read_tr16_b64_v4i16((LAS v4i16_t*)b);
    return (bf16x8){x[0], x[1], x[2], x[3], y[0], y[1], y[2], y[3]};
}
struct AttnState { f32x4 o[4]; float m, l; };
template <int NKB, bool MASKED>
__device__ __forceinline__ void attn_tile(AttnState& st, LAS const unsigned char* Kt, LAS const unsigned char* Vt, const bf16x8 (&qf)[2], int c0, int lane,
                                          LAS const float* rpbrow, int cw, int qc) {
    const int fr = lane & 15, fq = lane >> 4;
    f32x4 s[NKB];
#pragma unroll
    for (int kb = 0; kb < NKB; ++kb) {
        s[kb] = (f32x4){0.f, 0.f, 0.f, 0.f};
#pragma unroll
        for (int ks = 0; ks < 2; ++ks) {
            const bf16x8 a = *(LAS const bf16x8*)(Kt + (c0 + 16 * kb + fr) * AT_KP + (32 * ks + 8 * fq) * 2);
            s[kb] = __builtin_amdgcn_mfma_f32_16x16x32_bf16(a, qf[ks], s[kb], 0, 0, 0);
        }
    }
    float mloc = -1e30f;
#pragma unroll
    for (int kb = 0; kb < NKB; ++kb)
#pragma unroll
        for (int i = 0; i < 4; ++i) {
            float t = s[kb][i] * 0.125f;
            if (MASKED) { const int kc = cw + 16 * kb + 4 * fq + i, cs = min(max(qc - 8, 0), 48); t = (kc >= cs && kc < cs + 16) ? t + rpbrow[kc - qc + 15] : -1e30f; }
            s[kb][i] = t; mloc = fmaxf(mloc, t);
        }
    mloc = xmax32(xmax16(mloc));
    const float mn = fmaxf(st.m, mloc), alpha = __expf(st.m - mn);
    st.m = mn;
    float ls = 0.f;
#pragma unroll
    for (int kb = 0; kb < NKB; ++kb)
#pragma unroll
        for (int i = 0; i < 4; ++i) { const float pv = __expf(s[kb][i] - mn); s[kb][i] = pv; ls += pv; }
    st.l = st.l * alpha + ls;
#pragma unroll
    for (int db = 0; db < 4; ++db) st.o[db] = st.o[db] * alpha;
#pragma unroll
    for (int kk = 0; kk < NKB / 2; ++kk) {
        union { bf16x8 v; unsigned u[4]; } pf;
        pf.u[0] = pk2(s[2 * kk][0], s[2 * kk][1]); pf.u[1] = pk2(s[2 * kk][2], s[2 * kk][3]);
        pf.u[2] = pk2(s[2 * kk + 1][0], s[2 * kk + 1][1]); pf.u[3] = pk2(s[2 * kk + 1][2], s[2 * kk + 1][3]);
        LAS const unsigned char* va = Vt + (c0 + 32 * kk + 4 * fq + (fr >> 2)) * AT_KP + (4 * (fr & 3)) * 2;
#pragma unroll
        for (int db = 0; db < 4; ++db) {
            const bf16x8 vf = tr2(va + db * 32, va + 16 * AT_KP + db * 32);
            st.o[db] = __builtin_amdgcn_mfma_f32_16x16x32_bf16(vf, pf.v, st.o[db], 0, 0, 0);
        }
    }
}
struct AttnChain { AttnState st; bf16x8 qf[2]; int qrow, c0; };
__device__ __forceinline__ void attn_chain_init(AttnChain& ch, const bf16_t* proj, int qrow, int c0, int h, bool nat, int fq) {
    ch.qrow = qrow; ch.c0 = c0;
#pragma unroll
    for (int ks = 0; ks < 2; ++ks) ch.qf[ks] = *(const bf16x8*)(proj + (size_t)qrow * PN + PQ + h * 64 + 32 * ks + 8 * fq);
    ch.st.m = -1e30f; ch.st.l = 0.f;
#pragma unroll
    for (int db = 0; db < 4; ++db) ch.st.o[db] = (f32x4){0.f, 0.f, 0.f, 0.f};
}
__device__ __forceinline__ void attn_chain_store(const AttnChain& ch, bf16_t* mixb, int h, int fq) {
    const float inv = 1.f / xsum32(xsum16(ch.st.l));
    bf16_t* mix = mixb + (size_t)ch.qrow * D + 640 + h * 64 + 4 * fq;
#pragma unroll
    for (int db = 0; db < 4; ++db) { uint2 o; o.x = pk2(ch.st.o[db][0] * inv, ch.st.o[db][1] * inv); o.y = pk2(ch.st.o[db][2] * inv, ch.st.o[db][3] * inv); *(uint2*)(mix + 16 * db) = o; }
}
__device__ __forceinline__ void attn_unit(Frame& F, int l, int unit) {
    const int tid = F.tid, w = F.wave, fr = F.lane & 15, fq = F.lane >> 4;
    const bf16_t* proj = (const bf16_t*)(F.ws + OFF_PROJ);
    LAS unsigned char* lds = F.lds;
    const bool nat = unit < 192;
    int b, h, r = 0, rs_w = 0, rs0 = 0, nlat = 0;
    AttnChain ch0, ch1;
    if (nat) { b = unit / 24; h = (unit / 4) % 6; const int rq = unit % 4; r = 4 * rq + (w >> 1);
        rs_w = min(max(r - 4, 0), 8); rs0 = min(max(4 * rq - 4, 0), 8); const int rsl = min(max(4 * rq + 3 - 4, 0), 8); nlat = rsl + 8 - rs0;
        const int qb = MC + b * 1024 + r * 64 + fr;
        if (w & 1) { attn_chain_init(ch0, proj, qb + 32, 24, h, true, fq); attn_chain_init(ch1, proj, qb + 48, 32, h, true, fq); }
        else { attn_chain_init(ch0, proj, qb, 0, h, true, fq); attn_chain_init(ch1, proj, qb + 16, 8, h, true, fq); }
    } else { const int v = unit - 192; b = v / 6; h = v % 6; const int qb = b * 256 + 32 * w + fr;
        attn_chain_init(ch0, proj, qb, 0, h, false, fq); attn_chain_init(ch1, proj, qb + 16, 0, h, false, fq); }
    const int nlt = (nlat + 1) >> 1;
    const int ntiles = nat ? nlt + 2 : 2;
    if (nat) { const float* rpb = F.in[30] + (size_t)(l * 6 + h) * 465; for (int i = tid; i < 465; i += NTHREADS) ((LAS float*)(lds + AT_RPB))[i] = rpb[i]; }
    const int skey = tid >> 2, sch = (tid & 3) * 2;
    v4u rk0 = {0u, 0u, 0u, 0u}, rk1 = rk0, rv0 = rk0, rv1 = rk0;
#define AT_LOAD(ti_) do { const int ti__ = (ti_); \
        if (nat && ti__ >= nlt) { const size_t off = ((size_t)(b * 4 + l) * 256 + (ti__ - nlt) * 128 + skey) * 384 + h * 64 + sch * 8; \
            const bf16_t* pk_ = (const bf16_t*)(F.ws + OFF_CK) + off; const bf16_t* pv_ = (const bf16_t*)(F.ws + OFF_CV) + off; \
            rk0 = *(const v4u*)pk_; rk1 = *(const v4u*)(pk_ + 8); rv0 = *(const v4u*)pv_; rv1 = *(const v4u*)(pv_ + 8); \
        } else { const int grow = nat ? MC + b * 1024 + min(rs0 + 2 * ti__ + (skey >> 6), 15) * 64 + (skey & 63) : b * 256 + ti__ * 128 + skey; \
            const bf16_t* pr = proj + (size_t)grow * PN + h * 64 + sch * 8; rk0 = *(const v4u*)(pr + PK); rk1 = *(const v4u*)(pr + PK + 8); rv0 = *(const v4u*)(pr + PV); rv1 = *(const v4u*)(pr + PV + 8); } } while (0)
#define AT_WRITE(buf_) do { const int buf__ = (buf_); \
        *(LAS v4u*)(lds + AT_K0 + buf__ * AT_TILE + skey * AT_KP + sch * 16) = rk0; *(LAS v4u*)(lds + AT_K0 + buf__ * AT_TILE + skey * AT_KP + sch * 16 + 16) = rk1; \
        *(LAS v4u*)(lds + AT_V0 + buf__ * AT_TILE + skey * AT_KP + sch * 16) = rv0; *(LAS v4u*)(lds + AT_V0 + buf__ * AT_TILE + skey * AT_KP + sch * 16 + 16) = rv1; } while (0)
    AT_LOAD(0); AT_WRITE(0);
    __syncthreads();
    for (int ti = 0; ti < ntiles; ++ti) {
        const int buf = ti & 1;
        if (ti + 1 < ntiles) AT_LOAD(ti + 1);
        int lane = F.lane; asm volatile("" : "+v"(lane));
        LAS const unsigned char* Kt = lds + AT_K0 + buf * AT_TILE; LAS const unsigned char* Vt = lds + AT_V0 + buf * AT_TILE;
        if (nat && ti < nlt) {
#pragma unroll
            for (int sub = 0; sub < 2; ++sub) { const int kr = rs0 + 2 * ti + sub;
                if (kr >= rs_w && kr < rs_w + 8) { LAS const float* rrow = (LAS const float*)(lds + AT_RPB) + (kr - r + 7) * 31;
                    attn_tile<2, true>(ch0.st, Kt, Vt, ch0.qf, 64 * sub + ch0.c0, lane, rrow, ch0.c0, (ch0.qrow - MC) & 63); attn_tile<2, true>(ch1.st, Kt, Vt, ch1.qf, 64 * sub + ch1.c0, lane, rrow, ch1.c0, (ch1.qrow - MC) & 63); }
                __builtin_amdgcn_sched_barrier(0); }
        } else {
#pragma unroll
            for (int hf = 0; hf < 2; ++hf) {
                attn_tile<4, false>(ch0.st, Kt, Vt, ch0.qf, 64 * hf, lane, (LAS const float*)(lds + AT_RPB), 0, 0);
                attn_tile<4, false>(ch1.st, Kt, Vt, ch1.qf, 64 * hf, lane, (LAS const float*)(lds + AT_RPB), 0, 0); __builtin_amdgcn_sched_barrier(0); }
        }
        if (ti + 1 < ntiles) AT_WRITE(buf ^ 1);
        __syncthreads();
    }
    attn_chain_store(ch0, (bf16_t*)(F.ws + OFF_MIX), h, fq); attn_chain_store(ch1, (bf16_t*)(F.ws + OFF_MIX), h, fq);
}
constexpr int SS_P = 144;
constexpr int SS_IMG = 128 * SS_P;
constexpr int SS_HP = 144, SS_HIMG = 64 * SS_HP;
constexpr int SSA_B = 0, SSA_X = SS_IMG, SSA_TAB = 7 * SS_IMG;
constexpr int SSB_B = 0, SSB_C = SS_IMG, SSB_X = 2 * SS_IMG, SSB_H = 5 * SS_IMG, SSB_TAB = 5 * SS_IMG + 6 * SS_HIMG;
static_assert(SSB_TAB + 3 * 4 * 128 * 4 <= 163328 && SSA_TAB + 3 * 4 * 128 * 4 <= 163328, "SSD LDS map");
__device__ __forceinline__ void conv16(const bf16_t* proj, const float* cw, const float* cb, int seq_start, int seq_L, int t, int ch0, float (&v)[16]) {
#pragma unroll
    for (int e = 0; e < 16; e += 4) { const f32x4 b = *(const f32x4*)(cb + ch0 + e); v[e] = b[0]; v[e + 1] = b[1]; v[e + 2] = b[2]; v[e + 3] = b[3]; }
#pragma unroll
    for (int j = 0; j < 5; ++j) {
        const int tt = t + j - 2;
        if (tt >= 0 && tt < seq_L) {
            const bf16_t* src = proj + (size_t)(seq_start + tt) * PN + PX + ch0;
            const v4u r0 = *(const v4u*)src, r1 = *(const v4u*)(src + 8);
            const unsigned rr[8] = {r0[0], r0[1], r0[2], r0[3], r1[0], r1[1], r1[2], r1[3]};
#pragma unroll
            for (int e = 0; e < 16; e += 4) { const f32x4 w = *(const f32x4*)(cw + j * 640 + ch0 + e);
                v[e] += w[0] * __uint_as_float(rr[e / 2] << 16); v[e + 1] += w[1] * __uint_as_float(rr[e / 2] & 0xffff0000u);
                v[e + 2] += w[2] * __uint_as_float(rr[e / 2 + 1] << 16); v[e + 3] += w[3] * __uint_as_float(rr[e / 2 + 1] & 0xffff0000u); }
        }
    }
#pragma unroll
    for (int e = 0; e < 16; ++e) v[e] = silu_f(v[e]);
}
__device__ __forceinline__ void conv4x8(const bf16_t* proj, const float* cw, const float* cb, int seq_start, int seq_L, int t, int ch0, float (&v)[4][8]) {
    float xin[8][8];
#pragma unroll
    for (int rr = 0; rr < 8; ++rr) { const int tt = t - 2 + rr; v4u r = {0u, 0u, 0u, 0u};
        if (tt >= 0 && tt < seq_L) r = *(const v4u*)(proj + (size_t)(seq_start + tt) * PN + PX + ch0);
#pragma unroll
        for (int e = 0; e < 4; ++e) { xin[rr][2 * e] = __uint_as_float(r[e] << 16); xin[rr][2 * e + 1] = __uint_as_float(r[e] & 0xffff0000u); } }
    const f32x4 b0 = *(const f32x4*)(cb + ch0), b1 = *(const f32x4*)(cb + ch0 + 4);
#pragma unroll
    for (int k = 0; k < 4; ++k) { v[k][0] = b0[0]; v[k][1] = b0[1]; v[k][2] = b0[2]; v[k][3] = b0[3]; v[k][4] = b1[0]; v[k][5] = b1[1]; v[k][6] = b1[2]; v[k][7] = b1[3]; }
#pragma unroll
    for (int j = 0; j < 5; ++j) { const f32x4 w0 = *(const f32x4*)(cw + j * 640 + ch0), w1 = *(const f32x4*)(cw + j * 640 + ch0 + 4);
#pragma unroll
        for (int k = 0; k < 4; ++k) { v[k][0] += w0[0] * xin[k + j][0]; v[k][1] += w0[1] * xin[k + j][1]; v[k][2] += w0[2] * xin[k + j][2]; v[k][3] += w0[3] * xin[k + j][3];
            v[k][4] += w1[0] * xin[k + j][4]; v[k][5] += w1[1] * xin[k + j][5]; v[k][6] += w1[2] * xin[k + j][6]; v[k][7] += w1[3] * xin[k + j][7]; } }
#pragma unroll
    for (int k = 0; k < 4; ++k)
#pragma unroll
        for (int e = 0; e < 8; ++e) v[k][e] = silu_f(v[k][e]);
}
__device__ __forceinline__ void store8(LAS unsigned char* dst, const float (&v)[8], float sc) {
    v4u o; o[0] = pk2(v[0] * sc, v[1] * sc); o[1] = pk2(v[2] * sc, v[3] * sc); o[2] = pk2(v[4] * sc, v[5] * sc); o[3] = pk2(v[6] * sc, v[7] * sc);
    *(LAS v4u*)dst = o;
}
__device__ __forceinline__ void store16(LAS unsigned char* dst, const float (&v)[16], float sc) {
    v4u o0, o1;
    o0[0] = pk2(v[0] * sc, v[1] * sc); o0[1] = pk2(v[2] * sc, v[3] * sc); o0[2] = pk2(v[4] * sc, v[5] * sc); o0[3] = pk2(v[6] * sc, v[7] * sc);
    o1[0] = pk2(v[8] * sc, v[9] * sc); o1[1] = pk2(v[10] * sc, v[11] * sc); o1[2] = pk2(v[12] * sc, v[13] * sc); o1[3] = pk2(v[14] * sc, v[15] * sc);
    *(LAS v4u*)dst = o0; *(LAS v4u*)(dst + 16) = o1;
}
__device__ __forceinline__ void ssd_table(const float* dtraw  , float bias, float a, int dir, LAS float* tab, int lane) {
    const float d0 = softplus_f(dtraw[(2 * lane) * 12] + bias), d1 = softplus_f(dtraw[(2 * lane + 1) * 12] + bias);
    const float ps = d0 + d1; float x = ps;
    x += dppf<0x111>(x); x += dppf<0x112>(x); x += dppf<0x114>(x); x += dppf<0x118>(x);
    { const float t15 = rdlane(x, 15), t31 = rdlane(x, 31), t47 = rdlane(x, 47); const int rw = lane >> 4;
      x += (rw >= 1 ? t15 : 0.f) + (rw >= 2 ? t31 : 0.f) + (rw >= 3 ? t47 : 0.f); }
    tab[2 * lane] = d0; tab[2 * lane + 1] = d1;
    if (dir == 0) { const float ex = x - ps; tab[128 + 2 * lane] = a * (ex + d0); tab[128 + 2 * lane + 1] = a * (ex + ps); }
    else { const float tot = rdlane(x, 63); const float sx = tot - x; tab[128 + 2 * lane + 1] = a * (sx + d1); tab[128 + 2 * lane] = a * (sx + ps); }
}
__device__ __forceinline__ void ssd_a_unit(Frame& F, int l, int unit) {
    const int tid = F.tid, lane = F.lane, w = F.wave, fr = lane & 15, fq = lane >> 4;
    const int ci = unit >> 1, g = unit & 1, row0 = ci * 128;
    const SeqInfo q = row_seq(row0); const int t0 = row0 - q.start;
    const bf16_t* proj = (const bf16_t*)(F.ws + OFF_PROJ);
    const float* cw = F.in[14] + l * 5 * 640; const float* cb = F.in[15] + l * 640;
    LAS unsigned char* lds = F.lds; LAS float* tabs = (LAS float*)(lds + SSA_TAB);
    if (w < 6) { const int hh = w >> 1, dir = w & 1, h = 3 * g + hh;
        ssd_table((const float*)(F.ws + OFF_DT) + (size_t)row0 * 12 + dir * 6 + h, F.in[16][(l * 2 + dir) * 6 + h], -__expf(F.in[17][(l * 2 + dir) * 6 + h]), dir, tabs + (hh * 4 + dir * 2) * 128, lane); }
    float cv[2][4][8];
#pragma unroll
    for (int k2 = 0; k2 < 2; ++k2) { const int task = tid + k2 * NTHREADS, img = task >> 8, oc = (task >> 5) & 7, tb = task & 31;
        conv4x8(proj, cw, cb, q.start, q.L, t0 + 4 * tb, (img == 0 ? 384 + g * 64 : (3 * g + img - 1) * 64) + 8 * oc, cv[k2]); }
    __syncthreads();
#pragma unroll
    for (int k2 = 0; k2 < 2; ++k2) { const int task = tid + k2 * NTHREADS, img = task >> 8, oc = (task >> 5) & 7, tb = task & 31;
        if (img == 0) {
#pragma unroll
            for (int k = 0; k < 4; ++k) store8(lds + SSA_B + (4 * tb + k) * SS_P + oc * 16, cv[k2][k], 1.f);
        } else { const int hh = img - 1; LAS const float* tb4 = tabs + hh * 4 * 128;
#pragma unroll
            for (int k = 0; k < 4; ++k) { const int t = 4 * tb + k;
                const float wf = __expf(tb4[128 + 127] - tb4[128 + t]) * tb4[t], wb = __expf(tb4[384] - tb4[384 + t]) * tb4[256 + t];
                store8(lds + SSA_X + (2 * hh) * SS_IMG + t * SS_P + oc * 16, cv[k2][k], wf); store8(lds + SSA_X + (2 * hh + 1) * SS_IMG + t * SS_P + oc * 16, cv[k2][k], wb); } }
    }
    __syncthreads();
    const int dir = w >> 2, pb = w & 3;
    for (int hh = 0; hh < 3; ++hh) {
        const int h = 3 * g + hh;
        LAS const unsigned char* xa = lds + SSA_X + (2 * hh + dir) * SS_IMG + (4 * fq + (fr >> 2)) * SS_P + (16 * pb + 4 * (fr & 3)) * 2;
        LAS const unsigned char* ba = lds + SSA_B + (4 * fq + (fr >> 2)) * SS_P + (4 * (fr & 3)) * 2;
        f32x4 acc[4];
#pragma unroll
        for (int nb = 0; nb < 4; ++nb) acc[nb] = (f32x4){0.f, 0.f, 0.f, 0.f};
#pragma unroll
        for (int kk = 0; kk < 4; ++kk) {
            const bf16x8 af = tr2(xa + kk * 32 * SS_P, xa + (kk * 32 + 16) * SS_P);
#pragma unroll
            for (int nb = 0; nb < 4; ++nb) { const bf16x8 bfr = tr2(ba + kk * 32 * SS_P + nb * 32, ba + (kk * 32 + 16) * SS_P + nb * 32); acc[nb] = __builtin_amdgcn_mfma_f32_16x16x32_bf16(af, bfr, acc[nb], 0, 0, 0); }
        }
        float* cs = (float*)(F.ws + OFF_CS) + ((size_t)(ci * 6 + h) * 2 + dir) * 4096;
#pragma unroll
        for (int nb = 0; nb < 4; ++nb)
#pragma unroll
            for (int i = 0; i < 4; ++i) cs[(16 * pb + 4 * fq + i) * 64 + 16 * nb + fr] = acc[nb][i];
        if (tid == 0) { LAS const float* tb = tabs + hh * 4 * 128; float* cd = (float*)(F.ws + OFF_TAB + TAB_CD) + (size_t)(ci * 6 + h) * 2; cd[0] = __expf(tb[128 + 127]); cd[1] = __expf(tb[384]); }
    }
}
__device__ __forceinline__ void ssd_state_pass(Frame& F, int l) {
    const int tid = F.tid, p = tid >> 3, n0 = (tid & 7) * 8;
    const float* cdt = (const float*)(F.ws + OFF_TAB + TAB_CD); const float* csb = (const float*)(F.ws + OFF_CS);
    bf16_t* hin = (bf16_t*)(F.ws + OFF_HIN);
    for (int task = F.vcu; task < NSEQ * 12; task += F.G) {
        int s, hd; if (task < LB * 12) { s = CB + task / 12; hd = task % 12; } else { s = (task - LB * 12) / 12; hd = (task - LB * 12) % 12; }
        const int h = hd >> 1, dir = hd & 1;
        const SeqInfo q = seq_info(s); const int nch = q.L >> 7, ci0 = q.start >> 7;
        f32x4 s0 = {0.f, 0.f, 0.f, 0.f}, s1 = s0;
        if (!q.ctx) { const float* h0 = F.in[4] + ((((size_t)q.b * 4 + l) * 2 + dir) * 6 + h) * 4096 + p * 64 + n0; s0 = *(const f32x4*)h0; s1 = *(const f32x4*)(h0 + 4); }
        for (int k = 0; k < nch; k += 2) {
            size_t ix[2]; float dcy[2]; f32x4 c0[2], c1[2];
#pragma unroll
            for (int u = 0; u < 2; ++u) { const int c = dir == 0 ? k + u : nch - 1 - (k + u); ix[u] = (size_t)((ci0 + c) * 6 + h) * 2 + dir;
                dcy[u] = cdt[ix[u]]; const float* cs = csb + ix[u] * 4096 + p * 64 + n0; c0[u] = *(const f32x4*)cs; c1[u] = *(const f32x4*)(cs + 4); }
#pragma unroll
            for (int u = 0; u < 2; ++u) {
                v4u o; o[0] = pk2(s0[0], s0[1]); o[1] = pk2(s0[2], s0[3]); o[2] = pk2(s1[0], s1[1]); o[3] = pk2(s1[2], s1[3]);
                *(v4u*)(hin + ix[u] * 4096 + p * 64 + n0) = o;
                s0 = s0 * dcy[u] + c0[u]; s1 = s1 * dcy[u] + c1[u];
            }
        }
        if (q.ctx) { float* o4 = F.out + O_SSD + ((((size_t)q.b * 4 + l) * 2 + dir) * 6 + h) * 4096 + p * 64 + n0; *(f32x4*)o4 = s0; *(f32x4*)(o4 + 4) = s1; }
    }
}
__device__ __forceinline__ void ssd_b_unit(Frame& F, int l, int unit) {
    const int tid = F.tid, lane = F.lane, w = F.wave, fr = lane & 15, fq = lane >> 4;
    const int ci = unit >> 1, g = unit & 1, row0 = ci * 128;
    const SeqInfo q = row_seq(row0); const int t0 = row0 - q.start;
    const bf16_t* proj = (const bf16_t*)(F.ws + OFF_PROJ);
    const float* cw = F.in[14] + l * 5 * 640; const float* cb = F.in[15] + l * 640;
    LAS unsigned char* lds = F.lds; LAS float* tabs = (LAS float*)(lds + SSB_TAB);
    if (w < 6) { const int hh = w >> 1, dir = w & 1, h = 3 * g + hh;
        ssd_table((const float*)(F.ws + OFF_DT) + (size_t)row0 * 12 + dir * 6 + h, F.in[16][(l * 2 + dir) * 6 + h], -__expf(F.in[17][(l * 2 + dir) * 6 + h]), dir, tabs + (hh * 4 + dir * 2) * 128, lane); }
    {
        const bf16_t* hin = (const bf16_t*)(F.ws + OFF_HIN) + (size_t)((ci * 6 + 3 * g) * 2) * 4096 + (tid >> 3) * 64 + (tid & 7) * 8;
#pragma unroll
        for (int k = 0; k < 6; ++k) *(LAS v4u*)(lds + SSB_H + k * SS_HIMG + (tid >> 3) * SS_HP + (tid & 7) * 16) = *(const v4u*)(hin + (size_t)k * 4096);
    }
    for (int task = tid; task < 1280; task += NTHREADS) {
        const int img = task >> 8, oc = (task >> 5) & 7, tb = task & 31;
        const int chb = img == 0 ? 384 + g * 64 : (img == 1 ? 512 + g * 64 : (3 * g + img - 2) * 64);
        float v[4][8]; conv4x8(proj, cw, cb, q.start, q.L, t0 + 4 * tb, chb + 8 * oc, v);
        LAS unsigned char* dst = lds + (img == 0 ? SSB_B : (img == 1 ? SSB_C : SSB_X + (img - 2) * SS_IMG)) + (4 * tb) * SS_P + oc * 16;
#pragma unroll
        for (int k = 0; k < 4; ++k) store8(dst + k * SS_P, v[k], 1.f);
    }
    __syncthreads();
    bf16x8 cf[2];
#pragma unroll
    for (int ks = 0; ks < 2; ++ks) cf[ks] = *(LAS const bf16x8*)(lds + SSB_C + (16 * w + fr) * SS_P + (32 * ks + 8 * fq) * 2);
    f32x4 gt[8];
#pragma unroll
    for (int sb = 0; sb < 8; ++sb) { gt[sb] = (f32x4){0.f, 0.f, 0.f, 0.f};
#pragma unroll
        for (int ks = 0; ks < 2; ++ks) { const bf16x8 bfr = *(LAS const bf16x8*)(lds + SSB_B + (16 * sb + fr) * SS_P + (32 * ks + 8 * fq) * 2); gt[sb] = __builtin_amdgcn_mfma_f32_16x16x32_bf16(bfr, cf[ks], gt[sb], 0, 0, 0); } }
    float ss[4] = {0.f, 0.f, 0.f, 0.f};
    bf16_t* yup = (bf16_t*)(F.ws + OFF_MIX) + (size_t)(row0 + 16 * w + 4 * fq) * D + fr;
    for (int hh = 0; hh < 3; ++hh) {
        const int h = 3 * g + hh;
        LAS const float* tb = tabs + hh * 4 * 128;
        unsigned short zv[4][4];
#pragma unroll
        for (int i = 0; i < 4; ++i)
#pragma unroll
            for (int pb = 0; pb < 4; ++pb) zv[i][pb] = proj[(size_t)(row0 + 16 * w + 4 * fq + i) * PN + PZ + h * 64 + 16 * pb + fr];
        const float at = tb[128 + 16 * w + fr], bt = tb[384 + 16 * w + fr];
        f32x4 y[4];
#pragma unroll
        for (int pb = 0; pb < 4; ++pb) y[pb] = (f32x4){0.f, 0.f, 0.f, 0.f};
        LAS const unsigned char* xa = lds + SSB_X + hh * SS_IMG + (4 * fq + (fr >> 2)) * SS_P + (4 * (fr & 3)) * 2;
#pragma unroll
        for (int kk = 0; kk < 4; ++kk) {
            float mv[8];
#pragma unroll
            for (int half = 0; half < 2; ++half) { const int sb = 2 * kk + half; const int s0i = 16 * sb + 4 * fq;
                if (sb < w) { const f32x4 cumf = *(LAS const f32x4*)(tb + 128 + s0i), dtf = *(LAS const f32x4*)(tb + s0i);
#pragma unroll
                    for (int i = 0; i < 4; ++i) mv[half * 4 + i] = __expf(at - cumf[i]) * dtf[i] * gt[sb][i];
                } else if (sb > w) { const f32x4 cumb = *(LAS const f32x4*)(tb + 384 + s0i), dtb = *(LAS const f32x4*)(tb + 256 + s0i);
#pragma unroll
                    for (int i = 0; i < 4; ++i) mv[half * 4 + i] = __expf(bt - cumb[i]) * dtb[i] * gt[sb][i];
                } else { const f32x4 cumf = *(LAS const f32x4*)(tb + 128 + s0i), dtf = *(LAS const f32x4*)(tb + s0i), cumb = *(LAS const f32x4*)(tb + 384 + s0i), dtb = *(LAS const f32x4*)(tb + 256 + s0i);
#pragma unroll
                    for (int i = 0; i < 4; ++i) { const int s = s0i + i, t = 16 * w + fr; float m = 0.f;
                        if (s <= t) m += __expf(at - cumf[i]) * dtf[i];
                        if (s >= t) m += __expf(bt - cumb[i]) * dtb[i];
                        mv[half * 4 + i] = m * gt[sb][i]; } } }
            union { bf16x8 v; unsigned u[4]; } mf; mf.u[0] = pk2(mv[0], mv[1]); mf.u[1] = pk2(mv[2], mv[3]); mf.u[2] = pk2(mv[4], mv[5]); mf.u[3] = pk2(mv[6], mv[7]);
#pragma unroll
            for (int pb = 0; pb < 4; ++pb) { const bf16x8 xf = tr2(xa + kk * 32 * SS_P + pb * 32, xa + (kk * 32 + 16) * SS_P + pb * 32); y[pb] = __builtin_amdgcn_mfma_f32_16x16x32_bf16(mf.v, xf, y[pb], 0, 0, 0); }
        }
        f32x4 yf[4], yb[4];
#pragma unroll
        for (int pb = 0; pb < 4; ++pb) { yf[pb] = (f32x4){0.f, 0.f, 0.f, 0.f}; yb[pb] = yf[pb];
#pragma unroll
            for (int ks = 0; ks < 2; ++ks) {
                const bf16x8 hf = *(LAS const bf16x8*)(lds + SSB_H + (2 * hh) * SS_HIMG + (16 * pb + fr) * SS_HP + (32 * ks + 8 * fq) * 2);
                const bf16x8 hb = *(LAS const bf16x8*)(lds + SSB_H + (2 * hh + 1) * SS_HIMG + (16 * pb + fr) * SS_HP + (32 * ks + 8 * fq) * 2);
                yf[pb] = __builtin_amdgcn_mfma_f32_16x16x32_bf16(cf[ks], hf, yf[pb], 0, 0, 0);
                yb[pb] = __builtin_amdgcn_mfma_f32_16x16x32_bf16(cf[ks], hb, yb[pb], 0, 0, 0); } }
        const float dsk = F.in[18][l * 6 + h];
        float nwv[4];
#pragma unroll
        for (int pb = 0; pb < 4; ++pb) nwv[pb] = F.in[19][l * 384 + h * 64 + 16 * pb + fr];
        const f32x4 cumf4 = *(LAS const f32x4*)(tb + 128 + 16 * w + 4 * fq), cumb4 = *(LAS const f32x4*)(tb + 384 + 16 * w + 4 * fq);
#pragma unroll
        for (int i = 0; i < 4; ++i) { const float ef = __expf(cumf4[i]), eb = __expf(cumb4[i]); const int tl = 16 * w + 4 * fq + i;
#pragma unroll
            for (int pb = 0; pb < 4; ++pb) { const float xv = bf2f(*(LAS const bf16_t*)(lds + SSB_X + hh * SS_IMG + tl * SS_P + (16 * pb + fr) * 2));
                const float yv = y[pb][i] + ef * yf[pb][i] + eb * yb[pb][i] + dsk * xv;
                const float gv = yv * silu_f(bf2f(zv[i][pb])); ss[i] += gv * gv;
                yup[(size_t)i * D + h * 64 + 16 * pb] = f2bf(gv * nwv[pb]); } }
    }
#pragma unroll
    for (int i = 0; i < 4; ++i) { const float v = row16_sum(ss[i]);
        if (fr == 0) ((float*)(F.ws + OFF_TAB + TAB_SSQ))[(size_t)(row0 + 16 * w + 4 * fq + i) * 2 + g] = v; }
}
__device__ __forceinline__ void ssd_norm_panel(Frame& F, int l, int pm) {
    const float* nw = F.in[19] + l * 384; const float* ssq = (const float*)(F.ws + OFF_TAB + TAB_SSQ);
    const bf16_t* yu = (const bf16_t*)(F.ws + OFF_YU); bf16_t* mix = (bf16_t*)(F.ws + OFF_MIX);
    for (int i = F.tid; i < 256 * 48; i += NTHREADS) {
        const int row = pm * 256 + i / 48, c0 = (i % 48) * 8;
        const float rstd = rsqrtf((ssq[(size_t)row * 2] + ssq[(size_t)row * 2 + 1]) * (1.f / 384.f) + EPS);
        const v4u v = *(const v4u*)(yu + (size_t)row * 384 + c0); const f32x4 w0 = *(const f32x4*)(nw + c0), w1 = *(const f32x4*)(nw + c0 + 4);
        v4u o;
        o[0] = pk2(__uint_as_float(v[0] << 16) * rstd * w0[0], __uint_as_float(v[0] & 0xffff0000u) * rstd * w0[1]); o[1] = pk2(__uint_as_float(v[1] << 16) * rstd * w0[2], __uint_as_float(v[1] & 0xffff0000u) * rstd * w0[3]);
        o[2] = pk2(__uint_as_float(v[2] << 16) * rstd * w1[0], __uint_as_float(v[2] & 0xffff0000u) * rstd * w1[1]); o[3] = pk2(__uint_as_float(v[3] << 16) * rstd * w1[2], __uint_as_float(v[3] & 0xffff0000u) * rstd * w1[3]);
        *(v4u*)(mix + (size_t)row * D + c0) = o;
    }
    asm volatile("s_waitcnt vmcnt(0)" ::: "memory");
    __syncthreads();
}

constexpr int S5_HP = 272;
constexpr int S5_IMG = 64 * S5_HP;
constexpr int S5_GP = 528, S5_G = 4 * S5_IMG, S5_END = S5_G + 64 * S5_GP;
typedef float f32x16 __attribute__((ext_vector_type(16)));
typedef float f32x8 __attribute__((ext_vector_type(8)));
__device__ __forceinline__ float swap32sel(float x, int odd) {
    const auto r = __builtin_amdgcn_permlane32_swap(__float_as_uint(x), __float_as_uint(x), false, false);
    return __uint_as_float(odd ? r[1] : r[0]);
}
template <int DIR, bool FULL>
__device__ __forceinline__ void s5_dir(Frame& F, int l, int g, int p, int hi, const bf16x8 (&uf)[2], float& cr, float& ci, f32x16 (&hr)[2], f32x16 (&hq)[2]) {
    const float* ab = (const float*)(F.ws + OFF_TAB + TAB_ABAR) + (size_t)((((l * 2 + DIR) * 16 + g) * 64) + p) * 2;
    const float ar = ab[0], ai = ab[1];
    const float a2r = ar * ar - ai * ai, a2i = 2.f * ar * ai, a3r = a2r * ar - a2i * ai, a3i = a2r * ai + a2i * ar, a4r = a2r * a2r - a2i * a2i, a4i = 2.f * a2r * a2i;
    const bf16_t* bbt = (const bf16_t*)(F.ws + OFF_TAB + TAB_BBT) + ((size_t)(((l * 2 + DIR) * 16 + g) * 2) * 64 + p) * 16 + 8 * hi;
    const bf16x8 bre = *(const bf16x8*)bbt, bim = *(const bf16x8*)(bbt + 64 * 16);
    f32x16 xr[2], xi[2];
#pragma unroll
    for (int rb = 0; rb < 2; ++rb) {
        const f32x16 z = {0.f, 0.f, 0.f, 0.f, 0.f, 0.f, 0.f, 0.f, 0.f, 0.f, 0.f, 0.f, 0.f, 0.f, 0.f, 0.f};
        xr[rb] = __builtin_amdgcn_mfma_f32_32x32x16_bf16(uf[rb], bre, z, 0, 0, 0); xi[rb] = __builtin_amdgcn_mfma_f32_32x32x16_bf16(uf[rb], bim, z, 0, 0, 0);
    }
#pragma unroll
    for (int rb = 0; rb < 2; ++rb)
#pragma unroll
        for (int G4 = 0; G4 < 4; ++G4) {
            if (DIR == 0) {
#pragma unroll
                for (int e = 1; e < 4; ++e) { const int i = 4 * G4 + e; const float pr = xr[rb][i - 1], pi = xi[rb][i - 1]; xr[rb][i] += ar * pr - ai * pi; xi[rb][i] += ar * pi + ai * pr; }
            } else {
#pragma unroll
                for (int e = 2; e >= 0; --e) { const int i = 4 * G4 + e; const float pr = xr[rb][i + 1], pi = xi[rb][i + 1]; xr[rb][i] += ar * pr - ai * pi; xi[rb][i] += ar * pi + ai * pr; }
            }
        }
    f32x8 cinr = {0.f, 0.f, 0.f, 0.f, 0.f, 0.f, 0.f, 0.f}, cini = cinr;
#pragma unroll
    for (int kk = 0; kk < 16; ++kk) {
        const int k = DIR == 0 ? kk : 15 - kk, gi = k >> 1, rb = gi >> 2, il = 4 * (gi & 3) + (DIR == 0 ? 3 : 0), odd = k & 1;
        const bool first = DIR == 0 ? !odd : odd;
        if (first) { cinr[gi] = cr; cini[gi] = ci; } else { const bool own = (hi == odd); cinr[gi] = own ? cr : cinr[gi]; cini[gi] = own ? ci : cini[gi]; }
        const float nr = a4r * cr - a4i * ci + xr[rb][il], ni = a4r * ci + a4i * cr + xi[rb][il];
        cr = swap32sel(nr, odd); ci = swap32sel(ni, odd);
    }
    if (FULL) {
#pragma unroll
        for (int rb = 0; rb < 2; ++rb)
#pragma unroll
            for (int G4 = 0; G4 < 4; ++G4) {
                const int gi = rb * 4 + G4;
#pragma unroll
                for (int e = 0; e < 4; ++e) {
                    const int i = 4 * G4 + e, pw = DIR == 0 ? e + 1 : 4 - e;
                    const float pr = pw == 1 ? ar : (pw == 2 ? a2r : (pw == 3 ? a3r : a4r)), pi = pw == 1 ? ai : (pw == 2 ? a2i : (pw == 3 ? a3i : a4i));
                    hr[rb][i] += xr[rb][i] + pr * cinr[gi] - pi * cini[gi];
                    hq[rb][i] += xi[rb][i] + pr * cini[gi] + pi * cinr[gi];
                }
            }
    }
}
template <bool FULL>
__device__ __forceinline__ void s5_wave_unit(Frame& F, int l, int row0, int g, int ph, float& cfr, float& cfi, float& cbr, float& cbi, LAS unsigned char* himg) {
    const int lane = F.lane, r32 = lane & 31, hi = lane >> 5, p = 32 * ph + r32;
    const bf16_t* proj = (const bf16_t*)(F.ws + OFF_PROJ);
    bf16x8 uf[2];
#pragma unroll
    for (int rb = 0; rb < 2; ++rb) uf[rb] = *(const bf16x8*)(proj + (size_t)(row0 + 32 * rb + r32) * PN + PU + g * 16 + 8 * hi);
    f32x16 hr[2], hq[2];
#pragma unroll
    for (int rb = 0; rb < 2; ++rb) { hr[rb] = (f32x16){0.f, 0.f, 0.f, 0.f, 0.f, 0.f, 0.f, 0.f, 0.f, 0.f, 0.f, 0.f, 0.f, 0.f, 0.f, 0.f}; hq[rb] = hr[rb]; }
    s5_dir<0, FULL>(F, l, g, p, hi, uf, cfr, cfi, hr, hq);
    s5_dir<1, FULL>(F, l, g, p, hi, uf, cbr, cbi, hr, hq);
    if (FULL) {
#pragma unroll
        for (int rb = 0; rb < 2; ++rb)
#pragma unroll
            for (int i = 0; i < 16; ++i) { const int t = 32 * rb + 8 * (i >> 2) + 4 * hi + (i & 3);
                LAS bf16_t* d = (LAS bf16_t*)(himg + t * S5_HP) + p;
                const unsigned pk = pk2(hr[rb][i], hq[rb][i]); d[0] = (bf16_t)(pk & 0xffffu); d[64] = (bf16_t)(pk >> 16); }
    }
}
__device__ __forceinline__ void cpow64(float ar, float ai, float& or_, float& oi_) {
#pragma unroll
    for (int s = 0; s < 6; ++s) { const float nr = ar * ar - ai * ai, ni = 2.f * ar * ai; ar = nr; ai = ni; }
    or_ = ar; oi_ = ai;
}
__device__ __forceinline__ void s5_a_unit(Frame& F, int l, int cj) {
    const int w = F.wave, lane = F.lane, row0 = cj * 64;
    float* E = (float*)(F.ws + OFF_E);
    for (int it = w; it < 32; it += NWAVES) {
        const int g = it >> 1, ph = it & 1;
        float cfr = 0.f, cfi = 0.f, cbr = 0.f, cbi = 0.f;
        s5_wave_unit<false>(F, l, row0, g, ph, cfr, cfi, cbr, cbi, F.lds);
        if (lane < 32) { float2 v; v.x = cfr; v.y = cfi; *(float2*)(E + ((size_t)((cj * 2 + 0) * 16 + g) * 64 + 32 * ph + lane) * 2) = v;
                         v.x = cbr; v.y = cbi; *(float2*)(E + ((size_t)((cj * 2 + 1) * 16 + g) * 64 + 32 * ph + lane) * 2) = v; }
    }
}
__device__ __forceinline__ void s5_b_unit(Frame& F, int l, int cj) {
    const int w = F.wave, row0 = cj * 64;
    const SeqInfo q = row_seq(row0); const int j = (row0 - q.start) >> 6, nj = q.L >> 6, cj0 = cj - j;
    const bf16_t* proj = (const bf16_t*)(F.ws + OFF_PROJ);
    const float* E = (const float*)(F.ws + OFF_E);
    LAS unsigned char* lds = F.lds;
    for (int gi4 = 0; gi4 < 4; ++gi4) {
        bf16x8 ccf[2][4]; unsigned short uval[2][4]; float dskv[2];
        { int lnp = F.tid; asm volatile("" : "+v"(lnp)); lnp &= 63; const int fr = lnp & 15, fq = lnp >> 4;
#pragma unroll
          for (int tk = 0; tk < 2; ++tk) { const int task = 2 * w + tk, gsel = task >> 2, tb = task & 3, g = 4 * gi4 + gsel;
            const bf16_t* cc = (const bf16_t*)(F.ws + OFF_TAB + TAB_CC1) + ((size_t)(l * 16 + g) * 16 + fr) * 128 + 8 * fq;
#pragma unroll
            for (int ks = 0; ks < 4; ++ks) ccf[tk][ks] = *(const bf16x8*)(cc + ks * 32);
#pragma unroll
            for (int i = 0; i < 4; ++i) uval[tk][i] = proj[(size_t)(row0 + 16 * tb + 4 * fq + i) * PN + PU + g * 16 + fr];
            dskv[tk] = F.in[27][l * 256 + g * 16 + fr]; } }
        {
            { int t_ = F.tid; asm volatile("" : "+v"(t_)); F.tid = t_; F.lane = t_ & 63; }
            const int lane = F.lane; const int g = 4 * gi4 + (w >> 1), ph = w & 1, p = 32 * ph + (lane & 31);
            const float* h5 = (const float*)(F.ws + OFF_H5);
            const float2 hf = *(const float2*)(h5 + ((size_t)((cj * 2 + 0) * 16 + g) * 64 + p) * 2), hb = *(const float2*)(h5 + ((size_t)((cj * 2 + 1) * 16 + g) * 64 + p) * 2);
            float cr[2] = {hf.x, hb.x}, ci[2] = {hf.y, hb.y};
            s5_wave_unit<true>(F, l, row0, g, ph, cr[0], ci[0], cr[1], ci[1], lds + (w >> 1) * S5_IMG);
        }
        __syncthreads();
        int ln2 = F.tid; asm volatile("" : "+v"(ln2)); ln2 &= 63; const int fr = ln2 & 15, fq = ln2 >> 4;
#pragma unroll
        for (int tk = 0; tk < 2; ++tk) {
            const int task = 2 * w + tk, gsel = task >> 2, tb = task & 3, g = 4 * gi4 + gsel;
            LAS const unsigned char* hrow = lds + gsel * S5_IMG + (16 * tb + fr) * S5_HP + 16 * fq;
            f32x4 y = {0.f, 0.f, 0.f, 0.f};
#pragma unroll
            for (int ks = 0; ks < 4; ++ks) { const bf16x8 a = *(LAS const bf16x8*)(hrow + ks * 64); y = __builtin_amdgcn_mfma_f32_16x16x32_bf16(a, ccf[tk][ks], y, 0, 0, 0); }
#pragma unroll
            for (int i = 0; i < 4; ++i) { const int t = 16 * tb + 4 * fq + i;
                *((LAS bf16_t*)(lds + S5_G + t * S5_GP) + g * 16 + fr) = f2bf(gelu_tanh_f(y[i] + dskv[tk] * bf2f(uval[tk][i]))); }
        }
        __syncthreads();
    }
    {
        int ln3 = F.tid; asm volatile("" : "+v"(ln3)); ln3 &= 63; const int fr = ln3 & 15, fq = ln3 >> 4;
        f32x4 acc[2][4];
#pragma unroll
        for (int a = 0; a < 2; ++a)
#pragma unroll
            for (int tb = 0; tb < 4; ++tb) acc[a][tb] = (f32x4){0.f, 0.f, 0.f, 0.f};
        const bf16_t* wg = (const bf16_t*)(F.ws + OFF_WGLU) + (size_t)l * 65536 + (size_t)(32 * w + fr) * 256 + 8 * fq;
#pragma unroll
        for (int ks = 0; ks < 8; ++ks) {
            const bf16x8 b0 = *(const bf16x8*)(wg + ks * 32), b1 = *(const bf16x8*)(wg + 16 * 256 + ks * 32);
#pragma unroll
            for (int tb = 0; tb < 4; ++tb) { const bf16x8 a = *(LAS const bf16x8*)(lds + S5_G + (16 * tb + fr) * S5_GP + ks * 64 + 16 * fq);
                acc[0][tb] = __builtin_amdgcn_mfma_f32_16x16x32_bf16(a, b0, acc[0][tb], 0, 0, 0); acc[1][tb] = __builtin_amdgcn_mfma_f32_16x16x32_bf16(a, b1, acc[1][tb], 0, 0, 0); }
        }
#pragma unroll
        for (int a = 0; a < 2; ++a) { const int n = 32 * w + 16 * a + fr; const float bg = F.in[29][l * 256 + n];
#pragma unroll
            for (int tb = 0; tb < 4; ++tb)
#pragma unroll
                for (int i = 0; i < 4; ++i) { const int t = 16 * tb + 4 * fq + i; const float gv = bf2f(*((LAS const bf16_t*)(lds + S5_G + t * S5_GP) + n));
                    ((bf16_t*)(F.ws + OFF_MIX))[(size_t)(row0 + t) * D + 384 + n] = f2bf(gv * sigmoid_f(acc[a][tb][i] + bg)); } }
    }
}

__device__ __forceinline__ void s5_state_pass(Frame& F, int l) {
    const float* E = (const float*)(F.ws + OFF_E); float* H5 = (float*)(F.ws + OFF_H5);
    for (int idx = F.vcu * NTHREADS + F.tid; idx < NSEQ * 2048; idx += F.G * NTHREADS) {
        const int p = idx & 63, g = (idx >> 6) & 15, dir = (idx >> 10) & 1, sq = idx >> 11;
        const int s_ = sq < LB ? CB + sq : sq - LB;
        const SeqInfo q = seq_info(s_); const int nj = q.L >> 6, cj0 = q.start >> 6;
        const float* ab = (const float*)(F.ws + OFF_TAB + TAB_ABAR) + (size_t)((((l * 2 + dir) * 16 + g) * 64) + p) * 2;
        float a64r, a64i; cpow64(ab[0], ab[1], a64r, a64i);
        float cr = 0.f, ci = 0.f;
        if (!q.ctx) { const size_t o = (((size_t)q.b * 4 + l) * 2 + dir) * 1024 + g * 64 + p; cr = F.in[5][o]; ci = F.in[6][o]; }
        for (int k = 0; k < nj; k += 4) {
            float2 e[4];
#pragma unroll
            for (int u = 0; u < 4; ++u) { const int jj = dir == 0 ? k + u : nj - 1 - (k + u); e[u] = *(const float2*)(E + ((size_t)(((cj0 + jj) * 2 + dir) * 16 + g) * 64 + p) * 2); }
#pragma unroll
            for (int u = 0; u < 4; ++u) { const int jj = dir == 0 ? k + u : nj - 1 - (k + u);
                float2 hv; hv.x = cr; hv.y = ci; *(float2*)(H5 + ((size_t)(((cj0 + jj) * 2 + dir) * 16 + g) * 64 + p) * 2) = hv;
                const float nr = a64r * cr - a64i * ci + e[u].x, ni = a64r * ci + a64i * cr + e[u].y; cr = nr; ci = ni; }
        }
        if (q.ctx) { const size_t o = (((size_t)q.b * 4 + l) * 2 + dir) * 1024 + g * 64 + p; F.out[O_RE + o] = cr; F.out[O_IM + o] = ci; }
    }
}
__device__ __forceinline__ void phase_mixa(Frame& F, int l) {
    unsigned* ctr = F.ctl + CW_Q + 64 * (l * 8);
    for (;;) { const int u = queue_next(F, ctr); if (u >= 192) break; attn_unit(F, l, u); }
    for (;;) { const int u = queue_next(F, ctr + 64); if (u >= 256) break; ssd_a_unit(F, l, u); }
    for (;;) { const int u = queue_next(F, ctr + 128); if (u >= 192) break; attn_unit(F, l, 192 + u); }
    for (;;) { const int u = queue_next(F, ctr + 192); if (u >= 256) break; s5_a_unit(F, l, u); }
}
__device__ __forceinline__ void phase_mixb(Frame& F, int l) {
    unsigned* ctr = F.ctl + CW_Q + 64 * (l * 8 + 4);
    for (;;) { const int u = queue_next(F, ctr); if (u >= 256) break; s5_b_unit(F, l, u); }
    for (;;) { const int u = queue_next(F, ctr + 64); if (u >= 256) break; ssd_b_unit(F, l, u); }
}

struct Args { const float* in[35]; float* out; unsigned char* ws; int ph_lo, ph_hi, li, pad; };
#ifdef MK_PHASE_RANGE
#define IN(k) (lo <= (k) && (k) < hi)
#else
#define IN(k) true
#endif
#define REFRESH() do { int t_ = threadIdx.x; asm volatile("" : "+v"(t_)); F.tid = t_; F.lane = t_ & 63; \
        unsigned char* w_ = args.ws; asm volatile("" : "+s"(w_)); F.ws = w_; F.ctl = (unsigned*)(w_ + OFF_CTL); float* o_ = args.out; asm volatile("" : "+s"(o_)); F.out = o_; \
        const float* const* i_ = (const float* const*)__builtin_amdgcn_kernarg_segment_ptr(); asm volatile("" : "+s"(i_)); F.in = i_; \
        int g_ = gridDim.x, v_ = vcu0; asm volatile("" : "+s"(g_), "+s"(v_)); F.G = g_; F.vcu = v_; modsb = (const float*)(F.ws + OFF_MODS); XB = (bf16_t*)(F.ws + OFF_X); } while (0)
#define SEAM(k) do { if (IN(k) && IN((k) + 1) && (k) + 1 < PH_END) xcd_barrier(bar); } while (0)
template <int l>
__device__ __forceinline__ void layer_body(Frame& F, const Args& args, const XcdBarrier& bar, const int vcu0) {
    const int lo = args.ph_lo, hi = args.ph_hi; (void)lo; (void)hi;
    const float* modsb = (const float*)(F.ws + OFF_MODS);
    bf16_t* XB = (bf16_t*)(F.ws + OFF_X);
        const int pb = PH_L0 + l * PH_PER_LAYER;
        if (IN(pb + PH_G1)) { REFRESH();
            pg8::Gemm g{(const bf16_t*)(F.ws + OFF_H), (const bf16_t*)(F.ws + OFF_WIN) + (size_t)l * PNP * 1024, M, PNP, 1024}; pg8::StaticOrder S; S.init(M, PNP, F.G, (int)blockIdx.x);
            epi_side_fill(F, S, (const float*)(F.ws + OFF_TAB + TAB_SQ1), (const float*)(F.ws + OFF_TAB + TAB_B1) + (size_t)l * 9 * PNP, PNP);
            pg8::EpiProj E{(bf16_t*)(F.ws + OFF_PROJ), F.out + O_K, F.out + O_V, (float*)(F.ws + OFF_DT), (LAS const float*)(F.lds + EPI_SIDE_OFF), l, 0};
            pg8::gemm_phase<pg8::EpiProj, pg8::StaticOrder, true, true>(F.lds, g, S, E);
        }
        SEAM(pb + PH_G1);
        if (IN(pb + PH_MIXA)) { REFRESH(); phase_mixa(F, l); }
        SEAM(pb + PH_MIXA);
        if (IN(pb + PH_MIXB)) { REFRESH(); ssd_state_pass(F, l); s5_state_pass(F, l); xcd_barrier(bar); REFRESH(); phase_mixb(F, l); }
        SEAM(pb + PH_MIXB);
        if (IN(pb + PH_G3)) { REFRESH();
            pg8::Gemm g{(const bf16_t*)(F.ws + OFF_MIX), (const bf16_t*)(F.ws + OFF_WOUT) + (size_t)l * 1024 * 1024, M, D, 1024}; pg8::StaticOrder S; S.init(M, D, F.G, (int)blockIdx.x);
            { pg8::Unit u; if (S.next(0, u) && F.tid < 256) { const float* q2 = (const float*)(F.ws + OFF_TAB + TAB_SSQ) + (size_t)(u.pm * 256 + F.tid) * 2;
                ((LAS float*)(F.lds + EPI_SIDE_OFF))[F.tid] = rsqrtf((q2[0] + q2[1]) * (1.f / 384.f) + EPS); } __syncthreads(); }
            typedef pg8::EpiRes<6, l == 0> Epi3;
            Epi3 E{l == 0 ? (const void*)F.in[0] : (const void*)XB, l == 0 ? (const void*)(F.in[1] - (size_t)MC * D) : (const void*)XB, XB, modsb + (size_t)l * 9 * 6144 + 2 * 1024, F.in[12] + l * D, modsb + (size_t)l * 9 * 6144 + 4 * 1024,
                   (bf16_t*)(F.ws + OFF_H), (float*)(F.ws + OFF_TAB + TAB_SQ2), (LAS const float*)(F.lds + EPI_SIDE_OFF)};
            pg8::gemm_phase<Epi3, pg8::StaticOrder, true, true>(F.lds, g, S, E);
        }
        SEAM(pb + PH_G3);
        if (IN(pb + PH_G4)) { REFRESH();
            pg8::Gemm g{(const bf16_t*)(F.ws + OFF_H), (const bf16_t*)(F.ws + OFF_WFF1) + (size_t)l * DFF * 1024, M, DFF, 1024}; pg8::StaticOrder S; S.init(M, DFF, F.G, (int)blockIdx.x);
            epi_side_fill(F, S, (const float*)(F.ws + OFF_TAB + TAB_SQ2), (const float*)(F.ws + OFF_TAB + TAB_B2) + (size_t)l * 9 * DFF, DFF);
            pg8::EpiFF1 E{(bf16_t*)(F.ws + OFF_FFH), (LAS const float*)(F.lds + EPI_SIDE_OFF), 0};
            pg8::gemm_phase<pg8::EpiFF1, pg8::StaticOrder, true, true>(F.lds, g, S, E);
        }
        SEAM(pb + PH_G4);
        if (IN(pb + PH_G5)) { REFRESH();
            pg8::Gemm g{(const bf16_t*)(F.ws + OFF_FFH), (const bf16_t*)(F.ws + OFF_WFF2) + (size_t)l * 1024 * DFF, M, D, DFF}; pg8::StaticOrder S; S.init(M, D, F.G, (int)blockIdx.x);
            const int ln = l + 1 < DEPTH ? l + 1 : l;
            typedef pg8::EpiRes<0, false> Epi5;
            Epi5 E{(const void*)XB, (const void*)XB, XB, modsb + (size_t)l * 9 * 6144 + 5 * 1024, F.in[11] + ln * D, modsb + (size_t)ln * 9 * 6144 + 1 * 1024,
                   l + 1 < DEPTH ? (bf16_t*)(F.ws + OFF_H) : (bf16_t*)nullptr, (float*)(F.ws + OFF_TAB + TAB_SQ1), (LAS const float*)(F.lds + EPI_SIDE_OFF)};
            pg8::gemm_phase<Epi5, pg8::StaticOrder, true, true>(F.lds, g, S, E);
        }
        SEAM(pb + PH_G5);
    }
__global__ void __launch_bounds__(NTHREADS, 2) mega(Args args) {
    extern __shared__ __attribute__((aligned(16))) unsigned char lds[];
    Frame F;
    F.lds = (LAS unsigned char*)lds;
    F.MISC = (volatile LAS unsigned*)(F.lds + MISC_OFF);
    F.tid = threadIdx.x; F.lane = F.tid & 63; F.wave = __builtin_amdgcn_readfirstlane(F.tid >> 6);
    F.G = gridDim.x; { const int bx = blockIdx.x; F.vcu = (F.G % 8 == 0) ? (bx % 8) * (F.G / 8) + bx / 8 : bx; }
    { const float* const* inp = (const float* const*)__builtin_amdgcn_kernarg_segment_ptr(); asm volatile("" : "+s"(inp)); F.in = inp; }
    F.out = args.out; F.ws = args.ws; F.ctl = (unsigned*)(args.ws + OFF_CTL);
    for (int u = F.tid; u < (LDS_BYTES - LDSCTL_OFF) / 4; u += NTHREADS) ((LAS unsigned*)(F.lds + LDSCTL_OFF))[u] = 0u;
    __syncthreads();
    XcdBarrier bar = xcd_barrier_post(F.ctl + CW_BAR + args.li * XCD_BAR_WORDS, F.MISC + 8);
    const int lo = args.ph_lo, hi = args.ph_hi; (void)lo; (void)hi;
    const float* modsb = (const float*)(F.ws + OFF_MODS);
    bf16_t* XB = (bf16_t*)(F.ws + OFF_X);
    const int vcu0 = F.vcu;
    if (IN(PH_PRO)) phase_prologue(F);
    SEAM(PH_PRO);
    if (IN(PH_PRE)) { REFRESH(); phase_pre(F); }
    SEAM(PH_PRE);
    layer_body<0>(F, args, bar, vcu0); layer_body<1>(F, args, bar, vcu0); layer_body<2>(F, args, bar, vcu0); layer_body<3>(F, args, bar, vcu0);
    if (IN(PH_FINAL)) phase_final(F);
#undef IN
#undef SEAM
}
static void launch_mega(const Args& base, int lo, int hi, int li, hipStream_t stream) {
    Args a = base; a.ph_lo = lo; a.ph_hi = hi; a.li = li;
    hipLaunchKernelGGL(mega, dim3(256), dim3(NTHREADS), LDS_BYTES, stream, a);
}
extern "C" void kernel_launch(void* const* d_in, const int* in_sizes, int n_in, void* d_out, int out_size, void* d_ws, size_t ws_size, hipStream_t stream) {
    static int ready = 0;
    if (!ready) {
        if (n_in != 35 || out_size != (int)O_END || ws_size < WS_END) { fprintf(stderr, "kernel_launch: unexpected shapes n_in %d out %d ws %zu\n", n_in, out_size, ws_size); ready = -1; return; }
        if (hipFuncSetAttribute((const void*)mega, hipFuncAttributeMaxDynamicSharedMemorySize, LDS_BYTES) != hipSuccess) { fprintf(stderr, "kernel_launch: hipFuncSetAttribute failed\n"); ready = -1; return; }
        ready = 1;
    }
    if (ready < 0) return;
    Args a{}; for (int i = 0; i < 35; ++i) a.in[i] = (const float*)d_in[i]; a.out = (float*)d_out; a.ws = (unsigned char*)d_ws;
    (void)hipMemsetAsync((char*)d_ws + OFF_CTL, 0, CTL_ZERO_BYTES, stream);
    launch_mega(a, 0, PH_END, 0, stream);
}
```

```cpp
#include <hip/hip_runtime.h>
#include <stdint.h>
#include <stdio.h>

typedef unsigned short bf16_t;
typedef short bf16x8 __attribute__((ext_vector_type(8)));
typedef float f32x4 __attribute__((ext_vector_type(4)));

constexpr int D = 1024, DEPTH = 4;
constexpr int CB = 32, CL = 256, LB = 8, LL = 1024;
constexpr int MC = CB * CL;
constexpr int M = MC + LB * LL;
constexpr int NSEQ = CB + LB;
constexpr int IN_COLS = 2444;
constexpr int PN = 2432, PNP = 2560;
constexpr int PZ = 0, PX = 384, PU = 1024, PQ = 1280, PK = 1664, PV = 2048;
constexpr int DFF = 4096;
constexpr float EPS = 1e-6f;

constexpr size_t MiB = 1u << 20;
constexpr size_t OFF_CTL = 0, OFF_MODS = 1 * MiB, OFF_TAB = 2 * MiB, OFF_WIN = 8 * MiB, OFF_WOUT = 28 * MiB, OFF_WFF1 = 36 * MiB,
                 OFF_WFF2 = 68 * MiB, OFF_WGLU = 100 * MiB, OFF_DT = 101 * MiB, OFF_X = 102 * MiB, OFF_PROJ = 166 * MiB, OFF_MIX = 242 * MiB,
                 OFF_FFH = 166 * MiB, OFF_H = 294 * MiB, OFF_XBC = 294 * MiB, OFF_YSSD = 334 * MiB, OFF_YS5 = 358 * MiB, WS_END = 374 * MiB;
constexpr size_t TAB_ABAR = 0;
constexpr size_t TAB_SQ1 = 256 * 1024;
constexpr size_t TAB_SQ2 = 1280 * 1024;
constexpr size_t TAB_B1 = 2304 * 1024;
constexpr size_t TAB_B2 = 4352 * 1024;
constexpr size_t TAB_SSQ = 5 * MiB;
constexpr size_t OFF_CK = 134 * MiB, OFF_CV = 140 * MiB;
constexpr size_t OFF_H5 = 326 * MiB;
constexpr size_t OFF_HIN = 362 * MiB;
constexpr size_t OFF_YU = 274 * MiB;
constexpr size_t TAB_CD = 3 * MiB;
constexpr size_t OFF_CS = 334 * MiB;
constexpr size_t TAB_CC1 = 4 * MiB;
constexpr size_t TAB_BBT = 3 * MiB + 512 * 1024;
constexpr size_t OFF_E = 358 * MiB;

__device__ __forceinline__ int lane_id() { unsigned z = 0u; asm volatile("" : "+v"(z)); return (int)__builtin_amdgcn_mbcnt_hi(~0u, __builtin_amdgcn_mbcnt_lo(~0u, z)); }
__device__ __forceinline__ float bf2f(bf16_t v) { return __uint_as_float((unsigned)v << 16); }
typedef float f32x2_t __attribute__((ext_vector_type(2))); typedef __bf16 bf16x2_t __attribute__((ext_vector_type(2)));
__device__ __forceinline__ unsigned cvtpk(float lo, float hi) { f32x2_t v = {lo, hi}; bf16x2_t b = __builtin_convertvector(v, bf16x2_t); return __builtin_bit_cast(unsigned, b); }
__device__ __forceinline__ bf16_t f2bf(float f) { return (bf16_t)(cvtpk(f, f) & 0xffffu); }
__device__ __forceinline__ float sigmoid_f(float x) { return __builtin_amdgcn_rcpf(1.f + __expf(-x)); }
__device__ __forceinline__ float silu_f(float x) { return x * sigmoid_f(x); }
__device__ __forceinline__ float softplus_f(float x) { return x > 20.f ? x : log1pf(__expf(x)); }
__device__ __forceinline__ float gelu_tanh_f(float x) { const float u = 1.5957691216057308f * (x + 0.044715f * x * x * x); return x * sigmoid_f(u); }
template <int CTRL> __device__ __forceinline__ float dppf(float x) { return __uint_as_float((unsigned)__builtin_amdgcn_update_dpp(0, (int)__float_as_uint(x), CTRL, 0xf, 0xf, true)); }
__device__ __forceinline__ float row16_sum(float x) { x += dppf<0xB1>(x); x += dppf<0x4E>(x); x += dppf<0x141>(x); x += dppf<0x140>(x); return x; }
__device__ __forceinline__ float row16_max(float x) { x = fmaxf(x, dppf<0xB1>(x)); x = fmaxf(x, dppf<0x4E>(x)); x = fmaxf(x, dppf<0x141>(x)); x = fmaxf(x, dppf<0x140>(x)); return x; }
__device__ __forceinline__ float xsum16(float x) { const auto r = __builtin_amdgcn_permlane16_swap(__float_as_uint(x), __float_as_uint(x), false, false); return __uint_as_float(r[0]) + __uint_as_float(r[1]); }
__device__ __forceinline__ float xsum32(float x) { const auto r = __builtin_amdgcn_permlane32_swap(__float_as_uint(x), __float_as_uint(x), false, false); return __uint_as_float(r[0]) + __uint_as_float(r[1]); }
__device__ __forceinline__ float xmax16(float x) { const auto r = __builtin_amdgcn_permlane16_swap(__float_as_uint(x), __float_as_uint(x), false, false); return fmaxf(__uint_as_float(r[0]), __uint_as_float(r[1])); }
__device__ __forceinline__ float xmax32(float x) { const auto r = __builtin_amdgcn_permlane32_swap(__float_as_uint(x), __float_as_uint(x), false, false); return fmaxf(__uint_as_float(r[0]), __uint_as_float(r[1])); }
__device__ __forceinline__ float rdlane(float x, int l) { return __uint_as_float((unsigned)__builtin_amdgcn_readlane((int)__float_as_uint(x), l)); }
__device__ __forceinline__ float wave_sum(float v) { return xsum32(xsum16(row16_sum(v))); }
__device__ __forceinline__ float wave_max(float v) { return xmax32(xmax16(row16_max(v))); }
__device__ __forceinline__ int mod_row(int row) { return row < MC ? 0 : 1 + ((row - MC) >> 10); }

struct P {
    const float* in[35];
    float* out;
    unsigned char* ws;
};
constexpr size_t O_YP = 0, O_YS = 8388608, O_K = 16777216, O_V = O_K + 12582912, O_SSD = O_V + 12582912, O_RE = O_SSD + 6291456, O_IM = O_RE + 262144, O_END = O_IM + 262144;


#define LAS __attribute__((address_space(3)))
struct SeqInfo { int start, L, b, ctx; };
__device__ __forceinline__ SeqInfo seq_info(int s) { SeqInfo q; if (s < CB) { q.start = s * CL; q.L = CL; q.b = s; q.ctx = 1; } else { q.start = MC + (s - CB) * LL; q.L = LL; q.b = s - CB; q.ctx = 0; } return q; }
__device__ __forceinline__ SeqInfo row_seq(int row) { return seq_info(row < MC ? (row >> 8) : CB + ((row - MC) >> 10)); }
namespace pg8 {
#define PG8_LAS __attribute__((address_space(3)))
typedef unsigned short bf16_t;
typedef short bf16x8 __attribute__((ext_vector_type(8)));
typedef float f32x4 __attribute__((ext_vector_type(4)));
typedef unsigned u32x4 __attribute__((ext_vector_type(4)));
constexpr int BM = 256, BK = 64, HALF = 128, HTB = HALF * BK * 2  , STAGE_BYTES = 8 * HTB, NXCD = 8, WGM = 8;

__host__ __device__ __forceinline__ int lds_byte(int r, int c) { const int st = (r >> 4) * 2 + (c >> 5), rr = r & 15, cc = c & 31, ob = rr * 64 + cc * 2; return st * 1024 + (ob ^ (((ob >> 9) & 1) << 5)); }
__host__ __device__ __forceinline__ void stage_rc(int b, int& R, int& C) { const int st = b / 1024, sb = b % 1024, swz = sb ^ (((sb >> 9) & 1) << 5); R = (st >> 1) * 16 + swz / 64; C = (st & 1) * 32 + (swz % 64) / 2; }
__host__ __device__ __forceinline__ int perm32(int rho) { const int n = rho >> 4, i = rho & 15; return 8 * (i >> 2) + 4 * n + (i & 3); }

struct Unit { int pm, pn; };
struct Gemm { const bf16_t* A; const bf16_t* Bt; int M, N, K; };

struct StaticOrder {
    int nM, nN, nwg, G, c;
    __host__ __device__ void init(int M, int N, int G_, int c_) { nM = M / BM; nN = N / BM; nwg = nM * nN; G = G_; c = c_; }
    __host__ __device__ bool next(int i, Unit& u) const {
        const long L = (long)i * G + c; if (L >= nwg) return false;
        int wgid = (int)L; { const int q = nwg / NXCD, r = nwg % NXCD, xcd = wgid % NXCD, off = wgid / NXCD; wgid = (xcd < r ? xcd * (q + 1) : r * (q + 1) + (xcd - r) * q) + off; }
        const int nig = WGM * nN, gid = wgid / nig, fm = gid * WGM, gsz = (nM - fm) < WGM ? (nM - fm) : WGM;
        u.pm = fm + ((wgid % nig) % gsz); u.pn = (wgid % nig) / gsz; return true;
    }
    __device__ __forceinline__ void a_ready(const Unit&) const {}
    __device__ __forceinline__ void done(const Unit&) const {}
};

__device__ __forceinline__ unsigned cvt_pk_bf16(float lo, float hi) { unsigned r; asm volatile("v_cvt_pk_bf16_f32 %0, %1, %2" : "=v"(r) : "v"(lo), "v"(hi)); return r; }
__device__ __forceinline__ float row_rstd(const float* ssq, int row, int fq) {
    const f32x4 a = *(const f32x4*)(ssq + (size_t)row * 16 + 4 * fq);
    const float s = ::xsum32(::xsum16((a[0] + a[1]) + (a[2] + a[3])));
    return rsqrtf(s * (1.f / 1024.f) + ::EPS);
}
struct EpiProj {
    static constexpr bool PERM = true, AFTER_DRAIN = false; static constexpr int MID_T = 0;
    bf16_t* proj; float* ok; float* ov; float* dt; PG8_LAS const float* side; int l; mutable int slot;
    __device__ __forceinline__ void operator()(const f32x4 (&acc)[2][2][4][2], const Unit& u, int wr, int wc, int fr, int fq) const {
        const int row0 = u.pm * BM + wr * 64 + fr;
        PG8_LAS const float* rsp = side + slot * 256 + wr * 64 + fr; PG8_LAS const float* bsp = side + 1024 + slot * 256 + wc * 32 + 8 * fq; ++slot;
        float rs[2][4];
#pragma unroll
        for (int ai = 0; ai < 2; ++ai)
#pragma unroll
            for (int m = 0; m < 4; ++m) rs[ai][m] = rsp[ai * HALF + m * 16];
#pragma unroll
        for (int bj = 0; bj < 2; ++bj) {
            const int cb = u.pn * BM + bj * HALF;
            if (cb > ::PN) continue;
            const int col = cb + wc * 32 + 8 * fq;
            const f32x4 b0 = *(PG8_LAS const f32x4*)(bsp + bj * HALF), b1 = *(PG8_LAS const f32x4*)(bsp + bj * HALF + 4);
            const bool isk = (cb >= ::PK && cb < ::PV), isv = (cb >= ::PV && cb < ::PN), isdt = (cb == ::PN);
#pragma unroll
            for (int ai = 0; ai < 2; ++ai)
#pragma unroll
                for (int m = 0; m < 4; ++m) {
                    const int row = row0 + ai * HALF + m * 16;
                    const f32x4 v0 = acc[ai][bj][m][0] * rs[ai][m] + b0, v1 = acc[ai][bj][m][1] * rs[ai][m] + b1;
                    if (isdt) { if (wc == 0 && fq < 2) { float* d = dt + (size_t)row * 12 + 8 * fq; *(f32x4*)d = v0; if (fq == 0) *(f32x4*)(d + 4) = v1; } continue; }
                    u32x4 w; w.x = cvt_pk_bf16(v0[0], v0[1]); w.y = cvt_pk_bf16(v0[2], v0[3]); w.z = cvt_pk_bf16(v1[0], v1[1]); w.w = cvt_pk_bf16(v1[2], v1[3]);
                    *(u32x4*)(proj + (size_t)row * ::PN + col) = w;
                    if (u.pm < 32 && (isk || isv)) {
                        const int b = row >> 8, t = row & 255;
                        float* o = (isk ? ok : ov) + ((size_t)(b * 4 + l) * 256 + t) * 384 + (col - (isk ? ::PK : ::PV));
                        *(f32x4*)o = v0; *(f32x4*)(o + 4) = v1;
                    }
                }
        }
    }
};
template <int MID, bool XF32>
struct EpiRes {
    static constexpr bool PERM = true, AFTER_DRAIN = false; static constexpr int MID_T = MID;
    const void* xin_c; const void* xin_l; bf16_t* xout; const float* gate;
    const float* nw; const float* sc; bf16_t* xs; float* ssq;
    PG8_LAS const float* side;
    __device__ __forceinline__ void mid(f32x4 (&acc)[2][2][4][2], const Unit& u, int wr, int fr) const {
#pragma unroll
        for (int ai = 0; ai < 2; ++ai)
#pragma unroll
            for (int m = 0; m < 4; ++m) { const float sc_ = side[ai * HALF + wr * 64 + m * 16 + fr];
#pragma unroll
                for (int bj = 0; bj < 2; ++bj)
#pragma unroll
                    for (int n = 0; n < 2; ++n) acc[ai][bj][m][n] = acc[ai][bj][m][n] * sc_; }
    }
    __device__ __forceinline__ void operator()(const f32x4 (&acc)[2][2][4][2], const Unit& u, int wr, int wc, int fr, int fq) const {
        const int row0 = u.pm * BM + wr * 64 + fr, col0 = u.pn * BM + wc * 32 + 8 * fq;
        const int r = u.pm < 32 ? 0 : 1 + ((u.pm - 32) >> 2);
        const float* gt = gate + (size_t)r * 6144; const float* sr = sc + (size_t)r * 6144;
        const void* xin = u.pm < 32 ? xin_c : xin_l;
        float sq[2][4];
#pragma unroll
        for (int ai = 0; ai < 2; ++ai)
#pragma unroll
            for (int m = 0; m < 4; ++m) sq[ai][m] = 0.f;
#pragma unroll
        for (int bj = 0; bj < 2; ++bj) {
            const int col = col0 + bj * HALF;
            const f32x4 g0 = *(const f32x4*)(gt + col), g1 = *(const f32x4*)(gt + col + 4);
            f32x4 gs0 = {0.f, 0.f, 0.f, 0.f}, gs1 = gs0;
            if (xs) { gs0 = *(const f32x4*)(nw + col) * (*(const f32x4*)(sr + col) + 1.f); gs1 = *(const f32x4*)(nw + col + 4) * (*(const f32x4*)(sr + col + 4) + 1.f); }
#pragma unroll
            for (int ai = 0; ai < 2; ++ai)
#pragma unroll
                for (int m = 0; m < 4; ++m) {
                    const size_t off = (size_t)(row0 + ai * HALF + m * 16) * ::D + col;
                    f32x4 xi0, xi1;
                    if (XF32) { xi0 = *(const f32x4*)((const float*)xin + off); xi1 = *(const f32x4*)((const float*)xin + off + 4); }
                    else { const u32x4 xr = *(const u32x4*)((const bf16_t*)xin + off);
                        xi0 = (f32x4){__uint_as_float(xr.x << 16), __uint_as_float(xr.x & 0xffff0000u), __uint_as_float(xr.y << 16), __uint_as_float(xr.y & 0xffff0000u)};
                        xi1 = (f32x4){__uint_as_float(xr.z << 16), __uint_as_float(xr.z & 0xffff0000u), __uint_as_float(xr.w << 16), __uint_as_float(xr.w & 0xffff0000u)}; }
                    const f32x4 x0 = xi0 + g0 * acc[ai][bj][m][0], x1 = xi1 + g1 * acc[ai][bj][m][1];
                    { u32x4 xo; xo.x = cvt_pk_bf16(x0[0], x0[1]); xo.y = cvt_pk_bf16(x0[2], x0[3]); xo.z = cvt_pk_bf16(x1[0], x1[1]); xo.w = cvt_pk_bf16(x1[2], x1[3]); *(u32x4*)(xout + off) = xo; }
                    if (xs) { sq[ai][m] += ((x0[0] * x0[0] + x0[1] * x0[1]) + (x0[2] * x0[2] + x0[3] * x0[3])) + ((x1[0] * x1[0] + x1[1] * x1[1]) + (x1[2] * x1[2] + x1[3] * x1[3]));
                        const f32x4 h0 = x0 * gs0, h1 = x1 * gs1; u32x4 o; o.x = cvt_pk_bf16(h0[0], h0[1]); o.y = cvt_pk_bf16(h0[2], h0[3]); o.z = cvt_pk_bf16(h1[0], h1[1]); o.w = cvt_pk_bf16(h1[2], h1[3]);
                        *(u32x4*)(xs + off) = o; }
                }
        }
        if (xs) {
#pragma unroll
            for (int ai = 0; ai < 2; ++ai)
#pragma unroll
                for (int m = 0; m < 4; ++m) { const float t = ::xsum32(::xsum16(sq[ai][m])); if (fq == 0) ssq[(size_t)(row0 + ai * HALF + m * 16) * 16 + u.pn * 4 + wc] = t; }
        }
    }
};
struct EpiFF1 {
    static constexpr bool PERM = true, AFTER_DRAIN = false; static constexpr int MID_T = 0;
    bf16_t* h; PG8_LAS const float* side; mutable int slot;
    __device__ __forceinline__ void operator()(const f32x4 (&acc)[2][2][4][2], const Unit& u, int wr, int wc, int fr, int fq) const {
        const int row0 = u.pm * BM + wr * 64 + fr, col0 = u.pn * BM + wc * 32 + 8 * fq;
        PG8_LAS const float* rsp = side + slot * 256 + wr * 64 + fr; PG8_LAS const float* bsp = side + 1024 + slot * 256 + wc * 32 + 8 * fq; ++slot;
        f32x4 bv[2][2];
#pragma unroll
        for (int bj = 0; bj < 2; ++bj) { bv[bj][0] = *(PG8_LAS const f32x4*)(bsp + bj * HALF); bv[bj][1] = *(PG8_LAS const f32x4*)(bsp + bj * HALF + 4); }
#pragma unroll
        for (int ai = 0; ai < 2; ++ai)
#pragma unroll
            for (int m = 0; m < 4; ++m) {
                const int row = row0 + ai * HALF + m * 16; const float rs = rsp[ai * HALF + m * 16];
                bf16_t* rowp = h + (size_t)row * ::DFF + col0;
#pragma unroll
                for (int bj = 0; bj < 2; ++bj) {
                    f32x4 v0 = acc[ai][bj][m][0] * rs + bv[bj][0], v1 = acc[ai][bj][m][1] * rs + bv[bj][1];
#pragma unroll
                    for (int e = 0; e < 4; ++e) { const float a = fmaxf(v0[e], 0.f), b = fmaxf(v1[e], 0.f); v0[e] = a * a; v1[e] = b * b; }
                    u32x4 w; w.x = cvt_pk_bf16(v0[0], v0[1]); w.y = cvt_pk_bf16(v0[2], v0[3]); w.z = cvt_pk_bf16(v1[0], v1[1]); w.w = cvt_pk_bf16(v1[2], v1[3]);
                    *(u32x4*)(rowp + bj * HALF) = w;
                }
            }
    }
};
template <class Epi, class Sched, bool ALIGN_EPI = false, bool SP2 = false>
__device__ __forceinline__ void gemm_phase(PG8_LAS unsigned char* lds, const Gemm g, const Sched& S, const Epi& E, const int wave_in) {
    int tid_ = wave_in * 64 + ::lane_id(); asm volatile("" : "+v"(tid_));
    const int tid = tid_, wid = __builtin_amdgcn_readfirstlane(tid >> 6), lane = tid & 63, wr = wid >> 2, wc = wid & 3, fr = lane & 15, fq = lane >> 4;
    const int K = g.K, nt = K / BK;
    unsigned voffA[2], voffB[2];
#pragma unroll
    for (int i = 0; i < 2; ++i) { int R, C; stage_rc(tid * 16 + i * 8192, R, C); const int Rb = Epi::PERM ? ((R & ~31) + perm32(R & 31)) : R;
        voffA[i] = (unsigned)(R * K + C) * 2u; voffB[i] = (unsigned)(Rb * K + C) * 2u; }
    const size_t kstep = (size_t)(BK * 2);
    const size_t hstep = (size_t)HALF * K * 2;
    const size_t tstep = 2 * hstep;
    const unsigned ldsw = (unsigned)wid * 1024u;
    const int aoff = lds_byte(wr * 64 + fr, fq * 8), boff = lds_byte(wc * 32 + fr, fq * 8);
#define PG8_SA(b, h) (((b) * 2 + (h)) * HTB)
#define PG8_SB(b, h) ((4 + (b) * 2 + (h)) * HTB)
#define PG8_STAGE(bufoff, gbase, voff) do { _Pragma("unroll") for (int _i = 0; _i < 2; ++_i) \
        __builtin_amdgcn_global_load_lds((const unsigned*)((const char*)(gbase) + (voff)[_i]), (PG8_LAS unsigned*)(lds + (bufoff) + ldsw + _i * 8192), 16, 0, 0); } while (0)
#define PG8_LDA(dst, b, h) do { _Pragma("unroll") for (int m = 0; m < 4; ++m) _Pragma("unroll") for (int k = 0; k < 2; ++k) dst[m][k] = *(const PG8_LAS bf16x8*)(lds + PG8_SA(b, h) + aoff + m * 2048 + k * 1024); } while (0)
#define PG8_LDB(dst, b, h) do { _Pragma("unroll") for (int n = 0; n < 2; ++n) _Pragma("unroll") for (int k = 0; k < 2; ++k) dst[n][k] = *(const PG8_LAS bf16x8*)(lds + PG8_SB(b, h) + boff + n * 2048 + k * 1024); } while (0)
#define PG8_MMA(ai, bj, At, Bt) do { __builtin_amdgcn_s_setprio(1); _Pragma("unroll") for (int m = 0; m < 4; ++m) _Pragma("unroll") for (int n = 0; n < 2; ++n) _Pragma("unroll") for (int k = 0; k < 2; ++k) \
        acc[ai][bj][m][n] = __builtin_amdgcn_mfma_f32_16x16x32_bf16(Bt[n][k], At[m][k], acc[ai][bj][m][n], 0, 0, 0); __builtin_amdgcn_s_setprio(0); } while (0)
#define PG8_WAIT_V(n) asm volatile("s_waitcnt vmcnt(" #n ")" ::: "memory")
#define PG8_WAIT_L(n) asm volatile("s_waitcnt lgkmcnt(" #n ")" ::: "memory")
#define PG8_BAR __builtin_amdgcn_s_barrier()
#define PG8_SCHED __builtin_amdgcn_sched_barrier(0)
    Unit cur, nxt; int ui = 0;
    if (!S.next(0, cur)) return;
    f32x4 acc[2][2][4][2];
#pragma unroll
    for (int a = 0; a < 2; ++a)
#pragma unroll
        for (int b = 0; b < 2; ++b)
#pragma unroll
            for (int m = 0; m < 4; ++m)
#pragma unroll
                for (int n = 0; n < 2; ++n) acc[a][b][m][n] = (f32x4){0.f, 0.f, 0.f, 0.f};
    bf16x8 At[4][2], B0[2][2], B1[2][2];
    const char* cA = (const char*)g.A + (size_t)cur.pm * tstep; const char* cB = (const char*)g.Bt + (size_t)cur.pn * tstep;
    S.a_ready(cur);
    if constexpr (SP2) {
        PG8_STAGE(PG8_SB(0, 0), cB, voffB); PG8_STAGE(PG8_SB(0, 1), cB + hstep, voffB); PG8_STAGE(PG8_SA(0, 0), cA, voffA); PG8_STAGE(PG8_SA(0, 1), cA + hstep, voffA);
        if (wr == 1) PG8_BAR;
        PG8_WAIT_V(2); PG8_BAR;
        PG8_STAGE(PG8_SB(1, 0), cB + kstep, voffB); PG8_STAGE(PG8_SA(1, 0), cA + kstep, voffA); PG8_STAGE(PG8_SB(1, 1), cB + hstep + kstep, voffB);
        PG8_WAIT_V(6); PG8_BAR;
    } else {
        PG8_STAGE(PG8_SB(0, 0), cB, voffB); PG8_STAGE(PG8_SA(0, 0), cA, voffA); PG8_STAGE(PG8_SB(0, 1), cB + hstep, voffB); PG8_STAGE(PG8_SA(0, 1), cA + hstep, voffA);
        if (wr == 1) PG8_BAR;
        PG8_WAIT_V(4); PG8_BAR;
        PG8_STAGE(PG8_SB(1, 0), cB + kstep, voffB); PG8_STAGE(PG8_SA(1, 0), cA + kstep, voffA); PG8_STAGE(PG8_SB(1, 1), cB + hstep + kstep, voffB);
        PG8_WAIT_V(6); PG8_BAR;
    }
    for (;;) {
        const bool has_next = S.next(ui + 1, nxt);
        const char* nA = has_next ? (const char*)g.A + (size_t)nxt.pm * tstep : cA; const char* nB = has_next ? (const char*)g.Bt + (size_t)nxt.pn * tstep : cB;
        for (int t = 0; t < nt; t += 2) {
            if constexpr (Epi::MID_T > 0) { if (t == Epi::MID_T) E.mid(acc, cur, wr, fr); }
            const bool last = (t == nt - 2);
            const char* a1 = cA + (size_t)(t + 1) * kstep;
            const char* a2 = last ? nA : cA + (size_t)(t + 2) * kstep; const char* b2 = last ? nB : cB + (size_t)(t + 2) * kstep;
            const char* a3 = a2 + kstep; const char* b3 = b2 + kstep;
            if (last && has_next) S.a_ready(nxt);
            if constexpr (SP2) {
            PG8_LDB(B0, 0, 0); PG8_LDB(B1, 0, 1); PG8_SCHED; PG8_LDA(At, 0, 0); PG8_STAGE(PG8_SA(1, 1), a1 + hstep, voffA);
            PG8_WAIT_V(8); PG8_WAIT_L(0); PG8_BAR; PG8_MMA(0, 0, At, B0); PG8_MMA(0, 1, At, B1); PG8_BAR; PG8_SCHED;
            PG8_LDA(At, 0, 1); PG8_STAGE(PG8_SB(0, 0), b2, voffB); PG8_STAGE(PG8_SB(0, 1), b2 + hstep, voffB); PG8_STAGE(PG8_SA(0, 0), a2, voffA);
            PG8_WAIT_V(8); PG8_WAIT_L(0); PG8_BAR; PG8_MMA(1, 0, At, B0); PG8_MMA(1, 1, At, B1); PG8_BAR; PG8_SCHED;
            PG8_LDB(B0, 1, 0); PG8_LDB(B1, 1, 1); PG8_SCHED; PG8_LDA(At, 1, 0); PG8_STAGE(PG8_SA(0, 1), a2 + hstep, voffA);
            PG8_WAIT_V(8); PG8_WAIT_L(0); PG8_BAR; PG8_MMA(0, 0, At, B0); PG8_MMA(0, 1, At, B1); PG8_BAR; PG8_SCHED;
            PG8_LDA(At, 1, 1); PG8_STAGE(PG8_SB(1, 0), b3, voffB); PG8_STAGE(PG8_SB(1, 1), b3 + hstep, voffB); PG8_STAGE(PG8_SA(1, 0), a3, voffA);
            PG8_WAIT_V(8); PG8_WAIT_L(0); PG8_BAR; PG8_MMA(1, 0, At, B0); PG8_MMA(1, 1, At, B1); PG8_BAR; PG8_SCHED;
            } else {
            PG8_LDB(B0, 0, 0); PG8_SCHED; PG8_LDA(At, 0, 0); PG8_STAGE(PG8_SA(1, 1), a1 + hstep, voffA);
            PG8_WAIT_L(8); PG8_BAR; PG8_WAIT_L(0); PG8_MMA(0, 0, At, B0); PG8_BAR; PG8_SCHED;
            PG8_LDB(B1, 0, 1); PG8_STAGE(PG8_SB(0, 0), b2, voffB);
            PG8_BAR; PG8_WAIT_L(0); PG8_MMA(0, 1, At, B1); PG8_BAR;
            PG8_LDA(At, 0, 1); PG8_STAGE(PG8_SA(0, 0), a2, voffA);
            PG8_BAR; PG8_WAIT_L(0); PG8_MMA(1, 0, At, B0); PG8_BAR; PG8_SCHED;
            PG8_STAGE(PG8_SB(0, 1), b2 + hstep, voffB);
            PG8_WAIT_V(6); PG8_BAR; PG8_MMA(1, 1, At, B1); PG8_BAR;
            PG8_LDB(B0, 1, 0); PG8_SCHED; PG8_LDA(At, 1, 0); PG8_STAGE(PG8_SA(0, 1), a2 + hstep, voffA);
            PG8_WAIT_L(8); PG8_BAR; PG8_WAIT_L(0); PG8_MMA(0, 0, At, B0); PG8_BAR; PG8_SCHED;
            PG8_LDB(B1, 1, 1); PG8_STAGE(PG8_SB(1, 0), b3, voffB);
            PG8_BAR; PG8_WAIT_L(0); PG8_MMA(0, 1, At, B1); PG8_BAR;
            PG8_LDA(At, 1, 1); PG8_STAGE(PG8_SA(1, 0), a3, voffA);
            PG8_BAR; PG8_WAIT_L(0); PG8_MMA(1, 0, At, B0); PG8_BAR; PG8_SCHED;
            PG8_STAGE(PG8_SB(1, 1), b3 + hstep, voffB);
            PG8_WAIT_V(6); PG8_BAR; PG8_MMA(1, 1, At, B1); PG8_BAR;
            }
        }
        if constexpr (ALIGN_EPI) { if (wr == 0) PG8_BAR; }
        if constexpr (!Epi::AFTER_DRAIN) { E(acc, cur, wr, wc, fr, fq); S.done(cur); }
        if (!has_next) break;
#pragma unroll
        for (int a = 0; a < 2; ++a)
#pragma unroll
            for (int b = 0; b < 2; ++b)
#pragma unroll
                for (int m = 0; m < 4; ++m)
#pragma unroll
                    for (int n = 0; n < 2; ++n) acc[a][b][m][n] = (f32x4){0.f, 0.f, 0.f, 0.f};
        cur = nxt; cA = nA; cB = nB; ++ui;
        if constexpr (ALIGN_EPI) { if (wr == 1) PG8_BAR; }
    }
    PG8_WAIT_V(0);
    if constexpr (!ALIGN_EPI) { if (wr == 0) PG8_BAR; }
    PG8_BAR;
    if constexpr (Epi::AFTER_DRAIN) { E.fused(acc, cur, wr, wc, fr, fq, lds, wid, lane); S.done(cur); }
#undef PG8_SA
#undef PG8_SB
#undef PG8_STAGE
#undef PG8_LDA
#undef PG8_LDB
#undef PG8_MMA
#undef PG8_WAIT_V
#undef PG8_WAIT_L
#undef PG8_BAR
#undef PG8_SCHED
}
}

constexpr int NWAVES = 8, NTHREADS = 512;
constexpr int RING_BYTES = 131072, LDS_BYTES = 163840, LDSCTL_OFF = LDS_BYTES - 512, MISC_OFF = LDSCTL_OFF + 320;
#define GAS __attribute__((address_space(1)))
typedef unsigned v4u __attribute__((ext_vector_type(4)));
typedef GAS unsigned gu32;
#define LDS_WAIT() asm volatile("s_waitcnt lgkmcnt(0)" ::: "memory")
#define VM_WAIT() asm volatile("s_waitcnt vmcnt(0)" ::: "memory")
__device__ __forceinline__ unsigned pk2(float lo, float hi) { return cvtpk(lo, hi); }
constexpr int CW_BAR = 4096, CW_Q = 65536;
constexpr size_t CTL_ZERO_BYTES = 1 * MiB;

#define XB_TMO      128
#define XB_XCNT(j)  (256  + 64 * (j))
#define XB_XSUB(j)  (1280 + 64 * (j))
#define XB_XGEN(j)  (2304 + 64 * (j))
#define XB_TOP      3328
#define XB_TOPGEN   3392
#define XCD_BAR_WORDS 3456
#define XB_SPIN_CAP (1u << 18)

__device__ __forceinline__ unsigned xb_ld(unsigned* p)              { return __hip_atomic_load(p, __ATOMIC_RELAXED, __HIP_MEMORY_SCOPE_AGENT); }
__device__ __forceinline__ unsigned xb_add(unsigned* p, unsigned v) { return __hip_atomic_fetch_add(p, v, __ATOMIC_RELAXED, __HIP_MEMORY_SCOPE_AGENT); }
__device__ __forceinline__ unsigned xb_xcc_id() { return (unsigned)__builtin_amdgcn_s_getreg((3 << 11) | 20) & 0xFu; }
#define XB_SPIN(cond, bar) do { unsigned _sp = 0; while (cond) { __builtin_amdgcn_s_sleep(1); \
    if ((++_sp & 255u) == 0u) { if (xb_ld(&(bar)[XB_TMO])) break; if (_sp > XB_SPIN_CAP) { atomicAdd(&(bar)[XB_TMO], 1u); break; } } } } while (0)

struct XcdBarrier {
    unsigned* bar; unsigned x;
    volatile LAS unsigned* st;
};

__device__ __forceinline__ XcdBarrier xcd_barrier_post(unsigned* bar, volatile LAS unsigned* st) {
    XcdBarrier b; b.bar = bar; b.x = xb_xcc_id(); b.st = st;
    if (threadIdx.x == 0) (void)xb_add(&bar[XB_XCNT(b.x)], 1u);
    return b;
}
__device__ __forceinline__ void xcd_barrier_complete(unsigned* bar, unsigned x, unsigned& nloc, unsigned& nx) {
    const unsigned G = gridDim.x * gridDim.y * gridDim.z;
    unsigned sum, cnt, mine, sp = 0u;
    for (;;) {
        sum = 0u; cnt = 0u; mine = 0u;
#pragma unroll
        for (unsigned j = 0; j < 16; ++j) { const unsigned c = xb_ld(&bar[XB_XCNT(j)]); sum += c; cnt += (c > 0u) ? 1u : 0u; mine = (j == x) ? c : mine; }
        if (sum == G) break;
        __builtin_amdgcn_s_sleep(1);
        if ((++sp & 255u) == 0u) { if (xb_ld(&bar[XB_TMO])) break; if (sp > XB_SPIN_CAP) { atomicAdd(&bar[XB_TMO], 1u); break; } }
    }
    nloc = mine > 0u ? mine : 1u; nx = cnt > 0u ? cnt : 1u;
}

__device__ __forceinline__ void xcd_barrier(const XcdBarrier& b, const bool is_t0) {
    asm volatile("s_waitcnt vmcnt(0)" ::: "memory");
    __syncthreads();
    if (is_t0) {
        unsigned* bar = b.bar;
        __builtin_amdgcn_s_waitcnt(0);
        unsigned nloc = b.st[0], nx = b.st[1];
        if (nloc == 0u) { xcd_barrier_complete(bar, b.x, nloc, nx); b.st[0] = nloc; b.st[1] = nx; }
        const unsigned old = xb_add(&bar[XB_XSUB(b.x)], 1u);
        const unsigned gen = old / nloc;
        if (old + 1u == (gen + 1u) * nloc) {
            __builtin_amdgcn_fence(__ATOMIC_RELEASE, "agent");
            asm volatile("s_waitcnt vmcnt(0)" ::: "memory");
            const unsigned og = xb_add(&bar[XB_TOP], 1u);
            const unsigned tg = og / nx;
            if (og + 1u == (tg + 1u) * nx) xb_add(&bar[XB_TOPGEN], 1u);
            else XB_SPIN(xb_ld(&bar[XB_TOPGEN]) == tg, bar);
            __builtin_amdgcn_fence(__ATOMIC_ACQUIRE, "agent");
            xb_add(&bar[XB_XGEN(b.x)], 1u);
            asm volatile("s_waitcnt vmcnt(0)" ::: "memory");
        } else {
            XB_SPIN(xb_ld(&bar[XB_XGEN(b.x)]) == gen, bar);
            __builtin_amdgcn_fence(__ATOMIC_ACQUIRE, "agent");
            asm volatile("s_waitcnt vmcnt(0)" ::: "memory");
        }
    }
    __syncthreads();
}


struct Frame {
    LAS unsigned char* lds;
    volatile LAS unsigned* MISC;
    unsigned* ctl;
    int tid, lane, wave, vcu, G;
    const float* const* in; float* out; unsigned char* ws;
};
constexpr int PH_PRO = 0, PH_PRE = 1, PH_L0 = 2, PH_PER_LAYER = 6, PH_G1 = 0, PH_MIXA = 1, PH_MIXB = 2, PH_G3 = 3, PH_G4 = 4, PH_G5 = 5, PH_FINAL = PH_L0 + DEPTH * PH_PER_LAYER, PH_END = PH_FINAL + 1;

__device__ __forceinline__ int queue_next(Frame& F, unsigned* ctr);
constexpr int TR_P = 144;
__device__ __forceinline__ void transpose_item(const float* W, int K, int Nsrc, int src_n0, bf16_t* WT, int dst_n0, int k0, LAS unsigned char* scr, int lane, int nvalid = 64) {
    const int l16 = lane & 15, l4 = lane >> 4;
    f32x4 v[16];
#pragma unroll
    for (int i = 0; i < 16; ++i) v[i] = (src_n0 >= 0 && 4 * l16 < nvalid) ? *(const f32x4*)(W + (size_t)(k0 + 4 * i + l4) * Nsrc + src_n0 + 4 * l16) : (f32x4){0.f, 0.f, 0.f, 0.f};
#pragma unroll
    for (int i = 0; i < 16; ++i)
#pragma unroll
        for (int e = 0; e < 4; ++e) *(LAS bf16_t*)(scr + (4 * l16 + e) * TR_P + (4 * i + l4) * 2) = f2bf(v[i][e]);
    LDS_WAIT(); asm volatile("" ::: "memory");
#pragma unroll
    for (int jn = 0; jn < 8; ++jn) { const int n = 8 * jn + (lane >> 3), c = lane & 7;
        *(v4u*)(WT + (size_t)(dst_n0 + n) * K + k0 + 8 * c) = *(LAS const v4u*)(scr + n * TR_P + c * 16); }
    LDS_WAIT(); asm volatile("" ::: "memory");
}
__device__ __forceinline__ void phase_prologue(Frame& F) {
    const float* const* in = F.in;
    for (int idx = F.vcu * NTHREADS + F.tid; idx < 8192; idx += F.G * NTHREADS) {
        const int pp = idx & 63, g = (idx >> 6) & 15, dir = (idx >> 10) & 1, l = idx >> 11;
        const float are = in[20][idx], aim = in[21][idx];
        const float dt = __expf(in[22][(l * 2 + dir) * 16 + g]);
        const float zr = are * dt, zi = aim * dt;
        const float e = expf(zr); float rev = zi * 0.15915494309189535f; rev -= rintf(rev);
        const float ar = e * cosf(rev * 6.283185307179586f), ai = e * sinf(rev * 6.283185307179586f);
        float* abar = (float*)(F.ws + OFF_TAB + TAB_ABAR);
        abar[idx * 2] = ar; abar[idx * 2 + 1] = ai;
        const float xr = ar - 1.f, xi = ai, den = are * are + aim * aim;
        const float fr = (xr * are + xi * aim) / den, fi = (xi * are - xr * aim) / den;
        for (int c = 0; c < 16; ++c) {
            const float br = in[23][((l * 16 + g) * 64 + pp) * 16 + c], bi = in[24][((l * 16 + g) * 64 + pp) * 16 + c];
            bf16_t* bbt = (bf16_t*)(F.ws + OFF_TAB + TAB_BBT) + ((size_t)(((l * 2 + dir) * 16 + g) * 2) * 64 + pp) * 16 + c;
            bbt[0] = f2bf(fr * br - fi * bi); bbt[64 * 16] = f2bf(fr * bi + fi * br);
        }
    }
    for (int i = F.vcu * NTHREADS + F.tid; i < 4 * 16 * 16 * 128; i += F.G * NTHREADS) {
        const int k = i & 127, c = (i >> 7) & 15, g = (i >> 11) & 15, l = i >> 15, ri = k >> 6, pp = k & 63;
        const size_t si = ((size_t)(l * 16 + g) * 16 + c) * 64 + pp;
        ((bf16_t*)(F.ws + OFF_TAB + TAB_CC1))[i] = f2bf(ri ? -in[26][si] : in[25][si]);
    }
    for (int i = F.vcu * NTHREADS + F.tid; i < 2 * 3145728 / 8; i += F.G * NTHREADS) {
        const int which = i >= 3145728 / 8; const size_t e = (size_t)(which ? i - 3145728 / 8 : i) * 8;
        const float* src = in[which ? 3 : 2] + e; const f32x4 a = *(const f32x4*)src, b = *(const f32x4*)(src + 4);
        v4u o; o[0] = pk2(a[0], a[1]); o[1] = pk2(a[2], a[3]); o[2] = pk2(b[0], b[1]); o[3] = pk2(b[2], b[3]);
        *(v4u*)((bf16_t*)(F.ws + (which ? OFF_CV : OFF_CK)) + e) = o;
    }
    constexpr int I_IN = 16 * (PNP / 64), I_OUT = 16 * 16, I_F1 = 16 * (DFF / 64), I_F2 = (DFF / 64) * 16, I_GLU = 4 * 4, I_L = I_IN + I_OUT + I_F1 + I_F2 + I_GLU, N_TR = DEPTH * I_L;
    constexpr int N_UNITS = 96 + (N_TR + 7) / 8;
    unsigned* ctr = F.ctl + CW_Q + 64 * 63;
    for (;;) {
        const int u = queue_next(F, ctr); if (u >= N_UNITS) break;
        if (u < 96) {
            LAS float* ssil = (LAS float*)F.lds;
            LAS float* part = (LAS float*)(F.lds + 9 * 1024 * 4);
            for (int i = F.tid; i < 9 * 1024; i += NTHREADS) { const int r = i >> 10, k = i & 1023; const float v = r == 0 ? in[8][k] : in[7][(r - 1) * 1024 + k]; ssil[i] = silu_f(v); }
            __syncthreads();
            const int l = u / 24, n0 = (u % 24) * 256;
            const float* w = in[9] + (size_t)l * 1024 * 6144 + n0 + 4 * F.lane;
            f32x4 acc[9];
#pragma unroll
            for (int r = 0; r < 9; ++r) acc[r] = (f32x4){0.f, 0.f, 0.f, 0.f};
            const int kb = F.wave * 128;
            for (int k = 0; k < 128; k += 4) {
                f32x4 wv[4];
#pragma unroll
                for (int e = 0; e < 4; ++e) wv[e] = *(const f32x4*)(w + (size_t)(kb + k + e) * 6144);
#pragma unroll
                for (int r = 0; r < 9; ++r) { const f32x4 sv = *(LAS const f32x4*)(ssil + r * 1024 + kb + k);
                    acc[r] += wv[0] * sv[0]; acc[r] += wv[1] * sv[1]; acc[r] += wv[2] * sv[2]; acc[r] += wv[3] * sv[3]; }
            }
#pragma unroll
            for (int r = 0; r < 9; ++r) *(LAS f32x4*)(part + (F.wave * 9 + r) * 256 + 4 * F.lane) = acc[r];
            __syncthreads();
            float* mods = (float*)(F.ws + OFF_MODS);
            for (int i = F.tid; i < 9 * 256; i += NTHREADS) { const int r = i >> 8, jn = i & 255; float sacc = in[10][l * 6144 + n0 + jn];
#pragma unroll
                for (int w8 = 0; w8 < 8; ++w8) sacc += part[(w8 * 9 + r) * 256 + jn];
                mods[(size_t)(l * 9 + r) * 6144 + n0 + jn] = sacc; }
        } else {
            const int it = (u - 96) * 8 + F.wave;
            if (it < N_TR) {
                LAS unsigned char* scr = F.lds + F.wave * (64 * TR_P);
                const int l = it / I_L; int r = it % I_L;
                if (r < I_IN) { const int nb = r % (PNP / 64), kb = r / (PNP / 64), n0 = nb * 64; const int src = n0 > PN ? -1 : (n0 == PN ? 1024 : (n0 >= 1024 ? n0 + 12 : n0));
                    transpose_item(in[13] + (size_t)l * 1024 * IN_COLS, 1024, IN_COLS, src, (bf16_t*)(F.ws + OFF_WIN) + (size_t)l * PNP * 1024, n0, kb * 64, scr, F.lane, n0 == PN ? 12 : 64); }
                else if ((r -= I_IN) < I_OUT) { const int nb = r % 16, kb = r / 16; transpose_item(in[31] + (size_t)l * 1024 * 1024, 1024, 1024, nb * 64, (bf16_t*)(F.ws + OFF_WOUT) + (size_t)l * 1024 * 1024, nb * 64, kb * 64, scr, F.lane); }
                else if ((r -= I_OUT) < I_F1) { const int nb = r % (DFF / 64), kb = r / (DFF / 64); transpose_item(in[32] + (size_t)l * 1024 * DFF, 1024, DFF, nb * 64, (bf16_t*)(F.ws + OFF_WFF1) + (size_t)l * DFF * 1024, nb * 64, kb * 64, scr, F.lane); }
                else if ((r -= I_F1) < I_F2) { const int nb = r % 16, kb = r / 16; transpose_item(in[33] + (size_t)l * DFF * 1024, DFF, 1024, nb * 64, (bf16_t*)(F.ws + OFF_WFF2) + (size_t)l * 1024 * DFF, nb * 64, kb * 64, scr, F.lane); }
                else { r -= I_F2; const int nb = r % 4, kb = r / 4; transpose_item(in[28] + (size_t)l * 65536, 256, 256, nb * 64, (bf16_t*)(F.ws + OFF_WGLU) + (size_t)l * 65536, nb * 64, kb * 64, scr, F.lane); }
            }
        }
    }
}
__device__ __forceinline__ void phase_pre(Frame& F) {
    const float* const* in = F.in; const int lane = F.lane;
    for (int row = F.vcu * NWAVES + F.wave; row < M; row += F.G * NWAVES) {
        const float* xr = row < MC ? in[0] + (size_t)row * D : in[1] + (size_t)(row - MC) * D;
        const float* sc = (const float*)(F.ws + OFF_MODS) + (size_t)mod_row(row) * 6144 + 1024; const float* gw = in[11];
        bf16_t* h = (bf16_t*)(F.ws + OFF_H) + (size_t)row * D;
        float s = 0.f;
#pragma unroll
        for (int j = 0; j < 4; ++j) { const int c = 4 * lane + 256 * j; const f32x4 v = *(const f32x4*)(xr + c), g = *(const f32x4*)(gw + c), a = *(const f32x4*)(sc + c);
            s += v.x * v.x + v.y * v.y + v.z * v.z + v.w * v.w;
            uint2 o; o.x = pk2(v.x * g.x * (1.f + a.x), v.y * g.y * (1.f + a.y)); o.y = pk2(v.z * g.z * (1.f + a.z), v.w * g.w * (1.f + a.w)); *(uint2*)(h + c) = o; }
        s = wave_sum(s);
        if (lane < 16) ((float*)(F.ws + OFF_TAB + TAB_SQ1))[(size_t)row * 16 + lane] = lane == 0 ? s : 0.f;
    }
    const int fr = lane & 15, fq = lane >> 4, w = F.wave;
    LAS float* red = (LAS float*)F.lds;
    for (int task = F.vcu; task < DEPTH * 104; task += F.G) {
        const int l = task / 104, t = task % 104, which = t >= 40, n0 = (which ? t - 40 : t) * 64;
        const float* mods = (const float*)(F.ws + OFF_MODS) + (size_t)l * 9 * 6144 + (which ? 3 : 0) * 1024;
        const bf16_t* wt = which ? (const bf16_t*)(F.ws + OFF_WFF1) + (size_t)l * DFF * 1024 : (const bf16_t*)(F.ws + OFF_WIN) + (size_t)l * PNP * 1024;
        float* bo = (float*)(F.ws + OFF_TAB + (which ? TAB_B2 : TAB_B1)) + (size_t)l * 9 * (which ? DFF : PNP);
        f32x4 acc[4];
#pragma unroll
        for (int nb = 0; nb < 4; ++nb) acc[nb] = (f32x4){0.f, 0.f, 0.f, 0.f};
#pragma unroll
        for (int ks = 0; ks < 4; ++ks) {
            const int k0 = 128 * w + 32 * ks + 8 * fq;
            union { bf16x8 v; unsigned u[4]; } af; af.u[0] = af.u[1] = af.u[2] = af.u[3] = 0u;
            if (fr < 9) { const f32x4 a0 = *(const f32x4*)(mods + (size_t)fr * 6144 + k0), a1 = *(const f32x4*)(mods + (size_t)fr * 6144 + k0 + 4);
                af.u[0] = pk2(a0[0], a0[1]); af.u[1] = pk2(a0[2], a0[3]); af.u[2] = pk2(a1[0], a1[1]); af.u[3] = pk2(a1[2], a1[3]); }
#pragma unroll
            for (int nb = 0; nb < 4; ++nb) { const bf16x8 bfr = *(const bf16x8*)(wt + (size_t)(n0 + 16 * nb + fr) * 1024 + k0); acc[nb] = __builtin_amdgcn_mfma_f32_16x16x32_bf16(af.v, bfr, acc[nb], 0, 0, 0); }
        }
        __syncthreads();
#pragma unroll
        for (int nb = 0; nb < 4; ++nb) *(LAS f32x4*)(red + ((w * 4 + nb) * 64 + lane) * 4) = acc[nb];
        __syncthreads();
        for (int i = F.tid; i < 1024; i += NTHREADS) { float sacc = 0.f;
#pragma unroll
            for (int w8 = 0; w8 < 8; ++w8) sacc += red[w8 * 1024 + i];
            const int nb = i >> 8, ln = (i >> 2) & 63, e = i & 3, r = 4 * (ln >> 4) + e;
            if (r < 9) bo[(size_t)r * (which ? DFF : PNP) + n0 + 16 * nb + (ln & 15)] = sacc; }
    }
}
constexpr int EPI_SIDE_OFF = RING_BYTES;
template <class Sched>
__device__ __forceinline__ void epi_side_fill(Frame& F, const Sched& S, const float* ssq, const float* bias, int ldb) {
    LAS float* side = (LAS float*)(F.lds + EPI_SIDE_OFF);
    pg8::Unit u;
    for (int i = 0; i < 4 && S.next(i, u); ++i) {
        if (F.tid < 256) { const f32x4* p = (const f32x4*)(ssq + (size_t)(u.pm * 256 + F.tid) * 16); const f32x4 a = p[0], b = p[1], c = p[2], d = p[3];
            const float sm = ((a[0] + a[1]) + (a[2] + a[3])) + ((b[0] + b[1]) + (b[2] + b[3])) + ((c[0] + c[1]) + (c[2] + c[3])) + ((d[0] + d[1]) + (d[2] + d[3]));
            side[i * 256 + F.tid] = rsqrtf(sm * (1.f / 1024.f) + EPS); }
        else { const int r = u.pm < 32 ? 0 : 1 + ((u.pm - 32) >> 2); side[1024 + i * 256 + F.tid - 256] = bias[(size_t)r * ldb + u.pn * 256 + F.tid - 256]; }
    }
    __syncthreads();
}
__device__ __forceinline__ void phase_final(Frame& F) {
    const int lane = F.lane; const float* gw = F.in[34];
    for (int row = F.vcu * NWAVES + F.wave; row < M; row += F.G * NWAVES) {
        const bf16_t* xr = (const bf16_t*)(F.ws + OFF_X) + (size_t)row * D;
        f32x4 v[4]; float s = 0.f;
#pragma unroll
        for (int j = 0; j < 4; ++j) { const uint2 q = *(const uint2*)(xr + 4 * lane + 256 * j); v[j] = (f32x4){__uint_as_float(q.x << 16), __uint_as_float(q.x & 0xffff0000u), __uint_as_float(q.y << 16), __uint_as_float(q.y & 0xffff0000u)};
            s += v[j].x * v[j].x + v[j].y * v[j].y + v[j].z * v[j].z + v[j].w * v[j].w; }
        const float rstd = rsqrtf(wave_sum(s) * (1.f / D) + EPS);
        float* o = F.out + (size_t)row * D;
#pragma unroll
        for (int j = 0; j < 4; ++j) { const int c = 4 * lane + 256 * j; const f32x4 g = *(const f32x4*)(gw + c); f32x4 r = {v[j].x * rstd * g.x, v[j].y * rstd * g.y, v[j].z * rstd * g.z, v[j].w * rstd * g.w}; *(f32x4*)(o + c) = r; }
    }
}


typedef short v4i16_t __attribute__((ext_vector_type(4)));
constexpr int AT_KP = 160;
constexpr int AT_TILE = 128 * AT_KP;
constexpr int AT_K0 = 0, AT_V0 = 2 * AT_TILE, AT_RPB = 4 * AT_TILE, AT_END = AT_RPB + 2048;
__device__ __forceinline__ int queue_next(Frame& F, unsigned* ctr) {
    int t_ = F.wave * 64 + lane_id(); asm volatile("" : "+v"(t_));
    unsigned slot = MISC_OFF + 64; asm volatile("" : "+v"(slot));
    volatile LAS unsigned* bw = (volatile LAS unsigned*)(F.lds + slot);
    __syncthreads();
    if (t_ == 0) *bw = atomicAdd(ctr, 1u);
    __syncthreads();
    F.tid = t_; F.lane = t_ & 63;
    return (int)*bw;
}
__device__ __forceinline__ bf16x8 tr2(LAS const unsigned char* a, LAS const unsigned char* b) {
    const v4i16_t x = __builtin_amdgcn_ds_read_tr16_b64_v4i16((LAS v4i16_t*)a), y = __builtin_amdgcn_ds_read_tr16_b64_v4i16((LAS v4i16_t*)b);
    return (bf16x8){x[0], x[1], x[2], x[3], y[0], y[1], y[2], y[3]};
}
struct AttnState { f32x4 o[4]; float m, l; };
template <int NKB, bool MASKED>
__device__ __forceinline__ void attn_tile(AttnState& st, LAS const unsigned char* Kt, LAS const unsigned char* Vt, const bf16x8 (&qf)[2], int c0, int lane,
                                          LAS const float* rpbrow, int cw, int qc) {
    const int fr = lane & 15, fq = lane >> 4;
    f32x4 s[NKB];
#pragma unroll
    for (int kb = 0; kb < NKB; ++kb) {
        s[kb] = (f32x4){0.f, 0.f, 0.f, 0.f};
#pragma unroll
        for (int ks = 0; ks < 2; ++ks) {
            const bf16x8 a = *(LAS const bf16x8*)(Kt + (c0 + 16 * kb + fr) * AT_KP + (32 * ks + 8 * fq) * 2);
            s[kb] = __builtin_amdgcn_mfma_f32_16x16x32_bf16(a, qf[ks], s[kb], 0, 0, 0);
        }
    }
    float mloc = -1e30f;
#pragma unroll
    for (int kb = 0; kb < NKB; ++kb)
#pragma unroll
        for (int i = 0; i < 4; ++i) {
            float t = s[kb][i] * 0.125f;
            if (MASKED) { const int kc = cw + 16 * kb + 4 * fq + i, cs = min(max(qc - 8, 0), 48); t = (kc >= cs && kc < cs + 16) ? t + rpbrow[kc - qc + 15] : -1e30f; }
            s[kb][i] = t; mloc = fmaxf(mloc, t);
        }
    mloc = xmax32(xmax16(mloc));
    const float mn = fmaxf(st.m, mloc), alpha = __expf(st.m - mn);
    st.m = mn;
    float ls = 0.f;
#pragma unroll
    for (int kb = 0; kb < NKB; ++kb)
#pragma unroll
        for (int i = 0; i < 4; ++i) { const float pv = __expf(s[kb][i] - mn); s[kb][i] = pv; ls += pv; }
    st.l = st.l * alpha + ls;
#pragma unroll
    for (int db = 0; db < 4; ++db) st.o[db] = st.o[db] * alpha;
#pragma unroll
    for (int kk = 0; kk < NKB / 2; ++kk) {
        union { bf16x8 v; unsigned u[4]; } pf;
        pf.u[0] = pk2(s[2 * kk][0], s[2 * kk][1]); pf.u[1] = pk2(s[2 * kk][2], s[2 * kk][3]);
        pf.u[2] = pk2(s[2 * kk + 1][0], s[2 * kk + 1][1]); pf.u[3] = pk2(s[2 * kk + 1][2], s[2 * kk + 1][3]);
        LAS const unsigned char* va = Vt + (c0 + 32 * kk + 4 * fq + (fr >> 2)) * AT_KP + (4 * (fr & 3)) * 2;
#pragma unroll
        for (int db = 0; db < 4; ++db) {
            const bf16x8 vf = tr2(va + db * 32, va + 16 * AT_KP + db * 32);
            st.o[db] = __builtin_amdgcn_mfma_f32_16x16x32_bf16(vf, pf.v, st.o[db], 0, 0, 0);
        }
    }
}
struct AttnChain { AttnState st; bf16x8 qf[2]; int qrow, c0; };
__device__ __forceinline__ void attn_chain_init(AttnChain& ch, const bf16_t* proj, int qrow, int c0, int h, bool nat, int fq) {
    ch.qrow = qrow; ch.c0 = c0;
#pragma unroll
    for (int ks = 0; ks < 2; ++ks) ch.qf[ks] = *(const bf16x8*)(proj + (size_t)qrow * PN + PQ + h * 64 + 32 * ks + 8 * fq);
    ch.st.m = -1e30f; ch.st.l = 0.f;
#pragma unroll
    for (int db = 0; db < 4; ++db) ch.st.o[db] = (f32x4){0.f, 0.f, 0.f, 0.f};
}
__device__ __forceinline__ void attn_chain_store(const AttnChain& ch, bf16_t* mixb, int h, int fq) {
    const float inv = 1.f / xsum32(xsum16(ch.st.l));
    bf16_t* mix = mixb + (size_t)ch.qrow * D + 640 + h * 64 + 4 * fq;
#pragma unroll
    for (int db = 0; db < 4; ++db) { uint2 o; o.x = pk2(ch.st.o[db][0] * inv, ch.st.o[db][1] * inv); o.y = pk2(ch.st.o[db][2] * inv, ch.st.o[db][3] * inv); *(uint2*)(mix + 16 * db) = o; }
}
__device__ __forceinline__ void attn_unit(Frame& F, int l, int unit) {
    const int tid = F.tid, w = F.wave, fr = F.lane & 15, fq = F.lane >> 4;
    const bf16_t* proj = (const bf16_t*)(F.ws + OFF_PROJ);
    LAS unsigned char* lds = F.lds;
    const bool nat = unit < 192;
    int b, h, r = 0, rs_w = 0, rs0 = 0, nlat = 0;
    AttnChain ch0, ch1;
    if (nat) { b = unit / 24; h = (unit / 4) % 6; const int rq = unit % 4; r = 4 * rq + (w >> 1);
        rs_w = min(max(r - 4, 0), 8); rs0 = min(max(4 * rq - 4, 0), 8); const int rsl = min(max(4 * rq + 3 - 4, 0), 8); nlat = rsl + 8 - rs0;
        const int qb = MC + b * 1024 + r * 64 + fr;
        if (w & 1) { attn_chain_init(ch0, proj, qb + 32, 24, h, true, fq); attn_chain_init(ch1, proj, qb + 48, 32, h, true, fq); }
        else { attn_chain_init(ch0, proj, qb, 0, h, true, fq); attn_chain_init(ch1, proj, qb + 16, 8, h, true, fq); }
    } else { const int v = unit - 192; b = v / 6; h = v % 6; const int qb = b * 256 + 32 * w + fr;
        attn_chain_init(ch0, proj, qb, 0, h, false, fq); attn_chain_init(ch1, proj, qb + 16, 0, h, false, fq); }
    const int nlt = (nlat + 1) >> 1;
    const int ntiles = nat ? nlt + 2 : 2;
    if (nat) { const float* rpb = F.in[30] + (size_t)(l * 6 + h) * 465; for (int i = tid; i < 465; i += NTHREADS) ((LAS float*)(lds + AT_RPB))[i] = rpb[i]; }
    const int skey = tid >> 2, sch = (tid & 3) * 2;
    v4u rk0 = {0u, 0u, 0u, 0u}, rk1 = rk0, rv0 = rk0, rv1 = rk0;
#define AT_LOAD(ti_) do { const int ti__ = (ti_); \
        if (nat && ti__ >= nlt) { const size_t off = ((size_t)(b * 4 + l) * 256 + (ti__ - nlt) * 128 + skey) * 384 + h * 64 + sch * 8; \
            const bf16_t* pk_ = (const bf16_t*)(F.ws + OFF_CK) + off; const bf16_t* pv_ = (const bf16_t*)(F.ws + OFF_CV) + off; \
            rk0 = *(const v4u*)pk_; rk1 = *(const v4u*)(pk_ + 8); rv0 = *(const v4u*)pv_; rv1 = *(const v4u*)(pv_ + 8); \
        } else { const int grow = nat ? MC + b * 1024 + min(rs0 + 2 * ti__ + (skey >> 6), 15) * 64 + (skey & 63) : b * 256 + ti__ * 128 + skey; \
            const bf16_t* pr = proj + (size_t)grow * PN + h * 64 + sch * 8; rk0 = *(const v4u*)(pr + PK); rk1 = *(const v4u*)(pr + PK + 8); rv0 = *(const v4u*)(pr + PV); rv1 = *(const v4u*)(pr + PV + 8); } } while (0)
#define AT_WRITE(buf_) do { const int buf__ = (buf_); \
        *(LAS v4u*)(lds + AT_K0 + buf__ * AT_TILE + skey * AT_KP + sch * 16) = rk0; *(LAS v4u*)(lds + AT_K0 + buf__ * AT_TILE + skey * AT_KP + sch * 16 + 16) = rk1; \
        *(LAS v4u*)(lds + AT_V0 + buf__ * AT_TILE + skey * AT_KP + sch * 16) = rv0; *(LAS v4u*)(lds + AT_V0 + buf__ * AT_TILE + skey * AT_KP + sch * 16 + 16) = rv1; } while (0)
    AT_LOAD(0); AT_WRITE(0);
    __syncthreads();
    for (int ti = 0; ti < ntiles; ++ti) {
        const int buf = ti & 1;
        if (ti + 1 < ntiles) AT_LOAD(ti + 1);
        int lane = F.lane; asm volatile("" : "+v"(lane));
        LAS const unsigned char* Kt = lds + AT_K0 + buf * AT_TILE; LAS const unsigned char* Vt = lds + AT_V0 + buf * AT_TILE;
        if (nat && ti < nlt) {
#pragma unroll
            for (int sub = 0; sub < 2; ++sub) { const int kr = rs0 + 2 * ti + sub;
                if (kr >= rs_w && kr < rs_w + 8) { LAS const float* rrow = (LAS const float*)(lds + AT_RPB) + (kr - r + 7) * 31;
                    attn_tile<2, true>(ch0.st, Kt, Vt, ch0.qf, 64 * sub + ch0.c0, lane, rrow, ch0.c0, (ch0.qrow - MC) & 63); attn_tile<2, true>(ch1.st, Kt, Vt, ch1.qf, 64 * sub + ch1.c0, lane, rrow, ch1.c0, (ch1.qrow - MC) & 63); }
                __builtin_amdgcn_sched_barrier(0); }
        } else {
#pragma unroll
            for (int hf = 0; hf < 2; ++hf) {
                attn_tile<4, false>(ch0.st, Kt, Vt, ch0.qf, 64 * hf, lane, (LAS const float*)(lds + AT_RPB), 0, 0);
                attn_tile<4, false>(ch1.st, Kt, Vt, ch1.qf, 64 * hf, lane, (LAS const float*)(lds + AT_RPB), 0, 0); __builtin_amdgcn_sched_barrier(0); }
        }
        if (ti + 1 < ntiles) AT_WRITE(buf ^ 1);
        __syncthreads();
    }
    attn_chain_store(ch0, (bf16_t*)(F.ws + OFF_MIX), h, fq); attn_chain_store(ch1, (bf16_t*)(F.ws + OFF_MIX), h, fq);
}
constexpr int SS_P = 144;
constexpr int SS_IMG = 128 * SS_P;
constexpr int SS_HP = 144, SS_HIMG = 64 * SS_HP;
constexpr int SSA_B = 0, SSA_X = SS_IMG, SSA_TAB = 7 * SS_IMG;
constexpr int SSB_B = 0, SSB_C = SS_IMG, SSB_X = 2 * SS_IMG, SSB_H = 5 * SS_IMG, SSB_TAB = 5 * SS_IMG + 6 * SS_HIMG;
static_assert(SSB_TAB + 3 * 4 * 128 * 4 <= 163328 && SSA_TAB + 3 * 4 * 128 * 4 <= 163328, "SSD LDS map");
__device__ __forceinline__ void conv16(const bf16_t* proj, const float* cw, const float* cb, int seq_start, int seq_L, int t, int ch0, float (&v)[16]) {
#pragma unroll
    for (int e = 0; e < 16; e += 4) { const f32x4 b = *(const f32x4*)(cb + ch0 + e); v[e] = b[0]; v[e + 1] = b[1]; v[e + 2] = b[2]; v[e + 3] = b[3]; }
#pragma unroll
    for (int j = 0; j < 5; ++j) {
        const int tt = t + j - 2;
        if (tt >= 0 && tt < seq_L) {
            const bf16_t* src = proj + (size_t)(seq_start + tt) * PN + PX + ch0;
            const v4u r0 = *(const v4u*)src, r1 = *(const v4u*)(src + 8);
            const unsigned rr[8] = {r0[0], r0[1], r0[2], r0[3], r1[0], r1[1], r1[2], r1[3]};
#pragma unroll
            for (int e = 0; e < 16; e += 4) { const f32x4 w = *(const f32x4*)(cw + j * 640 + ch0 + e);
                v[e] += w[0] * __uint_as_float(rr[e / 2] << 16); v[e + 1] += w[1] * __uint_as_float(rr[e / 2] & 0xffff0000u);
                v[e + 2] += w[2] * __uint_as_float(rr[e / 2 + 1] << 16); v[e + 3] += w[3] * __uint_as_float(rr[e / 2 + 1] & 0xffff0000u); }
        }
    }
#pragma unroll
    for (int e = 0; e < 16; ++e) v[e] = silu_f(v[e]);
}
__device__ __forceinline__ void conv4x8(const bf16_t* proj, const float* cw, const float* cb, int seq_start, int seq_L, int t, int ch0, float (&v)[4][8]) {
    float xin[8][8];
#pragma unroll
    for (int rr = 0; rr < 8; ++rr) { const int tt = t - 2 + rr; v4u r = {0u, 0u, 0u, 0u};
        if (tt >= 0 && tt < seq_L) r = *(const v4u*)(proj + (size_t)(seq_start + tt) * PN + PX + ch0);
#pragma unroll
        for (int e = 0; e < 4; ++e) { xin[rr][2 * e] = __uint_as_float(r[e] << 16); xin[rr][2 * e + 1] = __uint_as_float(r[e] & 0xffff0000u); } }
    const f32x4 b0 = *(const f32x4*)(cb + ch0), b1 = *(const f32x4*)(cb + ch0 + 4);
#pragma unroll
    for (int k = 0; k < 4; ++k) { v[k][0] = b0[0]; v[k][1] = b0[1]; v[k][2] = b0[2]; v[k][3] = b0[3]; v[k][4] = b1[0]; v[k][5] = b1[1]; v[k][6] = b1[2]; v[k][7] = b1[3]; }
#pragma unroll
    for (int j = 0; j < 5; ++j) { const f32x4 w0 = *(const f32x4*)(cw + j * 640 + ch0), w1 = *(const f32x4*)(cw + j * 640 + ch0 + 4);
#pragma unroll
        for (int k = 0; k < 4; ++k) { v[k][0] += w0[0] * xin[k + j][0]; v[k][1] += w0[1] * xin[k + j][1]; v[k][2] += w0[2] * xin[k + j][2]; v[k][3] += w0[3] * xin[k + j][3];
            v[k][4] += w1[0] * xin[k + j][4]; v[k][5] += w1[1] * xin[k + j][5]; v[k][6] += w1[2] * xin[k + j][6]; v[k][7] += w1[3] * xin[k + j][7]; } }
#pragma unroll
    for (int k = 0; k < 4; ++k)
#pragma unroll
        for (int e = 0; e < 8; ++e) v[k][e] = silu_f(v[k][e]);
}
__device__ __forceinline__ void store8(LAS unsigned char* dst, const float (&v)[8], float sc) {
    v4u o; o[0] = pk2(v[0] * sc, v[1] * sc); o[1] = pk2(v[2] * sc, v[3] * sc); o[2] = pk2(v[4] * sc, v[5] * sc); o[3] = pk2(v[6] * sc, v[7] * sc);
    *(LAS v4u*)dst = o;
}
__device__ __forceinline__ void store16(LAS unsigned char* dst, const float (&v)[16], float sc) {
    v4u o0, o1;
    o0[0] = pk2(v[0] * sc, v[1] * sc); o0[1] = pk2(v[2] * sc, v[3] * sc); o0[2] = pk2(v[4] * sc, v[5] * sc); o0[3] = pk2(v[6] * sc, v[7] * sc);
    o1[0] = pk2(v[8] * sc, v[9] * sc); o1[1] = pk2(v[10] * sc, v[11] * sc); o1[2] = pk2(v[12] * sc, v[13] * sc); o1[3] = pk2(v[14] * sc, v[15] * sc);
    *(LAS v4u*)dst = o0; *(LAS v4u*)(dst + 16) = o1;
}
__device__ __forceinline__ void ssd_table(const float* dtraw  , float bias, float a, int dir, LAS float* tab, int lane) {
    const float d0 = softplus_f(dtraw[(2 * lane) * 12] + bias), d1 = softplus_f(dtraw[(2 * lane + 1) * 12] + bias);
    const float ps = d0 + d1; float x = ps;
    x += dppf<0x111>(x); x += dppf<0x112>(x); x += dppf<0x114>(x); x += dppf<0x118>(x);
    { const float t15 = rdlane(x, 15), t31 = rdlane(x, 31), t47 = rdlane(x, 47); const int rw = lane >> 4;
      x += (rw >= 1 ? t15 : 0.f) + (rw >= 2 ? t31 : 0.f) + (rw >= 3 ? t47 : 0.f); }
    tab[2 * lane] = d0; tab[2 * lane + 1] = d1;
    if (dir == 0) { const float ex = x - ps; tab[128 + 2 * lane] = a * (ex + d0); tab[128 + 2 * lane + 1] = a * (ex + ps); }
    else { const float tot = rdlane(x, 63); const float sx = tot - x; tab[128 + 2 * lane + 1] = a * (sx + d1); tab[128 + 2 * lane] = a * (sx + ps); }
}
__device__ __forceinline__ void ssd_a_unit(Frame& F, int l, int unit) {
    const int tid = F.tid, lane = F.lane, w = F.wave, fr = lane & 15, fq = lane >> 4;
    const int ci = unit >> 1, g = unit & 1, row0 = ci * 128;
    const SeqInfo q = row_seq(row0); const int t0 = row0 - q.start;
    const bf16_t* proj = (const bf16_t*)(F.ws + OFF_PROJ);
    const float* cw = F.in[14] + l * 5 * 640; const float* cb = F.in[15] + l * 640;
    LAS unsigned char* lds = F.lds; LAS float* tabs = (LAS float*)(lds + SSA_TAB);
    if (w < 6) { const int hh = w >> 1, dir = w & 1, h = 3 * g + hh;
        ssd_table((const float*)(F.ws + OFF_DT) + (size_t)row0 * 12 + dir * 6 + h, F.in[16][(l * 2 + dir) * 6 + h], -__expf(F.in[17][(l * 2 + dir) * 6 + h]), dir, tabs + (hh * 4 + dir * 2) * 128, lane); }
    float cv[2][4][8];
#pragma unroll
    for (int k2 = 0; k2 < 2; ++k2) { const int task = tid + k2 * NTHREADS, img = task >> 8, oc = (task >> 5) & 7, tb = task & 31;
        conv4x8(proj, cw, cb, q.start, q.L, t0 + 4 * tb, (img == 0 ? 384 + g * 64 : (3 * g + img - 1) * 64) + 8 * oc, cv[k2]); }
    __syncthreads();
#pragma unroll
    for (int k2 = 0; k2 < 2; ++k2) { const int task = tid + k2 * NTHREADS, img = task >> 8, oc = (task >> 5) & 7, tb = task & 31;
        if (img == 0) {
#pragma unroll
            for (int k = 0; k < 4; ++k) store8(lds + SSA_B + (4 * tb + k) * SS_P + oc * 16, cv[k2][k], 1.f);
        } else { const int hh = img - 1; LAS const float* tb4 = tabs + hh * 4 * 128;
#pragma unroll
            for (int k = 0; k < 4; ++k) { const int t = 4 * tb + k;
                const float wf = __expf(tb4[128 + 127] - tb4[128 + t]) * tb4[t], wb = __expf(tb4[384] - tb4[384 + t]) * tb4[256 + t];
                store8(lds + SSA_X + (2 * hh) * SS_IMG + t * SS_P + oc * 16, cv[k2][k], wf); store8(lds + SSA_X + (2 * hh + 1) * SS_IMG + t * SS_P + oc * 16, cv[k2][k], wb); } }
    }
    __syncthreads();
    const int dir = w >> 2, pb = w & 3;
    for (int hh = 0; hh < 3; ++hh) {
        const int h = 3 * g + hh;
        LAS const unsigned char* xa = lds + SSA_X + (2 * hh + dir) * SS_IMG + (4 * fq + (fr >> 2)) * SS_P + (16 * pb + 4 * (fr & 3)) * 2;
        LAS const unsigned char* ba = lds + SSA_B + (4 * fq + (fr >> 2)) * SS_P + (4 * (fr & 3)) * 2;
        f32x4 acc[4];
#pragma unroll
        for (int nb = 0; nb < 4; ++nb) acc[nb] = (f32x4){0.f, 0.f, 0.f, 0.f};
#pragma unroll
        for (int kk = 0; kk < 4; ++kk) {
            const bf16x8 af = tr2(xa + kk * 32 * SS_P, xa + (kk * 32 + 16) * SS_P);
#pragma unroll
            for (int nb = 0; nb < 4; ++nb) { const bf16x8 bfr = tr2(ba + kk * 32 * SS_P + nb * 32, ba + (kk * 32 + 16) * SS_P + nb * 32); acc[nb] = __builtin_amdgcn_mfma_f32_16x16x32_bf16(af, bfr, acc[nb], 0, 0, 0); }
        }
        float* cs = (float*)(F.ws + OFF_CS) + ((size_t)(ci * 6 + h) * 2 + dir) * 4096;
#pragma unroll
        for (int nb = 0; nb < 4; ++nb)
#pragma unroll
            for (int i = 0; i < 4; ++i) cs[(16 * pb + 4 * fq + i) * 64 + 16 * nb + fr] = acc[nb][i];
        if (tid == 0) { LAS const float* tb = tabs + hh * 4 * 128; float* cd = (float*)(F.ws + OFF_TAB + TAB_CD) + (size_t)(ci * 6 + h) * 2; cd[0] = __expf(tb[128 + 127]); cd[1] = __expf(tb[384]); }
    }
}
__device__ __forceinline__ void ssd_state_pass(Frame& F, int l) {
    const int tid = F.tid, p = tid >> 3, n0 = (tid & 7) * 8;
    const float* cdt = (const float*)(F.ws + OFF_TAB + TAB_CD); const float* csb = (const float*)(F.ws + OFF_CS);
    bf16_t* hin = (bf16_t*)(F.ws + OFF_HIN);
    for (int task = F.vcu; task < NSEQ * 12; task += F.G) {
        int s, hd; if (task < LB * 12) { s = CB + task / 12; hd = task % 12; } else { s = (task - LB * 12) / 12; hd = (task - LB * 12) % 12; }
        const int h = hd >> 1, dir = hd & 1;
        const SeqInfo q = seq_info(s); const int nch = q.L >> 7, ci0 = q.start >> 7;
        f32x4 s0 = {0.f, 0.f, 0.f, 0.f}, s1 = s0;
        if (!q.ctx) { const float* h0 = F.in[4] + ((((size_t)q.b * 4 + l) * 2 + dir) * 6 + h) * 4096 + p * 64 + n0; s0 = *(const f32x4*)h0; s1 = *(const f32x4*)(h0 + 4); }
        for (int k = 0; k < nch; k += 2) {
            size_t ix[2]; float dcy[2]; f32x4 c0[2], c1[2];
#pragma unroll
            for (int u = 0; u < 2; ++u) { const int c = dir == 0 ? k + u : nch - 1 - (k + u); ix[u] = (size_t)((ci0 + c) * 6 + h) * 2 + dir;
                dcy[u] = cdt[ix[u]]; const float* cs = csb + ix[u] * 4096 + p * 64 + n0; c0[u] = *(const f32x4*)cs; c1[u] = *(const f32x4*)(cs + 4); }
#pragma unroll
            for (int u = 0; u < 2; ++u) {
                v4u o; o[0] = pk2(s0[0], s0[1]); o[1] = pk2(s0[2], s0[3]); o[2] = pk2(s1[0], s1[1]); o[3] = pk2(s1[2], s1[3]);
                *(v4u*)(hin + ix[u] * 4096 + p * 64 + n0) = o;
                s0 = s0 * dcy[u] + c0[u]; s1 = s1 * dcy[u] + c1[u];
            }
        }
        if (q.ctx) { float* o4 = F.out + O_SSD + ((((size_t)q.b * 4 + l) * 2 + dir) * 6 + h) * 4096 + p * 64 + n0; *(f32x4*)o4 = s0; *(f32x4*)(o4 + 4) = s1; }
    }
}
__device__ __forceinline__ void ssd_b_unit(Frame& F, int l, int unit) {
    const int tid = F.tid, lane = F.lane, w = F.wave, fr = lane & 15, fq = lane >> 4;
    const int ci = unit >> 1, g = unit & 1, row0 = ci * 128;
    const SeqInfo q = row_seq(row0); const int t0 = row0 - q.start;
    const bf16_t* proj = (const bf16_t*)(F.ws + OFF_PROJ);
    const float* cw = F.in[14] + l * 5 * 640; const float* cb = F.in[15] + l * 640;
    LAS unsigned char* lds = F.lds; LAS float* tabs = (LAS float*)(lds + SSB_TAB);
    if (w < 6) { const int hh = w >> 1, dir = w & 1, h = 3 * g + hh;
        ssd_table((const float*)(F.ws + OFF_DT) + (size_t)row0 * 12 + dir * 6 + h, F.in[16][(l * 2 + dir) * 6 + h], -__expf(F.in[17][(l * 2 + dir) * 6 + h]), dir, tabs + (hh * 4 + dir * 2) * 128, lane); }
    {
        const bf16_t* hin = (const bf16_t*)(F.ws + OFF_HIN) + (size_t)((ci * 6 + 3 * g) * 2) * 4096 + (tid >> 3) * 64 + (tid & 7) * 8;
#pragma unroll
        for (int k = 0; k < 6; ++k) *(LAS v4u*)(lds + SSB_H + k * SS_HIMG + (tid >> 3) * SS_HP + (tid & 7) * 16) = *(const v4u*)(hin + (size_t)k * 4096);
    }
    for (int task = tid; task < 1280; task += NTHREADS) {
        const int img = task >> 8, oc = (task >> 5) & 7, tb = task & 31;
        const int chb = img == 0 ? 384 + g * 64 : (img == 1 ? 512 + g * 64 : (3 * g + img - 2) * 64);
        float v[4][8]; conv4x8(proj, cw, cb, q.start, q.L, t0 + 4 * tb, chb + 8 * oc, v);
        LAS unsigned char* dst = lds + (img == 0 ? SSB_B : (img == 1 ? SSB_C : SSB_X + (img - 2) * SS_IMG)) + (4 * tb) * SS_P + oc * 16;
#pragma unroll
        for (int k = 0; k < 4; ++k) store8(dst + k * SS_P, v[k], 1.f);
    }
    __syncthreads();
    bf16x8 cf[2];
#pragma unroll
    for (int ks = 0; ks < 2; ++ks) cf[ks] = *(LAS const bf16x8*)(lds + SSB_C + (16 * w + fr) * SS_P + (32 * ks + 8 * fq) * 2);
    f32x4 gt[8];
#pragma unroll
    for (int sb = 0; sb < 8; ++sb) { gt[sb] = (f32x4){0.f, 0.f, 0.f, 0.f};
#pragma unroll
        for (int ks = 0; ks < 2; ++ks) { const bf16x8 bfr = *(LAS const bf16x8*)(lds + SSB_B + (16 * sb + fr) * SS_P + (32 * ks + 8 * fq) * 2); gt[sb] = __builtin_amdgcn_mfma_f32_16x16x32_bf16(bfr, cf[ks], gt[sb], 0, 0, 0); } }
    float ss[4] = {0.f, 0.f, 0.f, 0.f};
    bf16_t* yup = (bf16_t*)(F.ws + OFF_MIX) + (size_t)(row0 + 16 * w + 4 * fq) * D + fr;
    for (int hh = 0; hh < 3; ++hh) {
        const int h = 3 * g + hh;
        LAS const float* tb = tabs + hh * 4 * 128;
        unsigned short zv[4][4];
#pragma unroll
        for (int i = 0; i < 4; ++i)
#pragma unroll
            for (int pb = 0; pb < 4; ++pb) zv[i][pb] = proj[(size_t)(row0 + 16 * w + 4 * fq + i) * PN + PZ + h * 64 + 16 * pb + fr];
        const float at = tb[128 + 16 * w + fr], bt = tb[384 + 16 * w + fr];
        f32x4 y[4];
#pragma unroll
        for (int pb = 0; pb < 4; ++pb) y[pb] = (f32x4){0.f, 0.f, 0.f, 0.f};
        LAS const unsigned char* xa = lds + SSB_X + hh * SS_IMG + (4 * fq + (fr >> 2)) * SS_P + (4 * (fr & 3)) * 2;
#pragma unroll
        for (int kk = 0; kk < 4; ++kk) {
            float mv[8];
#pragma unroll
            for (int half = 0; half < 2; ++half) { const int sb = 2 * kk + half; const int s0i = 16 * sb + 4 * fq;
                if (sb < w) { const f32x4 cumf = *(LAS const f32x4*)(tb + 128 + s0i), dtf = *(LAS const f32x4*)(tb + s0i);
#pragma unroll
                    for (int i = 0; i < 4; ++i) mv[half * 4 + i] = __expf(at - cumf[i]) * dtf[i] * gt[sb][i];
                } else if (sb > w) { const f32x4 cumb = *(LAS const f32x4*)(tb + 384 + s0i), dtb = *(LAS const f32x4*)(tb + 256 + s0i);
#pragma unroll
                    for (int i = 0; i < 4; ++i) mv[half * 4 + i] = __expf(bt - cumb[i]) * dtb[i] * gt[sb][i];
                } else { const f32x4 cumf = *(LAS const f32x4*)(tb + 128 + s0i), dtf = *(LAS const f32x4*)(tb + s0i), cumb = *(LAS const f32x4*)(tb + 384 + s0i), dtb = *(LAS const f32x4*)(tb + 256 + s0i);
#pragma unroll
                    for (int i = 0; i < 4; ++i) { const int s = s0i + i, t = 16 * w + fr; float m = 0.f;
                        if (s <= t) m += __expf(at - cumf[i]) * dtf[i];
                        if (s >= t) m += __expf(bt - cumb[i]) * dtb[i];
                        mv[half * 4 + i] = m * gt[sb][i]; } } }
            union { bf16x8 v; unsigned u[4]; } mf; mf.u[0] = pk2(mv[0], mv[1]); mf.u[1] = pk2(mv[2], mv[3]); mf.u[2] = pk2(mv[4], mv[5]); mf.u[3] = pk2(mv[6], mv[7]);
#pragma unroll
            for (int pb = 0; pb < 4; ++pb) { const bf16x8 xf = tr2(xa + kk * 32 * SS_P + pb * 32, xa + (kk * 32 + 16) * SS_P + pb * 32); y[pb] = __builtin_amdgcn_mfma_f32_16x16x32_bf16(mf.v, xf, y[pb], 0, 0, 0); }
        }
        f32x4 yf[4], yb[4];
#pragma unroll
        for (int pb = 0; pb < 4; ++pb) { yf[pb] = (f32x4){0.f, 0.f, 0.f, 0.f}; yb[pb] = yf[pb];
#pragma unroll
            for (int ks = 0; ks < 2; ++ks) {
                const bf16x8 hf = *(LAS const bf16x8*)(lds + SSB_H + (2 * hh) * SS_HIMG + (16 * pb + fr) * SS_HP + (32 * ks + 8 * fq) * 2);
                const bf16x8 hb = *(LAS const bf16x8*)(lds + SSB_H + (2 * hh + 1) * SS_HIMG + (16 * pb + fr) * SS_HP + (32 * ks + 8 * fq) * 2);
                yf[pb] = __builtin_amdgcn_mfma_f32_16x16x32_bf16(cf[ks], hf, yf[pb], 0, 0, 0);
                yb[pb] = __builtin_amdgcn_mfma_f32_16x16x32_bf16(cf[ks], hb, yb[pb], 0, 0, 0); } }
        const float dsk = F.in[18][l * 6 + h];
        float nwv[4];
#pragma unroll
        for (int pb = 0; pb < 4; ++pb) nwv[pb] = F.in[19][l * 384 + h * 64 + 16 * pb + fr];
        const f32x4 cumf4 = *(LAS const f32x4*)(tb + 128 + 16 * w + 4 * fq), cumb4 = *(LAS const f32x4*)(tb + 384 + 16 * w + 4 * fq);
#pragma unroll
        for (int i = 0; i < 4; ++i) { const float ef = __expf(cumf4[i]), eb = __expf(cumb4[i]); const int tl = 16 * w + 4 * fq + i;
#pragma unroll
            for (int pb = 0; pb < 4; ++pb) { const float xv = bf2f(*(LAS const bf16_t*)(lds + SSB_X + hh * SS_IMG + tl * SS_P + (16 * pb + fr) * 2));
                const float yv = y[pb][i] + ef * yf[pb][i] + eb * yb[pb][i] + dsk * xv;
                const float gv = yv * silu_f(bf2f(zv[i][pb])); ss[i] += gv * gv;
                yup[(size_t)i * D + h * 64 + 16 * pb] = f2bf(gv * nwv[pb]); } }
    }
#pragma unroll
    for (int i = 0; i < 4; ++i) { const float v = row16_sum(ss[i]);
        if (fr == 0) ((float*)(F.ws + OFF_TAB + TAB_SSQ))[(size_t)(row0 + 16 * w + 4 * fq + i) * 2 + g] = v; }
}
__device__ __forceinline__ void ssd_norm_panel(Frame& F, int l, int pm) {
    const float* nw = F.in[19] + l * 384; const float* ssq = (const float*)(F.ws + OFF_TAB + TAB_SSQ);
    const bf16_t* yu = (const bf16_t*)(F.ws + OFF_YU); bf16_t* mix = (bf16_t*)(F.ws + OFF_MIX);
    for (int i = F.tid; i < 256 * 48; i += NTHREADS) {
        const int row = pm * 256 + i / 48, c0 = (i % 48) * 8;
        const float rstd = rsqrtf((ssq[(size_t)row * 2] + ssq[(size_t)row * 2 + 1]) * (1.f / 384.f) + EPS);
        const v4u v = *(const v4u*)(yu + (size_t)row * 384 + c0); const f32x4 w0 = *(const f32x4*)(nw + c0), w1 = *(const f32x4*)(nw + c0 + 4);
        v4u o;
        o[0] = pk2(__uint_as_float(v[0] << 16) * rstd * w0[0], __uint_as_float(v[0] & 0xffff0000u) * rstd * w0[1]); o[1] = pk2(__uint_as_float(v[1] << 16) * rstd * w0[2], __uint_as_float(v[1] & 0xffff0000u) * rstd * w0[3]);
        o[2] = pk2(__uint_as_float(v[2] << 16) * rstd * w1[0], __uint_as_float(v[2] & 0xffff0000u) * rstd * w1[1]); o[3] = pk2(__uint_as_float(v[3] << 16) * rstd * w1[2], __uint_as_float(v[3] & 0xffff0000u) * rstd * w1[3]);
        *(v4u*)(mix + (size_t)row * D + c0) = o;
    }
    asm volatile("s_waitcnt vmcnt(0)" ::: "memory");
    __syncthreads();
}

constexpr int S5_HP = 272;
constexpr int S5_IMG = 64 * S5_HP;
constexpr int S5_GP = 528, S5_G = 4 * S5_IMG, S5_END = S5_G + 64 * S5_GP;
typedef float f32x16 __attribute__((ext_vector_type(16)));
typedef float f32x8 __attribute__((ext_vector_type(8)));
__device__ __forceinline__ float swap32sel(float x, int odd) {
    const auto r = __builtin_amdgcn_permlane32_swap(__float_as_uint(x), __float_as_uint(x), false, false);
    return __uint_as_float(odd ? r[1] : r[0]);
}
template <int DIR, bool FULL>
__device__ __forceinline__ void s5_dir(Frame& F, int l, int g, int p, int hi, const bf16x8 (&uf)[2], float& cr, float& ci, f32x16 (&hr)[2], f32x16 (&hq)[2]) {
    const float* ab = (const float*)(F.ws + OFF_TAB + TAB_ABAR) + (size_t)((((l * 2 + DIR) * 16 + g) * 64) + p) * 2;
    const float ar = ab[0], ai = ab[1];
    const float a2r = ar * ar - ai * ai, a2i = 2.f * ar * ai, a3r = a2r * ar - a2i * ai, a3i = a2r * ai + a2i * ar, a4r = a2r * a2r - a2i * a2i, a4i = 2.f * a2r * a2i;
    const bf16_t* bbt = (const bf16_t*)(F.ws + OFF_TAB + TAB_BBT) + ((size_t)(((l * 2 + DIR) * 16 + g) * 2) * 64 + p) * 16 + 8 * hi;
    const bf16x8 bre = *(const bf16x8*)bbt, bim = *(const bf16x8*)(bbt + 64 * 16);
    f32x16 xr[2], xi[2];
#pragma unroll
    for (int rb = 0; rb < 2; ++rb) {
        const f32x16 z = {0.f, 0.f, 0.f, 0.f, 0.f, 0.f, 0.f, 0.f, 0.f, 0.f, 0.f, 0.f, 0.f, 0.f, 0.f, 0.f};
        xr[rb] = __builtin_amdgcn_mfma_f32_32x32x16_bf16(uf[rb], bre, z, 0, 0, 0); xi[rb] = __builtin_amdgcn_mfma_f32_32x32x16_bf16(uf[rb], bim, z, 0, 0, 0);
    }
#pragma unroll
    for (int rb = 0; rb < 2; ++rb)
#pragma unroll
        for (int G4 = 0; G4 < 4; ++G4) {
            if (DIR == 0) {
#pragma unroll
                for (int e = 1; e < 4; ++e) { const int i = 4 * G4 + e; const float pr = xr[rb][i - 1], pi = xi[rb][i - 1]; xr[rb][i] += ar * pr - ai * pi; xi[rb][i] += ar * pi + ai * pr; }
            } else {
#pragma unroll
                for (int e = 2; e >= 0; --e) { const int i = 4 * G4 + e; const float pr = xr[rb][i + 1], pi = xi[rb][i + 1]; xr[rb][i] += ar * pr - ai * pi; xi[rb][i] += ar * pi + ai * pr; }
            }
        }
    f32x8 cinr = {0.f, 0.f, 0.f, 0.f, 0.f, 0.f, 0.f, 0.f}, cini = cinr;
#pragma unroll
    for (int kk = 0; kk < 16; ++kk) {
        const int k = DIR == 0 ? kk : 15 - kk, gi = k >> 1, rb = gi >> 2, il = 4 * (gi & 3) + (DIR == 0 ? 3 : 0), odd = k & 1;
        const bool first = DIR == 0 ? !odd : odd;
        if (first) { cinr[gi] = cr; cini[gi] = ci; } else { const bool own = (hi == odd); cinr[gi] = own ? cr : cinr[gi]; cini[gi] = own ? ci : cini[gi]; }
        const float nr = a4r * cr - a4i * ci + xr[rb][il], ni = a4r * ci + a4i * cr + xi[rb][il];
        cr = swap32sel(nr, odd); ci = swap32sel(ni, odd);
    }
    if (FULL) {
#pragma unroll
        for (int rb = 0; rb < 2; ++rb)
#pragma unroll
            for (int G4 = 0; G4 < 4; ++G4) {
                const int gi = rb * 4 + G4;
#pragma unroll
                for (int e = 0; e < 4; ++e) {
                    const int i = 4 * G4 + e, pw = DIR == 0 ? e + 1 : 4 - e;
                    const float pr = pw == 1 ? ar : (pw == 2 ? a2r : (pw == 3 ? a3r : a4r)), pi = pw == 1 ? ai : (pw == 2 ? a2i : (pw == 3 ? a3i : a4i));
                    hr[rb][i] += xr[rb][i] + pr * cinr[gi] - pi * cini[gi];
                    hq[rb][i] += xi[rb][i] + pr * cini[gi] + pi * cinr[gi];
                }
            }
    }
}
template <bool FULL>
__device__ __forceinline__ void s5_wave_unit(Frame& F, int l, int row0, int g, int ph, float& cfr, float& cfi, float& cbr, float& cbi, LAS unsigned char* himg) {
    const int lane = F.lane, r32 = lane & 31, hi = lane >> 5, p = 32 * ph + r32;
    const bf16_t* proj = (const bf16_t*)(F.ws + OFF_PROJ);
    bf16x8 uf[2];
#pragma unroll
    for (int rb = 0; rb < 2; ++rb) uf[rb] = *(const bf16x8*)(proj + (size_t)(row0 + 32 * rb + r32) * PN + PU + g * 16 + 8 * hi);
    f32x16 hr[2], hq[2];
#pragma unroll
    for (int rb = 0; rb < 2; ++rb) { hr[rb] = (f32x16){0.f, 0.f, 0.f, 0.f, 0.f, 0.f, 0.f, 0.f, 0.f, 0.f, 0.f, 0.f, 0.f, 0.f, 0.f, 0.f}; hq[rb] = hr[rb]; }
    s5_dir<0, FULL>(F, l, g, p, hi, uf, cfr, cfi, hr, hq);
    s5_dir<1, FULL>(F, l, g, p, hi, uf, cbr, cbi, hr, hq);
    if (FULL) {
#pragma unroll
        for (int rb = 0; rb < 2; ++rb)
#pragma unroll
            for (int i = 0; i < 16; ++i) { const int t = 32 * rb + 8 * (i >> 2) + 4 * hi + (i & 3);
                LAS bf16_t* d = (LAS bf16_t*)(himg + t * S5_HP) + p;
                const unsigned pk = pk2(hr[rb][i], hq[rb][i]); d[0] = (bf16_t)(pk & 0xffffu); d[64] = (bf16_t)(pk >> 16); }
    }
}
__device__ __forceinline__ void cpow64(float ar, float ai, float& or_, float& oi_) {
#pragma unroll
    for (int s = 0; s < 6; ++s) { const float nr = ar * ar - ai * ai, ni = 2.f * ar * ai; ar = nr; ai = ni; }
    or_ = ar; oi_ = ai;
}
__device__ __forceinline__ void s5_a_unit(Frame& F, int l, int cj) {
    const int w = F.wave, lane = F.lane, row0 = cj * 64;
    float* E = (float*)(F.ws + OFF_E);
    for (int it = w; it < 32; it += NWAVES) {
        const int g = it >> 1, ph = it & 1;
        float cfr = 0.f, cfi = 0.f, cbr = 0.f, cbi = 0.f;
        s5_wave_unit<false>(F, l, row0, g, ph, cfr, cfi, cbr, cbi, F.lds);
        if (lane < 32) { float2 v; v.x = cfr; v.y = cfi; *(float2*)(E + ((size_t)((cj * 2 + 0) * 16 + g) * 64 + 32 * ph + lane) * 2) = v;
                         v.x = cbr; v.y = cbi; *(float2*)(E + ((size_t)((cj * 2 + 1) * 16 + g) * 64 + 32 * ph + lane) * 2) = v; }
    }
}
__device__ __forceinline__ void s5_b_unit(Frame& F, int l, int cj) {
    const int w = F.wave, row0 = cj * 64;
    const SeqInfo q = row_seq(row0); const int j = (row0 - q.start) >> 6, nj = q.L >> 6, cj0 = cj - j;
    const bf16_t* proj = (const bf16_t*)(F.ws + OFF_PROJ);
    const float* E = (const float*)(F.ws + OFF_E);
    LAS unsigned char* lds = F.lds;
    for (int gi4 = 0; gi4 < 4; ++gi4) {
        bf16x8 ccf[2][4]; unsigned short uval[2][4]; float dskv[2];
        { int lnp = F.tid; asm volatile("" : "+v"(lnp)); lnp &= 63; const int fr = lnp & 15, fq = lnp >> 4;
#pragma unroll
          for (int tk = 0; tk < 2; ++tk) { const int task = 2 * w + tk, gsel = task >> 2, tb = task & 3, g = 4 * gi4 + gsel;
            const bf16_t* cc = (const bf16_t*)(F.ws + OFF_TAB + TAB_CC1) + ((size_t)(l * 16 + g) * 16 + fr) * 128 + 8 * fq;
#pragma unroll
            for (int ks = 0; ks < 4; ++ks) ccf[tk][ks] = *(const bf16x8*)(cc + ks * 32);
#pragma unroll
            for (int i = 0; i < 4; ++i) uval[tk][i] = proj[(size_t)(row0 + 16 * tb + 4 * fq + i) * PN + PU + g * 16 + fr];
            dskv[tk] = F.in[27][l * 256 + g * 16 + fr]; } }
        {
            { int t_ = F.tid; asm volatile("" : "+v"(t_)); F.tid = t_; F.lane = t_ & 63; }
            const int lane = F.lane; const int g = 4 * gi4 + (w >> 1), ph = w & 1, p = 32 * ph + (lane & 31);
            const float* h5 = (const float*)(F.ws + OFF_H5);
            const float2 hf = *(const float2*)(h5 + ((size_t)((cj * 2 + 0) * 16 + g) * 64 + p) * 2), hb = *(const float2*)(h5 + ((size_t)((cj * 2 + 1) * 16 + g) * 64 + p) * 2);
            float cr[2] = {hf.x, hb.x}, ci[2] = {hf.y, hb.y};
            s5_wave_unit<true>(F, l, row0, g, ph, cr[0], ci[0], cr[1], ci[1], lds + (w >> 1) * S5_IMG);
        }
        __syncthreads();
        int ln2 = F.tid; asm volatile("" : "+v"(ln2)); ln2 &= 63; const int fr = ln2 & 15, fq = ln2 >> 4;
#pragma unroll
        for (int tk = 0; tk < 2; ++tk) {
            const int task = 2 * w + tk, gsel = task >> 2, tb = task & 3, g = 4 * gi4 + gsel;
            LAS const unsigned char* hrow = lds + gsel * S5_IMG + (16 * tb + fr) * S5_HP + 16 * fq;
            f32x4 y = {0.f, 0.f, 0.f, 0.f};
#pragma unroll
            for (int ks = 0; ks < 4; ++ks) { const bf16x8 a = *(LAS const bf16x8*)(hrow + ks * 64); y = __builtin_amdgcn_mfma_f32_16x16x32_bf16(a, ccf[tk][ks], y, 0, 0, 0); }
#pragma unroll
            for (int i = 0; i < 4; ++i) { const int t = 16 * tb + 4 * fq + i;
                *((LAS bf16_t*)(lds + S5_G + t * S5_GP) + g * 16 + fr) = f2bf(gelu_tanh_f(y[i] + dskv[tk] * bf2f(uval[tk][i]))); }
        }
        __syncthreads();
    }
    {
        int ln3 = F.tid; asm volatile("" : "+v"(ln3)); ln3 &= 63; const int fr = ln3 & 15, fq = ln3 >> 4;
        f32x4 acc[2][4];
#pragma unroll
        for (int a = 0; a < 2; ++a)
#pragma unroll
            for (int tb = 0; tb < 4; ++tb) acc[a][tb] = (f32x4){0.f, 0.f, 0.f, 0.f};
        const bf16_t* wg = (const bf16_t*)(F.ws + OFF_WGLU) + (size_t)l * 65536 + (size_t)(32 * w + fr) * 256 + 8 * fq;
#pragma unroll
        for (int ks = 0; ks < 8; ++ks) {
            const bf16x8 b0 = *(const bf16x8*)(wg + ks * 32), b1 = *(const bf16x8*)(wg + 16 * 256 + ks * 32);
#pragma unroll
            for (int tb = 0; tb < 4; ++tb) { const bf16x8 a = *(LAS const bf16x8*)(lds + S5_G + (16 * tb + fr) * S5_GP + ks * 64 + 16 * fq);
                acc[0][tb] = __builtin_amdgcn_mfma_f32_16x16x32_bf16(a, b0, acc[0][tb], 0, 0, 0); acc[1][tb] = __builtin_amdgcn_mfma_f32_16x16x32_bf16(a, b1, acc[1][tb], 0, 0, 0); }
        }
#pragma unroll
        for (int a = 0; a < 2; ++a) { const int n = 32 * w + 16 * a + fr; const float bg = F.in[29][l * 256 + n];
#pragma unroll
            for (int tb = 0; tb < 4; ++tb)
#pragma unroll
                for (int i = 0; i < 4; ++i) { const int t = 16 * tb + 4 * fq + i; const float gv = bf2f(*((LAS const bf16_t*)(lds + S5_G + t * S5_GP) + n));
                    ((bf16_t*)(F.ws + OFF_MIX))[(size_t)(row0 + t) * D + 384 + n] = f2bf(gv * sigmoid_f(acc[a][tb][i] + bg)); } }
    }
}

__device__ __forceinline__ void s5_state_pass(Frame& F, int l) {
    const float* E = (const float*)(F.ws + OFF_E); float* H5 = (float*)(F.ws + OFF_H5);
    for (int idx = F.vcu * NTHREADS + F.tid; idx < NSEQ * 2048; idx += F.G * NTHREADS) {
        const int p = idx & 63, g = (idx >> 6) & 15, dir = (idx >> 10) & 1, sq = idx >> 11;
        const int s_ = sq < LB ? CB + sq : sq - LB;
        const SeqInfo q = seq_info(s_); const int nj = q.L >> 6, cj0 = q.start >> 6;
        const float* ab = (const float*)(F.ws + OFF_TAB + TAB_ABAR) + (size_t)((((l * 2 + dir) * 16 + g) * 64) + p) * 2;
        float a64r, a64i; cpow64(ab[0], ab[1], a64r, a64i);
        float cr = 0.f, ci = 0.f;
        if (!q.ctx) { const size_t o = (((size_t)q.b * 4 + l) * 2 + dir) * 1024 + g * 64 + p; cr = F.in[5][o]; ci = F.in[6][o]; }
        for (int k = 0; k < nj; k += 4) {
            float2 e[4];
#pragma unroll
            for (int u = 0; u < 4; ++u) { const int jj = dir == 0 ? k + u : nj - 1 - (k + u); e[u] = *(const float2*)(E + ((size_t)(((cj0 + jj) * 2 + dir) * 16 + g) * 64 + p) * 2); }
#pragma unroll
            for (int u = 0; u < 4; ++u) { const int jj = dir == 0 ? k + u : nj - 1 - (k + u);
                float2 hv; hv.x = cr; hv.y = ci; *(float2*)(H5 + ((size_t)(((cj0 + jj) * 2 + dir) * 16 + g) * 64 + p) * 2) = hv;
                const float nr = a64r * cr - a64i * ci + e[u].x, ni = a64r * ci + a64i * cr + e[u].y; cr = nr; ci = ni; }
        }
        if (q.ctx) { const size_t o = (((size_t)q.b * 4 + l) * 2 + dir) * 1024 + g * 64 + p; F.out[O_RE + o] = cr; F.out[O_IM + o] = ci; }
    }
}
__device__ __forceinline__ void phase_mixa(Frame& F, int l) {
    unsigned* ctr = F.ctl + CW_Q + 64 * (l * 8);
    for (;;) { const int u = queue_next(F, ctr); if (u >= 192) break; attn_unit(F, l, u); }
    for (;;) { const int u = queue_next(F, ctr + 64); if (u >= 256) break; ssd_a_unit(F, l, u); }
    for (;;) { const int u = queue_next(F, ctr + 128); if (u >= 192) break; attn_unit(F, l, 192 + u); }
    for (;;) { const int u = queue_next(F, ctr + 192); if (u >= 256) break; s5_a_unit(F, l, u); }
}
__device__ __forceinline__ void phase_mixb(Frame& F, int l) {
    unsigned* ctr = F.ctl + CW_Q + 64 * (l * 8 + 4);
    for (;;) { const int u = queue_next(F, ctr); if (u >= 256) break; s5_b_unit(F, l, u); }
    for (;;) { const int u = queue_next(F, ctr + 64); if (u >= 256) break; ssd_b_unit(F, l, u); }
}

struct Args { const float* in[35]; float* out; unsigned char* ws; int ph_lo, ph_hi, li, pad; };
#ifdef MK_PHASE_RANGE
#define IN(k) (lo <= (k) && (k) < hi)
#else
#define IN(k) true
#endif
#define REFRESH() do { int t_ = F.wave * 64 + lane_id(); asm volatile("" : "+v"(t_)); F.tid = t_; F.lane = t_ & 63; \
        unsigned char* w_ = args.ws; asm volatile("" : "+s"(w_)); F.ws = w_; F.ctl = (unsigned*)(w_ + OFF_CTL); float* o_ = args.out; asm volatile("" : "+s"(o_)); F.out = o_; \
        const float* const* i_ = (const float* const*)__builtin_amdgcn_kernarg_segment_ptr(); asm volatile("" : "+s"(i_)); F.in = i_; \
        int g_ = gridDim.x, v_ = vcu0; asm volatile("" : "+s"(g_), "+s"(v_)); F.G = g_; F.vcu = v_; modsb = (const float*)(F.ws + OFF_MODS); XB = (bf16_t*)(F.ws + OFF_X); } while (0)
#define SEAM(k) do { if (IN(k) && IN((k) + 1) && (k) + 1 < PH_END) xcd_barrier(bar, F.wave == 0 && lane_id() == 0); } while (0)
template <int l>
__device__ __forceinline__ void layer_body(Frame& F, const Args& args, const XcdBarrier& bar, const int vcu0) {
    const int lo = args.ph_lo, hi = args.ph_hi; (void)lo; (void)hi;
    const float* modsb = (const float*)(F.ws + OFF_MODS);
    bf16_t* XB = (bf16_t*)(F.ws + OFF_X);
        const int pb = PH_L0 + l * PH_PER_LAYER;
        if (IN(pb + PH_G1)) { REFRESH();
            pg8::Gemm g{(const bf16_t*)(F.ws + OFF_H), (const bf16_t*)(F.ws + OFF_WIN) + (size_t)l * PNP * 1024, M, PNP, 1024}; pg8::StaticOrder S; S.init(M, PNP, F.G, (int)blockIdx.x);
            epi_side_fill(F, S, (const float*)(F.ws + OFF_TAB + TAB_SQ1), (const float*)(F.ws + OFF_TAB + TAB_B1) + (size_t)l * 9 * PNP, PNP);
            pg8::EpiProj E{(bf16_t*)(F.ws + OFF_PROJ), F.out + O_K, F.out + O_V, (float*)(F.ws + OFF_DT), (LAS const float*)(F.lds + EPI_SIDE_OFF), l, 0};
            pg8::gemm_phase<pg8::EpiProj, pg8::StaticOrder, true, true>(F.lds, g, S, E, F.wave);
        }
        SEAM(pb + PH_G1);
        if (IN(pb + PH_MIXA)) { REFRESH(); phase_mixa(F, l); }
        SEAM(pb + PH_MIXA);
        if (IN(pb + PH_MIXB)) { REFRESH(); ssd_state_pass(F, l); s5_state_pass(F, l); xcd_barrier(bar, F.wave == 0 && lane_id() == 0); REFRESH(); phase_mixb(F, l); }
        SEAM(pb + PH_MIXB);
        if (IN(pb + PH_G3)) { REFRESH();
            pg8::Gemm g{(const bf16_t*)(F.ws + OFF_MIX), (const bf16_t*)(F.ws + OFF_WOUT) + (size_t)l * 1024 * 1024, M, D, 1024}; pg8::StaticOrder S; S.init(M, D, F.G, (int)blockIdx.x);
            { pg8::Unit u; if (S.next(0, u) && F.tid < 256) { const float* q2 = (const float*)(F.ws + OFF_TAB + TAB_SSQ) + (size_t)(u.pm * 256 + F.tid) * 2;
                ((LAS float*)(F.lds + EPI_SIDE_OFF))[F.tid] = rsqrtf((q2[0] + q2[1]) * (1.f / 384.f) + EPS); } __syncthreads(); }
            typedef pg8::EpiRes<6, l == 0> Epi3;
            Epi3 E{l == 0 ? (const void*)F.in[0] : (const void*)XB, l == 0 ? (const void*)(F.in[1] - (size_t)MC * D) : (const void*)XB, XB, modsb + (size_t)l * 9 * 6144 + 2 * 1024, F.in[12] + l * D, modsb + (size_t)l * 9 * 6144 + 4 * 1024,
                   (bf16_t*)(F.ws + OFF_H), (float*)(F.ws + OFF_TAB + TAB_SQ2), (LAS const float*)(F.lds + EPI_SIDE_OFF)};
            pg8::gemm_phase<Epi3, pg8::StaticOrder, true, true>(F.lds, g, S, E, F.wave);
        }
        SEAM(pb + PH_G3);
        if (IN(pb + PH_G4)) { REFRESH();
            pg8::Gemm g{(const bf16_t*)(F.ws + OFF_H), (const bf16_t*)(F.ws + OFF_WFF1) + (size_t)l * DFF * 1024, M, DFF, 1024}; pg8::StaticOrder S; S.init(M, DFF, F.G, (int)blockIdx.x);
            epi_side_fill(F, S, (const float*)(F.ws + OFF_TAB + TAB_SQ2), (const float*)(F.ws + OFF_TAB + TAB_B2) + (size_t)l * 9 * DFF, DFF);
            pg8::EpiFF1 E{(bf16_t*)(F.ws + OFF_FFH), (LAS const float*)(F.lds + EPI_SIDE_OFF), 0};
            pg8::gemm_phase<pg8::EpiFF1, pg8::StaticOrder, true, true>(F.lds, g, S, E, F.wave);
        }
        SEAM(pb + PH_G4);
        if (IN(pb + PH_G5)) { REFRESH();
            pg8::Gemm g{(const bf16_t*)(F.ws + OFF_FFH), (const bf16_t*)(F.ws + OFF_WFF2) + (size_t)l * 1024 * DFF, M, D, DFF}; pg8::StaticOrder S; S.init(M, D, F.G, (int)blockIdx.x);
            const int ln = l + 1 < DEPTH ? l + 1 : l;
            typedef pg8::EpiRes<0, false> Epi5;
            Epi5 E{(const void*)XB, (const void*)XB, XB, modsb + (size_t)l * 9 * 6144 + 5 * 1024, F.in[11] + ln * D, modsb + (size_t)ln * 9 * 6144 + 1 * 1024,
                   l + 1 < DEPTH ? (bf16_t*)(F.ws + OFF_H) : (bf16_t*)nullptr, (float*)(F.ws + OFF_TAB + TAB_SQ1), (LAS const float*)(F.lds + EPI_SIDE_OFF)};
            pg8::gemm_phase<Epi5, pg8::StaticOrder, true, true>(F.lds, g, S, E, F.wave);
        }
        SEAM(pb + PH_G5);
    }
__global__ void __launch_bounds__(NTHREADS, 2) mega(Args args) {
    extern __shared__ __attribute__((aligned(16))) unsigned char lds[];
    Frame F;
    F.lds = (LAS unsigned char*)lds;
    F.MISC = (volatile LAS unsigned*)(F.lds + MISC_OFF);
    F.tid = threadIdx.x; F.lane = F.tid & 63; F.wave = __builtin_amdgcn_readfirstlane(F.tid >> 6);
    F.G = gridDim.x; { const int bx = blockIdx.x; F.vcu = (F.G % 8 == 0) ? (bx % 8) * (F.G / 8) + bx / 8 : bx; }
    { const float* const* inp = (const float* const*)__builtin_amdgcn_kernarg_segment_ptr(); asm volatile("" : "+s"(inp)); F.in = inp; }
    F.out = args.out; F.ws = args.ws; F.ctl = (unsigned*)(args.ws + OFF_CTL);
    for (int u = F.tid; u < (LDS_BYTES - LDSCTL_OFF) / 4; u += NTHREADS) ((LAS unsigned*)(F.lds + LDSCTL_OFF))[u] = 0u;
    __syncthreads();
    XcdBarrier bar = xcd_barrier_post(F.ctl + CW_BAR + args.li * XCD_BAR_WORDS, F.MISC + 8);
    const int lo = args.ph_lo, hi = args.ph_hi; (void)lo; (void)hi;
    const float* modsb = (const float*)(F.ws + OFF_MODS);
    bf16_t* XB = (bf16_t*)(F.ws + OFF_X);
    const int vcu0 = F.vcu;
    if (IN(PH_PRO)) phase_prologue(F);
    SEAM(PH_PRO);
    if (IN(PH_PRE)) { REFRESH(); phase_pre(F); }
    SEAM(PH_PRE);
    layer_body<0>(F, args, bar, vcu0); layer_body<1>(F, args, bar, vcu0); layer_body<2>(F, args, bar, vcu0); layer_body<3>(F, args, bar, vcu0);
    if (IN(PH_FINAL)) phase_final(F);
#undef IN
#undef SEAM
}
static void launch_mega(const Args& base, int lo, int hi, int li, hipStream_t stream) {
    Args a = base; a.ph_lo = lo; a.ph_hi = hi; a.li = li;
    hipLaunchKernelGGL(mega, dim3(256), dim3(NTHREADS), LDS_BYTES, stream, a);
}
extern "C" void kernel_launch(void* const* d_in, const int* in_sizes, int n_in, void* d_out, int out_size, void* d_ws, size_t ws_size, hipStream_t stream) {
    static int ready = 0;
    if (!ready) {
        if (n_in != 35 || out_size != (int)O_END || ws_size < WS_END) { fprintf(stderr, "kernel_launch: unexpected shapes n_in %d out %d ws %zu\n", n_in, out_size, ws_size); ready = -1; return; }
        if (hipFuncSetAttribute((const void*)mega, hipFuncAttributeMaxDynamicSharedMemorySize, LDS_BYTES) != hipSuccess) { fprintf(stderr, "kernel_launch: hipFuncSetAttribute failed\n"); ready = -1; return; }
        ready = 1;
    }
    if (ready < 0) return;
    Args a{}; for (int i = 0; i < 35; ++i) a.in[i] = (const float*)d_in[i]; a.out = (float*)d_out; a.ws = (unsigned char*)d_ws;
    (void)hipMemsetAsync((char*)d_ws + OFF_CTL, 0, CTL_ZERO_BYTES, stream);
    launch_mega(a, 0, PH_END, 0, stream);
}
```

```cpp
#include <hip/hip_runtime.h>
#include <stdint.h>
#include <stdio.h>

typedef unsigned short bf16_t;
typedef short bf16x8 __attribute__((ext_vector_type(8)));
typedef float f32x4 __attribute__((ext_vector_type(4)));

constexpr int D = 1024, DEPTH = 4;
constexpr int CB = 32, CL = 256, LB = 8, LL = 1024;
constexpr int MC = CB * CL;
constexpr int M = MC + LB * LL;
constexpr int NSEQ = CB + LB;
constexpr int IN_COLS = 2444;
constexpr int PN = 2432, PNP = 2560;
constexpr int PZ = 0, PX = 384, PU = 1024, PQ = 1280, PK = 1664, PV = 2048;
constexpr int DFF = 4096;
constexpr float EPS = 1e-6f;

constexpr size_t MiB = 1u << 20;
constexpr size_t OFF_CTL = 0, OFF_MODS = 1 * MiB, OFF_TAB = 2 * MiB, OFF_WIN = 8 * MiB, OFF_WOUT = 28 * MiB, OFF_WFF1 = 36 * MiB,
                 OFF_WFF2 = 68 * MiB, OFF_WGLU = 100 * MiB, OFF_DT = 101 * MiB, OFF_X = 102 * MiB, OFF_PROJ = 166 * MiB, OFF_MIX = 242 * MiB,
                 OFF_FFH = 166 * MiB, OFF_H = 294 * MiB, OFF_XBC = 294 * MiB, OFF_YSSD = 334 * MiB, OFF_YS5 = 358 * MiB, WS_END = 374 * MiB;
constexpr size_t TAB_ABAR = 0;
constexpr size_t TAB_SQ1 = 256 * 1024;
constexpr size_t TAB_SQ2 = 1280 * 1024;
constexpr size_t TAB_B1 = 2304 * 1024;
constexpr size_t TAB_B2 = 4352 * 1024;
constexpr size_t TAB_SSQ = 5 * MiB;
constexpr size_t OFF_CK = 134 * MiB, OFF_CV = 140 * MiB;
constexpr size_t OFF_H5 = 326 * MiB;
constexpr size_t OFF_HIN = 362 * MiB;
constexpr size_t OFF_YU = 274 * MiB;
constexpr size_t TAB_CD = 3 * MiB;
constexpr size_t OFF_CS = 334 * MiB;
constexpr size_t TAB_CC1 = 4 * MiB;
constexpr size_t TAB_BBT = 3 * MiB + 512 * 1024;
constexpr size_t OFF_E = 358 * MiB;

__device__ __forceinline__ int lane_id() { unsigned z = 0u; asm volatile("" : "+v"(z)); return (int)__builtin_amdgcn_mbcnt_hi(~0u, __builtin_amdgcn_mbcnt_lo(~0u, z)); }
__device__ __forceinline__ float bf2f(bf16_t v) { return __uint_as_float((unsigned)v << 16); }
typedef float f32x2_t __attribute__((ext_vector_type(2))); typedef __bf16 bf16x2_t __attribute__((ext_vector_type(2)));
__device__ __forceinline__ unsigned cvtpk(float lo, float hi) { f32x2_t v = {lo, hi}; bf16x2_t b = __builtin_convertvector(v, bf16x2_t); return __builtin_bit_cast(unsigned, b); }
__device__ __forceinline__ bf16_t f2bf(float f) { return (bf16_t)(cvtpk(f, f) & 0xffffu); }
__device__ __forceinline__ float sigmoid_f(float x) { return __builtin_amdgcn_rcpf(1.f + __expf(-x)); }
__device__ __forceinline__ float silu_f(float x) { return x * sigmoid_f(x); }
__device__ __forceinline__ float softplus_f(float x) { return x > 20.f ? x : log1pf(__expf(x)); }
__device__ __forceinline__ float gelu_tanh_f(float x) { const float u = 1.5957691216057308f * (x + 0.044715f * x * x * x); return x * sigmoid_f(u); }
template <int CTRL> __device__ __forceinline__ float dppf(float x) { return __uint_as_float((unsigned)__builtin_amdgcn_update_dpp(0, (int)__float_as_uint(x), CTRL, 0xf, 0xf, true)); }
__device__ __forceinline__ float row16_sum(float x) { x += dppf<0xB1>(x); x += dppf<0x4E>(x); x += dppf<0x141>(x); x += dppf<0x140>(x); return x; }
__device__ __forceinline__ float row16_max(float x) { x = fmaxf(x, dppf<0xB1>(x)); x = fmaxf(x, dppf<0x4E>(x)); x = fmaxf(x, dppf<0x141>(x)); x = fmaxf(x, dppf<0x140>(x)); return x; }
__device__ __forceinline__ float xsum16(float x) { const auto r = __builtin_amdgcn_permlane16_swap(__float_as_uint(x), __float_as_uint(x), false, false); return __uint_as_float(r[0]) + __uint_as_float(r[1]); }
__device__ __forceinline__ float xsum32(float x) { const auto r = __builtin_amdgcn_permlane32_swap(__float_as_uint(x), __float_as_uint(x), false, false); return __uint_as_float(r[0]) + __uint_as_float(r[1]); }
__device__ __forceinline__ float xmax16(float x) { const auto r = __builtin_amdgcn_permlane16_swap(__float_as_uint(x), __float_as_uint(x), false, false); return fmaxf(__uint_as_float(r[0]), __uint_as_float(r[1])); }
__device__ __forceinline__ float xmax32(float x) { const auto r = __builtin_amdgcn_permlane32_swap(__float_as_uint(x), __float_as_uint(x), false, false); return fmaxf(__uint_as_float(r[0]), __uint_as_float(r[1])); }
__device__ __forceinline__ float rdlane(float x, int l) { return __uint_as_float((unsigned)__builtin_amdgcn_readlane((int)__float_as_uint(x), l)); }
__device__ __forceinline__ float wave_sum(float v) { return xsum32(xsum16(row16_sum(v))); }
__device__ __forceinline__ float wave_max(float v) { return xmax32(xmax16(row16_max(v))); }
__device__ __forceinline__ int mod_row(int row) { return row < MC ? 0 : 1 + ((row - MC) >> 10); }

struct P {
    const float* in[35];
    float* out;
    unsigned char* ws;
};
constexpr size_t O_YP = 0, O_YS = 8388608, O_K = 16777216, O_V = O_K + 12582912, O_SSD = O_V + 12582912, O_RE = O_SSD + 6291456, O_IM = O_RE + 262144, O_END = O_IM + 262144;


#define LAS __attribute__((address_space(3)))
struct SeqInfo { int start, L, b, ctx; };
__device__ __forceinline__ SeqInfo seq_info(int s) { SeqInfo q; if (s < CB) { q.start = s * CL; q.L = CL; q.b = s; q.ctx = 1; } else { q.start = MC + (s - CB) * LL; q.L = LL; q.b = s - CB; q.ctx = 0; } return q; }
__device__ __forceinline__ SeqInfo row_seq(int row) { return seq_info(row < MC ? (row >> 8) : CB + ((row - MC) >> 10)); }
namespace pg8 {
#define PG8_LAS __attribute__((address_space(3)))
typedef unsigned short bf16_t;
typedef short bf16x8 __attribute__((ext_vector_type(8)));
typedef float f32x4 __attribute__((ext_vector_type(4)));
typedef unsigned u32x4 __attribute__((ext_vector_type(4)));
constexpr int BM = 256, BK = 64, HALF = 128, HTB = HALF * BK * 2  , STAGE_BYTES = 8 * HTB, NXCD = 8, WGM = 8;

__host__ __device__ __forceinline__ int lds_byte(int r, int c) { const int st = (r >> 4) * 2 + (c >> 5), rr = r & 15, cc = c & 31, ob = rr * 64 + cc * 2; return st * 1024 + (ob ^ (((ob >> 9) & 1) << 5)); }
__host__ __device__ __forceinline__ void stage_rc(int b, int& R, int& C) { const int st = b / 1024, sb = b % 1024, swz = sb ^ (((sb >> 9) & 1) << 5); R = (st >> 1) * 16 + swz / 64; C = (st & 1) * 32 + (swz % 64) / 2; }
__host__ __device__ __forceinline__ int perm32(int rho) { const int n = rho >> 4, i = rho & 15; return 8 * (i >> 2) + 4 * n + (i & 3); }

struct Unit { int pm, pn; };
struct Gemm { const bf16_t* A; const bf16_t* Bt; int M, N, K; };

struct StaticOrder {
    int nM, nN, nwg, G, c;
    __host__ __device__ void init(int M, int N, int G_, int c_) { nM = M / BM; nN = N / BM; nwg = nM * nN; G = G_; c = c_; }
    __host__ __device__ bool next(int i, Unit& u) const {
        const long L = (long)i * G + c; if (L >= nwg) return false;
        int wgid = (int)L; { const int q = nwg / NXCD, r = nwg % NXCD, xcd = wgid % NXCD, off = wgid / NXCD; wgid = (xcd < r ? xcd * (q + 1) : r * (q + 1) + (xcd - r) * q) + off; }
        const int nig = WGM * nN, gid = wgid / nig, fm = gid * WGM, gsz = (nM - fm) < WGM ? (nM - fm) : WGM;
        u.pm = fm + ((wgid % nig) % gsz); u.pn = (wgid % nig) / gsz; return true;
    }
    __device__ __forceinline__ void a_ready(const Unit&) const {}
    __device__ __forceinline__ void done(const Unit&) const {}
};

__device__ __forceinline__ unsigned cvt_pk_bf16(float lo, float hi) { unsigned r; asm volatile("v_cvt_pk_bf16_f32 %0, %1, %2" : "=v"(r) : "v"(lo), "v"(hi)); return r; }
__device__ __forceinline__ float row_rstd(const float* ssq, int row, int fq) {
    const f32x4 a = *(const f32x4*)(ssq + (size_t)row * 16 + 4 * fq);
    const float s = ::xsum32(::xsum16((a[0] + a[1]) + (a[2] + a[3])));
    return rsqrtf(s * (1.f / 1024.f) + ::EPS);
}
struct EpiProj {
    static constexpr bool PERM = true, AFTER_DRAIN = false; static constexpr int MID_T = 0;
    bf16_t* proj; float* ok; float* ov; float* dt; PG8_LAS const float* side; int l; mutable int slot;
    __device__ __forceinline__ void operator()(const f32x4 (&acc)[2][2][4][2], const Unit& u, int wr, int wc, int fr, int fq) const {
        const int row0 = u.pm * BM + wr * 64 + fr;
        PG8_LAS const float* rsp = side + slot * 256 + wr * 64 + fr; PG8_LAS const float* bsp = side + 1024 + slot * 256 + wc * 32 + 8 * fq; ++slot;
        float rs[2][4];
#pragma unroll
        for (int ai = 0; ai < 2; ++ai)
#pragma unroll
            for (int m = 0; m < 4; ++m) rs[ai][m] = rsp[ai * HALF + m * 16];
#pragma unroll
        for (int bj = 0; bj < 2; ++bj) {
            const int cb = u.pn * BM + bj * HALF;
            if (cb > ::PN) continue;
            const int col = cb + wc * 32 + 8 * fq;
            const f32x4 b0 = *(PG8_LAS const f32x4*)(bsp + bj * HALF), b1 = *(PG8_LAS const f32x4*)(bsp + bj * HALF + 4);
            const bool isk = (cb >= ::PK && cb < ::PV), isv = (cb >= ::PV && cb < ::PN), isdt = (cb == ::PN);
#pragma unroll
            for (int ai = 0; ai < 2; ++ai)
#pragma unroll
                for (int m = 0; m < 4; ++m) {
                    const int row = row0 + ai * HALF + m * 16;
                    const f32x4 v0 = acc[ai][bj][m][0] * rs[ai][m] + b0, v1 = acc[ai][bj][m][1] * rs[ai][m] + b1;
                    if (isdt) { if (wc == 0 && fq < 2) { float* d = dt + (size_t)row * 12 + 8 * fq; *(f32x4*)d = v0; if (fq == 0) *(f32x4*)(d + 4) = v1; } continue; }
                    u32x4 w; w.x = cvt_pk_bf16(v0[0], v0[1]); w.y = cvt_pk_bf16(v0[2], v0[3]); w.z = cvt_pk_bf16(v1[0], v1[1]); w.w = cvt_pk_bf16(v1[2], v1[3]);
                    *(u32x4*)(proj + (size_t)row * ::PN + col) = w;
                    if (u.pm < 32 && (isk || isv)) {
                        const int b = row >> 8, t = row & 255;
                        float* o = (isk ? ok : ov) + ((size_t)(b * 4 + l) * 256 + t) * 384 + (col - (isk ? ::PK : ::PV));
                        *(f32x4*)o = v0; *(f32x4*)(o + 4) = v1;
                    }
                }
        }
    }
};
template <int MID, bool XF32>
struct EpiRes {
    static constexpr bool PERM = true, AFTER_DRAIN = false; static constexpr int MID_T = MID;
    const void* xin_c; const void* xin_l; bf16_t* xout; const float* gate;
    const float* nw; const float* sc; bf16_t* xs; float* ssq;
    PG8_LAS const float* side;
    __device__ __forceinline__ void mid(f32x4 (&acc)[2][2][4][2], const Unit& u, int wr, int fr) const {
#pragma unroll
        for (int ai = 0; ai < 2; ++ai)
#pragma unroll
            for (int m = 0; m < 4; ++m) { const float sc_ = side[ai * HALF + wr * 64 + m * 16 + fr];
#pragma unroll
                for (int bj = 0; bj < 2; ++bj)
#pragma unroll
                    for (int n = 0; n < 2; ++n) acc[ai][bj][m][n] = acc[ai][bj][m][n] * sc_; }
    }
    __device__ __forceinline__ void operator()(const f32x4 (&acc)[2][2][4][2], const Unit& u, int wr, int wc, int fr, int fq) const {
        const int row0 = u.pm * BM + wr * 64 + fr, col0 = u.pn * BM + wc * 32 + 8 * fq;
        const int r = u.pm < 32 ? 0 : 1 + ((u.pm - 32) >> 2);
        const float* gt = gate + (size_t)r * 6144; const float* sr = sc + (size_t)r * 6144;
        const void* xin = u.pm < 32 ? xin_c : xin_l;
        float sq[2][4];
#pragma unroll
        for (int ai = 0; ai < 2; ++ai)
#pragma unroll
            for (int m = 0; m < 4; ++m) sq[ai][m] = 0.f;
#pragma unroll
        for (int bj = 0; bj < 2; ++bj) {
            const int col = col0 + bj * HALF;
            const f32x4 g0 = *(const f32x4*)(gt + col), g1 = *(const f32x4*)(gt + col + 4);
            f32x4 gs0 = {0.f, 0.f, 0.f, 0.f}, gs1 = gs0;
            if (xs) { gs0 = *(const f32x4*)(nw + col) * (*(const f32x4*)(sr + col) + 1.f); gs1 = *(const f32x4*)(nw + col + 4) * (*(const f32x4*)(sr + col + 4) + 1.f); }
#pragma unroll
            for (int ai = 0; ai < 2; ++ai)
#pragma unroll
                for (int m = 0; m < 4; ++m) {
                    const size_t off = (size_t)(row0 + ai * HALF + m * 16) * ::D + col;
                    f32x4 xi0, xi1;
                    if (XF32) { xi0 = *(const f32x4*)((const float*)xin + off); xi1 = *(const f32x4*)((const float*)xin + off + 4); }
                    else { const u32x4 xr = *(const u32x4*)((const bf16_t*)xin + off);
                        xi0 = (f32x4){__uint_as_float(xr.x << 16), __uint_as_float(xr.x & 0xffff0000u), __uint_as_float(xr.y << 16), __uint_as_float(xr.y & 0xffff0000u)};
                        xi1 = (f32x4){__uint_as_float(xr.z << 16), __uint_as_float(xr.z & 0xffff0000u), __uint_as_float(xr.w << 16), __uint_as_float(xr.w & 0xffff0000u)}; }
                    const f32x4 x0 = xi0 + g0 * acc[ai][bj][m][0], x1 = xi1 + g1 * acc[ai][bj][m][1];
                    { u32x4 xo; xo.x = cvt_pk_bf16(x0[0], x0[1]); xo.y = cvt_pk_bf16(x0[2], x0[3]); xo.z = cvt_pk_bf16(x1[0], x1[1]); xo.w = cvt_pk_bf16(x1[2], x1[3]); *(u32x4*)(xout + off) = xo; }
                    if (xs) { sq[ai][m] += ((x0[0] * x0[0] + x0[1] * x0[1]) + (x0[2] * x0[2] + x0[3] * x0[3])) + ((x1[0] * x1[0] + x1[1] * x1[1]) + (x1[2] * x1[2] + x1[3] * x1[3]));
                        const f32x4 h0 = x0 * gs0, h1 = x1 * gs1; u32x4 o; o.x = cvt_pk_bf16(h0[0], h0[1]); o.y = cvt_pk_bf16(h0[2], h0[3]); o.z = cvt_pk_bf16(h1[0], h1[1]); o.w = cvt_pk_bf16(h1[2], h1[3]);
                        *(u32x4*)(xs + off) = o; }
                }
        }
        if (xs) {
#pragma unroll
            for (int ai = 0; ai < 2; ++ai)
#pragma unroll
                for (int m = 0; m < 4; ++m) { const float t = ::xsum32(::xsum16(sq[ai][m])); if (fq == 0) ssq[(size_t)(row0 + ai * HALF + m * 16) * 16 + u.pn * 4 + wc] = t; }
        }
    }
};
struct EpiFF1 {
    static constexpr bool PERM = true, AFTER_DRAIN = false; static constexpr int MID_T = 0;
    bf16_t* h; PG8_LAS const float* side; mutable int slot;
    __device__ __forceinline__ void operator()(const f32x4 (&acc)[2][2][4][2], const Unit& u, int wr, int wc, int fr, int fq) const {
        const int row0 = u.pm * BM + wr * 64 + fr, col0 = u.pn * BM + wc * 32 + 8 * fq;
        PG8_LAS const float* rsp = side + slot * 256 + wr * 64 + fr; PG8_LAS const float* bsp = side + 1024 + slot * 256 + wc * 32 + 8 * fq; ++slot;
        f32x4 bv[2][2];
#pragma unroll
        for (int bj = 0; bj < 2; ++bj) { bv[bj][0] = *(PG8_LAS const f32x4*)(bsp + bj * HALF); bv[bj][1] = *(PG8_LAS const f32x4*)(bsp + bj * HALF + 4); }
#pragma unroll
        for (int ai = 0; ai < 2; ++ai)
#pragma unroll
            for (int m = 0; m < 4; ++m) {
                const int row = row0 + ai * HALF + m * 16; const float rs = rsp[ai * HALF + m * 16];
                bf16_t* rowp = h + (size_t)row * ::DFF + col0;
#pragma unroll
                for (int bj = 0; bj < 2; ++bj) {
                    f32x4 v0 = acc[ai][bj][m][0] * rs + bv[bj][0], v1 = acc[ai][bj][m][1] * rs + bv[bj][1];
#pragma unroll
                    for (int e = 0; e < 4; ++e) { const float a = fmaxf(v0[e], 0.f), b = fmaxf(v1[e], 0.f); v0[e] = a * a; v1[e] = b * b; }
                    u32x4 w; w.x = cvt_pk_bf16(v0[0], v0[1]); w.y = cvt_pk_bf16(v0[2], v0[3]); w.z = cvt_pk_bf16(v1[0], v1[1]); w.w = cvt_pk_bf16(v1[2], v1[3]);
                    *(u32x4*)(rowp + bj * HALF) = w;
                }
            }
    }
};
template <class Epi, class Sched, bool ALIGN_EPI = false, bool SP2 = false>
__device__ __forceinline__ void gemm_phase(PG8_LAS unsigned char* lds, const Gemm g, const Sched& S, const Epi& E, const int wave_in) {
    int tid_ = wave_in * 64 + ::lane_id(); asm volatile("" : "+v"(tid_));
    const int tid = tid_, wid = __builtin_amdgcn_readfirstlane(tid >> 6), lane = tid & 63, wr = wid >> 2, wc = wid & 3, fr = lane & 15, fq = lane >> 4;
    const int K = g.K, nt = K / BK;
    unsigned voffA[2], voffB[2];
#pragma unroll
    for (int i = 0; i < 2; ++i) { int R, C; stage_rc(tid * 16 + i * 8192, R, C); const int Rb = Epi::PERM ? ((R & ~31) + perm32(R & 31)) : R;
        voffA[i] = (unsigned)(R * K + C) * 2u; voffB[i] = (unsigned)(Rb * K + C) * 2u; }
    const size_t kstep = (size_t)(BK * 2);
    const size_t hstep = (size_t)HALF * K * 2;
    const size_t tstep = 2 * hstep;
    const unsigned ldsw = (unsigned)wid * 1024u;
    const int aoff = lds_byte(wr * 64 + fr, fq * 8), boff = lds_byte(wc * 32 + fr, fq * 8);
#define PG8_SA(b, h) (((b) * 2 + (h)) * HTB)
#define PG8_SB(b, h) ((4 + (b) * 2 + (h)) * HTB)
#define PG8_STAGE(bufoff, gbase, voff) do { _Pragma("unroll") for (int _i = 0; _i < 2; ++_i) \
        __builtin_amdgcn_global_load_lds((const unsigned*)((const char*)(gbase) + (voff)[_i]), (PG8_LAS unsigned*)(lds + (bufoff) + ldsw + _i * 8192), 16, 0, 0); } while (0)
#define PG8_LDA(dst, b, h) do { _Pragma("unroll") for (int m = 0; m < 4; ++m) _Pragma("unroll") for (int k = 0; k < 2; ++k) dst[m][k] = *(const PG8_LAS bf16x8*)(lds + PG8_SA(b, h) + aoff + m * 2048 + k * 1024); } while (0)
#define PG8_LDB(dst, b, h) do { _Pragma("unroll") for (int n = 0; n < 2; ++n) _Pragma("unroll") for (int k = 0; k < 2; ++k) dst[n][k] = *(const PG8_LAS bf16x8*)(lds + PG8_SB(b, h) + boff + n * 2048 + k * 1024); } while (0)
#define PG8_MMA(ai, bj, At, Bt) do { __builtin_amdgcn_s_setprio(1); _Pragma("unroll") for (int m = 0; m < 4; ++m) _Pragma("unroll") for (int n = 0; n < 2; ++n) _Pragma("unroll") for (int k = 0; k < 2; ++k) \
        acc[ai][bj][m][n] = __builtin_amdgcn_mfma_f32_16x16x32_bf16(Bt[n][k], At[m][k], acc[ai][bj][m][n], 0, 0, 0); __builtin_amdgcn_s_setprio(0); } while (0)
#define PG8_WAIT_V(n) asm volatile("s_waitcnt vmcnt(" #n ")" ::: "memory")
#define PG8_WAIT_L(n) asm volatile("s_waitcnt lgkmcnt(" #n ")" ::: "memory")
#define PG8_BAR __builtin_amdgcn_s_barrier()
#define PG8_SCHED __builtin_amdgcn_sched_barrier(0)
    Unit cur, nxt; int ui = 0;
    if (!S.next(0, cur)) return;
    f32x4 acc[2][2][4][2];
#pragma unroll
    for (int a = 0; a < 2; ++a)
#pragma unroll
        for (int b = 0; b < 2; ++b)
#pragma unroll
            for (int m = 0; m < 4; ++m)
#pragma unroll
                for (int n = 0; n < 2; ++n) acc[a][b][m][n] = (f32x4){0.f, 0.f, 0.f, 0.f};
    bf16x8 At[4][2], B0[2][2], B1[2][2];
    const char* cA = (const char*)g.A + (size_t)cur.pm * tstep; const char* cB = (const char*)g.Bt + (size_t)cur.pn * tstep;
    S.a_ready(cur);
    if constexpr (SP2) {
        PG8_STAGE(PG8_SB(0, 0), cB, voffB); PG8_STAGE(PG8_SB(0, 1), cB + hstep, voffB); PG8_STAGE(PG8_SA(0, 0), cA, voffA); PG8_STAGE(PG8_SA(0, 1), cA + hstep, voffA);
        if (wr == 1) PG8_BAR;
        PG8_WAIT_V(2); PG8_BAR;
        PG8_STAGE(PG8_SB(1, 0), cB + kstep, voffB); PG8_STAGE(PG8_SA(1, 0), cA + kstep, voffA); PG8_STAGE(PG8_SB(1, 1), cB + hstep + kstep, voffB);
        PG8_WAIT_V(6); PG8_BAR;
    } else {
        PG8_STAGE(PG8_SB(0, 0), cB, voffB); PG8_STAGE(PG8_SA(0, 0), cA, voffA); PG8_STAGE(PG8_SB(0, 1), cB + hstep, voffB); PG8_STAGE(PG8_SA(0, 1), cA + hstep, voffA);
        if (wr == 1) PG8_BAR;
        PG8_WAIT_V(4); PG8_BAR;
        PG8_STAGE(PG8_SB(1, 0), cB + kstep, voffB); PG8_STAGE(PG8_SA(1, 0), cA + kstep, voffA); PG8_STAGE(PG8_SB(1, 1), cB + hstep + kstep, voffB);
        PG8_WAIT_V(6); PG8_BAR;
    }
    for (;;) {
        const bool has_next = S.next(ui + 1, nxt);
        const char* nA = has_next ? (const char*)g.A + (size_t)nxt.pm * tstep : cA; const char* nB = has_next ? (const char*)g.Bt + (size_t)nxt.pn * tstep : cB;
        for (int t = 0; t < nt; t += 2) {
            if constexpr (Epi::MID_T > 0) { if (t == Epi::MID_T) E.mid(acc, cur, wr, fr); }
            const bool last = (t == nt - 2);
            const char* a1 = cA + (size_t)(t + 1) * kstep;
            const char* a2 = last ? nA : cA + (size_t)(t + 2) * kstep; const char* b2 = last ? nB : cB + (size_t)(t + 2) * kstep;
            const char* a3 = a2 + kstep; const char* b3 = b2 + kstep;
            if (last && has_next) S.a_ready(nxt);
            if constexpr (SP2) {
            PG8_LDB(B0, 0, 0); PG8_LDB(B1, 0, 1); PG8_SCHED; PG8_LDA(At, 0, 0); PG8_STAGE(PG8_SA(1, 1), a1 + hstep, voffA);
            PG8_WAIT_V(8); PG8_WAIT_L(0); PG8_BAR; PG8_MMA(0, 0, At, B0); PG8_MMA(0, 1, At, B1); PG8_BAR; PG8_SCHED;
            PG8_LDA(At, 0, 1); PG8_STAGE(PG8_SB(0, 0), b2, voffB); PG8_STAGE(PG8_SB(0, 1), b2 + hstep, voffB); PG8_STAGE(PG8_SA(0, 0), a2, voffA);
            PG8_WAIT_V(8); PG8_WAIT_L(0); PG8_BAR; PG8_MMA(1, 0, At, B0); PG8_MMA(1, 1, At, B1); PG8_BAR; PG8_SCHED;
            PG8_LDB(B0, 1, 0); PG8_LDB(B1, 1, 1); PG8_SCHED; PG8_LDA(At, 1, 0); PG8_STAGE(PG8_SA(0, 1), a2 + hstep, voffA);
            PG8_WAIT_V(8); PG8_WAIT_L(0); PG8_BAR; PG8_MMA(0, 0, At, B0); PG8_MMA(0, 1, At, B1); PG8_BAR; PG8_SCHED;
            PG8_LDA(At, 1, 1); PG8_STAGE(PG8_SB(1, 0), b3, voffB); PG8_STAGE(PG8_SB(1, 1), b3 + hstep, voffB); PG8_STAGE(PG8_SA(1, 0), a3, voffA);
            PG8_WAIT_V(8); PG8_WAIT_L(0); PG8_BAR; PG8_MMA(1, 0, At, B0); PG8_MMA(1, 1, At, B1); PG8_BAR; PG8_SCHED;
            } else {
            PG8_LDB(B0, 0, 0); PG8_SCHED; PG8_LDA(At, 0, 0); PG8_STAGE(PG8_SA(1, 1), a1 + hstep, voffA);
            PG8_WAIT_L(8); PG8_BAR; PG8_WAIT_L(0); PG8_MMA(0, 0, At, B0); PG8_BAR; PG8_SCHED;
            PG8_LDB(B1, 0, 1); PG8_STAGE(PG8_SB(0, 0), b2, voffB);
            PG8_BAR; PG8_WAIT_L(0); PG8_MMA(0, 1, At, B1); PG8_BAR;
            PG8_LDA(At, 0, 1); PG8_STAGE(PG8_SA(0, 0), a2, voffA);
            PG8_BAR; PG8_WAIT_L(0); PG8_MMA(1, 0, At, B0); PG8_BAR; PG8_SCHED;
            PG8_STAGE(PG8_SB(0, 1), b2 + hstep, voffB);
            PG8_WAIT_V(6); PG8_BAR; PG8_MMA(1, 1, At, B1); PG8_BAR;
            PG8_LDB(B0, 1, 0); PG8_SCHED; PG8_LDA(At, 1, 0); PG8_STAGE(PG8_SA(0, 1), a2 + hstep, voffA);
            PG8_WAIT_L(8); PG8_BAR; PG8_WAIT_L(0); PG8_MMA(0, 0, At, B0); PG8_BAR; PG8_SCHED;
            PG8_LDB(B1, 1, 1); PG8_STAGE(PG8_SB(1, 0), b3, voffB);
            PG8_BAR; PG8_WAIT_L(0); PG8_MMA(0, 1, At, B1); PG8_BAR;
            PG8_LDA(At, 1, 1); PG8_STAGE(PG8_SA(1, 0), a3, voffA);
            PG8_BAR; PG8_WAIT_L(0); PG8_MMA(1, 0, At, B0); PG8_BAR; PG8_SCHED;
            PG8_STAGE(PG8_SB(1, 1), b3 + hstep, voffB);
            PG8_WAIT_V(6); PG8_BAR; PG8_MMA(1, 1, At, B1); PG8_BAR;
            }
        }
        if constexpr (ALIGN_EPI) { if (wr == 0) PG8_BAR; }
        if constexpr (!Epi::AFTER_DRAIN) { E(acc, cur, wr, wc, fr, fq); S.done(cur); }
        if (!has_next) break;
#pragma unroll
        for (int a = 0; a < 2; ++a)
#pragma unroll
            for (int b = 0; b < 2; ++b)
#pragma unroll
                for (int m = 0; m < 4; ++m)
#pragma unroll
                    for (int n = 0; n < 2; ++n) acc[a][b][m][n] = (f32x4){0.f, 0.f, 0.f, 0.f};
        cur = nxt; cA = nA; cB = nB; ++ui;
        if constexpr (ALIGN_EPI) { if (wr == 1) PG8_BAR; }
    }
    PG8_WAIT_V(0);
    if constexpr (!ALIGN_EPI) { if (wr == 0) PG8_BAR; }
    PG8_BAR;
    if constexpr (Epi::AFTER_DRAIN) { E.fused(acc, cur, wr, wc, fr, fq, lds, wid, lane); S.done(cur); }
#undef PG8_SA
#undef PG8_SB
#undef PG8_STAGE
#undef PG8_LDA
#undef PG8_LDB
#undef PG8_MMA
#undef PG8_WAIT_V
#undef PG8_WAIT_L
#undef PG8_BAR
#undef PG8_SCHED
}
}

constexpr int NWAVES = 8, NTHREADS = 512;
constexpr int RING_BYTES = 131072, LDS_BYTES = 163840, LDSCTL_OFF = LDS_BYTES - 512, MISC_OFF = LDSCTL_OFF + 320;
#define GAS __attribute__((address_space(1)))
typedef unsigned v4u __attribute__((ext_vector_type(4)));
typedef GAS unsigned gu32;
#define LDS_WAIT() asm volatile("s_waitcnt lgkmcnt(0)" ::: "memory")
#define VM_WAIT() asm volatile("s_waitcnt vmcnt(0)" ::: "memory")
__device__ __forceinline__ unsigned pk2(float lo, float hi) { return cvtpk(lo, hi); }
constexpr int CW_BAR = 4096, CW_Q = 65536;
constexpr size_t CTL_ZERO_BYTES = 1 * MiB;

#define XB_TMO      128
#define XB_XCNT(j)  (256  + 64 * (j))
#define XB_XSUB(j)  (1280 + 64 * (j))
#define XB_XGEN(j)  (2304 + 64 * (j))
#define XB_TOP      3328
#define XB_TOPGEN   3392
#define XCD_BAR_WORDS 3456
#define XB_SPIN_CAP (1u << 18)

__device__ __forceinline__ unsigned xb_ld(unsigned* p)              { return __hip_atomic_load(p, __ATOMIC_RELAXED, __HIP_MEMORY_SCOPE_AGENT); }
__device__ __forceinline__ unsigned xb_add(unsigned* p, unsigned v) { return __hip_atomic_fetch_add(p, v, __ATOMIC_RELAXED, __HIP_MEMORY_SCOPE_AGENT); }
__device__ __forceinline__ unsigned xb_xcc_id() { return (unsigned)__builtin_amdgcn_s_getreg((3 << 11) | 20) & 0xFu; }
#define XB_SPIN(cond, bar) do { unsigned _sp = 0; while (cond) { __builtin_amdgcn_s_sleep(1); \
    if ((++_sp & 255u) == 0u) { if (xb_ld(&(bar)[XB_TMO])) break; if (_sp > XB_SPIN_CAP) { atomicAdd(&(bar)[XB_TMO], 1u); break; } } } } while (0)

struct XcdBarrier {
    unsigned* bar; unsigned x;
    volatile LAS unsigned* st;
};

__device__ __forceinline__ XcdBarrier xcd_barrier_post(unsigned* bar, volatile LAS unsigned* st) {
    XcdBarrier b; b.bar = bar; b.x = xb_xcc_id(); b.st = st;
    if (threadIdx.x == 0) (void)xb_add(&bar[XB_XCNT(b.x)], 1u);
    return b;
}
__device__ __forceinline__ void xcd_barrier_complete(unsigned* bar, unsigned x, unsigned& nloc, unsigned& nx) {
    const unsigned G = gridDim.x * gridDim.y * gridDim.z;
    unsigned sum, cnt, mine, sp = 0u;
    for (;;) {
        sum = 0u; cnt = 0u; mine = 0u;
#pragma unroll
        for (unsigned j = 0; j < 16; ++j) { const unsigned c = xb_ld(&bar[XB_XCNT(j)]); sum += c; cnt += (c > 0u) ? 1u : 0u; mine = (j == x) ? c : mine; }
        if (sum == G) break;
        __builtin_amdgcn_s_sleep(1);
        if ((++sp & 255u) == 0u) { if (xb_ld(&bar[XB_TMO])) break; if (sp > XB_SPIN_CAP) { atomicAdd(&bar[XB_TMO], 1u); break; } }
    }
    nloc = mine > 0u ? mine : 1u; nx = cnt > 0u ? cnt : 1u;
}

__device__ __forceinline__ void xcd_barrier(const XcdBarrier& b, const bool is_t0) {
    asm volatile("s_waitcnt vmcnt(0)" ::: "memory");
    __syncthreads();
    if (is_t0) {
        unsigned* bar = b.bar;
        __builtin_amdgcn_s_waitcnt(0);
        unsigned nloc = b.st[0], nx = b.st[1];
        if (nloc == 0u) { xcd_barrier_complete(bar, b.x, nloc, nx); b.st[0] = nloc; b.st[1] = nx; }
        const unsigned old = xb_add(&bar[XB_XSUB(b.x)], 1u);
        const unsigned gen = old / nloc;
        if (old + 1u == (gen + 1u) * nloc) {
            __builtin_amdgcn_fence(__ATOMIC_RELEASE, "agent");
            asm volatile("s_waitcnt vmcnt(0)" ::: "memory");
            const unsigned og = xb_add(&bar[XB_TOP], 1u);
            const unsigned tg = og / nx;
            if (og + 1u == (tg + 1u) * nx) xb_add(&bar[XB_TOPGEN], 1u);
            else XB_SPIN(xb_ld(&bar[XB_TOPGEN]) == tg, bar);
            __builtin_amdgcn_fence(__ATOMIC_ACQUIRE, "agent");
            xb_add(&bar[XB_XGEN(b.x)], 1u);
            asm volatile("s_waitcnt vmcnt(0)" ::: "memory");
        } else {
            XB_SPIN(xb_ld(&bar[XB_XGEN(b.x)]) == gen, bar);
            __builtin_amdgcn_fence(__ATOMIC_ACQUIRE, "agent");
            asm volatile("s_waitcnt vmcnt(0)" ::: "memory");
        }
    }
    __syncthreads();
}


struct Frame {
    LAS unsigned char* lds;
    volatile LAS unsigned* MISC;
    unsigned* ctl;
    int tid, lane, wave, vcu, G;
    const float* const* in; float* out; unsigned char* ws;
};
constexpr int PH_PRO = 0, PH_PRE = 1, PH_L0 = 2, PH_PER_LAYER = 6, PH_G1 = 0, PH_MIXA = 1, PH_MIXB = 2, PH_G3 = 3, PH_G4 = 4, PH_G5 = 5, PH_FINAL = PH_L0 + DEPTH * PH_PER_LAYER, PH_END = PH_FINAL + 1;

__device__ __forceinline__ int queue_next(Frame& F, unsigned* ctr);
constexpr int TR_P = 144;
__device__ __forceinline__ void transpose_item(const float* W, int K, int Nsrc, int src_n0, bf16_t* WT, int dst_n0, int k0, LAS unsigned char* scr, int lane, int nvalid = 64) {
    const int l16 = lane & 15, l4 = lane >> 4;
    f32x4 v[16];
#pragma unroll
    for (int i = 0; i < 16; ++i) v[i] = (src_n0 >= 0 && 4 * l16 < nvalid) ? *(const f32x4*)(W + (size_t)(k0 + 4 * i + l4) * Nsrc + src_n0 + 4 * l16) : (f32x4){0.f, 0.f, 0.f, 0.f};
#pragma unroll
    for (int i = 0; i < 16; ++i)
#pragma unroll
        for (int e = 0; e < 4; ++e) *(LAS bf16_t*)(scr + (4 * l16 + e) * TR_P + (4 * i + l4) * 2) = f2bf(v[i][e]);
    LDS_WAIT(); asm volatile("" ::: "memory");
#pragma unroll
    for (int jn = 0; jn < 8; ++jn) { const int n = 8 * jn + (lane >> 3), c = lane & 7;
        *(v4u*)(WT + (size_t)(dst_n0 + n) * K + k0 + 8 * c) = *(LAS const v4u*)(scr + n * TR_P + c * 16); }
    LDS_WAIT(); asm volatile("" ::: "memory");
}
constexpr int TR_IN = 16 * (PNP / 64), TR_OUT = 16 * 16, TR_F1 = 16 * (DFF / 64), TR_F2 = (DFF / 64) * 16, TR_GLU = 4 * 4, TR_L = TR_IN + TR_OUT + TR_F1 + TR_F2 + TR_GLU;
constexpr int TR_WG = (TR_L + 7) / 8;
__device__ __forceinline__ void transpose_layer_item(Frame& F, int l, int r) {
    const float* const* in = F.in;
    LAS unsigned char* scr = F.lds + F.wave * (64 * TR_P);
    if (r < TR_IN) { const int nb = r % (PNP / 64), kb = r / (PNP / 64), n0 = nb * 64; const int src = n0 > PN ? -1 : (n0 == PN ? 1024 : (n0 >= 1024 ? n0 + 12 : n0));
        transpose_item(in[13] + (size_t)l * 1024 * IN_COLS, 1024, IN_COLS, src, (bf16_t*)(F.ws + OFF_WIN) + (size_t)l * PNP * 1024, n0, kb * 64, scr, F.lane, n0 == PN ? 12 : 64); }
    else if ((r -= TR_IN) < TR_OUT) { const int nb = r % 16, kb = r / 16; transpose_item(in[31] + (size_t)l * 1024 * 1024, 1024, 1024, nb * 64, (bf16_t*)(F.ws + OFF_WOUT) + (size_t)l * 1024 * 1024, nb * 64, kb * 64, scr, F.lane); }
    else if ((r -= TR_OUT) < TR_F1) { const int nb = r % (DFF / 64), kb = r / (DFF / 64); transpose_item(in[32] + (size_t)l * 1024 * DFF, 1024, DFF, nb * 64, (bf16_t*)(F.ws + OFF_WFF1) + (size_t)l * DFF * 1024, nb * 64, kb * 64, scr, F.lane); }
    else if ((r -= TR_F1) < TR_F2) { const int nb = r % 16, kb = r / 16; transpose_item(in[33] + (size_t)l * DFF * 1024, DFF, 1024, nb * 64, (bf16_t*)(F.ws + OFF_WFF2) + (size_t)l * 1024 * DFF, nb * 64, kb * 64, scr, F.lane); }
    else { r -= TR_F2; const int nb = r % 4, kb = r / 4; transpose_item(in[28] + (size_t)l * 65536, 256, 256, nb * 64, (bf16_t*)(F.ws + OFF_WGLU) + (size_t)l * 65536, nb * 64, kb * 64, scr, F.lane); }
}
__device__ __forceinline__ void transpose_layer_queue(Frame& F, int l, unsigned* ctr) {
    for (;;) { const int u = queue_next(F, ctr); if (u >= TR_WG) break; const int it = u * 8 + F.wave; if (it < TR_L) transpose_layer_item(F, l, it); }
}
__device__ __forceinline__ void phase_prologue(Frame& F) {
    const float* const* in = F.in;
    for (int idx = F.vcu * NTHREADS + F.tid; idx < 8192; idx += F.G * NTHREADS) {
        const int pp = idx & 63, g = (idx >> 6) & 15, dir = (idx >> 10) & 1, l = idx >> 11;
        const float are = in[20][idx], aim = in[21][idx];
        const float dt = __expf(in[22][(l * 2 + dir) * 16 + g]);
        const float zr = are * dt, zi = aim * dt;
        const float e = expf(zr); float rev = zi * 0.15915494309189535f; rev -= rintf(rev);
        const float ar = e * cosf(rev * 6.283185307179586f), ai = e * sinf(rev * 6.283185307179586f);
        float* abar = (float*)(F.ws + OFF_TAB + TAB_ABAR);
        abar[idx * 2] = ar; abar[idx * 2 + 1] = ai;
        const float xr = ar - 1.f, xi = ai, den = are * are + aim * aim;
        const float fr = (xr * are + xi * aim) / den, fi = (xi * are - xr * aim) / den;
        for (int c = 0; c < 16; ++c) {
            const float br = in[23][((l * 16 + g) * 64 + pp) * 16 + c], bi = in[24][((l * 16 + g) * 64 + pp) * 16 + c];
            bf16_t* bbt = (bf16_t*)(F.ws + OFF_TAB + TAB_BBT) + ((size_t)(((l * 2 + dir) * 16 + g) * 2) * 64 + pp) * 16 + c;
            bbt[0] = f2bf(fr * br - fi * bi); bbt[64 * 16] = f2bf(fr * bi + fi * br);
        }
    }
    for (int i = F.vcu * NTHREADS + F.tid; i < 4 * 16 * 16 * 128; i += F.G * NTHREADS) {
        const int k = i & 127, c = (i >> 7) & 15, g = (i >> 11) & 15, l = i >> 15, ri = k >> 6, pp = k & 63;
        const size_t si = ((size_t)(l * 16 + g) * 16 + c) * 64 + pp;
        ((bf16_t*)(F.ws + OFF_TAB + TAB_CC1))[i] = f2bf(ri ? -in[26][si] : in[25][si]);
    }
    for (int i = F.vcu * NTHREADS + F.tid; i < 2 * 3145728 / 8; i += F.G * NTHREADS) {
        const int which = i >= 3145728 / 8; const size_t e = (size_t)(which ? i - 3145728 / 8 : i) * 8;
        const float* src = in[which ? 3 : 2] + e; const f32x4 a = *(const f32x4*)src, b = *(const f32x4*)(src + 4);
        v4u o; o[0] = pk2(a[0], a[1]); o[1] = pk2(a[2], a[3]); o[2] = pk2(b[0], b[1]); o[3] = pk2(b[2], b[3]);
        *(v4u*)((bf16_t*)(F.ws + (which ? OFF_CV : OFF_CK)) + e) = o;
    }
    constexpr int N_UNITS = 96 + TR_WG;
    unsigned* ctr = F.ctl + CW_Q + 64 * 63;
    for (;;) {
        const int u = queue_next(F, ctr); if (u >= N_UNITS) break;
        if (u < 96) {
            LAS float* ssil = (LAS float*)F.lds;
            LAS float* part = (LAS float*)(F.lds + 9 * 1024 * 4);
            for (int i = F.tid; i < 9 * 1024; i += NTHREADS) { const int r = i >> 10, k = i & 1023; const float v = r == 0 ? in[8][k] : in[7][(r - 1) * 1024 + k]; ssil[i] = silu_f(v); }
            __syncthreads();
            const int l = u / 24, n0 = (u % 24) * 256;
            const float* w = in[9] + (size_t)l * 1024 * 6144 + n0 + 4 * F.lane;
            f32x4 acc[9];
#pragma unroll
            for (int r = 0; r < 9; ++r) acc[r] = (f32x4){0.f, 0.f, 0.f, 0.f};
            const int kb = F.wave * 128;
            for (int k = 0; k < 128; k += 4) {
                f32x4 wv[4];
#pragma unroll
                for (int e = 0; e < 4; ++e) wv[e] = *(const f32x4*)(w + (size_t)(kb + k + e) * 6144);
#pragma unroll
                for (int r = 0; r < 9; ++r) { const f32x4 sv = *(LAS const f32x4*)(ssil + r * 1024 + kb + k);
                    acc[r] += wv[0] * sv[0]; acc[r] += wv[1] * sv[1]; acc[r] += wv[2] * sv[2]; acc[r] += wv[3] * sv[3]; }
            }
#pragma unroll
            for (int r = 0; r < 9; ++r) *(LAS f32x4*)(part + (F.wave * 9 + r) * 256 + 4 * F.lane) = acc[r];
            __syncthreads();
            float* mods = (float*)(F.ws + OFF_MODS);
            for (int i = F.tid; i < 9 * 256; i += NTHREADS) { const int r = i >> 8, jn = i & 255; float sacc = in[10][l * 6144 + n0 + jn];
#pragma unroll
                for (int w8 = 0; w8 < 8; ++w8) sacc += part[(w8 * 9 + r) * 256 + jn];
                mods[(size_t)(l * 9 + r) * 6144 + n0 + jn] = sacc; }
        } else {
            const int it = (u - 96) * 8 + F.wave;
            if (it < TR_L) transpose_layer_item(F, 0, it);
        }
    }
}
__device__ __forceinline__ void bias_task(Frame& F, int l, int t);
__device__ __forceinline__ void phase_pre(Frame& F) {
    const float* const* in = F.in; const int lane = F.lane;
    for (int row = F.vcu * NWAVES + F.wave; row < M; row += F.G * NWAVES) {
        const float* xr = row < MC ? in[0] + (size_t)row * D : in[1] + (size_t)(row - MC) * D;
        const float* sc = (const float*)(F.ws + OFF_MODS) + (size_t)mod_row(row) * 6144 + 1024; const float* gw = in[11];
        bf16_t* h = (bf16_t*)(F.ws + OFF_H) + (size_t)row * D;
        float s = 0.f;
#pragma unroll
        for (int j = 0; j < 4; ++j) { const int c = 4 * lane + 256 * j; const f32x4 v = *(const f32x4*)(xr + c), g = *(const f32x4*)(gw + c), a = *(const f32x4*)(sc + c);
            s += v.x * v.x + v.y * v.y + v.z * v.z + v.w * v.w;
            uint2 o; o.x = pk2(v.x * g.x * (1.f + a.x), v.y * g.y * (1.f + a.y)); o.y = pk2(v.z * g.z * (1.f + a.z), v.w * g.w * (1.f + a.w)); *(uint2*)(h + c) = o; }
        s = wave_sum(s);
        if (lane < 16) ((float*)(F.ws + OFF_TAB + TAB_SQ1))[(size_t)row * 16 + lane] = lane == 0 ? s : 0.f;
    }
    for (int task = F.vcu; task < 104; task += F.G) bias_task(F, 0, task);
}
__device__ __forceinline__ void bias_task(Frame& F, int l, int t) {
    const int lane = F.lane, fr = lane & 15, fq = lane >> 4, w = F.wave;
    LAS float* red = (LAS float*)F.lds;
    {
        const int which = t >= 40, n0 = (which ? t - 40 : t) * 64;
        const float* mods = (const float*)(F.ws + OFF_MODS) + (size_t)l * 9 * 6144 + (which ? 3 : 0) * 1024;
        const bf16_t* wt = which ? (const bf16_t*)(F.ws + OFF_WFF1) + (size_t)l * DFF * 1024 : (const bf16_t*)(F.ws + OFF_WIN) + (size_t)l * PNP * 1024;
        float* bo = (float*)(F.ws + OFF_TAB + (which ? TAB_B2 : TAB_B1)) + (size_t)l * 9 * (which ? DFF : PNP);
        f32x4 acc[4];
#pragma unroll
        for (int nb = 0; nb < 4; ++nb) acc[nb] = (f32x4){0.f, 0.f, 0.f, 0.f};
#pragma unroll
        for (int ks = 0; ks < 4; ++ks) {
            const int k0 = 128 * w + 32 * ks + 8 * fq;
            union { bf16x8 v; unsigned u[4]; } af; af.u[0] = af.u[1] = af.u[2] = af.u[3] = 0u;
            if (fr < 9) { const f32x4 a0 = *(const f32x4*)(mods + (size_t)fr * 6144 + k0), a1 = *(const f32x4*)(mods + (size_t)fr * 6144 + k0 + 4);
                af.u[0] = pk2(a0[0], a0[1]); af.u[1] = pk2(a0[2], a0[3]); af.u[2] = pk2(a1[0], a1[1]); af.u[3] = pk2(a1[2], a1[3]); }
#pragma unroll
            for (int nb = 0; nb < 4; ++nb) { const bf16x8 bfr = *(const bf16x8*)(wt + (size_t)(n0 + 16 * nb + fr) * 1024 + k0); acc[nb] = __builtin_amdgcn_mfma_f32_16x16x32_bf16(af.v, bfr, acc[nb], 0, 0, 0); }
        }
        __syncthreads();
#pragma unroll
        for (int nb = 0; nb < 4; ++nb) *(LAS f32x4*)(red + ((w * 4 + nb) * 64 + lane) * 4) = acc[nb];
        __syncthreads();
        for (int i = F.tid; i < 1024; i += NTHREADS) { float sacc = 0.f;
#pragma unroll
            for (int w8 = 0; w8 < 8; ++w8) sacc += red[w8 * 1024 + i];
            const int nb = i >> 8, ln = (i >> 2) & 63, e = i & 3, r = 4 * (ln >> 4) + e;
            if (r < 9) bo[(size_t)r * (which ? DFF : PNP) + n0 + 16 * nb + (ln & 15)] = sacc; }
    }
}
constexpr int EPI_SIDE_OFF = RING_BYTES;
template <class Sched>
__device__ __forceinline__ void epi_side_fill(Frame& F, const Sched& S, const float* ssq, const float* bias, int ldb) {
    LAS float* side = (LAS float*)(F.lds + EPI_SIDE_OFF);
    pg8::Unit u;
    for (int i = 0; i < 4 && S.next(i, u); ++i) {
        if (F.tid < 256) { const f32x4* p = (const f32x4*)(ssq + (size_t)(u.pm * 256 + F.tid) * 16); const f32x4 a = p[0], b = p[1], c = p[2], d = p[3];
            const float sm = ((a[0] + a[1]) + (a[2] + a[3])) + ((b[0] + b[1]) + (b[2] + b[3])) + ((c[0] + c[1]) + (c[2] + c[3])) + ((d[0] + d[1]) + (d[2] + d[3]));
            side[i * 256 + F.tid] = rsqrtf(sm * (1.f / 1024.f) + EPS); }
        else { const int r = u.pm < 32 ? 0 : 1 + ((u.pm - 32) >> 2); side[1024 + i * 256 + F.tid - 256] = bias[(size_t)r * ldb + u.pn * 256 + F.tid - 256]; }
    }
    __syncthreads();
}
__device__ __forceinline__ void phase_final(Frame& F) {
    const int lane = F.lane; const float* gw = F.in[34];
    for (int row = F.vcu * NWAVES + F.wave; row < M; row += F.G * NWAVES) {
        const bf16_t* xr = (const bf16_t*)(F.ws + OFF_X) + (size_t)row * D;
        f32x4 v[4]; float s = 0.f;
#pragma unroll
        for (int j = 0; j < 4; ++j) { const uint2 q = *(const uint2*)(xr + 4 * lane + 256 * j); v[j] = (f32x4){__uint_as_float(q.x << 16), __uint_as_float(q.x & 0xffff0000u), __uint_as_float(q.y << 16), __uint_as_float(q.y & 0xffff0000u)};
            s += v[j].x * v[j].x + v[j].y * v[j].y + v[j].z * v[j].z + v[j].w * v[j].w; }
        const float rstd = rsqrtf(wave_sum(s) * (1.f / D) + EPS);
        float* o = F.out + (size_t)row * D;
#pragma unroll
        for (int j = 0; j < 4; ++j) { const int c = 4 * lane + 256 * j; const f32x4 g = *(const f32x4*)(gw + c); f32x4 r = {v[j].x * rstd * g.x, v[j].y * rstd * g.y, v[j].z * rstd * g.z, v[j].w * rstd * g.w}; *(f32x4*)(o + c) = r; }
    }
}


typedef short v4i16_t __attribute__((ext_vector_type(4)));
constexpr int AT_KP = 160;
constexpr int AT_TILE = 128 * AT_KP;
constexpr int AT_K0 = 0, AT_V0 = 2 * AT_TILE, AT_RPB = 4 * AT_TILE, AT_END = AT_RPB + 2048;
__device__ __forceinline__ int queue_next(Frame& F, unsigned* ctr) {
    int t_ = F.wave * 64 + lane_id(); asm volatile("" : "+v"(t_));
    unsigned slot = MISC_OFF + 64; asm volatile("" : "+v"(slot));
    volatile LAS unsigned* bw = (volatile LAS unsigned*)(F.lds + slot);
    __syncthreads();
    if (t_ == 0) *bw = atomicAdd(ctr, 1u);
    __syncthreads();
    F.tid = t_; F.lane = t_ & 63;
    return (int)*bw;
}
__device__ __forceinline__ bf16x8 tr2(LAS const unsigned char* a, LAS const unsigned char* b) {
    const v4i16_t x = __builtin_amdgcn_ds_read_tr16_b64_v4i16((LAS v4i16_t*)a), y = __builtin_amdgcn_ds_read_tr16_b64_v4i16((LAS v4i16_t*)b);
    return (bf16x8){x[0], x[1], x[2], x[3], y[0], y[1], y[2], y[3]};
}
struct AttnState { f32x4 o[4]; float m, l; };
template <int NKB, bool MASKED>
__device__ __forceinline__ void attn_tile(AttnState& st, LAS const unsigned char* Kt, LAS const unsigned char* Vt, const bf16x8 (&qf)[2], int c0, int lane,
                                          LAS const float* rpbrow, int cw, int qc) {
    const int fr = lane & 15, fq = lane >> 4;
    f32x4 s[NKB];
#pragma unroll
    for (int kb = 0; kb < NKB; ++kb) {
        s[kb] = (f32x4){0.f, 0.f, 0.f, 0.f};
#pragma unroll
        for (int ks = 0; ks < 2; ++ks) {
            const bf16x8 a = *(LAS const bf16x8*)(Kt + (c0 + 16 * kb + fr) * AT_KP + (32 * ks + 8 * fq) * 2);
            s[kb] = __builtin_amdgcn_mfma_f32_16x16x32_bf16(a, qf[ks], s[kb], 0, 0, 0);
        }
    }
    float mloc = -1e30f;
#pragma unroll
    for (int kb = 0; kb < NKB; ++kb)
#pragma unroll
        for (int i = 0; i < 4; ++i) {
            float t = s[kb][i] * 0.125f;
            if (MASKED) { const int kc = cw + 16 * kb + 4 * fq + i, cs = min(max(qc - 8, 0), 48); t = (kc >= cs && kc < cs + 16) ? t + rpbrow[kc - qc + 15] : -1e30f; }
            s[kb][i] = t; mloc = fmaxf(mloc, t);
        }
    mloc = xmax32(xmax16(mloc));
    const float mn = fmaxf(st.m, mloc), alpha = __expf(st.m - mn);
    st.m = mn;
    float ls = 0.f;
#pragma unroll
    for (int kb = 0; kb < NKB; ++kb)
#pragma unroll
        for (int i = 0; i < 4; ++i) { const float pv = __expf(s[kb][i] - mn); s[kb][i] = pv; ls += pv; }
    st.l = st.l * alpha + ls;
#pragma unroll
    for (int db = 0; db < 4; ++db) st.o[db] = st.o[db] * alpha;
#pragma unroll
    for (int kk = 0; kk < NKB / 2; ++kk) {
        union { bf16x8 v; unsigned u[4]; } pf;
        pf.u[0] = pk2(s[2 * kk][0], s[2 * kk][1]); pf.u[1] = pk2(s[2 * kk][2], s[2 * kk][3]);
        pf.u[2] = pk2(s[2 * kk + 1][0], s[2 * kk + 1][1]); pf.u[3] = pk2(s[2 * kk + 1][2], s[2 * kk + 1][3]);
        LAS const unsigned char* va = Vt + (c0 + 32 * kk + 4 * fq + (fr >> 2)) * AT_KP + (4 * (fr & 3)) * 2;
#pragma unroll
        for (int db = 0; db < 4; ++db) {
            const bf16x8 vf = tr2(va + db * 32, va + 16 * AT_KP + db * 32);
            st.o[db] = __builtin_amdgcn_mfma_f32_16x16x32_bf16(vf, pf.v, st.o[db], 0, 0, 0);
        }
    }
}
struct AttnChain { AttnState st; bf16x8 qf[2]; int qrow, c0; };
__device__ __forceinline__ void attn_chain_init(AttnChain& ch, const bf16_t* proj, int qrow, int c0, int h, bool nat, int fq) {
    ch.qrow = qrow; ch.c0 = c0;
#pragma unroll
    for (int ks = 0; ks < 2; ++ks) ch.qf[ks] = *(const bf16x8*)(proj + (size_t)qrow * PN + PQ + h * 64 + 32 * ks + 8 * fq);
    ch.st.m = -1e30f; ch.st.l = 0.f;
#pragma unroll
    for (int db = 0; db < 4; ++db) ch.st.o[db] = (f32x4){0.f, 0.f, 0.f, 0.f};
}
__device__ __forceinline__ void attn_chain_store(const AttnChain& ch, bf16_t* mixb, int h, int fq) {
    const float inv = 1.f / xsum32(xsum16(ch.st.l));
    bf16_t* mix = mixb + (size_t)ch.qrow * D + 640 + h * 64 + 4 * fq;
#pragma unroll
    for (int db = 0; db < 4; ++db) { uint2 o; o.x = pk2(ch.st.o[db][0] * inv, ch.st.o[db][1] * inv); o.y = pk2(ch.st.o[db][2] * inv, ch.st.o[db][3] * inv); *(uint2*)(mix + 16 * db) = o; }
}
__device__ __forceinline__ void attn_unit(Frame& F, int l, int unit) {
    const int tid = F.tid, w = F.wave, fr = F.lane & 15, fq = F.lane >> 4;
    const bf16_t* proj = (const bf16_t*)(F.ws + OFF_PROJ);
    LAS unsigned char* lds = F.lds;
    const bool nat = unit < 192;
    int b, h, r = 0, rs_w = 0, rs0 = 0, nlat = 0;
    AttnChain ch0, ch1;
    if (nat) { b = unit / 24; h = (unit / 4) % 6; const int rq = unit % 4; r = 4 * rq + (w >> 1);
        rs_w = min(max(r - 4, 0), 8); rs0 = min(max(4 * rq - 4, 0), 8); const int rsl = min(max(4 * rq + 3 - 4, 0), 8); nlat = rsl + 8 - rs0;
        const int qb = MC + b * 1024 + r * 64 + fr;
        if (w & 1) { attn_chain_init(ch0, proj, qb + 32, 24, h, true, fq); attn_chain_init(ch1, proj, qb + 48, 32, h, true, fq); }
        else { attn_chain_init(ch0, proj, qb, 0, h, true, fq); attn_chain_init(ch1, proj, qb + 16, 8, h, true, fq); }
    } else { const int v = unit - 192; b = v / 6; h = v % 6; const int qb = b * 256 + 32 * w + fr;
        attn_chain_init(ch0, proj, qb, 0, h, false, fq); attn_chain_init(ch1, proj, qb + 16, 0, h, false, fq); }
    const int nlt = (nlat + 1) >> 1;
    const int ntiles = nat ? nlt + 2 : 2;
    if (nat) { const float* rpb = F.in[30] + (size_t)(l * 6 + h) * 465; for (int i = tid; i < 465; i += NTHREADS) ((LAS float*)(lds + AT_RPB))[i] = rpb[i]; }
    const int skey = tid >> 2, sch = (tid & 3) * 2;
    v4u rk0 = {0u, 0u, 0u, 0u}, rk1 = rk0, rv0 = rk0, rv1 = rk0;
#define AT_LOAD(ti_) do { const int ti__ = (ti_); \
        if (nat && ti__ >= nlt) { const size_t off = ((size_t)(b * 4 + l) * 256 + (ti__ - nlt) * 128 + skey) * 384 + h * 64 + sch * 8; \
            const bf16_t* pk_ = (const bf16_t*)(F.ws + OFF_CK) + off; const bf16_t* pv_ = (const bf16_t*)(F.ws + OFF_CV) + off; \
            rk0 = *(const v4u*)pk_; rk1 = *(const v4u*)(pk_ + 8); rv0 = *(const v4u*)pv_; rv1 = *(const v4u*)(pv_ + 8); \
        } else { const int grow = nat ? MC + b * 1024 + min(rs0 + 2 * ti__ + (skey >> 6), 15) * 64 + (skey & 63) : b * 256 + ti__ * 128 + skey; \
            const bf16_t* pr = proj + (size_t)grow * PN + h * 64 + sch * 8; rk0 = *(const v4u*)(pr + PK); rk1 = *(const v4u*)(pr + PK + 8); rv0 = *(const v4u*)(pr + PV); rv1 = *(const v4u*)(pr + PV + 8); } } while (0)
#define AT_WRITE(buf_) do { const int buf__ = (buf_); \
        *(LAS v4u*)(lds + AT_K0 + buf__ * AT_TILE + skey * AT_KP + sch * 16) = rk0; *(LAS v4u*)(lds + AT_K0 + buf__ * AT_TILE + skey * AT_KP + sch * 16 + 16) = rk1; \
        *(LAS v4u*)(lds + AT_V0 + buf__ * AT_TILE + skey * AT_KP + sch * 16) = rv0; *(LAS v4u*)(lds + AT_V0 + buf__ * AT_TILE + skey * AT_KP + sch * 16 + 16) = rv1; } while (0)
    AT_LOAD(0); AT_WRITE(0);
    __syncthreads();
    for (int ti = 0; ti < ntiles; ++ti) {
        const int buf = ti & 1;
        if (ti + 1 < ntiles) AT_LOAD(ti + 1);
        int lane = F.lane; asm volatile("" : "+v"(lane));
        LAS const unsigned char* Kt = lds + AT_K0 + buf * AT_TILE; LAS const unsigned char* Vt = lds + AT_V0 + buf * AT_TILE;
        if (nat && ti < nlt) {
#pragma unroll
            for (int sub = 0; sub < 2; ++sub) { const int kr = rs0 + 2 * ti + sub;
                if (kr >= rs_w && kr < rs_w + 8) { LAS const float* rrow = (LAS const float*)(lds + AT_RPB) + (kr - r + 7) * 31;
                    attn_tile<2, true>(ch0.st, Kt, Vt, ch0.qf, 64 * sub + ch0.c0, lane, rrow, ch0.c0, (ch0.qrow - MC) & 63); attn_tile<2, true>(ch1.st, Kt, Vt, ch1.qf, 64 * sub + ch1.c0, lane, rrow, ch1.c0, (ch1.qrow - MC) & 63); }
                __builtin_amdgcn_sched_barrier(0); }
        } else {
#pragma unroll
            for (int hf = 0; hf < 2; ++hf) {
                attn_tile<4, false>(ch0.st, Kt, Vt, ch0.qf, 64 * hf, lane, (LAS const float*)(lds + AT_RPB), 0, 0);
                attn_tile<4, false>(ch1.st, Kt, Vt, ch1.qf, 64 * hf, lane, (LAS const float*)(lds + AT_RPB), 0, 0); __builtin_amdgcn_sched_barrier(0); }
        }
        if (ti + 1 < ntiles) AT_WRITE(buf ^ 1);
        __syncthreads();
    }
    attn_chain_store(ch0, (bf16_t*)(F.ws + OFF_MIX), h, fq); attn_chain_store(ch1, (bf16_t*)(F.ws + OFF_MIX), h, fq);
}
constexpr int SS_P = 144;
constexpr int SS_IMG = 128 * SS_P;
constexpr int SS_HP = 144, SS_HIMG = 64 * SS_HP;
constexpr int SSA_B = 0, SSA_X = SS_IMG, SSA_TAB = 7 * SS_IMG;
constexpr int SSB_B = 0, SSB_C = SS_IMG, SSB_X = 2 * SS_IMG, SSB_H = 5 * SS_IMG, SSB_TAB = 5 * SS_IMG + 6 * SS_HIMG;
static_assert(SSB_TAB + 3 * 4 * 128 * 4 <= 163328 && SSA_TAB + 3 * 4 * 128 * 4 <= 163328, "SSD LDS map");
__device__ __forceinline__ void conv16(const bf16_t* proj, const float* cw, const float* cb, int seq_start, int seq_L, int t, int ch0, float (&v)[16]) {
#pragma unroll
    for (int e = 0; e < 16; e += 4) { const f32x4 b = *(const f32x4*)(cb + ch0 + e); v[e] = b[0]; v[e + 1] = b[1]; v[e + 2] = b[2]; v[e + 3] = b[3]; }
#pragma unroll
    for (int j = 0; j < 5; ++j) {
        const int tt = t + j - 2;
        if (tt >= 0 && tt < seq_L) {
            const bf16_t* src = proj + (size_t)(seq_start + tt) * PN + PX + ch0;
            const v4u r0 = *(const v4u*)src, r1 = *(const v4u*)(src + 8);
            const unsigned rr[8] = {r0[0], r0[1], r0[2], r0[3], r1[0], r1[1], r1[2], r1[3]};
#pragma unroll
            for (int e = 0; e < 16; e += 4) { const f32x4 w = *(const f32x4*)(cw + j * 640 + ch0 + e);
                v[e] += w[0] * __uint_as_float(rr[e / 2] << 16); v[e + 1] += w[1] * __uint_as_float(rr[e / 2] & 0xffff0000u);
                v[e + 2] += w[2] * __uint_as_float(rr[e / 2 + 1] << 16); v[e + 3] += w[3] * __uint_as_float(rr[e / 2 + 1] & 0xffff0000u); }
        }
    }
#pragma unroll
    for (int e = 0; e < 16; ++e) v[e] = silu_f(v[e]);
}
__device__ __forceinline__ void conv4x8(const bf16_t* proj, const float* cw, const float* cb, int seq_start, int seq_L, int t, int ch0, float (&v)[4][8]) {
    float xin[8][8];
#pragma unroll
    for (int rr = 0; rr < 8; ++rr) { const int tt = t - 2 + rr; v4u r = {0u, 0u, 0u, 0u};
        if (tt >= 0 && tt < seq_L) r = *(const v4u*)(proj + (size_t)(seq_start + tt) * PN + PX + ch0);
#pragma unroll
        for (int e = 0; e < 4; ++e) { xin[rr][2 * e] = __uint_as_float(r[e] << 16); xin[rr][2 * e + 1] = __uint_as_float(r[e] & 0xffff0000u); } }
    const f32x4 b0 = *(const f32x4*)(cb + ch0), b1 = *(const f32x4*)(cb + ch0 + 4);
#pragma unroll
    for (int k = 0; k < 4; ++k) { v[k][0] = b0[0]; v[k][1] = b0[1]; v[k][2] = b0[2]; v[k][3] = b0[3]; v[k][4] = b1[0]; v[k][5] = b1[1]; v[k][6] = b1[2]; v[k][7] = b1[3]; }
#pragma unroll
    for (int j = 0; j < 5; ++j) { const f32x4 w0 = *(const f32x4*)(cw + j * 640 + ch0), w1 = *(const f32x4*)(cw + j * 640 + ch0 + 4);
#pragma unroll
        for (int k = 0; k < 4; ++k) { v[k][0] += w0[0] * xin[k + j][0]; v[k][1] += w0[1] * xin[k + j][1]; v[k][2] += w0[2] * xin[k + j][2]; v[k][3] += w0[3] * xin[k + j][3];
            v[k][4] += w1[0] * xin[k + j][4]; v[k][5] += w1[1] * xin[k + j][5]; v[k][6] += w1[2] * xin[k + j][6]; v[k][7] += w1[3] * xin[k + j][7]; } }
#pragma unroll
    for (int k = 0; k < 4; ++k)
#pragma unroll
        for (int e = 0; e < 8; ++e) v[k][e] = silu_f(v[k][e]);
}
__device__ __forceinline__ void store8(LAS unsigned char* dst, const float (&v)[8], float sc) {
    v4u o; o[0] = pk2(v[0] * sc, v[1] * sc); o[1] = pk2(v[2] * sc, v[3] * sc); o[2] = pk2(v[4] * sc, v[5] * sc); o[3] = pk2(v[6] * sc, v[7] * sc);
    *(LAS v4u*)dst = o;
}
__device__ __forceinline__ void store16(LAS unsigned char* dst, const float (&v)[16], float sc) {
    v4u o0, o1;
    o0[0] = pk2(v[0] * sc, v[1] * sc); o0[1] = pk2(v[2] * sc, v[3] * sc); o0[2] = pk2(v[4] * sc, v[5] * sc); o0[3] = pk2(v[6] * sc, v[7] * sc);
    o1[0] = pk2(v[8] * sc, v[9] * sc); o1[1] = pk2(v[10] * sc, v[11] * sc); o1[2] = pk2(v[12] * sc, v[13] * sc); o1[3] = pk2(v[14] * sc, v[15] * sc);
    *(LAS v4u*)dst = o0; *(LAS v4u*)(dst + 16) = o1;
}
__device__ __forceinline__ void ssd_table(const float* dtraw  , float bias, float a, int dir, LAS float* tab, int lane) {
    const float d0 = softplus_f(dtraw[(2 * lane) * 12] + bias), d1 = softplus_f(dtraw[(2 * lane + 1) * 12] + bias);
    const float ps = d0 + d1; float x = ps;
    x += dppf<0x111>(x); x += dppf<0x112>(x); x += dppf<0x114>(x); x += dppf<0x118>(x);
    { const float t15 = rdlane(x, 15), t31 = rdlane(x, 31), t47 = rdlane(x, 47); const int rw = lane >> 4;
      x += (rw >= 1 ? t15 : 0.f) + (rw >= 2 ? t31 : 0.f) + (rw >= 3 ? t47 : 0.f); }
    tab[2 * lane] = d0; tab[2 * lane + 1] = d1;
    if (dir == 0) { const float ex = x - ps; tab[128 + 2 * lane] = a * (ex + d0); tab[128 + 2 * lane + 1] = a * (ex + ps); }
    else { const float tot = rdlane(x, 63); const float sx = tot - x; tab[128 + 2 * lane + 1] = a * (sx + d1); tab[128 + 2 * lane] = a * (sx + ps); }
}
__device__ __forceinline__ void ssd_a_unit(Frame& F, int l, int unit) {
    const int tid = F.tid, lane = F.lane, w = F.wave, fr = lane & 15, fq = lane >> 4;
    const int ci = unit >> 1, g = unit & 1, row0 = ci * 128;
    const SeqInfo q = row_seq(row0); const int t0 = row0 - q.start;
    const bf16_t* proj = (const bf16_t*)(F.ws + OFF_PROJ);
    const float* cw = F.in[14] + l * 5 * 640; const float* cb = F.in[15] + l * 640;
    LAS unsigned char* lds = F.lds; LAS float* tabs = (LAS float*)(lds + SSA_TAB);
    if (w < 6) { const int hh = w >> 1, dir = w & 1, h = 3 * g + hh;
        ssd_table((const float*)(F.ws + OFF_DT) + (size_t)row0 * 12 + dir * 6 + h, F.in[16][(l * 2 + dir) * 6 + h], -__expf(F.in[17][(l * 2 + dir) * 6 + h]), dir, tabs + (hh * 4 + dir * 2) * 128, lane); }
    float cv[2][4][8];
#pragma unroll
    for (int k2 = 0; k2 < 2; ++k2) { const int task = tid + k2 * NTHREADS, img = task >> 8, oc = (task >> 5) & 7, tb = task & 31;
        conv4x8(proj, cw, cb, q.start, q.L, t0 + 4 * tb, (img == 0 ? 384 + g * 64 : (3 * g + img - 1) * 64) + 8 * oc, cv[k2]); }
    __syncthreads();
#pragma unroll
    for (int k2 = 0; k2 < 2; ++k2) { const int task = tid + k2 * NTHREADS, img = task >> 8, oc = (task >> 5) & 7, tb = task & 31;
        if (img == 0) {
#pragma unroll
            for (int k = 0; k < 4; ++k) store8(lds + SSA_B + (4 * tb + k) * SS_P + oc * 16, cv[k2][k], 1.f);
        } else { const int hh = img - 1; LAS const float* tb4 = tabs + hh * 4 * 128;
#pragma unroll
            for (int k = 0; k < 4; ++k) { const int t = 4 * tb + k;
                const float wf = __expf(tb4[128 + 127] - tb4[128 + t]) * tb4[t], wb = __expf(tb4[384] - tb4[384 + t]) * tb4[256 + t];
                store8(lds + SSA_X + (2 * hh) * SS_IMG + t * SS_P + oc * 16, cv[k2][k], wf); store8(lds + SSA_X + (2 * hh + 1) * SS_IMG + t * SS_P + oc * 16, cv[k2][k], wb); } }
    }
    __syncthreads();
    const int dir = w >> 2, pb = w & 3;
    for (int hh = 0; hh < 3; ++hh) {
        const int h = 3 * g + hh;
        LAS const unsigned char* xa = lds + SSA_X + (2 * hh + dir) * SS_IMG + (4 * fq + (fr >> 2)) * SS_P + (16 * pb + 4 * (fr & 3)) * 2;
        LAS const unsigned char* ba = lds + SSA_B + (4 * fq + (fr >> 2)) * SS_P + (4 * (fr & 3)) * 2;
        f32x4 acc[4];
#pragma unroll
        for (int nb = 0; nb < 4; ++nb) acc[nb] = (f32x4){0.f, 0.f, 0.f, 0.f};
#pragma unroll
        for (int kk = 0; kk < 4; ++kk) {
            const bf16x8 af = tr2(xa + kk * 32 * SS_P, xa + (kk * 32 + 16) * SS_P);
#pragma unroll
            for (int nb = 0; nb < 4; ++nb) { const bf16x8 bfr = tr2(ba + kk * 32 * SS_P + nb * 32, ba + (kk * 32 + 16) * SS_P + nb * 32); acc[nb] = __builtin_amdgcn_mfma_f32_16x16x32_bf16(af, bfr, acc[nb], 0, 0, 0); }
        }
        float* cs = (float*)(F.ws + OFF_CS) + ((size_t)(ci * 6 + h) * 2 + dir) * 4096;
#pragma unroll
        for (int nb = 0; nb < 4; ++nb)
#pragma unroll
            for (int i = 0; i < 4; ++i) cs[(16 * pb + 4 * fq + i) * 64 + 16 * nb + fr] = acc[nb][i];
        if (tid == 0) { LAS const float* tb = tabs + hh * 4 * 128; float* cd = (float*)(F.ws + OFF_TAB + TAB_CD) + (size_t)(ci * 6 + h) * 2; cd[0] = __expf(tb[128 + 127]); cd[1] = __expf(tb[384]); }
    }
}
__device__ __forceinline__ void ssd_state_pass(Frame& F, int l) {
    const int tid = F.tid, p = tid >> 3, n0 = (tid & 7) * 8;
    const float* cdt = (const float*)(F.ws + OFF_TAB + TAB_CD); const float* csb = (const float*)(F.ws + OFF_CS);
    bf16_t* hin = (bf16_t*)(F.ws + OFF_HIN);
    for (int task = F.vcu; task < NSEQ * 12; task += F.G) {
        int s, hd; if (task < LB * 12) { s = CB + task / 12; hd = task % 12; } else { s = (task - LB * 12) / 12; hd = (task - LB * 12) % 12; }
        const int h = hd >> 1, dir = hd & 1;
        const SeqInfo q = seq_info(s); const int nch = q.L >> 7, ci0 = q.start >> 7;
        f32x4 s0 = {0.f, 0.f, 0.f, 0.f}, s1 = s0;
        if (!q.ctx) { const float* h0 = F.in[4] + ((((size_t)q.b * 4 + l) * 2 + dir) * 6 + h) * 4096 + p * 64 + n0; s0 = *(const f32x4*)h0; s1 = *(const f32x4*)(h0 + 4); }
        for (int k = 0; k < nch; k += 2) {
            size_t ix[2]; float dcy[2]; f32x4 c0[2], c1[2];
#pragma unroll
            for (int u = 0; u < 2; ++u) { const int c = dir == 0 ? k + u : nch - 1 - (k + u); ix[u] = (size_t)((ci0 + c) * 6 + h) * 2 + dir;
                dcy[u] = cdt[ix[u]]; const float* cs = csb + ix[u] * 4096 + p * 64 + n0; c0[u] = *(const f32x4*)cs; c1[u] = *(const f32x4*)(cs + 4); }
#pragma unroll
            for (int u = 0; u < 2; ++u) {
                v4u o; o[0] = pk2(s0[0], s0[1]); o[1] = pk2(s0[2], s0[3]); o[2] = pk2(s1[0], s1[1]); o[3] = pk2(s1[2], s1[3]);
                *(v4u*)(hin + ix[u] * 4096 + p * 64 + n0) = o;
                s0 = s0 * dcy[u] + c0[u]; s1 = s1 * dcy[u] + c1[u];
            }
        }
        if (q.ctx) { float* o4 = F.out + O_SSD + ((((size_t)q.b * 4 + l) * 2 + dir) * 6 + h) * 4096 + p * 64 + n0; *(f32x4*)o4 = s0; *(f32x4*)(o4 + 4) = s1; }
    }
}
__device__ __forceinline__ void ssd_b_unit(Frame& F, int l, int unit) {
    const int tid = F.tid, lane = F.lane, w = F.wave, fr = lane & 15, fq = lane >> 4;
    const int ci = unit >> 1, g = unit & 1, row0 = ci * 128;
    const SeqInfo q = row_seq(row0); const int t0 = row0 - q.start;
    const bf16_t* proj = (const bf16_t*)(F.ws + OFF_PROJ);
    const float* cw = F.in[14] + l * 5 * 640; const float* cb = F.in[15] + l * 640;
    LAS unsigned char* lds = F.lds; LAS float* tabs = (LAS float*)(lds + SSB_TAB);
    if (w < 6) { const int hh = w >> 1, dir = w & 1, h = 3 * g + hh;
        ssd_table((const float*)(F.ws + OFF_DT) + (size_t)row0 * 12 + dir * 6 + h, F.in[16][(l * 2 + dir) * 6 + h], -__expf(F.in[17][(l * 2 + dir) * 6 + h]), dir, tabs + (hh * 4 + dir * 2) * 128, lane); }
    {
        const bf16_t* hin = (const bf16_t*)(F.ws + OFF_HIN) + (size_t)((ci * 6 + 3 * g) * 2) * 4096 + (tid >> 3) * 64 + (tid & 7) * 8;
#pragma unroll
        for (int k = 0; k < 6; ++k) *(LAS v4u*)(lds + SSB_H + k * SS_HIMG + (tid >> 3) * SS_HP + (tid & 7) * 16) = *(const v4u*)(hin + (size_t)k * 4096);
    }
    for (int task = tid; task < 1280; task += NTHREADS) {
        const int img = task >> 8, oc = (task >> 5) & 7, tb = task & 31;
        const int chb = img == 0 ? 384 + g * 64 : (img == 1 ? 512 + g * 64 : (3 * g + img - 2) * 64);
        float v[4][8]; conv4x8(proj, cw, cb, q.start, q.L, t0 + 4 * tb, chb + 8 * oc, v);
        LAS unsigned char* dst = lds + (img == 0 ? SSB_B : (img == 1 ? SSB_C : SSB_X + (img - 2) * SS_IMG)) + (4 * tb) * SS_P + oc * 16;
#pragma unroll
        for (int k = 0; k < 4; ++k) store8(dst + k * SS_P, v[k], 1.f);
    }
    __syncthreads();
    bf16x8 cf[2];
#pragma unroll
    for (int ks = 0; ks < 2; ++ks) cf[ks] = *(LAS const bf16x8*)(lds + SSB_C + (16 * w + fr) * SS_P + (32 * ks + 8 * fq) * 2);
    f32x4 gt[8];
#pragma unroll
    for (int sb = 0; sb < 8; ++sb) { gt[sb] = (f32x4){0.f, 0.f, 0.f, 0.f};
#pragma unroll
        for (int ks = 0; ks < 2; ++ks) { const bf16x8 bfr = *(LAS const bf16x8*)(lds + SSB_B + (16 * sb + fr) * SS_P + (32 * ks + 8 * fq) * 2); gt[sb] = __builtin_amdgcn_mfma_f32_16x16x32_bf16(bfr, cf[ks], gt[sb], 0, 0, 0); } }
    float ss[4] = {0.f, 0.f, 0.f, 0.f};
    bf16_t* yup = (bf16_t*)(F.ws + OFF_MIX) + (size_t)(row0 + 16 * w + 4 * fq) * D + fr;
    for (int hh = 0; hh < 3; ++hh) {
        const int h = 3 * g + hh;
        LAS const float* tb = tabs + hh * 4 * 128;
        unsigned short zv[4][4];
#pragma unroll
        for (int i = 0; i < 4; ++i)
#pragma unroll
            for (int pb = 0; pb < 4; ++pb) zv[i][pb] = proj[(size_t)(row0 + 16 * w + 4 * fq + i) * PN + PZ + h * 64 + 16 * pb + fr];
        const float at = tb[128 + 16 * w + fr], bt = tb[384 + 16 * w + fr];
        f32x4 y[4];
#pragma unroll
        for (int pb = 0; pb < 4; ++pb) y[pb] = (f32x4){0.f, 0.f, 0.f, 0.f};
        LAS const unsigned char* xa = lds + SSB_X + hh * SS_IMG + (4 * fq + (fr >> 2)) * SS_P + (4 * (fr & 3)) * 2;
#pragma unroll
        for (int kk = 0; kk < 4; ++kk) {
            float mv[8];
#pragma unroll
            for (int half = 0; half < 2; ++half) { const int sb = 2 * kk + half; const int s0i = 16 * sb + 4 * fq;
                if (sb < w) { const f32x4 cumf = *(LAS const f32x4*)(tb + 128 + s0i), dtf = *(LAS const f32x4*)(tb + s0i);
#pragma unroll
                    for (int i = 0; i < 4; ++i) mv[half * 4 + i] = __expf(at - cumf[i]) * dtf[i] * gt[sb][i];
                } else if (sb > w) { const f32x4 cumb = *(LAS const f32x4*)(tb + 384 + s0i), dtb = *(LAS const f32x4*)(tb + 256 + s0i);
#pragma unroll
                    for (int i = 0; i < 4; ++i) mv[half * 4 + i] = __expf(bt - cumb[i]) * dtb[i] * gt[sb][i];
                } else { const f32x4 cumf = *(LAS const f32x4*)(tb + 128 + s0i), dtf = *(LAS const f32x4*)(tb + s0i), cumb = *(LAS const f32x4*)(tb + 384 + s0i), dtb = *(LAS const f32x4*)(tb + 256 + s0i);
#pragma unroll
                    for (int i = 0; i < 4; ++i) { const int s = s0i + i, t = 16 * w + fr; float m = 0.f;
                        if (s <= t) m += __expf(at - cumf[i]) * dtf[i];
                        if (s >= t) m += __expf(bt - cumb[i]) * dtb[i];
                        mv[half * 4 + i] = m * gt[sb][i]; } } }
            union { bf16x8 v; unsigned u[4]; } mf; mf.u[0] = pk2(mv[0], mv[1]); mf.u[1] = pk2(mv[2], mv[3]); mf.u[2] = pk2(mv[4], mv[5]); mf.u[3] = pk2(mv[6], mv[7]);
#pragma unroll
            for (int pb = 0; pb < 4; ++pb) { const bf16x8 xf = tr2(xa + kk * 32 * SS_P + pb * 32, xa + (kk * 32 + 16) * SS_P + pb * 32); y[pb] = __builtin_amdgcn_mfma_f32_16x16x32_bf16(mf.v, xf, y[pb], 0, 0, 0); }
        }
        f32x4 yf[4], yb[4];
#pragma unroll
        for (int pb = 0; pb < 4; ++pb) { yf[pb] = (f32x4){0.f, 0.f, 0.f, 0.f}; yb[pb] = yf[pb];
#pragma unroll
            for (int ks = 0; ks < 2; ++ks) {
                const bf16x8 hf = *(LAS const bf16x8*)(lds + SSB_H + (2 * hh) * SS_HIMG + (16 * pb + fr) * SS_HP + (32 * ks + 8 * fq) * 2);
                const bf16x8 hb = *(LAS const bf16x8*)(lds + SSB_H + (2 * hh + 1) * SS_HIMG + (16 * pb + fr) * SS_HP + (32 * ks + 8 * fq) * 2);
                yf[pb] = __builtin_amdgcn_mfma_f32_16x16x32_bf16(cf[ks], hf, yf[pb], 0, 0, 0);
                yb[pb] = __builtin_amdgcn_mfma_f32_16x16x32_bf16(cf[ks], hb, yb[pb], 0, 0, 0); } }
        const float dsk = F.in[18][l * 6 + h];
        float nwv[4];
#pragma unroll
        for (int pb = 0; pb < 4; ++pb) nwv[pb] = F.in[19][l * 384 + h * 64 + 16 * pb + fr];
        const f32x4 cumf4 = *(LAS const f32x4*)(tb + 128 + 16 * w + 4 * fq), cumb4 = *(LAS const f32x4*)(tb + 384 + 16 * w + 4 * fq);
#pragma unroll
        for (int i = 0; i < 4; ++i) { const float ef = __expf(cumf4[i]), eb = __expf(cumb4[i]); const int tl = 16 * w + 4 * fq + i;
#pragma unroll
            for (int pb = 0; pb < 4; ++pb) { const float xv = bf2f(*(LAS const bf16_t*)(lds + SSB_X + hh * SS_IMG + tl * SS_P + (16 * pb + fr) * 2));
                const float yv = y[pb][i] + ef * yf[pb][i] + eb * yb[pb][i] + dsk * xv;
                const float gv = yv * silu_f(bf2f(zv[i][pb])); ss[i] += gv * gv;
                yup[(size_t)i * D + h * 64 + 16 * pb] = f2bf(gv * nwv[pb]); } }
    }
#pragma unroll
    for (int i = 0; i < 4; ++i) { const float v = row16_sum(ss[i]);
        if (fr == 0) ((float*)(F.ws + OFF_TAB + TAB_SSQ))[(size_t)(row0 + 16 * w + 4 * fq + i) * 2 + g] = v; }
}
__device__ __forceinline__ void ssd_norm_panel(Frame& F, int l, int pm) {
    const float* nw = F.in[19] + l * 384; const float* ssq = (const float*)(F.ws + OFF_TAB + TAB_SSQ);
    const bf16_t* yu = (const bf16_t*)(F.ws + OFF_YU); bf16_t* mix = (bf16_t*)(F.ws + OFF_MIX);
    for (int i = F.tid; i < 256 * 48; i += NTHREADS) {
        const int row = pm * 256 + i / 48, c0 = (i % 48) * 8;
        const float rstd = rsqrtf((ssq[(size_t)row * 2] + ssq[(size_t)row * 2 + 1]) * (1.f / 384.f) + EPS);
        const v4u v = *(const v4u*)(yu + (size_t)row * 384 + c0); const f32x4 w0 = *(const f32x4*)(nw + c0), w1 = *(const f32x4*)(nw + c0 + 4);
        v4u o;
        o[0] = pk2(__uint_as_float(v[0] << 16) * rstd * w0[0], __uint_as_float(v[0] & 0xffff0000u) * rstd * w0[1]); o[1] = pk2(__uint_as_float(v[1] << 16) * rstd * w0[2], __uint_as_float(v[1] & 0xffff0000u) * rstd * w0[3]);
        o[2] = pk2(__uint_as_float(v[2] << 16) * rstd * w1[0], __uint_as_float(v[2] & 0xffff0000u) * rstd * w1[1]); o[3] = pk2(__uint_as_float(v[3] << 16) * rstd * w1[2], __uint_as_float(v[3] & 0xffff0000u) * rstd * w1[3]);
        *(v4u*)(mix + (size_t)row * D + c0) = o;
    }
    asm volatile("s_waitcnt vmcnt(0)" ::: "memory");
    __syncthreads();
}

constexpr int S5_HP = 272;
constexpr int S5_IMG = 64 * S5_HP;
constexpr int S5_GP = 528, S5_G = 4 * S5_IMG, S5_END = S5_G + 64 * S5_GP;
typedef float f32x16 __attribute__((ext_vector_type(16)));
typedef float f32x8 __attribute__((ext_vector_type(8)));
__device__ __forceinline__ float swap32sel(float x, int odd) {
    const auto r = __builtin_amdgcn_permlane32_swap(__float_as_uint(x), __float_as_uint(x), false, false);
    return __uint_as_float(odd ? r[1] : r[0]);
}
template <int DIR, bool FULL>
__device__ __forceinline__ void s5_dir(Frame& F, int l, int g, int p, int hi, const bf16x8 (&uf)[2], float& cr, float& ci, f32x16 (&hr)[2], f32x16 (&hq)[2]) {
    const float* ab = (const float*)(F.ws + OFF_TAB + TAB_ABAR) + (size_t)((((l * 2 + DIR) * 16 + g) * 64) + p) * 2;
    const float ar = ab[0], ai = ab[1];
    const float a2r = ar * ar - ai * ai, a2i = 2.f * ar * ai, a3r = a2r * ar - a2i * ai, a3i = a2r * ai + a2i * ar, a4r = a2r * a2r - a2i * a2i, a4i = 2.f * a2r * a2i;
    const bf16_t* bbt = (const bf16_t*)(F.ws + OFF_TAB + TAB_BBT) + ((size_t)(((l * 2 + DIR) * 16 + g) * 2) * 64 + p) * 16 + 8 * hi;
    const bf16x8 bre = *(const bf16x8*)bbt, bim = *(const bf16x8*)(bbt + 64 * 16);
    f32x16 xr[2], xi[2];
#pragma unroll
    for (int rb = 0; rb < 2; ++rb) {
        const f32x16 z = {0.f, 0.f, 0.f, 0.f, 0.f, 0.f, 0.f, 0.f, 0.f, 0.f, 0.f, 0.f, 0.f, 0.f, 0.f, 0.f};
        xr[rb] = __builtin_amdgcn_mfma_f32_32x32x16_bf16(uf[rb], bre, z, 0, 0, 0); xi[rb] = __builtin_amdgcn_mfma_f32_32x32x16_bf16(uf[rb], bim, z, 0, 0, 0);
    }
#pragma unroll
    for (int rb = 0; rb < 2; ++rb)
#pragma unroll
        for (int G4 = 0; G4 < 4; ++G4) {
            if (DIR == 0) {
#pragma unroll
                for (int e = 1; e < 4; ++e) { const int i = 4 * G4 + e; const float pr = xr[rb][i - 1], pi = xi[rb][i - 1]; xr[rb][i] += ar * pr - ai * pi; xi[rb][i] += ar * pi + ai * pr; }
            } else {
#pragma unroll
                for (int e = 2; e >= 0; --e) { const int i = 4 * G4 + e; const float pr = xr[rb][i + 1], pi = xi[rb][i + 1]; xr[rb][i] += ar * pr - ai * pi; xi[rb][i] += ar * pi + ai * pr; }
            }
        }
    f32x8 cinr = {0.f, 0.f, 0.f, 0.f, 0.f, 0.f, 0.f, 0.f}, cini = cinr;
#pragma unroll
    for (int kk = 0; kk < 16; ++kk) {
        const int k = DIR == 0 ? kk : 15 - kk, gi = k >> 1, rb = gi >> 2, il = 4 * (gi & 3) + (DIR == 0 ? 3 : 0), odd = k & 1;
        const bool first = DIR == 0 ? !odd : odd;
        if (first) { cinr[gi] = cr; cini[gi] = ci; } else { const bool own = (hi == odd); cinr[gi] = own ? cr : cinr[gi]; cini[gi] = own ? ci : cini[gi]; }
        const float nr = a4r * cr - a4i * ci + xr[rb][il], ni = a4r * ci + a4i * cr + xi[rb][il];
        cr = swap32sel(nr, odd); ci = swap32sel(ni, odd);
    }
    if (FULL) {
#pragma unroll
        for (int rb = 0; rb < 2; ++rb)
#pragma unroll
            for (int G4 = 0; G4 < 4; ++G4) {
                const int gi = rb * 4 + G4;
#pragma unroll
                for (int e = 0; e < 4; ++e) {
                    const int i = 4 * G4 + e, pw = DIR == 0 ? e + 1 : 4 - e;
                    const float pr = pw == 1 ? ar : (pw == 2 ? a2r : (pw == 3 ? a3r : a4r)), pi = pw == 1 ? ai : (pw == 2 ? a2i : (pw == 3 ? a3i : a4i));
                    hr[rb][i] += xr[rb][i] + pr * cinr[gi] - pi * cini[gi];
                    hq[rb][i] += xi[rb][i] + pr * cini[gi] + pi * cinr[gi];
                }
            }
    }
}
template <bool FULL>
__device__ __forceinline__ void s5_wave_unit(Frame& F, int l, int row0, int g, int ph, float& cfr, float& cfi, float& cbr, float& cbi, LAS unsigned char* himg) {
    const int lane = F.lane, r32 = lane & 31, hi = lane >> 5, p = 32 * ph + r32;
    const bf16_t* proj = (const bf16_t*)(F.ws + OFF_PROJ);
    bf16x8 uf[2];
#pragma unroll
    for (int rb = 0; rb < 2; ++rb) uf[rb] = *(const bf16x8*)(proj + (size_t)(row0 + 32 * rb + r32) * PN + PU + g * 16 + 8 * hi);
    f32x16 hr[2], hq[2];
#pragma unroll
    for (int rb = 0; rb < 2; ++rb) { hr[rb] = (f32x16){0.f, 0.f, 0.f, 0.f, 0.f, 0.f, 0.f, 0.f, 0.f, 0.f, 0.f, 0.f, 0.f, 0.f, 0.f, 0.f}; hq[rb] = hr[rb]; }
    s5_dir<0, FULL>(F, l, g, p, hi, uf, cfr, cfi, hr, hq);
    s5_dir<1, FULL>(F, l, g, p, hi, uf, cbr, cbi, hr, hq);
    if (FULL) {
#pragma unroll
        for (int rb = 0; rb < 2; ++rb)
#pragma unroll
            for (int i = 0; i < 16; ++i) { const int t = 32 * rb + 8 * (i >> 2) + 4 * hi + (i & 3);
                LAS bf16_t* d = (LAS bf16_t*)(himg + t * S5_HP) + p;
                const unsigned pk = pk2(hr[rb][i], hq[rb][i]); d[0] = (bf16_t)(pk & 0xffffu); d[64] = (bf16_t)(pk >> 16); }
    }
}
__device__ __forceinline__ void cpow64(float ar, float ai, float& or_, float& oi_) {
#pragma unroll
    for (int s = 0; s < 6; ++s) { const float nr = ar * ar - ai * ai, ni = 2.f * ar * ai; ar = nr; ai = ni; }
    or_ = ar; oi_ = ai;
}
__device__ __forceinline__ void s5_a_unit(Frame& F, int l, int cj) {
    const int w = F.wave, lane = F.lane, row0 = cj * 64;
    float* E = (float*)(F.ws + OFF_E);
    for (int it = w; it < 32; it += NWAVES) {
        const int g = it >> 1, ph = it & 1;
        float cfr = 0.f, cfi = 0.f, cbr = 0.f, cbi = 0.f;
        s5_wave_unit<false>(F, l, row0, g, ph, cfr, cfi, cbr, cbi, F.lds);
        if (lane < 32) { float2 v; v.x = cfr; v.y = cfi; *(float2*)(E + ((size_t)((cj * 2 + 0) * 16 + g) * 64 + 32 * ph + lane) * 2) = v;
                         v.x = cbr; v.y = cbi; *(float2*)(E + ((size_t)((cj * 2 + 1) * 16 + g) * 64 + 32 * ph + lane) * 2) = v; }
    }
}
__device__ __forceinline__ void s5_b_unit(Frame& F, int l, int cj) {
    const int w = F.wave, row0 = cj * 64;
    const SeqInfo q = row_seq(row0); const int j = (row0 - q.start) >> 6, nj = q.L >> 6, cj0 = cj - j;
    const bf16_t* proj = (const bf16_t*)(F.ws + OFF_PROJ);
    const float* E = (const float*)(F.ws + OFF_E);
    LAS unsigned char* lds = F.lds;
    for (int gi4 = 0; gi4 < 4; ++gi4) {
        bf16x8 ccf[2][4]; unsigned short uval[2][4]; float dskv[2];
        { int lnp = F.tid; asm volatile("" : "+v"(lnp)); lnp &= 63; const int fr = lnp & 15, fq = lnp >> 4;
#pragma unroll
          for (int tk = 0; tk < 2; ++tk) { const int task = 2 * w + tk, gsel = task >> 2, tb = task & 3, g = 4 * gi4 + gsel;
            const bf16_t* cc = (const bf16_t*)(F.ws + OFF_TAB + TAB_CC1) + ((size_t)(l * 16 + g) * 16 + fr) * 128 + 8 * fq;
#pragma unroll
            for (int ks = 0; ks < 4; ++ks) ccf[tk][ks] = *(const bf16x8*)(cc + ks * 32);
#pragma unroll
            for (int i = 0; i < 4; ++i) uval[tk][i] = proj[(size_t)(row0 + 16 * tb + 4 * fq + i) * PN + PU + g * 16 + fr];
            dskv[tk] = F.in[27][l * 256 + g * 16 + fr]; } }
        {
            { int t_ = F.tid; asm volatile("" : "+v"(t_)); F.tid = t_; F.lane = t_ & 63; }
            const int lane = F.lane; const int g = 4 * gi4 + (w >> 1), ph = w & 1, p = 32 * ph + (lane & 31);
            const float* h5 = (const float*)(F.ws + OFF_H5);
            const float2 hf = *(const float2*)(h5 + ((size_t)((cj * 2 + 0) * 16 + g) * 64 + p) * 2), hb = *(const float2*)(h5 + ((size_t)((cj * 2 + 1) * 16 + g) * 64 + p) * 2);
            float cr[2] = {hf.x, hb.x}, ci[2] = {hf.y, hb.y};
            s5_wave_unit<true>(F, l, row0, g, ph, cr[0], ci[0], cr[1], ci[1], lds + (w >> 1) * S5_IMG);
        }
        __syncthreads();
        int ln2 = F.tid; asm volatile("" : "+v"(ln2)); ln2 &= 63; const int fr = ln2 & 15, fq = ln2 >> 4;
#pragma unroll
        for (int tk = 0; tk < 2; ++tk) {
            const int task = 2 * w + tk, gsel = task >> 2, tb = task & 3, g = 4 * gi4 + gsel;
            LAS const unsigned char* hrow = lds + gsel * S5_IMG + (16 * tb + fr) * S5_HP + 16 * fq;
            f32x4 y = {0.f, 0.f, 0.f, 0.f};
#pragma unroll
            for (int ks = 0; ks < 4; ++ks) { const bf16x8 a = *(LAS const bf16x8*)(hrow + ks * 64); y = __builtin_amdgcn_mfma_f32_16x16x32_bf16(a, ccf[tk][ks], y, 0, 0, 0); }
#pragma unroll
            for (int i = 0; i < 4; ++i) { const int t = 16 * tb + 4 * fq + i;
                *((LAS bf16_t*)(lds + S5_G + t * S5_GP) + g * 16 + fr) = f2bf(gelu_tanh_f(y[i] + dskv[tk] * bf2f(uval[tk][i]))); }
        }
        __syncthreads();
    }
    {
        int ln3 = F.tid; asm volatile("" : "+v"(ln3)); ln3 &= 63; const int fr = ln3 & 15, fq = ln3 >> 4;
        f32x4 acc[2][4];
#pragma unroll
        for (int a = 0; a < 2; ++a)
#pragma unroll
            for (int tb = 0; tb < 4; ++tb) acc[a][tb] = (f32x4){0.f, 0.f, 0.f, 0.f};
        const bf16_t* wg = (const bf16_t*)(F.ws + OFF_WGLU) + (size_t)l * 65536 + (size_t)(32 * w + fr) * 256 + 8 * fq;
#pragma unroll
        for (int ks = 0; ks < 8; ++ks) {
            const bf16x8 b0 = *(const bf16x8*)(wg + ks * 32), b1 = *(const bf16x8*)(wg + 16 * 256 + ks * 32);
#pragma unroll
            for (int tb = 0; tb < 4; ++tb) { const bf16x8 a = *(LAS const bf16x8*)(lds + S5_G + (16 * tb + fr) * S5_GP + ks * 64 + 16 * fq);
                acc[0][tb] = __builtin_amdgcn_mfma_f32_16x16x32_bf16(a, b0, acc[0][tb], 0, 0, 0); acc[1][tb] = __builtin_amdgcn_mfma_f32_16x16x32_bf16(a, b1, acc[1][tb], 0, 0, 0); }
        }
#pragma unroll
        for (int a = 0; a < 2; ++a) { const int n = 32 * w + 16 * a + fr; const float bg = F.in[29][l * 256 + n];
#pragma unroll
            for (int tb = 0; tb < 4; ++tb)
#pragma unroll
                for (int i = 0; i < 4; ++i) { const int t = 16 * tb + 4 * fq + i; const float gv = bf2f(*((LAS const bf16_t*)(lds + S5_G + t * S5_GP) + n));
                    ((bf16_t*)(F.ws + OFF_MIX))[(size_t)(row0 + t) * D + 384 + n] = f2bf(gv * sigmoid_f(acc[a][tb][i] + bg)); } }
    }
}

__device__ __forceinline__ void s5_state_pass(Frame& F, int l) {
    const float* E = (const float*)(F.ws + OFF_E); float* H5 = (float*)(F.ws + OFF_H5);
    for (int idx = F.vcu * NTHREADS + F.tid; idx < NSEQ * 2048; idx += F.G * NTHREADS) {
        const int p = idx & 63, g = (idx >> 6) & 15, dir = (idx >> 10) & 1, sq = idx >> 11;
        const int s_ = sq < LB ? CB + sq : sq - LB;
        const SeqInfo q = seq_info(s_); const int nj = q.L >> 6, cj0 = q.start >> 6;
        const float* ab = (const float*)(F.ws + OFF_TAB + TAB_ABAR) + (size_t)((((l * 2 + dir) * 16 + g) * 64) + p) * 2;
        float a64r, a64i; cpow64(ab[0], ab[1], a64r, a64i);
        float cr = 0.f, ci = 0.f;
        if (!q.ctx) { const size_t o = (((size_t)q.b * 4 + l) * 2 + dir) * 1024 + g * 64 + p; cr = F.in[5][o]; ci = F.in[6][o]; }
        for (int k = 0; k < nj; k += 4) {
            float2 e[4];
#pragma unroll
            for (int u = 0; u < 4; ++u) { const int jj = dir == 0 ? k + u : nj - 1 - (k + u); e[u] = *(const float2*)(E + ((size_t)(((cj0 + jj) * 2 + dir) * 16 + g) * 64 + p) * 2); }
#pragma unroll
            for (int u = 0; u < 4; ++u) { const int jj = dir == 0 ? k + u : nj - 1 - (k + u);
                float2 hv; hv.x = cr; hv.y = ci; *(float2*)(H5 + ((size_t)(((cj0 + jj) * 2 + dir) * 16 + g) * 64 + p) * 2) = hv;
                const float nr = a64r * cr - a64i * ci + e[u].x, ni = a64r * ci + a64i * cr + e[u].y; cr = nr; ci = ni; }
        }
        if (q.ctx) { const size_t o = (((size_t)q.b * 4 + l) * 2 + dir) * 1024 + g * 64 + p; F.out[O_RE + o] = cr; F.out[O_IM + o] = ci; }
    }
}
__device__ __forceinline__ void phase_mixa(Frame& F, int l) {
    unsigned* ctr = F.ctl + CW_Q + 64 * (l * 8);
    for (;;) { const int u = queue_next(F, ctr); if (u >= 192) break; attn_unit(F, l, u); }
    for (;;) { const int u = queue_next(F, ctr + 64); if (u >= 256) break; ssd_a_unit(F, l, u); }
    for (;;) { const int u = queue_next(F, ctr + 128); if (u >= 192) break; attn_unit(F, l, 192 + u); }
    for (;;) { const int u = queue_next(F, ctr + 192); if (u >= 256) break; s5_a_unit(F, l, u); }
    if (l + 1 < DEPTH) for (;;) { const int u = queue_next(F, F.ctl + CW_Q + 64 * (52 + l)); if (u >= 104) break; bias_task(F, l + 1, u); }
}
__device__ __forceinline__ void phase_mixb(Frame& F, int l) {
    unsigned* ctr = F.ctl + CW_Q + 64 * (l * 8 + 4);
    for (;;) { const int u = queue_next(F, ctr); if (u >= 256) break; s5_b_unit(F, l, u); }
    for (;;) { const int u = queue_next(F, ctr + 64); if (u >= 256) break; ssd_b_unit(F, l, u); }
}

struct Args { const float* in[35]; float* out; unsigned char* ws; int ph_lo, ph_hi, li, pad; };
#ifdef MK_PHASE_RANGE
#define IN(k) (lo <= (k) && (k) < hi)
#else
#define IN(k) true
#endif
#define REFRESH() do { int t_ = F.wave * 64 + lane_id(); asm volatile("" : "+v"(t_)); F.tid = t_; F.lane = t_ & 63; \
        unsigned char* w_ = args.ws; asm volatile("" : "+s"(w_)); F.ws = w_; F.ctl = (unsigned*)(w_ + OFF_CTL); float* o_ = args.out; asm volatile("" : "+s"(o_)); F.out = o_; \
        const float* const* i_ = (const float* const*)__builtin_amdgcn_kernarg_segment_ptr(); asm volatile("" : "+s"(i_)); F.in = i_; \
        int g_ = gridDim.x, v_ = vcu0; asm volatile("" : "+s"(g_), "+s"(v_)); F.G = g_; F.vcu = v_; modsb = (const float*)(F.ws + OFF_MODS); XB = (bf16_t*)(F.ws + OFF_X); } while (0)
#define SEAM(k) do { if (IN(k) && IN((k) + 1) && (k) + 1 < PH_END) xcd_barrier(bar, F.wave == 0 && lane_id() == 0); } while (0)
template <int l>
__device__ __forceinline__ void layer_body(Frame& F, const Args& args, const XcdBarrier& bar, const int vcu0) {
    const int lo = args.ph_lo, hi = args.ph_hi; (void)lo; (void)hi;
    const float* modsb = (const float*)(F.ws + OFF_MODS);
    bf16_t* XB = (bf16_t*)(F.ws + OFF_X);
        const int pb = PH_L0 + l * PH_PER_LAYER;
        if (IN(pb + PH_G1)) { REFRESH();
            pg8::Gemm g{(const bf16_t*)(F.ws + OFF_H), (const bf16_t*)(F.ws + OFF_WIN) + (size_t)l * PNP * 1024, M, PNP, 1024}; pg8::StaticOrder S; S.init(M, PNP, F.G, (int)blockIdx.x);
            epi_side_fill(F, S, (const float*)(F.ws + OFF_TAB + TAB_SQ1), (const float*)(F.ws + OFF_TAB + TAB_B1) + (size_t)l * 9 * PNP, PNP);
            pg8::EpiProj E{(bf16_t*)(F.ws + OFF_PROJ), F.out + O_K, F.out + O_V, (float*)(F.ws + OFF_DT), (LAS const float*)(F.lds + EPI_SIDE_OFF), l, 0};
            pg8::gemm_phase<pg8::EpiProj, pg8::StaticOrder, true, true>(F.lds, g, S, E, F.wave);
            if (l + 1 < DEPTH) { REFRESH(); transpose_layer_queue(F, l + 1, F.ctl + CW_Q + 64 * (48 + l)); }
        }
        SEAM(pb + PH_G1);
        if (IN(pb + PH_MIXA)) { REFRESH(); phase_mixa(F, l); }
        SEAM(pb + PH_MIXA);
        if (IN(pb + PH_MIXB)) { REFRESH(); ssd_state_pass(F, l); s5_state_pass(F, l); xcd_barrier(bar, F.wave == 0 && lane_id() == 0); REFRESH(); phase_mixb(F, l); }
        SEAM(pb + PH_MIXB);
        if (IN(pb + PH_G3)) { REFRESH();
            pg8::Gemm g{(const bf16_t*)(F.ws + OFF_MIX), (const bf16_t*)(F.ws + OFF_WOUT) + (size_t)l * 1024 * 1024, M, D, 1024}; pg8::StaticOrder S; S.init(M, D, F.G, (int)blockIdx.x);
            { pg8::Unit u; if (S.next(0, u) && F.tid < 256) { const float* q2 = (const float*)(F.ws + OFF_TAB + TAB_SSQ) + (size_t)(u.pm * 256 + F.tid) * 2;
                ((LAS float*)(F.lds + EPI_SIDE_OFF))[F.tid] = rsqrtf((q2[0] + q2[1]) * (1.f / 384.f) + EPS); } __syncthreads(); }
            typedef pg8::EpiRes<6, l == 0> Epi3;
            Epi3 E{l == 0 ? (const void*)F.in[0] : (const void*)XB, l == 0 ? (const void*)(F.in[1] - (size_t)MC * D) : (const void*)XB, XB, modsb + (size_t)l * 9 * 6144 + 2 * 1024, F.in[12] + l * D, modsb + (size_t)l * 9 * 6144 + 4 * 1024,
                   (bf16_t*)(F.ws + OFF_H), (float*)(F.ws + OFF_TAB + TAB_SQ2), (LAS const float*)(F.lds + EPI_SIDE_OFF)};
            pg8::gemm_phase<Epi3, pg8::StaticOrder, true, true>(F.lds, g, S, E, F.wave);
        }
        SEAM(pb + PH_G3);
        if (IN(pb + PH_G4)) { REFRESH();
            pg8::Gemm g{(const bf16_t*)(F.ws + OFF_H), (const bf16_t*)(F.ws + OFF_WFF1) + (size_t)l * DFF * 1024, M, DFF, 1024}; pg8::StaticOrder S; S.init(M, DFF, F.G, (int)blockIdx.x);
            epi_side_fill(F, S, (const float*)(F.ws + OFF_TAB + TAB_SQ2), (const float*)(F.ws + OFF_TAB + TAB_B2) + (size_t)l * 9 * DFF, DFF);
            pg8::EpiFF1 E{(bf16_t*)(F.ws + OFF_FFH), (LAS const float*)(F.lds + EPI_SIDE_OFF), 0};
            pg8::gemm_phase<pg8::EpiFF1, pg8::StaticOrder, true, true>(F.lds, g, S, E, F.wave);
        }
        SEAM(pb + PH_G4);
        if (IN(pb + PH_G5)) { REFRESH();
            pg8::Gemm g{(const bf16_t*)(F.ws + OFF_FFH), (const bf16_t*)(F.ws + OFF_WFF2) + (size_t)l * 1024 * DFF, M, D, DFF}; pg8::StaticOrder S; S.init(M, D, F.G, (int)blockIdx.x);
            const int ln = l + 1 < DEPTH ? l + 1 : l;
            typedef pg8::EpiRes<0, false> Epi5;
            Epi5 E{(const void*)XB, (const void*)XB, XB, modsb + (size_t)l * 9 * 6144 + 5 * 1024, F.in[11] + ln * D, modsb + (size_t)ln * 9 * 6144 + 1 * 1024,
                   l + 1 < DEPTH ? (bf16_t*)(F.ws + OFF_H) : (bf16_t*)nullptr, (float*)(F.ws + OFF_TAB + TAB_SQ1), (LAS const float*)(F.lds + EPI_SIDE_OFF)};
            pg8::gemm_phase<Epi5, pg8::StaticOrder, true, true>(F.lds, g, S, E, F.wave);
        }
        SEAM(pb + PH_G5);
    }
__global__ void __launch_bounds__(NTHREADS, 2) mega(Args args) {
    extern __shared__ __attribute__((aligned(16))) unsigned char lds[];
    Frame F;
    F.lds = (LAS unsigned char*)lds;
    F.MISC = (volatile LAS unsigned*)(F.lds + MISC_OFF);
    F.tid = threadIdx.x; F.lane = F.tid & 63; F.wave = __builtin_amdgcn_readfirstlane(F.tid >> 6);
    F.G = gridDim.x; { const int bx = blockIdx.x; F.vcu = (F.G % 8 == 0) ? (bx % 8) * (F.G / 8) + bx / 8 : bx; }
    { const float* const* inp = (const float* const*)__builtin_amdgcn_kernarg_segment_ptr(); asm volatile("" : "+s"(inp)); F.in = inp; }
    F.out = args.out; F.ws = args.ws; F.ctl = (unsigned*)(args.ws + OFF_CTL);
    for (int u = F.tid; u < (LDS_BYTES - LDSCTL_OFF) / 4; u += NTHREADS) ((LAS unsigned*)(F.lds + LDSCTL_OFF))[u] = 0u;
    __syncthreads();
    XcdBarrier bar = xcd_barrier_post(F.ctl + CW_BAR + args.li * XCD_BAR_WORDS, F.MISC + 8);
    const int lo = args.ph_lo, hi = args.ph_hi; (void)lo; (void)hi;
    const float* modsb = (const float*)(F.ws + OFF_MODS);
    bf16_t* XB = (bf16_t*)(F.ws + OFF_X);
    const int vcu0 = F.vcu;
    if (IN(PH_PRO)) phase_prologue(F);
    SEAM(PH_PRO);
    if (IN(PH_PRE)) { REFRESH(); phase_pre(F); }
    SEAM(PH_PRE);
    layer_body<0>(F, args, bar, vcu0); layer_body<1>(F, args, bar, vcu0); layer_body<2>(F, args, bar, vcu0); layer_body<3>(F, args, bar, vcu0);
    if (IN(PH_FINAL)) phase_final(F);
#undef IN
#undef SEAM
}
static void launch_mega(const Args& base, int lo, int hi, int li, hipStream_t stream) {
    Args a = base; a.ph_lo = lo; a.ph_hi = hi; a.li = li;
    hipLaunchKernelGGL(mega, dim3(256), dim3(NTHREADS), LDS_BYTES, stream, a);
}
extern "C" void kernel_launch(void* const* d_in, const int* in_sizes, int n_in, void* d_out, int out_size, void* d_ws, size_t ws_size, hipStream_t stream) {
    static int ready = 0;
    if (!ready) {
        if (n_in != 35 || out_size != (int)O_END || ws_size < WS_END) { fprintf(stderr, "kernel_launch: unexpected shapes n_in %d out %d ws %zu\n", n_in, out_size, ws_size); ready = -1; return; }
        if (hipFuncSetAttribute((const void*)mega, hipFuncAttributeMaxDynamicSharedMemorySize, LDS_BYTES) != hipSuccess) { fprintf(stderr, "kernel_launch: hipFuncSetAttribute failed\n"); ready = -1; return; }
        ready = 1;
    }
    if (ready < 0) return;
    Args a{}; for (int i = 0; i < 35; ++i) a.in[i] = (const float*)d_in[i]; a.out = (float*)d_out; a.ws = (unsigned char*)d_ws;
    (void)hipMemsetAsync((char*)d_ws + OFF_CTL, 0, CTL_ZERO_BYTES, stream);
    launch_mega(a, 0, PH_END, 0, stream);
}
```

```cpp
#include <hip/hip_runtime.h>
#include <stdint.h>
#include <stdio.h>

typedef unsigned short bf16_t;
typedef short bf16x8 __attribute__((ext_vector_type(8)));
typedef float f32x4 __attribute__((ext_vector_type(4)));

constexpr int D = 1024, DEPTH = 4;
constexpr int CB = 32, CL = 256, LB = 8, LL = 1024;
constexpr int MC = CB * CL;
constexpr int M = MC + LB * LL;
constexpr int NSEQ = CB + LB;
constexpr int IN_COLS = 2444;
constexpr int PN = 2432, PNP = 2560;
constexpr int PZ = 0, PX = 384, PU = 1024, PQ = 1280, PK = 1664, PV = 2048;
constexpr int DFF = 4096;
constexpr float EPS = 1e-6f;

constexpr size_t MiB = 1u << 20;
constexpr size_t OFF_CTL = 0, OFF_MODS = 1 * MiB, OFF_TAB = 2 * MiB, OFF_WIN = 8 * MiB, OFF_WOUT = 28 * MiB, OFF_WFF1 = 36 * MiB,
                 OFF_WFF2 = 68 * MiB, OFF_WGLU = 100 * MiB, OFF_DT = 101 * MiB, OFF_X = 102 * MiB, OFF_PROJ = 166 * MiB, OFF_MIX = 242 * MiB,
                 OFF_FFH = 166 * MiB, OFF_H = 294 * MiB, WS_END = 374 * MiB;
constexpr size_t TAB_ABAR = 0;
constexpr size_t TAB_SQ1 = 256 * 1024;
constexpr size_t TAB_SQ2 = 1280 * 1024;
constexpr size_t TAB_B1 = 2304 * 1024;
constexpr size_t TAB_B2 = 4352 * 1024;
constexpr size_t TAB_SSQ = 5 * MiB;
constexpr size_t OFF_TK = 146 * MiB;
constexpr size_t OFF_PT64 = 150 * MiB;
constexpr size_t OFF_BB32 = 162 * MiB;
constexpr size_t OFF_CK = 134 * MiB, OFF_CV = 140 * MiB;
constexpr size_t OFF_H5 = 326 * MiB;
constexpr size_t OFF_HIN = 362 * MiB;
constexpr size_t TAB_CD = 3 * MiB;
constexpr size_t OFF_CS = 334 * MiB;
constexpr size_t TAB_CC1 = 4 * MiB;
constexpr size_t TAB_BBT = 3 * MiB + 512 * 1024;
constexpr size_t OFF_E = 358 * MiB;

__device__ __forceinline__ int lane_id() { unsigned z = 0u; asm volatile("" : "+v"(z)); return (int)__builtin_amdgcn_mbcnt_hi(~0u, __builtin_amdgcn_mbcnt_lo(~0u, z)); }
__device__ __forceinline__ float bf2f(bf16_t v) { return __uint_as_float((unsigned)v << 16); }
typedef float f32x2_t __attribute__((ext_vector_type(2))); typedef __bf16 bf16x2_t __attribute__((ext_vector_type(2)));
__device__ __forceinline__ unsigned cvtpk(float lo, float hi) { f32x2_t v = {lo, hi}; bf16x2_t b = __builtin_convertvector(v, bf16x2_t); return __builtin_bit_cast(unsigned, b); }
__device__ __forceinline__ bf16_t f2bf(float f) { return (bf16_t)(cvtpk(f, f) & 0xffffu); }
__device__ __forceinline__ float sigmoid_f(float x) { return __builtin_amdgcn_rcpf(1.f + __expf(-x)); }
__device__ __forceinline__ float silu_f(float x) { return x * sigmoid_f(x); }
__device__ __forceinline__ float softplus_f(float x) { return x > 20.f ? x : log1pf(__expf(x)); }
__device__ __forceinline__ float gelu_tanh_f(float x) { const float u = 1.5957691216057308f * (x + 0.044715f * x * x * x); return x * sigmoid_f(u); }
template <int CTRL> __device__ __forceinline__ float dppf(float x) { return __uint_as_float((unsigned)__builtin_amdgcn_update_dpp(0, (int)__float_as_uint(x), CTRL, 0xf, 0xf, true)); }
__device__ __forceinline__ float row16_sum(float x) { x += dppf<0xB1>(x); x += dppf<0x4E>(x); x += dppf<0x141>(x); x += dppf<0x140>(x); return x; }
__device__ __forceinline__ float row16_max(float x) { x = fmaxf(x, dppf<0xB1>(x)); x = fmaxf(x, dppf<0x4E>(x)); x = fmaxf(x, dppf<0x141>(x)); x = fmaxf(x, dppf<0x140>(x)); return x; }
__device__ __forceinline__ float xsum16(float x) { const auto r = __builtin_amdgcn_permlane16_swap(__float_as_uint(x), __float_as_uint(x), false, false); return __uint_as_float(r[0]) + __uint_as_float(r[1]); }
__device__ __forceinline__ float xsum32(float x) { const auto r = __builtin_amdgcn_permlane32_swap(__float_as_uint(x), __float_as_uint(x), false, false); return __uint_as_float(r[0]) + __uint_as_float(r[1]); }
__device__ __forceinline__ float xmax16(float x) { const auto r = __builtin_amdgcn_permlane16_swap(__float_as_uint(x), __float_as_uint(x), false, false); return fmaxf(__uint_as_float(r[0]), __uint_as_float(r[1])); }
__device__ __forceinline__ float xmax32(float x) { const auto r = __builtin_amdgcn_permlane32_swap(__float_as_uint(x), __float_as_uint(x), false, false); return fmaxf(__uint_as_float(r[0]), __uint_as_float(r[1])); }
__device__ __forceinline__ float rdlane(float x, int l) { return __uint_as_float((unsigned)__builtin_amdgcn_readlane((int)__float_as_uint(x), l)); }
__device__ __forceinline__ float wave_sum(float v) { return xsum32(xsum16(row16_sum(v))); }
__device__ __forceinline__ float wave_max(float v) { return xmax32(xmax16(row16_max(v))); }
__device__ __forceinline__ int mod_row(int row) { return row < MC ? 0 : 1 + ((row - MC) >> 10); }

constexpr size_t O_YP = 0, O_YS = 8388608, O_K = 16777216, O_V = O_K + 12582912, O_SSD = O_V + 12582912, O_RE = O_SSD + 6291456, O_IM = O_RE + 262144, O_END = O_IM + 262144;


#define LAS __attribute__((address_space(3)))
struct SeqInfo { int start, L, b, ctx; };
__device__ __forceinline__ SeqInfo seq_info(int s) { SeqInfo q; if (s < CB) { q.start = s * CL; q.L = CL; q.b = s; q.ctx = 1; } else { q.start = MC + (s - CB) * LL; q.L = LL; q.b = s - CB; q.ctx = 0; } return q; }
__device__ __forceinline__ SeqInfo row_seq(int row) { return seq_info(row < MC ? (row >> 8) : CB + ((row - MC) >> 10)); }
namespace pg8 {
#define PG8_LAS __attribute__((address_space(3)))
typedef unsigned short bf16_t;
typedef short bf16x8 __attribute__((ext_vector_type(8)));
typedef float f32x4 __attribute__((ext_vector_type(4)));
typedef unsigned u32x4 __attribute__((ext_vector_type(4)));
constexpr int BM = 256, BK = 64, HALF = 128, HTB = HALF * BK * 2  , STAGE_BYTES = 8 * HTB, NXCD = 8, WGM = 8;

__host__ __device__ __forceinline__ int lds_byte(int r, int c) { const int st = (r >> 4) * 2 + (c >> 5), rr = r & 15, cc = c & 31, ob = rr * 64 + cc * 2; return st * 1024 + (ob ^ (((ob >> 9) & 1) << 5)); }
__host__ __device__ __forceinline__ void stage_rc(int b, int& R, int& C) { const int st = b / 1024, sb = b % 1024, swz = sb ^ (((sb >> 9) & 1) << 5); R = (st >> 1) * 16 + swz / 64; C = (st & 1) * 32 + (swz % 64) / 2; }
__host__ __device__ __forceinline__ int perm32(int rho) { const int n = rho >> 4, i = rho & 15; return 8 * (i >> 2) + 4 * n + (i & 3); }

struct Unit { int pm, pn; };
struct Gemm { const bf16_t* A; const bf16_t* Bt; int M, N, K; };

struct StaticOrder {
    int nM, nN, nwg, G, c;
    __host__ __device__ void init(int M, int N, int G_, int c_) { nM = M / BM; nN = N / BM; nwg = nM * nN; G = G_; c = c_; }
    __host__ __device__ bool next(int i, Unit& u) const {
        const long L = (long)i * G + c; if (L >= nwg) return false;
        int wgid = (int)L; { const int q = nwg / NXCD, r = nwg % NXCD, xcd = wgid % NXCD, off = wgid / NXCD; wgid = (xcd < r ? xcd * (q + 1) : r * (q + 1) + (xcd - r) * q) + off; }
        const int nig = WGM * nN, gid = wgid / nig, fm = gid * WGM, gsz = (nM - fm) < WGM ? (nM - fm) : WGM;
        u.pm = fm + ((wgid % nig) % gsz); u.pn = (wgid % nig) / gsz; return true;
    }
    __device__ __forceinline__ void a_ready(const Unit&) const {}
    __device__ __forceinline__ void done(const Unit&) const {}
};

__device__ __forceinline__ unsigned cvt_pk_bf16(float lo, float hi) { unsigned r; asm volatile("v_cvt_pk_bf16_f32 %0, %1, %2" : "=v"(r) : "v"(lo), "v"(hi)); return r; }
__device__ __forceinline__ float row_rstd(const float* ssq, int row, int fq) {
    const f32x4 a = *(const f32x4*)(ssq + (size_t)row * 16 + 4 * fq);
    const float s = ::xsum32(::xsum16((a[0] + a[1]) + (a[2] + a[3])));
    return rsqrtf(s * (1.f / 1024.f) + ::EPS);
}
__device__ __forceinline__ void st_wt16(void* base, size_t byte_off, u32x4 v) { const unsigned o = (unsigned)byte_off; asm volatile("global_store_dwordx4 %0, %1, %2 sc1\n\ts_nop 1" :: "v"(o), "v"(v), "s"(base) : "memory"); }
struct EpiProj {
    static constexpr bool PERM = true, AFTER_DRAIN = false; static constexpr int MID_T = 0;
    bf16_t* proj; float* ok; float* ov; float* dt; PG8_LAS const float* side; int l; mutable int slot;
    __device__ __forceinline__ void operator()(const f32x4 (&acc)[2][2][4][2], const Unit& u, int wr, int wc, int fr, int fq) const {
        const int row0 = u.pm * BM + wr * 64 + fr;
        PG8_LAS const float* rsp = side + slot * 256 + wr * 64 + fr; PG8_LAS const float* bsp = side + 1024 + slot * 256 + wc * 32 + 8 * fq; ++slot;
        float rs[2][4];
#pragma unroll
        for (int ai = 0; ai < 2; ++ai)
#pragma unroll
            for (int m = 0; m < 4; ++m) rs[ai][m] = rsp[ai * HALF + m * 16];
#pragma unroll
        for (int bj = 0; bj < 2; ++bj) {
            const int cb = u.pn * BM + bj * HALF;
            if (cb > ::PN) continue;
            const int col = cb + wc * 32 + 8 * fq;
            const f32x4 b0 = *(PG8_LAS const f32x4*)(bsp + bj * HALF), b1 = *(PG8_LAS const f32x4*)(bsp + bj * HALF + 4);
            const bool isk = (cb >= ::PK && cb < ::PV), isv = (cb >= ::PV && cb < ::PN), isdt = (cb == ::PN);
#pragma unroll
            for (int ai = 0; ai < 2; ++ai)
#pragma unroll
                for (int m = 0; m < 4; ++m) {
                    const int row = row0 + ai * HALF + m * 16;
                    const f32x4 v0 = acc[ai][bj][m][0] * rs[ai][m] + b0, v1 = acc[ai][bj][m][1] * rs[ai][m] + b1;
                    if (isdt) { if (wc == 0 && fq < 2) { float* d = dt + (size_t)row * 12 + 8 * fq; *(f32x4*)d = v0; if (fq == 0) *(f32x4*)(d + 4) = v1; } continue; }
                    u32x4 w; w.x = cvt_pk_bf16(v0[0], v0[1]); w.y = cvt_pk_bf16(v0[2], v0[3]); w.z = cvt_pk_bf16(v1[0], v1[1]); w.w = cvt_pk_bf16(v1[2], v1[3]);
                    st_wt16(proj, ((size_t)row * ::PN + col) * 2, w);
                    if (u.pm < 32 && (isk || isv)) {
                        const int b = row >> 8, t = row & 255;
                        float* o = (isk ? ok : ov) + ((size_t)(b * 4 + l) * 256 + t) * 384 + (col - (isk ? ::PK : ::PV));
                        __builtin_nontemporal_store(v0, (f32x4*)o); __builtin_nontemporal_store(v1, (f32x4*)(o + 4));
                    }
                }
        }
    }
};
template <int MID, bool XF32>
struct EpiRes {
    static constexpr bool PERM = true, AFTER_DRAIN = false; static constexpr int MID_T = MID;
    const void* xin_c; const void* xin_l; bf16_t* xout; const float* gate;
    const float* nw; const float* sc; bf16_t* xs; float* ssq;
    PG8_LAS const float* side;
    __device__ __forceinline__ void mid(f32x4 (&acc)[2][2][4][2], const Unit& u, int wr, int fr) const {
#pragma unroll
        for (int ai = 0; ai < 2; ++ai)
#pragma unroll
            for (int m = 0; m < 4; ++m) { const float sc_ = side[ai * HALF + wr * 64 + m * 16 + fr];
#pragma unroll
                for (int bj = 0; bj < 2; ++bj)
#pragma unroll
                    for (int n = 0; n < 2; ++n) acc[ai][bj][m][n] = acc[ai][bj][m][n] * sc_; }
    }
    __device__ __forceinline__ void operator()(const f32x4 (&acc)[2][2][4][2], const Unit& u, int wr, int wc, int fr, int fq) const {
        const int row0 = u.pm * BM + wr * 64 + fr, col0 = u.pn * BM + wc * 32 + 8 * fq;
        const int r = u.pm < 32 ? 0 : 1 + ((u.pm - 32) >> 2);
        const float* gt = gate + (size_t)r * 6144; const float* sr = sc + (size_t)r * 6144;
        const void* xin = u.pm < 32 ? xin_c : xin_l;
        float sq[2][4];
#pragma unroll
        for (int ai = 0; ai < 2; ++ai)
#pragma unroll
            for (int m = 0; m < 4; ++m) sq[ai][m] = 0.f;
#pragma unroll
        for (int bj = 0; bj < 2; ++bj) {
            const int col = col0 + bj * HALF;
            const f32x4 g0 = *(const f32x4*)(gt + col), g1 = *(const f32x4*)(gt + col + 4);
            f32x4 gs0 = {0.f, 0.f, 0.f, 0.f}, gs1 = gs0;
            if (xs) { gs0 = *(const f32x4*)(nw + col) * (*(const f32x4*)(sr + col) + 1.f); gs1 = *(const f32x4*)(nw + col + 4) * (*(const f32x4*)(sr + col + 4) + 1.f); }
#pragma unroll
            for (int ai = 0; ai < 2; ++ai)
#pragma unroll
                for (int m = 0; m < 4; ++m) {
                    const size_t off = (size_t)(row0 + ai * HALF + m * 16) * ::D + col;
                    f32x4 xi0, xi1;
                    if (XF32) { xi0 = __builtin_nontemporal_load((const f32x4*)((const float*)xin + off)); xi1 = __builtin_nontemporal_load((const f32x4*)((const float*)xin + off + 4)); }
                    else { const u32x4 xr = __builtin_nontemporal_load((const u32x4*)((const bf16_t*)xin + off));
                        xi0 = (f32x4){__uint_as_float(xr.x << 16), __uint_as_float(xr.x & 0xffff0000u), __uint_as_float(xr.y << 16), __uint_as_float(xr.y & 0xffff0000u)};
                        xi1 = (f32x4){__uint_as_float(xr.z << 16), __uint_as_float(xr.z & 0xffff0000u), __uint_as_float(xr.w << 16), __uint_as_float(xr.w & 0xffff0000u)}; }
                    const f32x4 x0 = xi0 + g0 * acc[ai][bj][m][0], x1 = xi1 + g1 * acc[ai][bj][m][1];
                    { u32x4 xo; xo.x = cvt_pk_bf16(x0[0], x0[1]); xo.y = cvt_pk_bf16(x0[2], x0[3]); xo.z = cvt_pk_bf16(x1[0], x1[1]); xo.w = cvt_pk_bf16(x1[2], x1[3]); *(u32x4*)(xout + off) = xo; }
                    if (xs) { sq[ai][m] += ((x0[0] * x0[0] + x0[1] * x0[1]) + (x0[2] * x0[2] + x0[3] * x0[3])) + ((x1[0] * x1[0] + x1[1] * x1[1]) + (x1[2] * x1[2] + x1[3] * x1[3]));
                        const f32x4 h0 = x0 * gs0, h1 = x1 * gs1; u32x4 o; o.x = cvt_pk_bf16(h0[0], h0[1]); o.y = cvt_pk_bf16(h0[2], h0[3]); o.z = cvt_pk_bf16(h1[0], h1[1]); o.w = cvt_pk_bf16(h1[2], h1[3]);
                        *(u32x4*)(xs + off) = o; }
                }
        }
        if (xs) {
#pragma unroll
            for (int ai = 0; ai < 2; ++ai)
#pragma unroll
                for (int m = 0; m < 4; ++m) { const float t = ::xsum32(::xsum16(sq[ai][m])); if (fq == 0) ssq[(size_t)(row0 + ai * HALF + m * 16) * 16 + u.pn * 4 + wc] = t; }
        }
    }
};
struct EpiFF1 {
    static constexpr bool PERM = true, AFTER_DRAIN = false; static constexpr int MID_T = 0;
    bf16_t* h; PG8_LAS const float* side; mutable int slot;
    __device__ __forceinline__ void operator()(const f32x4 (&acc)[2][2][4][2], const Unit& u, int wr, int wc, int fr, int fq) const {
        const int row0 = u.pm * BM + wr * 64 + fr, col0 = u.pn * BM + wc * 32 + 8 * fq;
        PG8_LAS const float* rsp = side + slot * 256 + wr * 64 + fr; PG8_LAS const float* bsp = side + 1024 + slot * 256 + wc * 32 + 8 * fq; ++slot;
        f32x4 bv[2][2];
#pragma unroll
        for (int bj = 0; bj < 2; ++bj) { bv[bj][0] = *(PG8_LAS const f32x4*)(bsp + bj * HALF); bv[bj][1] = *(PG8_LAS const f32x4*)(bsp + bj * HALF + 4); }
#pragma unroll
        for (int ai = 0; ai < 2; ++ai)
#pragma unroll
            for (int m = 0; m < 4; ++m) {
                const int row = row0 + ai * HALF + m * 16; const float rs = rsp[ai * HALF + m * 16];
                bf16_t* rowp = h + (size_t)row * ::DFF + col0;
#pragma unroll
                for (int bj = 0; bj < 2; ++bj) {
                    f32x4 v0 = acc[ai][bj][m][0] * rs + bv[bj][0], v1 = acc[ai][bj][m][1] * rs + bv[bj][1];
#pragma unroll
                    for (int e = 0; e < 4; ++e) { const float a = fmaxf(v0[e], 0.f), b = fmaxf(v1[e], 0.f); v0[e] = a * a; v1[e] = b * b; }
                    u32x4 w; w.x = cvt_pk_bf16(v0[0], v0[1]); w.y = cvt_pk_bf16(v0[2], v0[3]); w.z = cvt_pk_bf16(v1[0], v1[1]); w.w = cvt_pk_bf16(v1[2], v1[3]);
                    st_wt16(h, ((size_t)row * ::DFF + col0 + bj * HALF) * 2, w);
                }
            }
    }
};
template <class Epi, class Sched, bool ALIGN_EPI = false, bool SP2 = false>
__device__ __forceinline__ void gemm_phase(PG8_LAS unsigned char* lds, const Gemm g, const Sched& S, const Epi& E, const int wave_in) {
    int tid_ = wave_in * 64 + ::lane_id(); asm volatile("" : "+v"(tid_));
    const int tid = tid_, wid = __builtin_amdgcn_readfirstlane(tid >> 6), lane = tid & 63, wr = wid >> 2, wc = wid & 3, fr = lane & 15, fq = lane >> 4;
    const int K = g.K, nt = K / BK;
    unsigned voffA[2], voffB[2];
#pragma unroll
    for (int i = 0; i < 2; ++i) { int R, C; stage_rc(tid * 16 + i * 8192, R, C); const int Rb = Epi::PERM ? ((R & ~31) + perm32(R & 31)) : R;
        voffA[i] = (unsigned)(R * K + C) * 2u; voffB[i] = (unsigned)(Rb * K + C) * 2u; }
    const size_t kstep = (size_t)(BK * 2);
    const size_t hstep = (size_t)HALF * K * 2;
    const size_t tstep = 2 * hstep;
    const unsigned ldsw = (unsigned)wid * 1024u;
    const int aoff = lds_byte(wr * 64 + fr, fq * 8), boff = lds_byte(wc * 32 + fr, fq * 8);
#define PG8_SA(b, h) (((b) * 2 + (h)) * HTB)
#define PG8_SB(b, h) ((4 + (b) * 2 + (h)) * HTB)
#define PG8_STAGE(bufoff, gbase, voff) do { _Pragma("unroll") for (int _i = 0; _i < 2; ++_i) \
        __builtin_amdgcn_global_load_lds((const unsigned*)((const char*)(gbase) + (voff)[_i]), (PG8_LAS unsigned*)(lds + (bufoff) + ldsw + _i * 8192), 16, 0, 0); } while (0)
#define PG8_LDA(dst, b, h) do { _Pragma("unroll") for (int m = 0; m < 4; ++m) _Pragma("unroll") for (int k = 0; k < 2; ++k) dst[m][k] = *(const PG8_LAS bf16x8*)(lds + PG8_SA(b, h) + aoff + m * 2048 + k * 1024); } while (0)
#define PG8_LDB(dst, b, h) do { _Pragma("unroll") for (int n = 0; n < 2; ++n) _Pragma("unroll") for (int k = 0; k < 2; ++k) dst[n][k] = *(const PG8_LAS bf16x8*)(lds + PG8_SB(b, h) + boff + n * 2048 + k * 1024); } while (0)
#define PG8_MMA(ai, bj, At, Bt) do { __builtin_amdgcn_s_setprio(1); _Pragma("unroll") for (int m = 0; m < 4; ++m) _Pragma("unroll") for (int n = 0; n < 2; ++n) _Pragma("unroll") for (int k = 0; k < 2; ++k) \
        acc[ai][bj][m][n] = __builtin_amdgcn_mfma_f32_16x16x32_bf16(Bt[n][k], At[m][k], acc[ai][bj][m][n], 0, 0, 0); __builtin_amdgcn_s_setprio(0); } while (0)
#define PG8_WAIT_V(n) asm volatile("s_waitcnt vmcnt(" #n ")" ::: "memory")
#define PG8_WAIT_L(n) asm volatile("s_waitcnt lgkmcnt(" #n ")" ::: "memory")
#define PG8_BAR __builtin_amdgcn_s_barrier()
#define PG8_SCHED __builtin_amdgcn_sched_barrier(0)
    Unit cur, nxt; int ui = 0;
    if (!S.next(0, cur)) return;
    f32x4 acc[2][2][4][2];
#pragma unroll
    for (int a = 0; a < 2; ++a)
#pragma unroll
        for (int b = 0; b < 2; ++b)
#pragma unroll
            for (int m = 0; m < 4; ++m)
#pragma unroll
                for (int n = 0; n < 2; ++n) acc[a][b][m][n] = (f32x4){0.f, 0.f, 0.f, 0.f};
    bf16x8 At[4][2], B0[2][2], B1[2][2];
    const char* cA = (const char*)g.A + (size_t)cur.pm * tstep; const char* cB = (const char*)g.Bt + (size_t)cur.pn * tstep;
    S.a_ready(cur);
    if constexpr (SP2) {
        PG8_STAGE(PG8_SB(0, 0), cB, voffB); PG8_STAGE(PG8_SB(0, 1), cB + hstep, voffB); PG8_STAGE(PG8_SA(0, 0), cA, voffA); PG8_STAGE(PG8_SA(0, 1), cA + hstep, voffA);
        if (wr == 1) PG8_BAR;
        PG8_WAIT_V(2); PG8_BAR;
        PG8_STAGE(PG8_SB(1, 0), cB + kstep, voffB); PG8_STAGE(PG8_SA(1, 0), cA + kstep, voffA); PG8_STAGE(PG8_SB(1, 1), cB + hstep + kstep, voffB);
        PG8_WAIT_V(6); PG8_BAR;
    } else {
        PG8_STAGE(PG8_SB(0, 0), cB, voffB); PG8_STAGE(PG8_SA(0, 0), cA, voffA); PG8_STAGE(PG8_SB(0, 1), cB + hstep, voffB); PG8_STAGE(PG8_SA(0, 1), cA + hstep, voffA);
        if (wr == 1) PG8_BAR;
        PG8_WAIT_V(4); PG8_BAR;
        PG8_STAGE(PG8_SB(1, 0), cB + kstep, voffB); PG8_STAGE(PG8_SA(1, 0), cA + kstep, voffA); PG8_STAGE(PG8_SB(1, 1), cB + hstep + kstep, voffB);
        PG8_WAIT_V(6); PG8_BAR;
    }
    for (;;) {
        const bool has_next = S.next(ui + 1, nxt);
        const char* nA = has_next ? (const char*)g.A + (size_t)nxt.pm * tstep : cA; const char* nB = has_next ? (const char*)g.Bt + (size_t)nxt.pn * tstep : cB;
        for (int t = 0; t < nt; t += 2) {
            if constexpr (Epi::MID_T > 0) { if (t == Epi::MID_T) E.mid(acc, cur, wr, fr); }
            const bool last = (t == nt - 2);
            const char* a1 = cA + (size_t)(t + 1) * kstep;
            const char* a2 = last ? nA : cA + (size_t)(t + 2) * kstep; const char* b2 = last ? nB : cB + (size_t)(t + 2) * kstep;
            const char* a3 = a2 + kstep; const char* b3 = b2 + kstep;
            if (last && has_next) S.a_ready(nxt);
            if constexpr (SP2) {
            PG8_LDB(B0, 0, 0); PG8_LDB(B1, 0, 1); PG8_SCHED; PG8_LDA(At, 0, 0); PG8_STAGE(PG8_SA(1, 1), a1 + hstep, voffA);
            PG8_WAIT_V(8); PG8_WAIT_L(0); PG8_BAR; PG8_MMA(0, 0, At, B0); PG8_MMA(0, 1, At, B1); PG8_BAR; PG8_SCHED;
            PG8_LDA(At, 0, 1); PG8_STAGE(PG8_SB(0, 0), b2, voffB); PG8_STAGE(PG8_SB(0, 1), b2 + hstep, voffB); PG8_STAGE(PG8_SA(0, 0), a2, voffA);
            PG8_WAIT_V(8); PG8_WAIT_L(0); PG8_BAR; PG8_MMA(1, 0, At, B0); PG8_MMA(1, 1, At, B1); PG8_BAR; PG8_SCHED;
            PG8_LDB(B0, 1, 0); PG8_LDB(B1, 1, 1); PG8_SCHED; PG8_LDA(At, 1, 0); PG8_STAGE(PG8_SA(0, 1), a2 + hstep, voffA);
            PG8_WAIT_V(8); PG8_WAIT_L(0); PG8_BAR; PG8_MMA(0, 0, At, B0); PG8_MMA(0, 1, At, B1); PG8_BAR; PG8_SCHED;
            PG8_LDA(At, 1, 1); PG8_STAGE(PG8_SB(1, 0), b3, voffB); PG8_STAGE(PG8_SB(1, 1), b3 + hstep, voffB); PG8_STAGE(PG8_SA(1, 0), a3, voffA);
            PG8_WAIT_V(8); PG8_WAIT_L(0); PG8_BAR; PG8_MMA(1, 0, At, B0); PG8_MMA(1, 1, At, B1); PG8_BAR; PG8_SCHED;
            } else {
            PG8_LDB(B0, 0, 0); PG8_SCHED; PG8_LDA(At, 0, 0); PG8_STAGE(PG8_SA(1, 1), a1 + hstep, voffA);
            PG8_WAIT_L(8); PG8_BAR; PG8_WAIT_L(0); PG8_MMA(0, 0, At, B0); PG8_BAR; PG8_SCHED;
            PG8_LDB(B1, 0, 1); PG8_STAGE(PG8_SB(0, 0), b2, voffB);
            PG8_BAR; PG8_WAIT_L(0); PG8_MMA(0, 1, At, B1); PG8_BAR;
            PG8_LDA(At, 0, 1); PG8_STAGE(PG8_SA(0, 0), a2, voffA);
            PG8_BAR; PG8_WAIT_L(0); PG8_MMA(1, 0, At, B0); PG8_BAR; PG8_SCHED;
            PG8_STAGE(PG8_SB(0, 1), b2 + hstep, voffB);
            PG8_WAIT_V(6); PG8_BAR; PG8_MMA(1, 1, At, B1); PG8_BAR;
            PG8_LDB(B0, 1, 0); PG8_SCHED; PG8_LDA(At, 1, 0); PG8_STAGE(PG8_SA(0, 1), a2 + hstep, voffA);
            PG8_WAIT_L(8); PG8_BAR; PG8_WAIT_L(0); PG8_MMA(0, 0, At, B0); PG8_BAR; PG8_SCHED;
            PG8_LDB(B1, 1, 1); PG8_STAGE(PG8_SB(1, 0), b3, voffB);
            PG8_BAR; PG8_WAIT_L(0); PG8_MMA(0, 1, At, B1); PG8_BAR;
            PG8_LDA(At, 1, 1); PG8_STAGE(PG8_SA(1, 0), a3, voffA);
            PG8_BAR; PG8_WAIT_L(0); PG8_MMA(1, 0, At, B0); PG8_BAR; PG8_SCHED;
            PG8_STAGE(PG8_SB(1, 1), b3 + hstep, voffB);
            PG8_WAIT_V(6); PG8_BAR; PG8_MMA(1, 1, At, B1); PG8_BAR;
            }
        }
        if constexpr (ALIGN_EPI) { if (wr == 0) PG8_BAR; }
        if constexpr (!Epi::AFTER_DRAIN) { E(acc, cur, wr, wc, fr, fq); S.done(cur); }
        if (!has_next) break;
#pragma unroll
        for (int a = 0; a < 2; ++a)
#pragma unroll
            for (int b = 0; b < 2; ++b)
#pragma unroll
                for (int m = 0; m < 4; ++m)
#pragma unroll
                    for (int n = 0; n < 2; ++n) acc[a][b][m][n] = (f32x4){0.f, 0.f, 0.f, 0.f};
        cur = nxt; cA = nA; cB = nB; ++ui;
        if constexpr (ALIGN_EPI) { if (wr == 1) PG8_BAR; }
    }
    PG8_WAIT_V(0);
    if constexpr (!ALIGN_EPI) { if (wr == 0) PG8_BAR; }
    PG8_BAR;
    if constexpr (Epi::AFTER_DRAIN) { E.fused(acc, cur, wr, wc, fr, fq, lds, wid, lane); S.done(cur); }
#undef PG8_SA
#undef PG8_SB
#undef PG8_STAGE
#undef PG8_LDA
#undef PG8_LDB
#undef PG8_MMA
#undef PG8_WAIT_V
#undef PG8_WAIT_L
#undef PG8_BAR
#undef PG8_SCHED
}
}

constexpr int NWAVES = 8, NTHREADS = 512;
constexpr int RING_BYTES = 131072, LDS_BYTES = 163840, LDSCTL_OFF = LDS_BYTES - 512, MISC_OFF = LDSCTL_OFF + 320;
#define GAS __attribute__((address_space(1)))
typedef unsigned v4u __attribute__((ext_vector_type(4)));
typedef unsigned v2u __attribute__((ext_vector_type(2)));
typedef GAS unsigned gu32;
#define LDS_WAIT() asm volatile("s_waitcnt lgkmcnt(0)" ::: "memory")
#define VM_WAIT() asm volatile("s_waitcnt vmcnt(0)" ::: "memory")
__device__ __forceinline__ unsigned pk2(float lo, float hi) { return cvtpk(lo, hi); }
constexpr int CW_BAR = 4096, CW_Q = 65536;
constexpr size_t CTL_ZERO_BYTES = 1 * MiB;

#define XB_TMO      128
#define XB_XCNT(j)  (256  + 64 * (j))
#define XB_XSUB(j)  (1280 + 64 * (j))
#define XB_XGEN(j)  (2304 + 64 * (j))
#define XB_TOP      3328
#define XB_TOPGEN   3392
#define XCD_BAR_WORDS 3456
#define XB_SPIN_CAP (1u << 18)

__device__ __forceinline__ unsigned xb_ld(unsigned* p)              { return __hip_atomic_load(p, __ATOMIC_RELAXED, __HIP_MEMORY_SCOPE_AGENT); }
__device__ __forceinline__ unsigned xb_add(unsigned* p, unsigned v) { return __hip_atomic_fetch_add(p, v, __ATOMIC_RELAXED, __HIP_MEMORY_SCOPE_AGENT); }
__device__ __forceinline__ unsigned xb_xcc_id() { return (unsigned)__builtin_amdgcn_s_getreg((3 << 11) | 20) & 0xFu; }
#define XB_SPIN(cond, bar) do { unsigned _sp = 0; while (cond) { __builtin_amdgcn_s_sleep(1); \
    if ((++_sp & 255u) == 0u) { if (xb_ld(&(bar)[XB_TMO])) break; if (_sp > XB_SPIN_CAP) { atomicAdd(&(bar)[XB_TMO], 1u); break; } } } } while (0)

struct XcdBarrier {
    unsigned* bar; unsigned x;
    volatile LAS unsigned* st;
};

__device__ __forceinline__ XcdBarrier xcd_barrier_post(unsigned* bar, volatile LAS unsigned* st) {
    XcdBarrier b; b.bar = bar; b.x = xb_xcc_id(); b.st = st;
    if (threadIdx.x == 0) (void)xb_add(&bar[XB_XCNT(b.x)], 1u);
    return b;
}
__device__ __forceinline__ void xcd_barrier_complete(unsigned* bar, unsigned x, unsigned& nloc, unsigned& nx) {
    const unsigned G = gridDim.x * gridDim.y * gridDim.z;
    unsigned sum, cnt, mine, sp = 0u;
    for (;;) {
        sum = 0u; cnt = 0u; mine = 0u;
#pragma unroll
        for (unsigned j = 0; j < 16; ++j) { const unsigned c = xb_ld(&bar[XB_XCNT(j)]); sum += c; cnt += (c > 0u) ? 1u : 0u; mine = (j == x) ? c : mine; }
        if (sum == G) break;
        __builtin_amdgcn_s_sleep(1);
        if ((++sp & 255u) == 0u) { if (xb_ld(&bar[XB_TMO])) break; if (sp > XB_SPIN_CAP) { atomicAdd(&bar[XB_TMO], 1u); break; } }
    }
    nloc = mine > 0u ? mine : 1u; nx = cnt > 0u ? cnt : 1u;
}

__device__ __forceinline__ void xcd_barrier(const XcdBarrier& b, const bool is_t0) {
    asm volatile("s_waitcnt vmcnt(0)" ::: "memory");
    __syncthreads();
    if (is_t0) {
        unsigned* bar = b.bar;
        __builtin_amdgcn_s_waitcnt(0);
        unsigned nloc = b.st[0], nx = b.st[1];
        if (nloc == 0u) { xcd_barrier_complete(bar, b.x, nloc, nx); b.st[0] = nloc; b.st[1] = nx; }
        const unsigned old = xb_add(&bar[XB_XSUB(b.x)], 1u);
        const unsigned gen = old / nloc;
        if (old + 1u == (gen + 1u) * nloc) {
            __builtin_amdgcn_fence(__ATOMIC_RELEASE, "agent");
            asm volatile("s_waitcnt vmcnt(0)" ::: "memory");
            const unsigned og = xb_add(&bar[XB_TOP], 1u);
            const unsigned tg = og / nx;
            if (og + 1u == (tg + 1u) * nx) xb_add(&bar[XB_TOPGEN], 1u);
            else XB_SPIN(xb_ld(&bar[XB_TOPGEN]) == tg, bar);
            __builtin_amdgcn_fence(__ATOMIC_ACQUIRE, "agent");
            xb_add(&bar[XB_XGEN(b.x)], 1u);
            asm volatile("s_waitcnt vmcnt(0)" ::: "memory");
        } else {
            XB_SPIN(xb_ld(&bar[XB_XGEN(b.x)]) == gen, bar);
            __builtin_amdgcn_fence(__ATOMIC_ACQUIRE, "agent");
            asm volatile("s_waitcnt vmcnt(0)" ::: "memory");
        }
    }
    __syncthreads();
}


struct InPtrs { const GAS float* const* p; __device__ __forceinline__ const float* operator[](int k) const { return (const float*)p[k]; } };
struct Frame {
    LAS unsigned char* lds;
    volatile LAS unsigned* MISC;
    unsigned* ctl;
    int tid, lane, wave, vcu, G;
    InPtrs in; float* out; unsigned char* ws;
};
constexpr int PH_PRO = 0, PH_PRE = 1, PH_L0 = 2, PH_PER_LAYER = 6, PH_G1 = 0, PH_MIXA = 1, PH_MIXB = 2, PH_G3 = 3, PH_G4 = 4, PH_G5 = 5, PH_FINAL = PH_L0 + DEPTH * PH_PER_LAYER, PH_END = PH_FINAL + 1;

__device__ __forceinline__ int queue_next(Frame& F, unsigned* ctr);
constexpr int TR_P = 144;
__device__ __forceinline__ void transpose_item(const float* W, int K, int Nsrc, int src_n0, bf16_t* WT, int dst_n0, int k0, LAS unsigned char* scr, int lane, int nvalid = 64) {
    const int l16 = lane & 15, l4 = lane >> 4;
    f32x4 v[16];
#pragma unroll
    for (int i = 0; i < 16; ++i) v[i] = (src_n0 >= 0 && 4 * l16 < nvalid) ? __builtin_nontemporal_load((const f32x4*)(W + (size_t)(k0 + 4 * i + l4) * Nsrc + src_n0 + 4 * l16)) : (f32x4){0.f, 0.f, 0.f, 0.f};
#pragma unroll
    for (int i = 0; i < 16; ++i)
#pragma unroll
        for (int e = 0; e < 4; ++e) *(LAS bf16_t*)(scr + (4 * l16 + e) * TR_P + (4 * i + l4) * 2) = f2bf(v[i][e]);
    LDS_WAIT(); asm volatile("" ::: "memory");
#pragma unroll
    for (int jn = 0; jn < 8; ++jn) { const int n = 8 * jn + (lane >> 3), c = lane & 7;
        *(v4u*)(WT + (size_t)(dst_n0 + n) * K + k0 + 8 * c) = *(LAS const v4u*)(scr + n * TR_P + c * 16); }
    LDS_WAIT(); asm volatile("" ::: "memory");
}
constexpr int TR_IN = 16 * (PNP / 64), TR_OUT = 16 * 16, TR_F1 = 16 * (DFF / 64), TR_F2 = (DFF / 64) * 16, TR_GLU = 4 * 4, TR_L = TR_IN + TR_OUT + TR_F1 + TR_F2 + TR_GLU;
constexpr int TR_WG = (TR_L + 7) / 8;
__device__ __forceinline__ void transpose_layer_item(Frame& F, int l, int r) {
    const InPtrs in = F.in;
    LAS unsigned char* scr = F.lds + F.wave * (64 * TR_P);
    if (r < TR_IN) { const int nb = r % (PNP / 64), kb = r / (PNP / 64), n0 = nb * 64; const int src = n0 > PN ? -1 : (n0 == PN ? 1024 : (n0 >= 1024 ? n0 + 12 : n0));
        transpose_item(in[13] + (size_t)l * 1024 * IN_COLS, 1024, IN_COLS, src, (bf16_t*)(F.ws + OFF_WIN) + (size_t)l * PNP * 1024, n0, kb * 64, scr, F.lane, n0 == PN ? 12 : 64); }
    else if ((r -= TR_IN) < TR_OUT) { const int nb = r % 16, kb = r / 16; transpose_item(in[31] + (size_t)l * 1024 * 1024, 1024, 1024, nb * 64, (bf16_t*)(F.ws + OFF_WOUT) + (size_t)l * 1024 * 1024, nb * 64, kb * 64, scr, F.lane); }
    else if ((r -= TR_OUT) < TR_F1) { const int nb = r % (DFF / 64), kb = r / (DFF / 64); transpose_item(in[32] + (size_t)l * 1024 * DFF, 1024, DFF, nb * 64, (bf16_t*)(F.ws + OFF_WFF1) + (size_t)l * DFF * 1024, nb * 64, kb * 64, scr, F.lane); }
    else if ((r -= TR_F1) < TR_F2) { const int nb = r % 16, kb = r / 16; transpose_item(in[33] + (size_t)l * DFF * 1024, DFF, 1024, nb * 64, (bf16_t*)(F.ws + OFF_WFF2) + (size_t)l * 1024 * DFF, nb * 64, kb * 64, scr, F.lane); }
    else { r -= TR_F2; const int nb = r % 4, kb = r / 4; transpose_item(in[28] + (size_t)l * 65536, 256, 256, nb * 64, (bf16_t*)(F.ws + OFF_WGLU) + (size_t)l * 65536, nb * 64, kb * 64, scr, F.lane); }
}
__device__ __forceinline__ void transpose_layer_queue(Frame& F, int l, unsigned* ctr) {
    for (;;) { const int u = queue_next(F, ctr); if (u >= TR_WG) break; const int it = u * 8 + F.wave; if (it < TR_L) transpose_layer_item(F, l, it); }
}
__device__ __forceinline__ void phase_prologue(Frame& F) {
    const InPtrs in = F.in;
    for (int idx = F.vcu * NTHREADS + F.tid; idx < 8192; idx += F.G * NTHREADS) {
        const int pp = idx & 63, g = (idx >> 6) & 15, dir = (idx >> 10) & 1, l = idx >> 11;
        const float are = in[20][idx], aim = in[21][idx];
        const float dt = __expf(in[22][(l * 2 + dir) * 16 + g]);
        const float zr = are * dt, zi = aim * dt;
        const float e = expf(zr); float rev = zi * 0.15915494309189535f; rev -= rintf(rev);
        const float ar = e * cosf(rev * 6.283185307179586f), ai = e * sinf(rev * 6.283185307179586f);
        float* abar = (float*)(F.ws + OFF_TAB + TAB_ABAR);
        abar[idx * 2] = ar; abar[idx * 2 + 1] = ai;
        const float xr = ar - 1.f, xi = ai, den = are * are + aim * aim;
        const float fr = (xr * are + xi * aim) / den, fi = (xi * are - xr * aim) / den;
        for (int c = 0; c < 16; ++c) {
            const float br = in[23][((l * 16 + g) * 64 + pp) * 16 + c], bi = in[24][((l * 16 + g) * 64 + pp) * 16 + c];
            bf16_t* bbt = (bf16_t*)(F.ws + OFF_TAB + TAB_BBT) + ((size_t)(((l * 2 + dir) * 16 + g) * 2) * 64 + pp) * 16 + c;
            bbt[0] = f2bf(fr * br - fi * bi); bbt[64 * 16] = f2bf(fr * bi + fi * br);
            float2 b32; b32.x = fr * br - fi * bi; b32.y = fr * bi + fi * br; ((float2*)(F.ws + OFF_BB32))[(size_t)idx * 16 + c] = b32;
        }
        {
            float sr = ar, si = ai;
            bf16_t* pt = (bf16_t*)(F.ws + OFF_PT64) + (size_t)((l * 2 + dir) * 16 + g) * 64 * 128 + pp;
            for (int e2 = 1; e2 <= 64; ++e2) { const int t = dir == 0 ? e2 - 1 : 64 - e2; pt[t * 128] = f2bf(sr); pt[t * 128 + 64] = f2bf(si);
                const float nr = sr * ar - si * ai, ni = sr * ai + si * ar; sr = nr; si = ni; }
        }
    }
    for (int i = F.vcu * NTHREADS + F.tid; i < 4 * 16 * 16 * 128; i += F.G * NTHREADS) {
        const int pos = i & 127, c = (i >> 7) & 15, g = (i >> 11) & 15, l = i >> 15;
        const int ks = pos >> 5, fq_ = (pos >> 3) & 3, e = pos & 7, k = 32 * ks + (e < 4 ? 4 * fq_ + e : 16 + 4 * fq_ + e - 4), ri = k >> 6, pp = k & 63;
        const size_t si = ((size_t)(l * 16 + g) * 16 + c) * 64 + pp;
        ((bf16_t*)(F.ws + OFF_TAB + TAB_CC1))[i] = f2bf(ri ? -in[26][si] : in[25][si]);
    }
    for (int i = F.vcu * NTHREADS + F.tid; i < 2 * 3145728 / 8; i += F.G * NTHREADS) {
        const int which = i >= 3145728 / 8; const size_t e = (size_t)(which ? i - 3145728 / 8 : i) * 8;
        const float* src = in[which ? 3 : 2] + e; const f32x4 a = __builtin_nontemporal_load((const f32x4*)src), b = __builtin_nontemporal_load((const f32x4*)(src + 4));
        v4u o; o[0] = pk2(a[0], a[1]); o[1] = pk2(a[2], a[3]); o[2] = pk2(b[0], b[1]); o[3] = pk2(b[2], b[3]);
        *(v4u*)((bf16_t*)(F.ws + (which ? OFF_CV : OFF_CK)) + e) = o;
    }
    constexpr int N_UNITS = 96 + TR_WG;
    unsigned* ctr = F.ctl + CW_Q + 64 * 63;
    for (;;) {
        const int u = queue_next(F, ctr); if (u >= N_UNITS) break;
        if (u < 96) {
            LAS float* ssil = (LAS float*)F.lds;
            LAS float* part = (LAS float*)(F.lds + 9 * 1024 * 4);
            for (int i = F.tid; i < 9 * 1024; i += NTHREADS) { const int r = i >> 10, k = i & 1023; const float v = r == 0 ? in[8][k] : in[7][(r - 1) * 1024 + k]; ssil[i] = silu_f(v); }
            __syncthreads();
            const int l = u / 24, n0 = (u % 24) * 256;
            const float* w = in[9] + (size_t)l * 1024 * 6144 + n0 + 4 * F.lane;
            f32x4 acc[9];
#pragma unroll
            for (int r = 0; r < 9; ++r) acc[r] = (f32x4){0.f, 0.f, 0.f, 0.f};
            const int kb = F.wave * 128;
            for (int k = 0; k < 128; k += 4) {
                f32x4 wv[4];
#pragma unroll
                for (int e = 0; e < 4; ++e) wv[e] = __builtin_nontemporal_load((const f32x4*)(w + (size_t)(kb + k + e) * 6144));
#pragma unroll
                for (int r = 0; r < 9; ++r) { const f32x4 sv = *(LAS const f32x4*)(ssil + r * 1024 + kb + k);
                    acc[r] += wv[0] * sv[0]; acc[r] += wv[1] * sv[1]; acc[r] += wv[2] * sv[2]; acc[r] += wv[3] * sv[3]; }
            }
#pragma unroll
            for (int r = 0; r < 9; ++r) *(LAS f32x4*)(part + (F.wave * 9 + r) * 256 + 4 * F.lane) = acc[r];
            __syncthreads();
            float* mods = (float*)(F.ws + OFF_MODS);
            for (int i = F.tid; i < 9 * 256; i += NTHREADS) { const int r = i >> 8, jn = i & 255; float sacc = in[10][l * 6144 + n0 + jn];
#pragma unroll
                for (int w8 = 0; w8 < 8; ++w8) sacc += part[(w8 * 9 + r) * 256 + jn];
                mods[(size_t)(l * 9 + r) * 6144 + n0 + jn] = sacc; }
        } else {
            const int it = (u - 96) * 8 + F.wave;
            if (it < TR_L) transpose_layer_item(F, 0, it);
        }
    }
}
__device__ __forceinline__ void bias_task(Frame& F, int l, int t);
__device__ __forceinline__ void tk_gen_task(Frame& F, int l, int g, int half);
__device__ __forceinline__ void phase_pre(Frame& F) {
    const InPtrs in = F.in; const int lane = F.lane;
    for (int row = F.vcu * NWAVES + F.wave; row < M; row += F.G * NWAVES) {
        const float* xr = row < MC ? in[0] + (size_t)row * D : in[1] + (size_t)(row - MC) * D;
        const float* sc = (const float*)(F.ws + OFF_MODS) + (size_t)mod_row(row) * 6144 + 1024; const float* gw = in[11];
        bf16_t* h = (bf16_t*)(F.ws + OFF_H) + (size_t)row * D;
        float s = 0.f;
#pragma unroll
        for (int j = 0; j < 4; ++j) { const int c = 4 * lane + 256 * j; const f32x4 v = __builtin_nontemporal_load((const f32x4*)(xr + c)), g = *(const f32x4*)(gw + c), a = *(const f32x4*)(sc + c);
            s += v.x * v.x + v.y * v.y + v.z * v.z + v.w * v.w;
            uint2 o; o.x = pk2(v.x * g.x * (1.f + a.x), v.y * g.y * (1.f + a.y)); o.y = pk2(v.z * g.z * (1.f + a.z), v.w * g.w * (1.f + a.w)); *(uint2*)(h + c) = o; }
        s = wave_sum(s);
        if (lane < 16) ((float*)(F.ws + OFF_TAB + TAB_SQ1))[(size_t)row * 16 + lane] = lane == 0 ? s : 0.f;
    }
    for (int task = F.vcu - 128; task >= 0 && task < 128; task += F.G) tk_gen_task(F, task >> 5, (task >> 1) & 15, task & 1);
    for (int task = F.vcu; task < 104; task += F.G) bias_task(F, 0, task);
}
__device__ __forceinline__ void bias_task(Frame& F, int l, int t) {
    const int lane = F.lane, fr = lane & 15, fq = lane >> 4, w = F.wave;
    LAS float* red = (LAS float*)F.lds;
    {
        const int which = t >= 40, n0 = (which ? t - 40 : t) * 64;
        const float* mods = (const float*)(F.ws + OFF_MODS) + (size_t)l * 9 * 6144 + (which ? 3 : 0) * 1024;
        const bf16_t* wt = which ? (const bf16_t*)(F.ws + OFF_WFF1) + (size_t)l * DFF * 1024 : (const bf16_t*)(F.ws + OFF_WIN) + (size_t)l * PNP * 1024;
        float* bo = (float*)(F.ws + OFF_TAB + (which ? TAB_B2 : TAB_B1)) + (size_t)l * 9 * (which ? DFF : PNP);
        f32x4 acc[4];
#pragma unroll
        for (int nb = 0; nb < 4; ++nb) acc[nb] = (f32x4){0.f, 0.f, 0.f, 0.f};
#pragma unroll
        for (int ks = 0; ks < 4; ++ks) {
            const int k0 = 128 * w + 32 * ks + 8 * fq;
            union { bf16x8 v; unsigned u[4]; } af; af.u[0] = af.u[1] = af.u[2] = af.u[3] = 0u;
            if (fr < 9) { const f32x4 a0 = *(const f32x4*)(mods + (size_t)fr * 6144 + k0), a1 = *(const f32x4*)(mods + (size_t)fr * 6144 + k0 + 4);
                af.u[0] = pk2(a0[0], a0[1]); af.u[1] = pk2(a0[2], a0[3]); af.u[2] = pk2(a1[0], a1[1]); af.u[3] = pk2(a1[2], a1[3]); }
#pragma unroll
            for (int nb = 0; nb < 4; ++nb) { const bf16x8 bfr = *(const bf16x8*)(wt + (size_t)(n0 + 16 * nb + fr) * 1024 + k0); acc[nb] = __builtin_amdgcn_mfma_f32_16x16x32_bf16(af.v, bfr, acc[nb], 0, 0, 0); }
        }
        __syncthreads();
#pragma unroll
        for (int nb = 0; nb < 4; ++nb) *(LAS f32x4*)(red + ((w * 4 + nb) * 64 + lane) * 4) = acc[nb];
        __syncthreads();
        for (int i = F.tid; i < 1024; i += NTHREADS) { float sacc = 0.f;
#pragma unroll
            for (int w8 = 0; w8 < 8; ++w8) sacc += red[w8 * 1024 + i];
            const int nb = i >> 8, ln = (i >> 2) & 63, e = i & 3, r = 4 * (ln >> 4) + e;
            if (r < 9) bo[(size_t)r * (which ? DFF : PNP) + n0 + 16 * nb + (ln & 15)] = sacc; }
    }
}
constexpr int EPI_SIDE_OFF = RING_BYTES;
template <class Sched>
__device__ __forceinline__ void epi_side_fill(Frame& F, const Sched& S, const float* ssq, const float* bias, int ldb) {
    LAS float* side = (LAS float*)(F.lds + EPI_SIDE_OFF);
    pg8::Unit u;
    for (int i = 0; i < 4 && S.next(i, u); ++i) {
        if (F.tid < 256) { const f32x4* p = (const f32x4*)(ssq + (size_t)(u.pm * 256 + F.tid) * 16); const f32x4 a = p[0], b = p[1], c = p[2], d = p[3];
            const float sm = ((a[0] + a[1]) + (a[2] + a[3])) + ((b[0] + b[1]) + (b[2] + b[3])) + ((c[0] + c[1]) + (c[2] + c[3])) + ((d[0] + d[1]) + (d[2] + d[3]));
            side[i * 256 + F.tid] = rsqrtf(sm * (1.f / 1024.f) + EPS); }
        else { const int r = u.pm < 32 ? 0 : 1 + ((u.pm - 32) >> 2); side[1024 + i * 256 + F.tid - 256] = bias[(size_t)r * ldb + u.pn * 256 + F.tid - 256]; }
    }
    __syncthreads();
}
__device__ __forceinline__ void phase_final(Frame& F) {
    const int lane = F.lane; const float* gw = F.in[34];
    for (int row = F.vcu * NWAVES + F.wave; row < M; row += F.G * NWAVES) {
        const bf16_t* xr = (const bf16_t*)(F.ws + OFF_X) + (size_t)row * D;
        f32x4 v[4]; float s = 0.f;
#pragma unroll
        for (int j = 0; j < 4; ++j) { const uint2 q = *(const uint2*)(xr + 4 * lane + 256 * j); v[j] = (f32x4){__uint_as_float(q.x << 16), __uint_as_float(q.x & 0xffff0000u), __uint_as_float(q.y << 16), __uint_as_float(q.y & 0xffff0000u)};
            s += v[j].x * v[j].x + v[j].y * v[j].y + v[j].z * v[j].z + v[j].w * v[j].w; }
        const float rstd = rsqrtf(wave_sum(s) * (1.f / D) + EPS);
        float* o = F.out + (size_t)row * D;
#pragma unroll
        for (int j = 0; j < 4; ++j) { const int c = 4 * lane + 256 * j; const f32x4 g = *(const f32x4*)(gw + c); f32x4 r = {v[j].x * rstd * g.x, v[j].y * rstd * g.y, v[j].z * rstd * g.z, v[j].w * rstd * g.w}; __builtin_nontemporal_store(r, (f32x4*)(o + c)); }
    }
}


typedef short v4i16_t __attribute__((ext_vector_type(4)));
constexpr int AT_KP = 160;
constexpr int AT_TILE = 128 * AT_KP;
constexpr int AT_K0 = 0, AT_V0 = 2 * AT_TILE, AT_RPB = 4 * AT_TILE, AT_END = AT_RPB + 2048;
__device__ __forceinline__ int queue_next(Frame& F, unsigned* ctr) {
    int t_ = F.wave * 64 + lane_id(); asm volatile("" : "+v"(t_));
    unsigned slot = MISC_OFF + 64; asm volatile("" : "+v"(slot));
    volatile LAS unsigned* bw = (volatile LAS unsigned*)(F.lds + slot);
    __syncthreads();
    if (t_ == 0) *bw = atomicAdd(ctr, 1u);
    __syncthreads();
    F.tid = t_; F.lane = t_ & 63;
    return (int)*bw;
}
__device__ __forceinline__ bf16x8 tr2(LAS const unsigned char* a, LAS const unsigned char* b) {
    const v4i16_t x = __builtin_amdgcn_ds_read_tr16_b64_v4i16((LAS v4i16_t*)a), y = __builtin_amdgcn_ds_read_tr16_b64_v4i16((LAS v4i16_t*)b);
    return (bf16x8){x[0], x[1], x[2], x[3], y[0], y[1], y[2], y[3]};
}
struct AttnState { f32x4 o[4]; float m, l; };
template <int NKB, bool MASKED>
__device__ __forceinline__ void attn_tile(AttnState& st, LAS const unsigned char* Kt, LAS const unsigned char* Vt, const bf16x8 (&qf)[2], int c0, int lane,
                                          LAS const float* rpbrow, int cw, int qc) {
    const int fr = lane & 15, fq = lane >> 4;
    f32x4 s[NKB];
#pragma unroll
    for (int kb = 0; kb < NKB; ++kb) {
        s[kb] = (f32x4){0.f, 0.f, 0.f, 0.f};
#pragma unroll
        for (int ks = 0; ks < 2; ++ks) {
            const bf16x8 a = *(LAS const bf16x8*)(Kt + (c0 + 16 * kb + fr) * AT_KP + (32 * ks + 8 * fq) * 2);
            s[kb] = __builtin_amdgcn_mfma_f32_16x16x32_bf16(a, qf[ks], s[kb], 0, 0, 0);
        }
    }
    float mloc = -1e30f;
#pragma unroll
    for (int kb = 0; kb < NKB; ++kb)
#pragma unroll
        for (int i = 0; i < 4; ++i) {
            float t = s[kb][i] * 0.125f;
            if (MASKED) { const int kc = cw + 16 * kb + 4 * fq + i, cs = min(max(qc - 8, 0), 48); t = (kc >= cs && kc < cs + 16) ? t + rpbrow[kc - qc + 15] : -1e30f; }
            s[kb][i] = t; mloc = fmaxf(mloc, t);
        }
    mloc = xmax32(xmax16(mloc));
    const float mn = fmaxf(st.m, mloc), alpha = __expf(st.m - mn);
    st.m = mn;
    float ls = 0.f;
#pragma unroll
    for (int kb = 0; kb < NKB; ++kb)
#pragma unroll
        for (int i = 0; i < 4; ++i) { const float pv = __expf(s[kb][i] - mn); s[kb][i] = pv; ls += pv; }
    st.l = st.l * alpha + ls;
#pragma unroll
    for (int db = 0; db < 4; ++db) st.o[db] = st.o[db] * alpha;
#pragma unroll
    for (int kk = 0; kk < NKB / 2; ++kk) {
        union { bf16x8 v; unsigned u[4]; } pf;
        pf.u[0] = pk2(s[2 * kk][0], s[2 * kk][1]); pf.u[1] = pk2(s[2 * kk][2], s[2 * kk][3]);
        pf.u[2] = pk2(s[2 * kk + 1][0], s[2 * kk + 1][1]); pf.u[3] = pk2(s[2 * kk + 1][2], s[2 * kk + 1][3]);
        LAS const unsigned char* va = Vt + (c0 + 32 * kk + 4 * fq + (fr >> 2)) * AT_KP + (4 * (fr & 3)) * 2;
#pragma unroll
        for (int db = 0; db < 4; ++db) {
            const bf16x8 vf = tr2(va + db * 32, va + 16 * AT_KP + db * 32);
            st.o[db] = __builtin_amdgcn_mfma_f32_16x16x32_bf16(vf, pf.v, st.o[db], 0, 0, 0);
        }
    }
}
struct AttnChain { AttnState st; bf16x8 qf[2]; int qrow, c0; };
__device__ __forceinline__ void attn_chain_init(AttnChain& ch, const bf16_t* proj, int qrow, int c0, int h, bool nat, int fq) {
    ch.qrow = qrow; ch.c0 = c0;
#pragma unroll
    for (int ks = 0; ks < 2; ++ks) ch.qf[ks] = *(const bf16x8*)(proj + (size_t)qrow * PN + PQ + h * 64 + 32 * ks + 8 * fq);
    ch.st.m = -1e30f; ch.st.l = 0.f;
#pragma unroll
    for (int db = 0; db < 4; ++db) ch.st.o[db] = (f32x4){0.f, 0.f, 0.f, 0.f};
}
__device__ __forceinline__ void attn_chain_store(const AttnChain& ch, bf16_t* mixb, int h, int fq) {
    const float inv = 1.f / xsum32(xsum16(ch.st.l));
    bf16_t* mix = mixb + (size_t)ch.qrow * D + 640 + h * 64 + 4 * fq;
#pragma unroll
    for (int db = 0; db < 4; ++db) { uint2 o; o.x = pk2(ch.st.o[db][0] * inv, ch.st.o[db][1] * inv); o.y = pk2(ch.st.o[db][2] * inv, ch.st.o[db][3] * inv); *(uint2*)(mix + 16 * db) = o; }
}
__device__ __forceinline__ void attn_unit(Frame& F, int l, int unit) {
    const int tid = F.tid, w = F.wave, fr = F.lane & 15, fq = F.lane >> 4;
    const bf16_t* proj = (const bf16_t*)(F.ws + OFF_PROJ);
    LAS unsigned char* lds = F.lds;
    const bool nat = unit < 192;
    int b, h, r = 0, rs_w = 0, rs0 = 0, nlat = 0;
    AttnChain ch0, ch1;
    if (nat) { b = unit / 24; h = (unit / 4) % 6; const int rq = unit % 4; r = 4 * rq + (w >> 1);
        rs_w = min(max(r - 4, 0), 8); rs0 = min(max(4 * rq - 4, 0), 8); const int rsl = min(max(4 * rq + 3 - 4, 0), 8); nlat = rsl + 8 - rs0;
        const int qb = MC + b * 1024 + r * 64 + fr;
        if (w & 1) { attn_chain_init(ch0, proj, qb + 32, 24, h, true, fq); attn_chain_init(ch1, proj, qb + 48, 32, h, true, fq); }
        else { attn_chain_init(ch0, proj, qb, 0, h, true, fq); attn_chain_init(ch1, proj, qb + 16, 8, h, true, fq); }
    } else { const int v = unit - 192; b = v / 6; h = v % 6; const int qb = b * 256 + 32 * w + fr;
        attn_chain_init(ch0, proj, qb, 0, h, false, fq); attn_chain_init(ch1, proj, qb + 16, 0, h, false, fq); }
    const int nlt = (nlat + 1) >> 1;
    const int ntiles = nat ? nlt + 2 : 2;
    if (nat) { const float* rpb = F.in[30] + (size_t)(l * 6 + h) * 465; for (int i = tid; i < 465; i += NTHREADS) ((LAS float*)(lds + AT_RPB))[i] = rpb[i]; }
    const int skey = tid >> 2, sch = (tid & 3) * 2;
    v4u rk0 = {0u, 0u, 0u, 0u}, rk1 = rk0, rv0 = rk0, rv1 = rk0;
#define AT_LOAD(ti_) do { const int ti__ = (ti_); \
        if (nat && ti__ >= nlt) { const size_t off = ((size_t)(b * 4 + l) * 256 + (ti__ - nlt) * 128 + skey) * 384 + h * 64 + sch * 8; \
            const bf16_t* pk_ = (const bf16_t*)(F.ws + OFF_CK) + off; const bf16_t* pv_ = (const bf16_t*)(F.ws + OFF_CV) + off; \
            rk0 = *(const v4u*)pk_; rk1 = *(const v4u*)(pk_ + 8); rv0 = *(const v4u*)pv_; rv1 = *(const v4u*)(pv_ + 8); \
        } else { const int grow = nat ? MC + b * 1024 + min(rs0 + 2 * ti__ + (skey >> 6), 15) * 64 + (skey & 63) : b * 256 + ti__ * 128 + skey; \
            const bf16_t* pr = proj + (size_t)grow * PN + h * 64 + sch * 8; rk0 = *(const v4u*)(pr + PK); rk1 = *(const v4u*)(pr + PK + 8); rv0 = *(const v4u*)(pr + PV); rv1 = *(const v4u*)(pr + PV + 8); } } while (0)
#define AT_WRITE(buf_) do { const int buf__ = (buf_); \
        *(LAS v4u*)(lds + AT_K0 + buf__ * AT_TILE + skey * AT_KP + sch * 16) = rk0; *(LAS v4u*)(lds + AT_K0 + buf__ * AT_TILE + skey * AT_KP + sch * 16 + 16) = rk1; \
        *(LAS v4u*)(lds + AT_V0 + buf__ * AT_TILE + skey * AT_KP + sch * 16) = rv0; *(LAS v4u*)(lds + AT_V0 + buf__ * AT_TILE + skey * AT_KP + sch * 16 + 16) = rv1; } while (0)
    AT_LOAD(0); AT_WRITE(0);
    __syncthreads();
    for (int ti = 0; ti < ntiles; ++ti) {
        const int buf = ti & 1;
        if (ti + 1 < ntiles) AT_LOAD(ti + 1);
        int lane = F.lane; asm volatile("" : "+v"(lane));
        LAS const unsigned char* Kt = lds + AT_K0 + buf * AT_TILE; LAS const unsigned char* Vt = lds + AT_V0 + buf * AT_TILE;
        if (nat && ti < nlt) {
#pragma unroll
            for (int sub = 0; sub < 2; ++sub) { const int kr = rs0 + 2 * ti + sub;
                if (kr >= rs_w && kr < rs_w + 8) { LAS const float* rrow = (LAS const float*)(lds + AT_RPB) + (kr - r + 7) * 31;
                    attn_tile<2, true>(ch0.st, Kt, Vt, ch0.qf, 64 * sub + ch0.c0, lane, rrow, ch0.c0, (ch0.qrow - MC) & 63); attn_tile<2, true>(ch1.st, Kt, Vt, ch1.qf, 64 * sub + ch1.c0, lane, rrow, ch1.c0, (ch1.qrow - MC) & 63); }
                __builtin_amdgcn_sched_barrier(0); }
        } else {
#pragma unroll
            for (int hf = 0; hf < 2; ++hf) {
                attn_tile<4, false>(ch0.st, Kt, Vt, ch0.qf, 64 * hf, lane, (LAS const float*)(lds + AT_RPB), 0, 0);
                attn_tile<4, false>(ch1.st, Kt, Vt, ch1.qf, 64 * hf, lane, (LAS const float*)(lds + AT_RPB), 0, 0); __builtin_amdgcn_sched_barrier(0); }
        }
        if (ti + 1 < ntiles) AT_WRITE(buf ^ 1);
        __syncthreads();
    }
    attn_chain_store(ch0, (bf16_t*)(F.ws + OFF_MIX), h, fq); attn_chain_store(ch1, (bf16_t*)(F.ws + OFF_MIX), h, fq);
}
constexpr int SS_P = 144;
constexpr int SS_IMG = 128 * SS_P;
constexpr int SS_HP = 144, SS_HIMG = 64 * SS_HP;
constexpr int SSA_B = 0, SSA_X = SS_IMG, SSA_TAB = 7 * SS_IMG;
constexpr int SSB_B = 0, SSB_C = SS_IMG, SSB_X = 2 * SS_IMG, SSB_H = 5 * SS_IMG, SSB_TAB = 5 * SS_IMG + 6 * SS_HIMG;
static_assert(SSB_TAB + 3 * 4 * 128 * 4 <= 163328 && SSA_TAB + 3 * 4 * 128 * 4 <= 163328, "SSD LDS map");
__device__ __forceinline__ void conv4x8(const bf16_t* proj, const float* cw, const float* cb, int seq_start, int seq_L, int t, int ch0, float (&v)[4][8]) {
    float xin[8][8];
#pragma unroll
    for (int rr = 0; rr < 8; ++rr) { const int tt = t - 2 + rr; v4u r = {0u, 0u, 0u, 0u};
        if (tt >= 0 && tt < seq_L) r = *(const v4u*)(proj + (size_t)(seq_start + tt) * PN + PX + ch0);
#pragma unroll
        for (int e = 0; e < 4; ++e) { xin[rr][2 * e] = __uint_as_float(r[e] << 16); xin[rr][2 * e + 1] = __uint_as_float(r[e] & 0xffff0000u); } }
    const f32x4 b0 = *(const f32x4*)(cb + ch0), b1 = *(const f32x4*)(cb + ch0 + 4);
#pragma unroll
    for (int k = 0; k < 4; ++k) { v[k][0] = b0[0]; v[k][1] = b0[1]; v[k][2] = b0[2]; v[k][3] = b0[3]; v[k][4] = b1[0]; v[k][5] = b1[1]; v[k][6] = b1[2]; v[k][7] = b1[3]; }
#pragma unroll
    for (int j = 0; j < 5; ++j) { const f32x4 w0 = *(const f32x4*)(cw + j * 640 + ch0), w1 = *(const f32x4*)(cw + j * 640 + ch0 + 4);
#pragma unroll
        for (int k = 0; k < 4; ++k) { v[k][0] += w0[0] * xin[k + j][0]; v[k][1] += w0[1] * xin[k + j][1]; v[k][2] += w0[2] * xin[k + j][2]; v[k][3] += w0[3] * xin[k + j][3];
            v[k][4] += w1[0] * xin[k + j][4]; v[k][5] += w1[1] * xin[k + j][5]; v[k][6] += w1[2] * xin[k + j][6]; v[k][7] += w1[3] * xin[k + j][7]; } }
#pragma unroll
    for (int k = 0; k < 4; ++k)
#pragma unroll
        for (int e = 0; e < 8; ++e) v[k][e] = silu_f(v[k][e]);
}
__device__ __forceinline__ void store8(LAS unsigned char* dst, const float (&v)[8], float sc) {
    v4u o; o[0] = pk2(v[0] * sc, v[1] * sc); o[1] = pk2(v[2] * sc, v[3] * sc); o[2] = pk2(v[4] * sc, v[5] * sc); o[3] = pk2(v[6] * sc, v[7] * sc);
    *(LAS v4u*)dst = o;
}
__device__ __forceinline__ void ssd_table(const float* dtraw  , float bias, float a, int dir, LAS float* tab, int lane) {
    const float d0 = softplus_f(dtraw[(2 * lane) * 12] + bias), d1 = softplus_f(dtraw[(2 * lane + 1) * 12] + bias);
    const float ps = d0 + d1; float x = ps;
    x += dppf<0x111>(x); x += dppf<0x112>(x); x += dppf<0x114>(x); x += dppf<0x118>(x);
    { const float t15 = rdlane(x, 15), t31 = rdlane(x, 31), t47 = rdlane(x, 47); const int rw = lane >> 4;
      x += (rw >= 1 ? t15 : 0.f) + (rw >= 2 ? t31 : 0.f) + (rw >= 3 ? t47 : 0.f); }
    tab[2 * lane] = d0; tab[2 * lane + 1] = d1;
    if (dir == 0) { const float ex = x - ps; tab[128 + 2 * lane] = a * (ex + d0); tab[128 + 2 * lane + 1] = a * (ex + ps); }
    else { const float tot = rdlane(x, 63); const float sx = tot - x; tab[128 + 2 * lane + 1] = a * (sx + d1); tab[128 + 2 * lane] = a * (sx + ps); }
}
__device__ __forceinline__ void ssd_a_unit(Frame& F, int l, int unit) {
    const int tid = F.tid, lane = F.lane, w = F.wave, fr = lane & 15, fq = lane >> 4;
    const int ci = unit >> 1, g = unit & 1, row0 = ci * 128;
    const SeqInfo q = row_seq(row0); const int t0 = row0 - q.start;
    const bf16_t* proj = (const bf16_t*)(F.ws + OFF_PROJ);
    const float* cw = F.in[14] + l * 5 * 640; const float* cb = F.in[15] + l * 640;
    LAS unsigned char* lds = F.lds; LAS float* tabs = (LAS float*)(lds + SSA_TAB);
    if (w < 6) { const int hh = w >> 1, dir = w & 1, h = 3 * g + hh;
        ssd_table((const float*)(F.ws + OFF_DT) + (size_t)row0 * 12 + dir * 6 + h, F.in[16][(l * 2 + dir) * 6 + h], -__expf(F.in[17][(l * 2 + dir) * 6 + h]), dir, tabs + (hh * 4 + dir * 2) * 128, lane); }
    float cv[2][4][8];
#pragma unroll
    for (int k2 = 0; k2 < 2; ++k2) { const int task = tid + k2 * NTHREADS, img = task >> 8, oc = (task >> 5) & 7, tb = task & 31;
        conv4x8(proj, cw, cb, q.start, q.L, t0 + 4 * tb, (img == 0 ? 384 + g * 64 : (3 * g + img - 1) * 64) + 8 * oc, cv[k2]); }
    __syncthreads();
#pragma unroll
    for (int k2 = 0; k2 < 2; ++k2) { const int task = tid + k2 * NTHREADS, img = task >> 8, oc = (task >> 5) & 7, tb = task & 31;
        if (img == 0) {
#pragma unroll
            for (int k = 0; k < 4; ++k) store8(lds + SSA_B + (4 * tb + k) * SS_P + oc * 16, cv[k2][k], 1.f);
        } else { const int hh = img - 1; LAS const float* tb4 = tabs + hh * 4 * 128;
#pragma unroll
            for (int k = 0; k < 4; ++k) { const int t = 4 * tb + k;
                const float wf = __expf(tb4[128 + 127] - tb4[128 + t]) * tb4[t], wb = __expf(tb4[384] - tb4[384 + t]) * tb4[256 + t];
                store8(lds + SSA_X + (2 * hh) * SS_IMG + t * SS_P + oc * 16, cv[k2][k], wf); store8(lds + SSA_X + (2 * hh + 1) * SS_IMG + t * SS_P + oc * 16, cv[k2][k], wb); } }
    }
    __syncthreads();
    const int dir = w >> 2, pb = w & 3;
    for (int hh = 0; hh < 3; ++hh) {
        const int h = 3 * g + hh;
        LAS const unsigned char* xa = lds + SSA_X + (2 * hh + dir) * SS_IMG + (4 * fq + (fr >> 2)) * SS_P + (16 * pb + 4 * (fr & 3)) * 2;
        LAS const unsigned char* ba = lds + SSA_B + (4 * fq + (fr >> 2)) * SS_P + (4 * (fr & 3)) * 2;
        f32x4 acc[4];
#pragma unroll
        for (int nb = 0; nb < 4; ++nb) acc[nb] = (f32x4){0.f, 0.f, 0.f, 0.f};
#pragma unroll
        for (int kk = 0; kk < 4; ++kk) {
            const bf16x8 af = tr2(xa + kk * 32 * SS_P, xa + (kk * 32 + 16) * SS_P);
#pragma unroll
            for (int nb = 0; nb < 4; ++nb) { const bf16x8 bfr = tr2(ba + kk * 32 * SS_P + nb * 32, ba + (kk * 32 + 16) * SS_P + nb * 32); acc[nb] = __builtin_amdgcn_mfma_f32_16x16x32_bf16(af, bfr, acc[nb], 0, 0, 0); }
        }
        float* cs = (float*)(F.ws + OFF_CS) + ((size_t)(ci * 6 + h) * 2 + dir) * 4096;
#pragma unroll
        for (int nb = 0; nb < 4; ++nb)
#pragma unroll
            for (int i = 0; i < 4; ++i) cs[(16 * pb + 4 * fq + i) * 64 + 16 * nb + fr] = acc[nb][i];
        if (tid == 0) { LAS const float* tb = tabs + hh * 4 * 128; float* cd = (float*)(F.ws + OFF_TAB + TAB_CD) + (size_t)(ci * 6 + h) * 2; cd[0] = __expf(tb[128 + 127]); cd[1] = __expf(tb[384]); }
    }
}
__device__ __forceinline__ void ssd_state_pass(Frame& F, int l) {
    const int tid = F.tid, p = tid >> 3, n0 = (tid & 7) * 8;
    const float* cdt = (const float*)(F.ws + OFF_TAB + TAB_CD); const float* csb = (const float*)(F.ws + OFF_CS);
    bf16_t* hin = (bf16_t*)(F.ws + OFF_HIN);
    for (int task = F.vcu; task < NSEQ * 12; task += F.G) {
        int s, hd; if (task < LB * 12) { s = CB + task / 12; hd = task % 12; } else { s = (task - LB * 12) / 12; hd = (task - LB * 12) % 12; }
        const int h = hd >> 1, dir = hd & 1;
        const SeqInfo q = seq_info(s); const int nch = q.L >> 7, ci0 = q.start >> 7;
        f32x4 s0 = {0.f, 0.f, 0.f, 0.f}, s1 = s0;
        if (!q.ctx) { const float* h0 = F.in[4] + ((((size_t)q.b * 4 + l) * 2 + dir) * 6 + h) * 4096 + p * 64 + n0; s0 = *(const f32x4*)h0; s1 = *(const f32x4*)(h0 + 4); }
        for (int k = 0; k < nch; k += 2) {
            size_t ix[2]; float dcy[2]; f32x4 c0[2], c1[2];
#pragma unroll
            for (int u = 0; u < 2; ++u) { const int c = dir == 0 ? k + u : nch - 1 - (k + u); ix[u] = (size_t)((ci0 + c) * 6 + h) * 2 + dir;
                dcy[u] = cdt[ix[u]]; const float* cs = csb + ix[u] * 4096 + p * 64 + n0; c0[u] = *(const f32x4*)cs; c1[u] = *(const f32x4*)(cs + 4); }
#pragma unroll
            for (int u = 0; u < 2; ++u) {
                v4u o; o[0] = pk2(s0[0], s0[1]); o[1] = pk2(s0[2], s0[3]); o[2] = pk2(s1[0], s1[1]); o[3] = pk2(s1[2], s1[3]);
                *(v4u*)(hin + ix[u] * 4096 + p * 64 + n0) = o;
                s0 = s0 * dcy[u] + c0[u]; s1 = s1 * dcy[u] + c1[u];
            }
        }
        if (q.ctx) { float* o4 = F.out + O_SSD + ((((size_t)q.b * 4 + l) * 2 + dir) * 6 + h) * 4096 + p * 64 + n0; *(f32x4*)o4 = s0; *(f32x4*)(o4 + 4) = s1; }
    }
}
__device__ __forceinline__ void ssd_b_unit(Frame& F, int l, int unit) {
    const int tid = F.tid, lane = F.lane, w = F.wave, fr = lane & 15, fq = lane >> 4;
    const int ci = unit >> 1, g = unit & 1, row0 = ci * 128;
    const SeqInfo q = row_seq(row0); const int t0 = row0 - q.start;
    const bf16_t* proj = (const bf16_t*)(F.ws + OFF_PROJ);
    const float* cw = F.in[14] + l * 5 * 640; const float* cb = F.in[15] + l * 640;
    LAS unsigned char* lds = F.lds; LAS float* tabs = (LAS float*)(lds + SSB_TAB);
    if (w < 6) { const int hh = w >> 1, dir = w & 1, h = 3 * g + hh;
        ssd_table((const float*)(F.ws + OFF_DT) + (size_t)row0 * 12 + dir * 6 + h, F.in[16][(l * 2 + dir) * 6 + h], -__expf(F.in[17][(l * 2 + dir) * 6 + h]), dir, tabs + (hh * 4 + dir * 2) * 128, lane); }
    {
        const bf16_t* hin = (const bf16_t*)(F.ws + OFF_HIN) + (size_t)((ci * 6 + 3 * g) * 2) * 4096 + (tid >> 3) * 64 + (tid & 7) * 8;
#pragma unroll
        for (int k = 0; k < 6; ++k) *(LAS v4u*)(lds + SSB_H + k * SS_HIMG + (tid >> 3) * SS_HP + (tid & 7) * 16) = *(const v4u*)(hin + (size_t)k * 4096);
    }
    for (int task = tid; task < 1280; task += NTHREADS) {
        const int img = task >> 8, oc = (task >> 5) & 7, tb = task & 31;
        const int chb = img == 0 ? 384 + g * 64 : (img == 1 ? 512 + g * 64 : (3 * g + img - 2) * 64);
        float v[4][8]; conv4x8(proj, cw, cb, q.start, q.L, t0 + 4 * tb, chb + 8 * oc, v);
        LAS unsigned char* dst = lds + (img == 0 ? SSB_B : (img == 1 ? SSB_C : SSB_X + (img - 2) * SS_IMG)) + (4 * tb) * SS_P + oc * 16;
#pragma unroll
        for (int k = 0; k < 4; ++k) store8(dst + k * SS_P, v[k], 1.f);
    }
    __syncthreads();
    bf16x8 cf[2];
#pragma unroll
    for (int ks = 0; ks < 2; ++ks) cf[ks] = *(LAS const bf16x8*)(lds + SSB_C + (16 * w + fr) * SS_P + (32 * ks + 8 * fq) * 2);
    f32x4 gt[8];
#pragma unroll
    for (int sb = 0; sb < 8; ++sb) { gt[sb] = (f32x4){0.f, 0.f, 0.f, 0.f};
#pragma unroll
        for (int ks = 0; ks < 2; ++ks) { const bf16x8 bfr = *(LAS const bf16x8*)(lds + SSB_B + (16 * sb + fr) * SS_P + (32 * ks + 8 * fq) * 2); gt[sb] = __builtin_amdgcn_mfma_f32_16x16x32_bf16(bfr, cf[ks], gt[sb], 0, 0, 0); } }
    float ss[4] = {0.f, 0.f, 0.f, 0.f};
    bf16_t* yup = (bf16_t*)(F.ws + OFF_MIX) + (size_t)(row0 + 16 * w + 4 * fq) * D + fr;
    for (int hh = 0; hh < 3; ++hh) {
        const int h = 3 * g + hh;
        LAS const float* tb = tabs + hh * 4 * 128;
        unsigned short zv[4][4];
#pragma unroll
        for (int i = 0; i < 4; ++i)
#pragma unroll
            for (int pb = 0; pb < 4; ++pb) zv[i][pb] = proj[(size_t)(row0 + 16 * w + 4 * fq + i) * PN + PZ + h * 64 + 16 * pb + fr];
        const float at = tb[128 + 16 * w + fr], bt = tb[384 + 16 * w + fr];
        f32x4 y[4];
#pragma unroll
        for (int pb = 0; pb < 4; ++pb) y[pb] = (f32x4){0.f, 0.f, 0.f, 0.f};
        LAS const unsigned char* xa = lds + SSB_X + hh * SS_IMG + (4 * fq + (fr >> 2)) * SS_P + (4 * (fr & 3)) * 2;
#pragma unroll
        for (int kk = 0; kk < 4; ++kk) {
            float mv[8];
#pragma unroll
            for (int half = 0; half < 2; ++half) { const int sb = 2 * kk + half; const int s0i = 16 * sb + 4 * fq;
                if (sb < w) { const f32x4 cumf = *(LAS const f32x4*)(tb + 128 + s0i), dtf = *(LAS const f32x4*)(tb + s0i);
#pragma unroll
                    for (int i = 0; i < 4; ++i) mv[half * 4 + i] = __expf(at - cumf[i]) * dtf[i] * gt[sb][i];
                } else if (sb > w) { const f32x4 cumb = *(LAS const f32x4*)(tb + 384 + s0i), dtb = *(LAS const f32x4*)(tb + 256 + s0i);
#pragma unroll
                    for (int i = 0; i < 4; ++i) mv[half * 4 + i] = __expf(bt - cumb[i]) * dtb[i] * gt[sb][i];
                } else { const f32x4 cumf = *(LAS const f32x4*)(tb + 128 + s0i), dtf = *(LAS const f32x4*)(tb + s0i), cumb = *(LAS const f32x4*)(tb + 384 + s0i), dtb = *(LAS const f32x4*)(tb + 256 + s0i);
#pragma unroll
                    for (int i = 0; i < 4; ++i) { const int s = s0i + i, t = 16 * w + fr; float m = 0.f;
                        if (s <= t) m += __expf(at - cumf[i]) * dtf[i];
                        if (s >= t) m += __expf(bt - cumb[i]) * dtb[i];
                        mv[half * 4 + i] = m * gt[sb][i]; } } }
            union { bf16x8 v; unsigned u[4]; } mf; mf.u[0] = pk2(mv[0], mv[1]); mf.u[1] = pk2(mv[2], mv[3]); mf.u[2] = pk2(mv[4], mv[5]); mf.u[3] = pk2(mv[6], mv[7]);
#pragma unroll
            for (int pb = 0; pb < 4; ++pb) { const bf16x8 xf = tr2(xa + kk * 32 * SS_P + pb * 32, xa + (kk * 32 + 16) * SS_P + pb * 32); y[pb] = __builtin_amdgcn_mfma_f32_16x16x32_bf16(mf.v, xf, y[pb], 0, 0, 0); }
        }
        f32x4 yf[4], yb[4];
#pragma unroll
        for (int pb = 0; pb < 4; ++pb) { yf[pb] = (f32x4){0.f, 0.f, 0.f, 0.f}; yb[pb] = yf[pb];
#pragma unroll
            for (int ks = 0; ks < 2; ++ks) {
                const bf16x8 hf = *(LAS const bf16x8*)(lds + SSB_H + (2 * hh) * SS_HIMG + (16 * pb + fr) * SS_HP + (32 * ks + 8 * fq) * 2);
                const bf16x8 hb = *(LAS const bf16x8*)(lds + SSB_H + (2 * hh + 1) * SS_HIMG + (16 * pb + fr) * SS_HP + (32 * ks + 8 * fq) * 2);
                yf[pb] = __builtin_amdgcn_mfma_f32_16x16x32_bf16(cf[ks], hf, yf[pb], 0, 0, 0);
                yb[pb] = __builtin_amdgcn_mfma_f32_16x16x32_bf16(cf[ks], hb, yb[pb], 0, 0, 0); } }
        const float dsk = F.in[18][l * 6 + h];
        float nwv[4];
#pragma unroll
        for (int pb = 0; pb < 4; ++pb) nwv[pb] = F.in[19][l * 384 + h * 64 + 16 * pb + fr];
        const f32x4 cumf4 = *(LAS const f32x4*)(tb + 128 + 16 * w + 4 * fq), cumb4 = *(LAS const f32x4*)(tb + 384 + 16 * w + 4 * fq);
#pragma unroll
        for (int i = 0; i < 4; ++i) { const float ef = __expf(cumf4[i]), eb = __expf(cumb4[i]); const int tl = 16 * w + 4 * fq + i;
#pragma unroll
            for (int pb = 0; pb < 4; ++pb) { const float xv = bf2f(*(LAS const bf16_t*)(lds + SSB_X + hh * SS_IMG + tl * SS_P + (16 * pb + fr) * 2));
                const float yv = y[pb][i] + ef * yf[pb][i] + eb * yb[pb][i] + dsk * xv;
                const float gv = yv * silu_f(bf2f(zv[i][pb])); ss[i] += gv * gv;
                yup[(size_t)i * D + h * 64 + 16 * pb] = f2bf(gv * nwv[pb]); } }
    }
#pragma unroll
    for (int i = 0; i < 4; ++i) { const float v = row16_sum(ss[i]);
        if (fr == 0) ((float*)(F.ws + OFF_TAB + TAB_SSQ))[(size_t)(row0 + 16 * w + 4 * fq + i) * 2 + g] = v; }
}
constexpr int S5_HP = 144;
constexpr int S5_IMG = 128 * S5_HP;
constexpr int S5_GP = 528, S5_G = 4 * S5_IMG, S5_END = S5_G + 64 * S5_GP;
typedef float f32x16 __attribute__((ext_vector_type(16)));
typedef float f32x8 __attribute__((ext_vector_type(8)));
__device__ __forceinline__ float swap32sel(float x, int odd) {
    const auto r = __builtin_amdgcn_permlane32_swap(__float_as_uint(x), __float_as_uint(x), false, false);
    return __uint_as_float(odd ? r[1] : r[0]);
}
template <int DIR, bool FULL>
__device__ __forceinline__ void s5_dir(Frame& F, int l, int g, int p, int hi, const bf16x8 (&uf)[2], float& cr, float& ci, f32x16 (&hr)[2], f32x16 (&hq)[2]) {
    const float* ab = (const float*)(F.ws + OFF_TAB + TAB_ABAR) + (size_t)((((l * 2 + DIR) * 16 + g) * 64) + p) * 2;
    const float ar = ab[0], ai = ab[1];
    const float a2r = ar * ar - ai * ai, a2i = 2.f * ar * ai, a3r = a2r * ar - a2i * ai, a3i = a2r * ai + a2i * ar, a4r = a2r * a2r - a2i * a2i, a4i = 2.f * a2r * a2i;
    const bf16_t* bbt = (const bf16_t*)(F.ws + OFF_TAB + TAB_BBT) + ((size_t)(((l * 2 + DIR) * 16 + g) * 2) * 64 + p) * 16 + 8 * hi;
    const bf16x8 bre = *(const bf16x8*)bbt, bim = *(const bf16x8*)(bbt + 64 * 16);
    f32x16 xr[2], xi[2];
#pragma unroll
    for (int rb = 0; rb < 2; ++rb) {
        const f32x16 z = {0.f, 0.f, 0.f, 0.f, 0.f, 0.f, 0.f, 0.f, 0.f, 0.f, 0.f, 0.f, 0.f, 0.f, 0.f, 0.f};
        xr[rb] = __builtin_amdgcn_mfma_f32_32x32x16_bf16(uf[rb], bre, z, 0, 0, 0); xi[rb] = __builtin_amdgcn_mfma_f32_32x32x16_bf16(uf[rb], bim, z, 0, 0, 0);
    }
#pragma unroll
    for (int rb = 0; rb < 2; ++rb)
#pragma unroll
        for (int G4 = 0; G4 < 4; ++G4) {
            if (DIR == 0) {
#pragma unroll
                for (int e = 1; e < 4; ++e) { const int i = 4 * G4 + e; const float pr = xr[rb][i - 1], pi = xi[rb][i - 1]; xr[rb][i] += ar * pr - ai * pi; xi[rb][i] += ar * pi + ai * pr; }
            } else {
#pragma unroll
                for (int e = 2; e >= 0; --e) { const int i = 4 * G4 + e; const float pr = xr[rb][i + 1], pi = xi[rb][i + 1]; xr[rb][i] += ar * pr - ai * pi; xi[rb][i] += ar * pi + ai * pr; }
            }
        }
    f32x8 cinr = {0.f, 0.f, 0.f, 0.f, 0.f, 0.f, 0.f, 0.f}, cini = cinr;
#pragma unroll
    for (int kk = 0; kk < 16; ++kk) {
        const int k = DIR == 0 ? kk : 15 - kk, gi = k >> 1, rb = gi >> 2, il = 4 * (gi & 3) + (DIR == 0 ? 3 : 0), odd = k & 1;
        const bool first = DIR == 0 ? !odd : odd;
        if (first) { cinr[gi] = cr; cini[gi] = ci; } else { const bool own = (hi == odd); cinr[gi] = own ? cr : cinr[gi]; cini[gi] = own ? ci : cini[gi]; }
        const float nr = a4r * cr - a4i * ci + xr[rb][il], ni = a4r * ci + a4i * cr + xi[rb][il];
        cr = swap32sel(nr, odd); ci = swap32sel(ni, odd);
    }
    if (FULL) {
#pragma unroll
        for (int rb = 0; rb < 2; ++rb)
#pragma unroll
            for (int G4 = 0; G4 < 4; ++G4) {
                const int gi = rb * 4 + G4;
#pragma unroll
                for (int e = 0; e < 4; ++e) {
                    const int i = 4 * G4 + e, pw = DIR == 0 ? e + 1 : 4 - e;
                    const float pr = pw == 1 ? ar : (pw == 2 ? a2r : (pw == 3 ? a3r : a4r)), pi = pw == 1 ? ai : (pw == 2 ? a2i : (pw == 3 ? a3i : a4i));
                    hr[rb][i] += xr[rb][i] + pr * cinr[gi] - pi * cini[gi];
                    hq[rb][i] += xi[rb][i] + pr * cini[gi] + pi * cinr[gi];
                }
            }
    }
}
template <bool FULL>
__device__ __forceinline__ void s5_wave_unit(Frame& F, int l, int row0, int g, int ph, float& cfr, float& cfi, float& cbr, float& cbi, LAS unsigned char* himg) {
    const int lane = F.lane, r32 = lane & 31, hi = lane >> 5, p = 32 * ph + r32;
    const bf16_t* proj = (const bf16_t*)(F.ws + OFF_PROJ);
    bf16x8 uf[2];
#pragma unroll
    for (int rb = 0; rb < 2; ++rb) uf[rb] = *(const bf16x8*)(proj + (size_t)(row0 + 32 * rb + r32) * PN + PU + g * 16 + 8 * hi);
    f32x16 hr[2], hq[2];
#pragma unroll
    for (int rb = 0; rb < 2; ++rb) { hr[rb] = (f32x16){0.f, 0.f, 0.f, 0.f, 0.f, 0.f, 0.f, 0.f, 0.f, 0.f, 0.f, 0.f, 0.f, 0.f, 0.f, 0.f}; hq[rb] = hr[rb]; }
    s5_dir<0, FULL>(F, l, g, p, hi, uf, cfr, cfi, hr, hq);
    s5_dir<1, FULL>(F, l, g, p, hi, uf, cbr, cbi, hr, hq);
    if (FULL) {
#pragma unroll
        for (int rb = 0; rb < 2; ++rb)
#pragma unroll
            for (int G4 = 0; G4 < 4; ++G4) { const int t = 32 * rb + 8 * G4 + 4 * hi;
                v2u qr, qi; qr.x = pk2(hr[rb][4 * G4], hr[rb][4 * G4 + 1]); qr.y = pk2(hr[rb][4 * G4 + 2], hr[rb][4 * G4 + 3]); qi.x = pk2(hq[rb][4 * G4], hq[rb][4 * G4 + 1]); qi.y = pk2(hq[rb][4 * G4 + 2], hq[rb][4 * G4 + 3]);
                *(LAS v2u*)(himg + p * S5_HP + t * 2) = qr; *(LAS v2u*)(himg + (64 + p) * S5_HP + t * 2) = qi; }
    }
}
__device__ __forceinline__ void cpow64(float ar, float ai, float& or_, float& oi_) {
#pragma unroll
    for (int s = 0; s < 6; ++s) { const float nr = ar * ar - ai * ai, ni = 2.f * ar * ai; ar = nr; ai = ni; }
    or_ = ar; oi_ = ai;
}
__device__ __forceinline__ void s5_a_unit(Frame& F, int l, int cj) {
    const int w = F.wave, lane = F.lane, row0 = cj * 64;
    float* E = (float*)(F.ws + OFF_E);
    for (int it = w; it < 32; it += NWAVES) {
        const int g = it >> 1, ph = it & 1;
        float cfr = 0.f, cfi = 0.f, cbr = 0.f, cbi = 0.f;
        s5_wave_unit<false>(F, l, row0, g, ph, cfr, cfi, cbr, cbi, F.lds);
        if (lane < 32) { float2 v; v.x = cfr; v.y = cfi; *(float2*)(E + ((size_t)((cj * 2 + 0) * 16 + g) * 64 + 32 * ph + lane) * 2) = v;
                         v.x = cbr; v.y = cbi; *(float2*)(E + ((size_t)((cj * 2 + 1) * 16 + g) * 64 + 32 * ph + lane) * 2) = v; }
    }
}
__device__ __forceinline__ void tk_gen_task(Frame& F, int l, int g, int half) {
    const int lane = F.lane, fr = lane & 15, fq = lane >> 4, w = F.wave;
    const int di = 16 * w + fr;
    f32x4 acc[8];
#pragma unroll
    for (int nb = 0; nb < 8; ++nb) acc[nb] = (f32x4){0.f, 0.f, 0.f, 0.f};
#pragma unroll 1
    for (int c4 = 0; c4 < 4; ++c4) {
        const int dir = c4 >> 1, p0 = 32 * (c4 & 1) + 8 * fq;
        const int ex = dir == 0 ? di - 64 : 64 - di;
        const bool valid = ex >= 0 && ex <= 63;
        const float* ab = (const float*)(F.ws + OFF_TAB + TAB_ABAR) + ((size_t)((l * 2 + dir) * 16 + g) * 64 + p0) * 2;
        float zr[8], zi[8];
#pragma unroll
        for (int e = 0; e < 8; ++e) {
            float br = ab[2 * e], bi = ab[2 * e + 1], rr = 1.f, rq = 0.f; int n = valid ? ex : 0;
#pragma unroll
            for (int bit = 0; bit < 6; ++bit) { const bool on = n & 1; const float nr = rr * br - rq * bi, ni = rr * bi + rq * br; rr = on ? nr : rr; rq = on ? ni : rq; n >>= 1;
                const float s2r = br * br - bi * bi, s2i = 2.f * br * bi; br = s2r; bi = s2i; }
            zr[e] = valid ? rr : 0.f; zi[e] = valid ? rq : 0.f;
        }
        v4u t0, t1;
#pragma unroll
        for (int h2 = 0; h2 < 4; ++h2) { t0[h2] = pk2(zr[2 * h2], zr[2 * h2 + 1]); t1[h2] = pk2(zi[2 * h2], zi[2 * h2 + 1]); }
        const bf16x8 azr = __builtin_bit_cast(bf16x8, t0), azi = __builtin_bit_cast(bf16x8, t1);
        float2 bb[8];
#pragma unroll
        for (int e = 0; e < 8; ++e) bb[e] = ((const float2*)(F.ws + OFF_BB32))[((size_t)((l * 2 + dir) * 16 + g) * 64 + p0 + e) * 16 + fr];
#pragma unroll
        for (int nb = 0; nb < 8; ++nb) {
            size_t co = ((size_t)(l * 16 + g) * 16 + 8 * half + nb) * 64 + p0; if ((nb & 3) == 0 && nb) asm volatile("" : "+v"(co), "+v"(acc[nb - 1]));
            const f32x4 c0 = *(const f32x4*)(F.in[25] + co), c1 = *(const f32x4*)(F.in[25] + co + 4), d0 = *(const f32x4*)(F.in[26] + co), d1 = *(const f32x4*)(F.in[26] + co + 4);
            v4u wre, wim;
#pragma unroll
            for (int h2 = 0; h2 < 4; ++h2) {
                const int e0 = 2 * h2, e1 = e0 + 1;
                const float cr0 = e0 < 4 ? c0[e0] : c1[e0 - 4], ci0 = e0 < 4 ? d0[e0] : d1[e0 - 4], cr1 = e1 < 4 ? c0[e1] : c1[e1 - 4], ci1 = e1 < 4 ? d0[e1] : d1[e1 - 4];
                wre[h2] = pk2(cr0 * bb[e0].x - ci0 * bb[e0].y, cr1 * bb[e1].x - ci1 * bb[e1].y);
                wim[h2] = pk2(-(cr0 * bb[e0].y + ci0 * bb[e0].x), -(cr1 * bb[e1].y + ci1 * bb[e1].x));
            }
            acc[nb] = __builtin_amdgcn_mfma_f32_16x16x32_bf16(azr, __builtin_bit_cast(bf16x8, wre), acc[nb], 0, 0, 0);
            acc[nb] = __builtin_amdgcn_mfma_f32_16x16x32_bf16(azi, __builtin_bit_cast(bf16x8, wim), acc[nb], 0, 0, 0);
        }
    }
    bf16_t* tk = (bf16_t*)(F.ws + OFF_TK) + (size_t)(l * 16 + g) * 128 * 256;
#pragma unroll
    for (int nb = 0; nb < 8; ++nb) { const int co = 8 * half + nb; const float dsk = F.in[27][l * 256 + g * 16 + co];
#pragma unroll
        for (int i = 0; i < 4; ++i) { const int dr = 16 * w + 4 * fq + i; tk[(size_t)dr * 256 + co * 16 + fr] = f2bf(acc[nb][i] + ((dr == 64 && co == fr) ? dsk : 0.f)); } }
}
constexpr int S5C_PL = 1536, S5C_H = 32 * S5C_PL, S5C_RING = S5C_H + 16384, S5C_PT0 = S5C_RING + 32768;
constexpr size_t OFF_GS5 = 154 * MiB;
__device__ __forceinline__ void s5c_unit(Frame& F, int l, int u) {
    const int w = F.wave, gp = u & 7, cg = u >> 3, g0 = 2 * gp, row0 = cg * 512, cj0 = cg * 8;
    const bf16_t* proj = (const bf16_t*)(F.ws + OFF_PROJ);
    LAS unsigned char* lds = F.lds;
    int ln = F.tid; asm volatile("" : "+v"(ln)); ln &= 63; const int fr = ln & 15, fq = ln >> 4;
    const int gl = w & 1, g = g0 + gl, cp = w >> 1;
    const bf16_t* tkw = (const bf16_t*)(F.ws + OFF_TK) + (size_t)(l * 16 + g) * 128 * 256 + (size_t)(fq >> 1) * 256 + fr * 16 + 8 * (fq & 1) + (size_t)(4 * cp) * 256;
    LAS unsigned char* ringw = lds + S5C_RING + (gl * 8 + 2 * cp) * 1024 + ln * 16;
    LAS const unsigned char* ringr = lds + S5C_RING + (gl * 8) * 1024 + ln * 16;
    v4u tf[8][2];
    {
        const int tid = F.tid;
        v4u uu[4], hh[2];
#pragma unroll
        for (int k = 0; k < 4; ++k) { const int i = tid + k * NTHREADS, token = i >> 2; uu[k] = *(const v4u*)(proj + (size_t)(row0 + token) * PN + PU + (g0 + ((i >> 1) & 1)) * 16 + 8 * (i & 1)); }
#pragma unroll
        for (int k = 0; k < 2; ++k) { const int i = tid + k * NTHREADS; hh[k] = *(const v4u*)((const float*)(F.ws + OFF_H5) + ((size_t)(((cj0 + (i >> 7)) * 2 + ((i >> 6) & 1)) * 16 + g0) * 64) * 2 + 4 * (i & 63)); }
#pragma unroll
        for (int jb = 0; jb < 8; ++jb) { tf[jb][0] = *(const v4u*)(tkw + (size_t)(16 * jb) * 256); tf[jb][1] = *(const v4u*)(tkw + (size_t)(16 * jb + 2) * 256); }
#pragma unroll
        for (int k = 0; k < 2; ++k) { const int i = tid + k * NTHREADS, r = i & 31; *(LAS v4u*)(lds + (i >> 5) * S5C_PL + (r < 16 ? r : 64 + r) * 16) = (v4u){0u, 0u, 0u, 0u}; }
#pragma unroll
        for (int k = 0; k < 4; ++k) { const int i = tid + k * NTHREADS, token = i >> 2; *(LAS v4u*)(lds + (((token >> 6) * 2 + ((i >> 1) & 1)) * 2 + (i & 1)) * S5C_PL + (16 + (token & 63)) * 16) = uu[k]; }
#pragma unroll
        for (int k = 0; k < 2; ++k) { const int i = tid + k * NTHREADS; *(LAS v4u*)(lds + S5C_H + 16 * i) = hh[k]; }
        *(LAS v4u*)ringw = tf[0][0]; *(LAS v4u*)(ringw + 1024) = tf[0][1];
    }
    __syncthreads();
    f32x4 acc[2][4];
#pragma unroll
    for (int ch = 0; ch < 2; ++ch)
#pragma unroll
        for (int tb = 0; tb < 4; ++tb) acc[ch][tb] = (f32x4){0.f, 0.f, 0.f, 0.f};
    LAS const unsigned char* ulo = lds + (((2 * cp) * 2 + gl) * 2 + (fq & 1)) * S5C_PL + (fr + 2 - (fq >> 1)) * 16;
    f32x4 cc[8];
    v4u pf[2][4];
#pragma unroll
    for (int jo = 0; jo < 8; ++jo) {
        if (jo == 4) {
#pragma unroll
            for (int hp = 0; hp < 2; ++hp) { const size_t co = ((size_t)(l * 16 + g) * 16 + fr) * 64 + 32 * hp + 8 * fq;
                cc[4 * hp] = *(const f32x4*)(F.in[25] + co); cc[4 * hp + 1] = *(const f32x4*)(F.in[25] + co + 4); cc[4 * hp + 2] = *(const f32x4*)(F.in[26] + co); cc[4 * hp + 3] = *(const f32x4*)(F.in[26] + co + 4); }
#pragma unroll
            for (int dir = 0; dir < 2; ++dir)
#pragma unroll
                for (int ks = 0; ks < 4; ++ks) pf[dir][ks] = *(const v4u*)((const bf16_t*)(F.ws + OFF_PT64) + ((size_t)((l * 2 + dir) * 16 + g) * 64 + 16 * cp + fr) * 128 + 8 * fq + 32 * ks);
        }
        bf16x8 a[8];
#pragma unroll
        for (int ji = 0; ji < 8; ++ji) a[ji] = *(LAS const bf16x8*)(ringr + (jo & 1) * 16384 + ji * 1024);
        __builtin_amdgcn_sched_barrier(0);
        {
            const int tb_lo = jo > 4 ? jo - 4 : 0, tb_hi = jo < 3 ? jo : 3, ntb = tb_hi - tb_lo + 1, ns = 16 * ntb;
            bf16x8 bq[8];
#pragma unroll
            for (int s = 0; s < 8; ++s) bq[s] = *(LAS const bf16x8*)(ulo + (s % 2) * (4 * S5C_PL) + (2 * (39 - 8 * (jo - (tb_lo + (s / 2) % ntb)) - s / (2 * ntb))) * 16);
            __builtin_amdgcn_sched_barrier(0);
#pragma unroll
            for (int s = 0; s < ns; ++s) {
                const int ch = s % 2, tb = tb_lo + (s / 2) % ntb, ji = s / (2 * ntb);
                acc[ch][tb] = __builtin_amdgcn_mfma_f32_16x16x32_bf16(a[ji], bq[s & 7], acc[ch][tb], 0, 0, 0);
                if (s + 8 < ns) { const int s2 = s + 8; bq[s & 7] = *(LAS const bf16x8*)(ulo + (s2 % 2) * (4 * S5C_PL) + (2 * (39 - 8 * (jo - (tb_lo + (s2 / 2) % ntb)) - s2 / (2 * ntb))) * 16); }
                __builtin_amdgcn_sched_barrier(0);
            }
        }
        if (jo < 7) { *(LAS v4u*)(ringw + ((jo + 1) & 1) * 16384) = tf[jo + 1][0]; *(LAS v4u*)(ringw + ((jo + 1) & 1) * 16384 + 1024) = tf[jo + 1][1]; }
        else {
#pragma unroll
            for (int ks = 0; ks < 4; ++ks) *(LAS v4u*)(lds + S5C_PT0 + (gl * 16 + 4 * cp + ks) * 1024 + ln * 16) = pf[0][ks];
        }
        __syncthreads();
    }
#pragma unroll
    for (int ks = 0; ks < 4; ++ks) *(LAS v4u*)(lds + S5C_RING + (gl * 16 + 4 * cp + ks) * 1024 + ln * 16) = pf[1][ks];
#pragma unroll
    for (int dir = 0; dir < 2; ++dir) {
        if (dir == 1) __syncthreads();
        bf16x8 rg[16];
#pragma unroll
        for (int i = 0; i < 16; ++i) rg[i] = *(LAS const bf16x8*)(lds + (dir == 0 ? S5C_PT0 : S5C_RING) + (gl * 16 + i) * 1024 + ln * 16);
#pragma unroll
        for (int ch = 0; ch < 2; ++ch) {
            v4u fA[4];
#pragma unroll
            for (int hp = 0; hp < 2; ++hp) {
                const int p0 = 32 * hp + 8 * fq;
#pragma unroll
                for (int e2 = 0; e2 < 4; ++e2) { const f32x4 h = *(LAS const f32x4*)(lds + S5C_H + ((((2 * cp + ch) * 2 + dir) * 2 + gl) * 64 + p0 + 2 * e2) * 8);
                    const int e0 = 2 * e2, e1 = e0 + 1;
                    const float cr0 = e0 < 4 ? cc[4 * hp][e0] : cc[4 * hp + 1][e0 - 4], ci0 = e0 < 4 ? cc[4 * hp + 2][e0] : cc[4 * hp + 3][e0 - 4], cr1 = e1 < 4 ? cc[4 * hp][e1] : cc[4 * hp + 1][e1 - 4], ci1 = e1 < 4 ? cc[4 * hp + 2][e1] : cc[4 * hp + 3][e1 - 4];
                    fA[hp][e2] = pk2(cr0 * h[0] - ci0 * h[1], cr1 * h[2] - ci1 * h[3]); fA[2 + hp][e2] = pk2(-(cr0 * h[1] + ci0 * h[0]), -(cr1 * h[3] + ci1 * h[2])); }
            }
#pragma unroll
            for (int tb = 0; tb < 4; ++tb)
#pragma unroll
                for (int ks = 0; ks < 4; ++ks) acc[ch][tb] = __builtin_amdgcn_mfma_f32_16x16x32_bf16(__builtin_bit_cast(bf16x8, fA[ks]), rg[4 * tb + ks], acc[ch][tb], 0, 0, 0);
        }
        __builtin_amdgcn_sched_barrier(0);
    }
    bf16_t* gs = (bf16_t*)(F.ws + OFF_GS5) + (size_t)(row0 + 128 * cp + fr) * 256 + g * 16 + 4 * fq;
#pragma unroll
    for (int ch = 0; ch < 2; ++ch)
#pragma unroll
        for (int tb = 0; tb < 4; ++tb) { v2u o; o.x = pk2(gelu_tanh_f(acc[ch][tb][0]), gelu_tanh_f(acc[ch][tb][1])); o.y = pk2(gelu_tanh_f(acc[ch][tb][2]), gelu_tanh_f(acc[ch][tb][3]));
            *(v2u*)(gs + (size_t)(64 * ch + 16 * tb) * 256) = o; }
}
__device__ __forceinline__ void glu_unit(Frame& F, int l, int u) {
    const int w = F.wave, row0 = 64 * u;
    LAS unsigned char* lds = F.lds;
    int ln3 = F.tid; asm volatile("" : "+v"(ln3)); ln3 &= 63; const int fr = ln3 & 15, fq = ln3 >> 4;
    const bf16_t* wg = (const bf16_t*)(F.ws + OFF_WGLU) + (size_t)l * 65536 + (size_t)(32 * w + fr) * 256 + 8 * fq;
    {
        const int tid = F.tid; v4u gg[4];
#pragma unroll
        for (int k = 0; k < 4; ++k) { const int i = tid + k * NTHREADS; gg[k] = *(const v4u*)((const bf16_t*)(F.ws + OFF_GS5) + (size_t)(row0 + (i >> 5)) * 256 + 8 * (i & 31)); }
#pragma unroll
        for (int k = 0; k < 4; ++k) { const int i = tid + k * NTHREADS; *(LAS v4u*)(lds + (i >> 5) * S5_GP + 16 * (i & 31)) = gg[k]; }
    }
    bf16x8 b0[8], b1[8];
#pragma unroll
    for (int ks = 0; ks < 8; ++ks) { b0[ks] = *(const bf16x8*)(wg + ks * 32); b1[ks] = *(const bf16x8*)(wg + 16 * 256 + ks * 32); }
    __syncthreads();
    f32x4 acc[2][4];
#pragma unroll
    for (int a = 0; a < 2; ++a)
#pragma unroll
        for (int tb = 0; tb < 4; ++tb) acc[a][tb] = (f32x4){0.f, 0.f, 0.f, 0.f};
#pragma unroll
    for (int ks = 0; ks < 8; ++ks)
#pragma unroll
        for (int tb = 0; tb < 4; ++tb) { const bf16x8 a = *(LAS const bf16x8*)(lds + (16 * tb + fr) * S5_GP + ks * 64 + 16 * fq);
            acc[0][tb] = __builtin_amdgcn_mfma_f32_16x16x32_bf16(b0[ks], a, acc[0][tb], 0, 0, 0); acc[1][tb] = __builtin_amdgcn_mfma_f32_16x16x32_bf16(b1[ks], a, acc[1][tb], 0, 0, 0); }
#pragma unroll
    for (int a = 0; a < 2; ++a) { const int n0 = 32 * w + 16 * a + 4 * fq; const f32x4 bg = *(const f32x4*)(F.in[29] + l * 256 + n0);
#pragma unroll
        for (int tb = 0; tb < 4; ++tb) { const int t = 16 * tb + fr; const v2u gq = *(LAS const v2u*)(lds + t * S5_GP + n0 * 2);
            const float g0 = __uint_as_float(gq.x << 16), g1 = __uint_as_float(gq.x & 0xffff0000u), g2 = __uint_as_float(gq.y << 16), g3 = __uint_as_float(gq.y & 0xffff0000u);
            v2u o; o.x = pk2(g0 * sigmoid_f(acc[a][tb][0] + bg[0]), g1 * sigmoid_f(acc[a][tb][1] + bg[1])); o.y = pk2(g2 * sigmoid_f(acc[a][tb][2] + bg[2]), g3 * sigmoid_f(acc[a][tb][3] + bg[3]));
            *(v2u*)((bf16_t*)(F.ws + OFF_MIX) + (size_t)(row0 + t) * D + 384 + n0) = o; } }
}

__device__ __forceinline__ void s5_state_pass(Frame& F, int l) {
    const float* E = (const float*)(F.ws + OFF_E); float* H5 = (float*)(F.ws + OFF_H5);
    for (int idx = F.vcu * NTHREADS + F.tid; idx < NSEQ * 2048; idx += F.G * NTHREADS) {
        const int p = idx & 63, g = (idx >> 6) & 15, dir = (idx >> 10) & 1, sq = idx >> 11;
        const int s_ = sq < LB ? CB + sq : sq - LB;
        const SeqInfo q = seq_info(s_); const int nj = q.L >> 6, cj0 = q.start >> 6;
        const float* ab = (const float*)(F.ws + OFF_TAB + TAB_ABAR) + (size_t)((((l * 2 + dir) * 16 + g) * 64) + p) * 2;
        float a64r, a64i; cpow64(ab[0], ab[1], a64r, a64i);
        float cr = 0.f, ci = 0.f;
        if (!q.ctx) { const size_t o = (((size_t)q.b * 4 + l) * 2 + dir) * 1024 + g * 64 + p; cr = F.in[5][o]; ci = F.in[6][o]; }
        for (int k = 0; k < nj; k += 4) {
            float2 e[4];
#pragma unroll
            for (int u = 0; u < 4; ++u) { const int jj = dir == 0 ? k + u : nj - 1 - (k + u); e[u] = *(const float2*)(E + ((size_t)(((cj0 + jj) * 2 + dir) * 16 + g) * 64 + p) * 2); }
#pragma unroll
            for (int u = 0; u < 4; ++u) { const int jj = dir == 0 ? k + u : nj - 1 - (k + u);
                float2 hv; hv.x = cr; hv.y = ci; *(float2*)(H5 + ((size_t)(((cj0 + jj) * 2 + dir) * 16 + g) * 64 + p) * 2) = hv;
                const float nr = a64r * cr - a64i * ci + e[u].x, ni = a64r * ci + a64i * cr + e[u].y; cr = nr; ci = ni; }
        }
        if (q.ctx) { const size_t o = (((size_t)q.b * 4 + l) * 2 + dir) * 1024 + g * 64 + p; F.out[O_RE + o] = cr; F.out[O_IM + o] = ci; }
    }
}
__device__ __forceinline__ void phase_mixa(Frame& F, int l) {
    unsigned* ctr = F.ctl + CW_Q + 64 * (l * 8);
    const int nbias = l + 1 < DEPTH ? 104 : 0;
    int u = F.vcu;
#define QNEXT() (F.G + queue_next(F, ctr))
    while (u < 192) { attn_unit(F, l, u); u = QNEXT(); }
    while (u < 448) { ssd_a_unit(F, l, u - 192); u = QNEXT(); }
    while (u < 640) { attn_unit(F, l, 192 + u - 448); u = QNEXT(); }
    while (u < 896) { s5_a_unit(F, l, u - 640); u = QNEXT(); }
    while (u < 896 + nbias) { bias_task(F, l + 1, u - 896); u = QNEXT(); }
}
__device__ __forceinline__ void phase_mixb(Frame& F, int l) {
    unsigned* ctr = F.ctl + CW_Q + 64 * (l * 8 + 4);
    int u = F.vcu;
    while (u < 256) { ssd_b_unit(F, l, u); u = QNEXT(); }
    while (u < 512) { s5c_unit(F, l, u - 256); u = QNEXT(); }
}
__device__ __forceinline__ void phase_mixc(Frame& F, int l) { for (int u = F.vcu; u < 256; u += F.G) glu_unit(F, l, u); }
#undef QNEXT

struct Args { const float* in[35]; float* out; unsigned char* ws; int ph_lo, ph_hi, li, pad; };
#ifdef MK_PHASE_RANGE
#define IN(k) (lo <= (k) && (k) < hi)
#else
#define IN(k) true
#endif
#define REFRESH() do { int t_ = F.wave * 64 + lane_id(); asm volatile("" : "+v"(t_)); F.tid = t_; F.lane = t_ & 63; \
        GAS unsigned char* w_ = (GAS unsigned char*)args.ws; asm volatile("" : "+s"(w_)); F.ws = (unsigned char*)w_; F.ctl = (unsigned*)(w_ + OFF_CTL); GAS float* o_ = (GAS float*)args.out; asm volatile("" : "+s"(o_)); F.out = (float*)o_; \
        const GAS float* const* i_ = (const GAS float* const*)__builtin_amdgcn_kernarg_segment_ptr(); asm volatile("" : "+s"(i_)); F.in.p = i_; \
        int g_ = gridDim.x, v_ = vcu0; asm volatile("" : "+s"(g_), "+s"(v_)); F.G = g_; F.vcu = v_; modsb = (const float*)(F.ws + OFF_MODS); XB = (bf16_t*)(F.ws + OFF_X); } while (0)
#define SEAM(k) do { if (IN(k) && IN((k) + 1) && (k) + 1 < PH_END) xcd_barrier(bar, F.wave == 0 && lane_id() == 0); } while (0)
template <int l>
__device__ __forceinline__ void layer_body(Frame& F, const Args& args, const XcdBarrier& bar, const int vcu0) {
    const int lo = args.ph_lo, hi = args.ph_hi; (void)lo; (void)hi;
    const float* modsb = (const float*)(F.ws + OFF_MODS);
    bf16_t* XB = (bf16_t*)(F.ws + OFF_X);
        const int pb = PH_L0 + l * PH_PER_LAYER;
        if (IN(pb + PH_G1)) { REFRESH();
            pg8::Gemm g{(const bf16_t*)(F.ws + OFF_H), (const bf16_t*)(F.ws + OFF_WIN) + (size_t)l * PNP * 1024, M, PNP, 1024}; pg8::StaticOrder S; S.init(M, PNP, F.G, (int)blockIdx.x);
            epi_side_fill(F, S, (const float*)(F.ws + OFF_TAB + TAB_SQ1), (const float*)(F.ws + OFF_TAB + TAB_B1) + (size_t)l * 9 * PNP, PNP);
            pg8::EpiProj E{(bf16_t*)(F.ws + OFF_PROJ), F.out + O_K, F.out + O_V, (float*)(F.ws + OFF_DT), (LAS const float*)(F.lds + EPI_SIDE_OFF), l, 0};
            pg8::gemm_phase<pg8::EpiProj, pg8::StaticOrder, true, true>(F.lds, g, S, E, F.wave);
            { pg8::Unit u3; if (l + 1 < DEPTH && !S.next(2, u3)) { REFRESH(); transpose_layer_queue(F, l + 1, F.ctl + CW_Q + 64 * (48 + l)); } }
        }
        SEAM(pb + PH_G1);
        if (IN(pb + PH_MIXA)) { REFRESH(); phase_mixa(F, l); }
        SEAM(pb + PH_MIXA);
        if (IN(pb + PH_MIXB)) { REFRESH(); ssd_state_pass(F, l); s5_state_pass(F, l); xcd_barrier(bar, F.wave == 0 && lane_id() == 0); REFRESH(); phase_mixb(F, l); xcd_barrier(bar, F.wave == 0 && lane_id() == 0); REFRESH(); phase_mixc(F, l); }
        SEAM(pb + PH_MIXB);
        if (IN(pb + PH_G3)) { REFRESH();
            pg8::Gemm g{(const bf16_t*)(F.ws + OFF_MIX), (const bf16_t*)(F.ws + OFF_WOUT) + (size_t)l * 1024 * 1024, M, D, 1024}; pg8::StaticOrder S; S.init(M, D, F.G, (int)blockIdx.x);
            { pg8::Unit u; if (S.next(0, u) && F.tid < 256) { const float* q2 = (const float*)(F.ws + OFF_TAB + TAB_SSQ) + (size_t)(u.pm * 256 + F.tid) * 2;
                ((LAS float*)(F.lds + EPI_SIDE_OFF))[F.tid] = rsqrtf((q2[0] + q2[1]) * (1.f / 384.f) + EPS); } __syncthreads(); }
            typedef pg8::EpiRes<6, l == 0> Epi3;
            Epi3 E{l == 0 ? (const void*)F.in[0] : (const void*)XB, l == 0 ? (const void*)(F.in[1] - (size_t)MC * D) : (const void*)XB, XB, modsb + (size_t)l * 9 * 6144 + 2 * 1024, F.in[12] + l * D, modsb + (size_t)l * 9 * 6144 + 4 * 1024,
                   (bf16_t*)(F.ws + OFF_H), (float*)(F.ws + OFF_TAB + TAB_SQ2), (LAS const float*)(F.lds + EPI_SIDE_OFF)};
            pg8::gemm_phase<Epi3, pg8::StaticOrder, true, true>(F.lds, g, S, E, F.wave);
        }
        SEAM(pb + PH_G3);
        if (IN(pb + PH_G4)) { REFRESH();
            pg8::Gemm g{(const bf16_t*)(F.ws + OFF_H), (const bf16_t*)(F.ws + OFF_WFF1) + (size_t)l * DFF * 1024, M, DFF, 1024}; pg8::StaticOrder S; S.init(M, DFF, F.G, (int)blockIdx.x);
            epi_side_fill(F, S, (const float*)(F.ws + OFF_TAB + TAB_SQ2), (const float*)(F.ws + OFF_TAB + TAB_B2) + (size_t)l * 9 * DFF, DFF);
            pg8::EpiFF1 E{(bf16_t*)(F.ws + OFF_FFH), (LAS const float*)(F.lds + EPI_SIDE_OFF), 0};
            pg8::gemm_phase<pg8::EpiFF1, pg8::StaticOrder, true, true>(F.lds, g, S, E, F.wave);
        }
        SEAM(pb + PH_G4);
        if (IN(pb + PH_G5)) { REFRESH();
            pg8::Gemm g{(const bf16_t*)(F.ws + OFF_FFH), (const bf16_t*)(F.ws + OFF_WFF2) + (size_t)l * 1024 * DFF, M, D, DFF}; pg8::StaticOrder S; S.init(M, D, F.G, (int)blockIdx.x);
            const int ln = l + 1 < DEPTH ? l + 1 : l;
            typedef pg8::EpiRes<0, false> Epi5;
            Epi5 E{(const void*)XB, (const void*)XB, XB, modsb + (size_t)l * 9 * 6144 + 5 * 1024, F.in[11] + ln * D, modsb + (size_t)ln * 9 * 6144 + 1 * 1024,
                   l + 1 < DEPTH ? (bf16_t*)(F.ws + OFF_H) : (bf16_t*)nullptr, (float*)(F.ws + OFF_TAB + TAB_SQ1), (LAS const float*)(F.lds + EPI_SIDE_OFF)};
            pg8::gemm_phase<Epi5, pg8::StaticOrder, true, true>(F.lds, g, S, E, F.wave);
        }
        SEAM(pb + PH_G5);
    }
__global__ void __launch_bounds__(NTHREADS, 2) mega(Args args) {
    extern __shared__ __attribute__((aligned(16))) unsigned char lds[];
    Frame F;
    F.lds = (LAS unsigned char*)lds;
    F.MISC = (volatile LAS unsigned*)(F.lds + MISC_OFF);
    F.tid = threadIdx.x; F.lane = F.tid & 63; F.wave = __builtin_amdgcn_readfirstlane(F.tid >> 6);
    F.G = gridDim.x; { const int bx = blockIdx.x; F.vcu = (F.G % 8 == 0) ? (bx % 8) * (F.G / 8) + bx / 8 : bx; }
    { const GAS float* const* inp = (const GAS float* const*)__builtin_amdgcn_kernarg_segment_ptr(); asm volatile("" : "+s"(inp)); F.in.p = inp; }
    F.out = args.out; F.ws = args.ws; F.ctl = (unsigned*)(args.ws + OFF_CTL);
    for (int u = F.tid; u < (LDS_BYTES - LDSCTL_OFF) / 4; u += NTHREADS) ((LAS unsigned*)(F.lds + LDSCTL_OFF))[u] = 0u;
    __syncthreads();
    XcdBarrier bar = xcd_barrier_post(F.ctl + CW_BAR + args.li * XCD_BAR_WORDS, F.MISC + 8);
    const int lo = args.ph_lo, hi = args.ph_hi; (void)lo; (void)hi;
    const float* modsb = (const float*)(F.ws + OFF_MODS);
    bf16_t* XB = (bf16_t*)(F.ws + OFF_X);
    const int vcu0 = F.vcu;
    if (IN(PH_PRO)) phase_prologue(F);
    SEAM(PH_PRO);
    if (IN(PH_PRE)) { REFRESH(); phase_pre(F); }
    SEAM(PH_PRE);
    layer_body<0>(F, args, bar, vcu0); layer_body<1>(F, args, bar, vcu0); layer_body<2>(F, args, bar, vcu0); layer_body<3>(F, args, bar, vcu0);
    if (IN(PH_FINAL)) phase_final(F);
#undef IN
#undef SEAM
}
static void launch_mega(const Args& base, int lo, int hi, int li, hipStream_t stream) {
    Args a = base; a.ph_lo = lo; a.ph_hi = hi; a.li = li;
    hipLaunchKernelGGL(mega, dim3(256), dim3(NTHREADS), LDS_BYTES, stream, a);
}
extern "C" void kernel_launch(void* const* d_in, const int* in_sizes, int n_in, void* d_out, int out_size, void* d_ws, size_t ws_size, hipStream_t stream) {
    static int ready = 0;
    if (!ready) {
        if (n_in != 35 || out_size != (int)O_END || ws_size < WS_END) { fprintf(stderr, "kernel_launch: unexpected shapes n_in %d out %d ws %zu\n", n_in, out_size, ws_size); ready = -1; return; }
        if (hipFuncSetAttribute((const void*)mega, hipFuncAttributeMaxDynamicSharedMemorySize, LDS_BYTES) != hipSuccess) { fprintf(stderr, "kernel_launch: hipFuncSetAttribute failed\n"); ready = -1; return; }
        ready = 1;
    }
    if (ready < 0) return;
    Args a{}; for (int i = 0; i < 35; ++i) a.in[i] = (const float*)d_in[i]; a.out = (float*)d_out; a.ws = (unsigned char*)d_ws;
    (void)hipMemsetAsync((char*)d_ws + OFF_CTL, 0, CTL_ZERO_BYTES, stream);
    launch_mega(a, 0, PH_END, 0, stream);
}
```

```cpp
#include <hip/hip_runtime.h>
#include <stdint.h>
#include <stdio.h>

typedef unsigned short bf16_t;
typedef short bf16x8 __attribute__((ext_vector_type(8)));
typedef float f32x4 __attribute__((ext_vector_type(4)));

constexpr int D = 1024, DEPTH = 4;
constexpr int CB = 32, CL = 256, LB = 8, LL = 1024;
constexpr int MC = CB * CL;
constexpr int M = MC + LB * LL;
constexpr int NSEQ = CB + LB;
constexpr int IN_COLS = 2444;
constexpr int PN = 2432, PNP = 2560;
constexpr int PZ = 0, PX = 384, PU = 1024, PQ = 1280, PK = 1664, PV = 2048;
constexpr int DFF = 4096;
constexpr float EPS = 1e-6f;

constexpr size_t MiB = 1u << 20;
constexpr size_t OFF_CTL = 0, OFF_MODS = 1 * MiB, OFF_TAB = 2 * MiB, OFF_WIN = 8 * MiB, OFF_WOUT = 28 * MiB, OFF_WFF1 = 36 * MiB,
                 OFF_WFF2 = 68 * MiB, OFF_WGLU = 100 * MiB, OFF_DT = 101 * MiB, OFF_X = 102 * MiB, OFF_PROJ = 166 * MiB, OFF_MIX = 242 * MiB,
                 OFF_FFH = 166 * MiB, OFF_H = 294 * MiB, WS_END = 374 * MiB;
constexpr size_t TAB_ABAR = 0;
constexpr size_t TAB_SQ1 = 256 * 1024;
constexpr size_t TAB_SQ2 = 1280 * 1024;
constexpr size_t TAB_B1 = 2304 * 1024;
constexpr size_t TAB_B2 = 4352 * 1024;
constexpr size_t TAB_SSQ = 5 * MiB;
constexpr size_t OFF_TK = 146 * MiB;
constexpr size_t OFF_PT64 = 150 * MiB;
constexpr size_t OFF_BB32 = 162 * MiB;
constexpr size_t OFF_CK = 134 * MiB, OFF_CV = 140 * MiB;
constexpr size_t OFF_H5 = 326 * MiB;
constexpr size_t OFF_HIN = 362 * MiB;
constexpr size_t TAB_CD = 3 * MiB;
constexpr size_t OFF_CS = 334 * MiB;
constexpr size_t TAB_CC1 = 4 * MiB;
constexpr size_t TAB_BBT = 3 * MiB + 512 * 1024;
constexpr size_t OFF_E = 358 * MiB;

__device__ __forceinline__ int lane_id() { unsigned z = 0u; asm volatile("" : "+v"(z)); return (int)__builtin_amdgcn_mbcnt_hi(~0u, __builtin_amdgcn_mbcnt_lo(~0u, z)); }
__device__ __forceinline__ float bf2f(bf16_t v) { return __uint_as_float((unsigned)v << 16); }
typedef float f32x2_t __attribute__((ext_vector_type(2))); typedef __bf16 bf16x2_t __attribute__((ext_vector_type(2)));
__device__ __forceinline__ unsigned cvtpk(float lo, float hi) { f32x2_t v = {lo, hi}; bf16x2_t b = __builtin_convertvector(v, bf16x2_t); return __builtin_bit_cast(unsigned, b); }
__device__ __forceinline__ bf16_t f2bf(float f) { return (bf16_t)(cvtpk(f, f) & 0xffffu); }
__device__ __forceinline__ float sigmoid_f(float x) { return __builtin_amdgcn_rcpf(1.f + __expf(-x)); }
__device__ __forceinline__ float silu_f(float x) { return x * sigmoid_f(x); }
__device__ __forceinline__ float softplus_f(float x) { return x > 20.f ? x : log1pf(__expf(x)); }
__device__ __forceinline__ float gelu_tanh_f(float x) { const float u = 1.5957691216057308f * (x + 0.044715f * x * x * x); return x * sigmoid_f(u); }
template <int CTRL> __device__ __forceinline__ float dppf(float x) { return __uint_as_float((unsigned)__builtin_amdgcn_update_dpp(0, (int)__float_as_uint(x), CTRL, 0xf, 0xf, true)); }
__device__ __forceinline__ float row16_sum(float x) { x += dppf<0xB1>(x); x += dppf<0x4E>(x); x += dppf<0x141>(x); x += dppf<0x140>(x); return x; }
__device__ __forceinline__ float row16_max(float x) { x = fmaxf(x, dppf<0xB1>(x)); x = fmaxf(x, dppf<0x4E>(x)); x = fmaxf(x, dppf<0x141>(x)); x = fmaxf(x, dppf<0x140>(x)); return x; }
__device__ __forceinline__ float xsum16(float x) { const auto r = __builtin_amdgcn_permlane16_swap(__float_as_uint(x), __float_as_uint(x), false, false); return __uint_as_float(r[0]) + __uint_as_float(r[1]); }
__device__ __forceinline__ float xsum32(float x) { const auto r = __builtin_amdgcn_permlane32_swap(__float_as_uint(x), __float_as_uint(x), false, false); return __uint_as_float(r[0]) + __uint_as_float(r[1]); }
__device__ __forceinline__ float xmax16(float x) { const auto r = __builtin_amdgcn_permlane16_swap(__float_as_uint(x), __float_as_uint(x), false, false); return fmaxf(__uint_as_float(r[0]), __uint_as_float(r[1])); }
__device__ __forceinline__ float xmax32(float x) { const auto r = __builtin_amdgcn_permlane32_swap(__float_as_uint(x), __float_as_uint(x), false, false); return fmaxf(__uint_as_float(r[0]), __uint_as_float(r[1])); }
__device__ __forceinline__ float rdlane(float x, int l) { return __uint_as_float((unsigned)__builtin_amdgcn_readlane((int)__float_as_uint(x), l)); }
__device__ __forceinline__ float wave_sum(float v) { return xsum32(xsum16(row16_sum(v))); }
__device__ __forceinline__ float wave_max(float v) { return xmax32(xmax16(row16_max(v))); }
__device__ __forceinline__ int mod_row(int row) { return row < MC ? 0 : 1 + ((row - MC) >> 10); }

constexpr size_t O_YP = 0, O_YS = 8388608, O_K = 16777216, O_V = O_K + 12582912, O_SSD = O_V + 12582912, O_RE = O_SSD + 6291456, O_IM = O_RE + 262144, O_END = O_IM + 262144;


#define LAS __attribute__((address_space(3)))
struct SeqInfo { int start, L, b, ctx; };
__device__ __forceinline__ SeqInfo seq_info(int s) { SeqInfo q; if (s < CB) { q.start = s * CL; q.L = CL; q.b = s; q.ctx = 1; } else { q.start = MC + (s - CB) * LL; q.L = LL; q.b = s - CB; q.ctx = 0; } return q; }
__device__ __forceinline__ SeqInfo row_seq(int row) { return seq_info(row < MC ? (row >> 8) : CB + ((row - MC) >> 10)); }
namespace pg8 {
#define PG8_LAS __attribute__((address_space(3)))
typedef unsigned short bf16_t;
typedef short bf16x8 __attribute__((ext_vector_type(8)));
typedef float f32x4 __attribute__((ext_vector_type(4)));
typedef unsigned u32x4 __attribute__((ext_vector_type(4)));
constexpr int BM = 256, BK = 64, HALF = 128, HTB = HALF * BK * 2  , STAGE_BYTES = 8 * HTB, NXCD = 8, WGM = 8;

__host__ __device__ __forceinline__ int lds_byte(int r, int c) { const int st = (r >> 4) * 2 + (c >> 5), rr = r & 15, cc = c & 31, ob = rr * 64 + cc * 2; return st * 1024 + (ob ^ (((ob >> 9) & 1) << 5)); }
__host__ __device__ __forceinline__ void stage_rc(int b, int& R, int& C) { const int st = b / 1024, sb = b % 1024, swz = sb ^ (((sb >> 9) & 1) << 5); R = (st >> 1) * 16 + swz / 64; C = (st & 1) * 32 + (swz % 64) / 2; }
__host__ __device__ __forceinline__ int perm32(int rho) { const int n = rho >> 4, i = rho & 15; return 8 * (i >> 2) + 4 * n + (i & 3); }

struct Unit { int pm, pn; };
struct Gemm { const bf16_t* A; const bf16_t* Bt; int M, N, K; };

struct StaticOrder {
    int nM, nN, nwg, G, c;
    __host__ __device__ void init(int M, int N, int G_, int c_) { nM = M / BM; nN = N / BM; nwg = nM * nN; G = G_; c = c_; }
    __host__ __device__ bool next(int i, Unit& u) const {
        const long L = (long)i * G + c; if (L >= nwg) return false;
        int wgid = (int)L; { const int q = nwg / NXCD, r = nwg % NXCD, xcd = wgid % NXCD, off = wgid / NXCD; wgid = (xcd < r ? xcd * (q + 1) : r * (q + 1) + (xcd - r) * q) + off; }
        const int nig = WGM * nN, gid = wgid / nig, fm = gid * WGM, gsz = (nM - fm) < WGM ? (nM - fm) : WGM;
        u.pm = fm + ((wgid % nig) % gsz); u.pn = (wgid % nig) / gsz; return true;
    }
    __device__ __forceinline__ void a_ready(const Unit&) const {}
    __device__ __forceinline__ void done(const Unit&) const {}
};

__device__ __forceinline__ unsigned cvt_pk_bf16(float lo, float hi) { unsigned r; asm volatile("v_cvt_pk_bf16_f32 %0, %1, %2" : "=v"(r) : "v"(lo), "v"(hi)); return r; }
__device__ __forceinline__ float row_rstd(const float* ssq, int row, int fq) {
    const f32x4 a = *(const f32x4*)(ssq + (size_t)row * 16 + 4 * fq);
    const float s = ::xsum32(::xsum16((a[0] + a[1]) + (a[2] + a[3])));
    return rsqrtf(s * (1.f / 1024.f) + ::EPS);
}
__device__ __forceinline__ void st_wt16(void* base, size_t byte_off, u32x4 v) { const unsigned o = (unsigned)byte_off; asm volatile("global_store_dwordx4 %0, %1, %2 sc1\n\ts_nop 1" :: "v"(o), "v"(v), "s"(base) : "memory"); }
struct EpiProj {
    static constexpr bool PERM = true, AFTER_DRAIN = false; static constexpr int MID_T = 0;
    bf16_t* proj; float* ok; float* ov; float* dt; PG8_LAS const float* side; int l; mutable int slot;
    __device__ __forceinline__ void operator()(const f32x4 (&acc)[2][2][4][2], const Unit& u, int wr, int wc, int fr, int fq) const {
        const int row0 = u.pm * BM + wr * 64 + fr;
        PG8_LAS const float* rsp = side + slot * 256 + wr * 64 + fr; PG8_LAS const float* bsp = side + 1024 + slot * 256 + wc * 32 + 8 * fq; ++slot;
        float rs[2][4];
#pragma unroll
        for (int ai = 0; ai < 2; ++ai)
#pragma unroll
            for (int m = 0; m < 4; ++m) rs[ai][m] = rsp[ai * HALF + m * 16];
#pragma unroll
        for (int bj = 0; bj < 2; ++bj) {
            const int cb = u.pn * BM + bj * HALF;
            if (cb > ::PN) continue;
            const int col = cb + wc * 32 + 8 * fq;
            const f32x4 b0 = *(PG8_LAS const f32x4*)(bsp + bj * HALF), b1 = *(PG8_LAS const f32x4*)(bsp + bj * HALF + 4);
            const bool isk = (cb >= ::PK && cb < ::PV), isv = (cb >= ::PV && cb < ::PN), isdt = (cb == ::PN);
#pragma unroll
            for (int ai = 0; ai < 2; ++ai)
#pragma unroll
                for (int m = 0; m < 4; ++m) {
                    const int row = row0 + ai * HALF + m * 16;
                    const f32x4 v0 = acc[ai][bj][m][0] * rs[ai][m] + b0, v1 = acc[ai][bj][m][1] * rs[ai][m] + b1;
                    if (isdt) { if (wc == 0 && fq < 2) { float* d = dt + (size_t)row * 12 + 8 * fq; *(f32x4*)d = v0; if (fq == 0) *(f32x4*)(d + 4) = v1; } continue; }
                    u32x4 w; w.x = cvt_pk_bf16(v0[0], v0[1]); w.y = cvt_pk_bf16(v0[2], v0[3]); w.z = cvt_pk_bf16(v1[0], v1[1]); w.w = cvt_pk_bf16(v1[2], v1[3]);
                    st_wt16(proj, ((size_t)row * ::PN + col) * 2, w);
                    if (u.pm < 32 && (isk || isv)) {
                        const int b = row >> 8, t = row & 255;
                        float* o = (isk ? ok : ov) + ((size_t)(b * 4 + l) * 256 + t) * 384 + (col - (isk ? ::PK : ::PV));
                        __builtin_nontemporal_store(v0, (f32x4*)o); __builtin_nontemporal_store(v1, (f32x4*)(o + 4));
                    }
                }
        }
    }
};
template <int MID, bool XF32>
struct EpiRes {
    static constexpr bool PERM = true, AFTER_DRAIN = false; static constexpr int MID_T = MID;
    const void* xin_c; const void* xin_l; bf16_t* xout; const float* gate;
    const float* nw; const float* sc; bf16_t* xs; float* ssq;
    PG8_LAS const float* side;
    __device__ __forceinline__ void mid(f32x4 (&acc)[2][2][4][2], const Unit& u, int wr, int fr) const {
#pragma unroll
        for (int ai = 0; ai < 2; ++ai)
#pragma unroll
            for (int m = 0; m < 4; ++m) { const float sc_ = side[ai * HALF + wr * 64 + m * 16 + fr];
#pragma unroll
                for (int bj = 0; bj < 2; ++bj)
#pragma unroll
                    for (int n = 0; n < 2; ++n) acc[ai][bj][m][n] = acc[ai][bj][m][n] * sc_; }
    }
    __device__ __forceinline__ void operator()(const f32x4 (&acc)[2][2][4][2], const Unit& u, int wr, int wc, int fr, int fq) const {
        const int row0 = u.pm * BM + wr * 64 + fr, col0 = u.pn * BM + wc * 32 + 8 * fq;
        const int r = u.pm < 32 ? 0 : 1 + ((u.pm - 32) >> 2);
        const float* gt = gate + (size_t)r * 6144; const float* sr = sc + (size_t)r * 6144;
        const void* xin = u.pm < 32 ? xin_c : xin_l;
        float sq[2][4];
#pragma unroll
        for (int ai = 0; ai < 2; ++ai)
#pragma unroll
            for (int m = 0; m < 4; ++m) sq[ai][m] = 0.f;
#pragma unroll
        for (int bj = 0; bj < 2; ++bj) {
            const int col = col0 + bj * HALF;
            const f32x4 g0 = *(const f32x4*)(gt + col), g1 = *(const f32x4*)(gt + col + 4);
            f32x4 gs0 = {0.f, 0.f, 0.f, 0.f}, gs1 = gs0;
            if (xs) { gs0 = *(const f32x4*)(nw + col) * (*(const f32x4*)(sr + col) + 1.f); gs1 = *(const f32x4*)(nw + col + 4) * (*(const f32x4*)(sr + col + 4) + 1.f); }
#pragma unroll
            for (int ai = 0; ai < 2; ++ai)
#pragma unroll
                for (int m = 0; m < 4; ++m) {
                    const size_t off = (size_t)(row0 + ai * HALF + m * 16) * ::D + col;
                    f32x4 xi0, xi1;
                    if (XF32) { xi0 = *(const f32x4*)((const float*)xin + off); xi1 = *(const f32x4*)((const float*)xin + off + 4); }
                    else { const u32x4 xr = *(const u32x4*)((const bf16_t*)xin + off);
                        xi0 = (f32x4){__uint_as_float(xr.x << 16), __uint_as_float(xr.x & 0xffff0000u), __uint_as_float(xr.y << 16), __uint_as_float(xr.y & 0xffff0000u)};
                        xi1 = (f32x4){__uint_as_float(xr.z << 16), __uint_as_float(xr.z & 0xffff0000u), __uint_as_float(xr.w << 16), __uint_as_float(xr.w & 0xffff0000u)}; }
                    const f32x4 x0 = xi0 + g0 * acc[ai][bj][m][0], x1 = xi1 + g1 * acc[ai][bj][m][1];
                    { u32x4 xo; xo.x = cvt_pk_bf16(x0[0], x0[1]); xo.y = cvt_pk_bf16(x0[2], x0[3]); xo.z = cvt_pk_bf16(x1[0], x1[1]); xo.w = cvt_pk_bf16(x1[2], x1[3]); *(u32x4*)(xout + off) = xo; }
                    if (xs) { sq[ai][m] += ((x0[0] * x0[0] + x0[1] * x0[1]) + (x0[2] * x0[2] + x0[3] * x0[3])) + ((x1[0] * x1[0] + x1[1] * x1[1]) + (x1[2] * x1[2] + x1[3] * x1[3]));
                        const f32x4 h0 = x0 * gs0, h1 = x1 * gs1; u32x4 o; o.x = cvt_pk_bf16(h0[0], h0[1]); o.y = cvt_pk_bf16(h0[2], h0[3]); o.z = cvt_pk_bf16(h1[0], h1[1]); o.w = cvt_pk_bf16(h1[2], h1[3]);
                        *(u32x4*)(xs + off) = o; }
                }
        }
        if (xs) {
#pragma unroll
            for (int ai = 0; ai < 2; ++ai)
#pragma unroll
                for (int m = 0; m < 4; ++m) { const float t = ::xsum32(::xsum16(sq[ai][m])); if (fq == 0) ssq[(size_t)(row0 + ai * HALF + m * 16) * 16 + u.pn * 4 + wc] = t; }
        }
    }
};
struct EpiFF1 {
    static constexpr bool PERM = true, AFTER_DRAIN = false; static constexpr int MID_T = 0;
    bf16_t* h; PG8_LAS const float* side; mutable int slot;
    __device__ __forceinline__ void operator()(const f32x4 (&acc)[2][2][4][2], const Unit& u, int wr, int wc, int fr, int fq) const {
        const int row0 = u.pm * BM + wr * 64 + fr, col0 = u.pn * BM + wc * 32 + 8 * fq;
        PG8_LAS const float* rsp = side + slot * 256 + wr * 64 + fr; PG8_LAS const float* bsp = side + 1024 + slot * 256 + wc * 32 + 8 * fq; ++slot;
        f32x4 bv[2][2];
#pragma unroll
        for (int bj = 0; bj < 2; ++bj) { bv[bj][0] = *(PG8_LAS const f32x4*)(bsp + bj * HALF); bv[bj][1] = *(PG8_LAS const f32x4*)(bsp + bj * HALF + 4); }
#pragma unroll
        for (int ai = 0; ai < 2; ++ai)
#pragma unroll
            for (int m = 0; m < 4; ++m) {
                const int row = row0 + ai * HALF + m * 16; const float rs = rsp[ai * HALF + m * 16];
                bf16_t* rowp = h + (size_t)row * ::DFF + col0;
#pragma unroll
                for (int bj = 0; bj < 2; ++bj) {
                    f32x4 v0 = acc[ai][bj][m][0] * rs + bv[bj][0], v1 = acc[ai][bj][m][1] * rs + bv[bj][1];
#pragma unroll
                    for (int e = 0; e < 4; ++e) { const float a = fmaxf(v0[e], 0.f), b = fmaxf(v1[e], 0.f); v0[e] = a * a; v1[e] = b * b; }
                    u32x4 w; w.x = cvt_pk_bf16(v0[0], v0[1]); w.y = cvt_pk_bf16(v0[2], v0[3]); w.z = cvt_pk_bf16(v1[0], v1[1]); w.w = cvt_pk_bf16(v1[2], v1[3]);
                    st_wt16(h, ((size_t)row * ::DFF + col0 + bj * HALF) * 2, w);
                }
            }
    }
};
template <class Epi, class Sched, bool ALIGN_EPI = false, bool SP2 = false>
__device__ __forceinline__ void gemm_phase(PG8_LAS unsigned char* lds, const Gemm g, const Sched& S, const Epi& E, const int wave_in) {
    int tid_ = wave_in * 64 + ::lane_id(); asm volatile("" : "+v"(tid_));
    const int tid = tid_, wid = __builtin_amdgcn_readfirstlane(tid >> 6), lane = tid & 63, wr = wid >> 2, wc = wid & 3, fr = lane & 15, fq = lane >> 4;
    const int K = g.K, nt = K / BK;
    unsigned voffA[2], voffB[2];
#pragma unroll
    for (int i = 0; i < 2; ++i) { int R, C; stage_rc(tid * 16 + i * 8192, R, C); const int Rb = Epi::PERM ? ((R & ~31) + perm32(R & 31)) : R;
        voffA[i] = (unsigned)(R * K + C) * 2u; voffB[i] = (unsigned)(Rb * K + C) * 2u; }
    const size_t kstep = (size_t)(BK * 2);
    const size_t hstep = (size_t)HALF * K * 2;
    const size_t tstep = 2 * hstep;
    const unsigned ldsw = (unsigned)wid * 1024u;
    const int aoff = lds_byte(wr * 64 + fr, fq * 8), boff = lds_byte(wc * 32 + fr, fq * 8);
#define PG8_SA(b, h) (((b) * 2 + (h)) * HTB)
#define PG8_SB(b, h) ((4 + (b) * 2 + (h)) * HTB)
#define PG8_STAGE(bufoff, gbase, voff) do { _Pragma("unroll") for (int _i = 0; _i < 2; ++_i) \
        __builtin_amdgcn_global_load_lds((const unsigned*)((const char*)(gbase) + (voff)[_i]), (PG8_LAS unsigned*)(lds + (bufoff) + ldsw + _i * 8192), 16, 0, 0); } while (0)
#define PG8_LDA(dst, b, h) do { _Pragma("unroll") for (int m = 0; m < 4; ++m) _Pragma("unroll") for (int k = 0; k < 2; ++k) dst[m][k] = *(const PG8_LAS bf16x8*)(lds + PG8_SA(b, h) + aoff + m * 2048 + k * 1024); } while (0)
#define PG8_LDB(dst, b, h) do { _Pragma("unroll") for (int n = 0; n < 2; ++n) _Pragma("unroll") for (int k = 0; k < 2; ++k) dst[n][k] = *(const PG8_LAS bf16x8*)(lds + PG8_SB(b, h) + boff + n * 2048 + k * 1024); } while (0)
#define PG8_MMA(ai, bj, At, Bt) do { __builtin_amdgcn_s_setprio(1); _Pragma("unroll") for (int m = 0; m < 4; ++m) _Pragma("unroll") for (int n = 0; n < 2; ++n) _Pragma("unroll") for (int k = 0; k < 2; ++k) \
        acc[ai][bj][m][n] = __builtin_amdgcn_mfma_f32_16x16x32_bf16(Bt[n][k], At[m][k], acc[ai][bj][m][n], 0, 0, 0); __builtin_amdgcn_s_setprio(0); } while (0)
#define PG8_WAIT_V(n) asm volatile("s_waitcnt vmcnt(" #n ")" ::: "memory")
#define PG8_WAIT_L(n) asm volatile("s_waitcnt lgkmcnt(" #n ")" ::: "memory")
#define PG8_BAR __builtin_amdgcn_s_barrier()
#define PG8_SCHED __builtin_amdgcn_sched_barrier(0)
    Unit cur, nxt; int ui = 0;
    if (!S.next(0, cur)) return;
    f32x4 acc[2][2][4][2];
#pragma unroll
    for (int a = 0; a < 2; ++a)
#pragma unroll
        for (int b = 0; b < 2; ++b)
#pragma unroll
            for (int m = 0; m < 4; ++m)
#pragma unroll
                for (int n = 0; n < 2; ++n) acc[a][b][m][n] = (f32x4){0.f, 0.f, 0.f, 0.f};
    bf16x8 At[4][2], B0[2][2], B1[2][2];
    const char* cA = (const char*)g.A + (size_t)cur.pm * tstep; const char* cB = (const char*)g.Bt + (size_t)cur.pn * tstep;
    S.a_ready(cur);
    if constexpr (SP2) {
        PG8_STAGE(PG8_SB(0, 0), cB, voffB); PG8_STAGE(PG8_SB(0, 1), cB + hstep, voffB); PG8_STAGE(PG8_SA(0, 0), cA, voffA); PG8_STAGE(PG8_SA(0, 1), cA + hstep, voffA);
        if (wr == 1) PG8_BAR;
        PG8_WAIT_V(2); PG8_BAR;
        PG8_STAGE(PG8_SB(1, 0), cB + kstep, voffB); PG8_STAGE(PG8_SA(1, 0), cA + kstep, voffA); PG8_STAGE(PG8_SB(1, 1), cB + hstep + kstep, voffB);
        PG8_WAIT_V(6); PG8_BAR;
    } else {
        PG8_STAGE(PG8_SB(0, 0), cB, voffB); PG8_STAGE(PG8_SA(0, 0), cA, voffA); PG8_STAGE(PG8_SB(0, 1), cB + hstep, voffB); PG8_STAGE(PG8_SA(0, 1), cA + hstep, voffA);
        if (wr == 1) PG8_BAR;
        PG8_WAIT_V(4); PG8_BAR;
        PG8_STAGE(PG8_SB(1, 0), cB + kstep, voffB); PG8_STAGE(PG8_SA(1, 0), cA + kstep, voffA); PG8_STAGE(PG8_SB(1, 1), cB + hstep + kstep, voffB);
        PG8_WAIT_V(6); PG8_BAR;
    }
    for (;;) {
        const bool has_next = S.next(ui + 1, nxt);
        const char* nA = has_next ? (const char*)g.A + (size_t)nxt.pm * tstep : cA; const char* nB = has_next ? (const char*)g.Bt + (size_t)nxt.pn * tstep : cB;
        for (int t = 0; t < nt; t += 2) {
            if constexpr (Epi::MID_T > 0) { if (t == Epi::MID_T) E.mid(acc, cur, wr, fr); }
            const bool last = (t == nt - 2);
            const char* a1 = cA + (size_t)(t + 1) * kstep;
            const char* a2 = last ? nA : cA + (size_t)(t + 2) * kstep; const char* b2 = last ? nB : cB + (size_t)(t + 2) * kstep;
            const char* a3 = a2 + kstep; const char* b3 = b2 + kstep;
            if (last && has_next) S.a_ready(nxt);
            if constexpr (SP2) {
            PG8_LDB(B0, 0, 0); PG8_LDB(B1, 0, 1); PG8_SCHED; PG8_LDA(At, 0, 0); PG8_STAGE(PG8_SA(1, 1), a1 + hstep, voffA);
            PG8_WAIT_V(8); PG8_WAIT_L(0); PG8_BAR; PG8_MMA(0, 0, At, B0); PG8_MMA(0, 1, At, B1); PG8_BAR; PG8_SCHED;
            PG8_LDA(At, 0, 1); PG8_STAGE(PG8_SB(0, 0), b2, voffB); PG8_STAGE(PG8_SB(0, 1), b2 + hstep, voffB); PG8_STAGE(PG8_SA(0, 0), a2, voffA);
            PG8_WAIT_V(8); PG8_WAIT_L(0); PG8_BAR; PG8_MMA(1, 0, At, B0); PG8_MMA(1, 1, At, B1); PG8_BAR; PG8_SCHED;
            PG8_LDB(B0, 1, 0); PG8_LDB(B1, 1, 1); PG8_SCHED; PG8_LDA(At, 1, 0); PG8_STAGE(PG8_SA(0, 1), a2 + hstep, voffA);
            PG8_WAIT_V(8); PG8_WAIT_L(0); PG8_BAR; PG8_MMA(0, 0, At, B0); PG8_MMA(0, 1, At, B1); PG8_BAR; PG8_SCHED;
            PG8_LDA(At, 1, 1); PG8_STAGE(PG8_SB(1, 0), b3, voffB); PG8_STAGE(PG8_SB(1, 1), b3 + hstep, voffB); PG8_STAGE(PG8_SA(1, 0), a3, voffA);
            PG8_WAIT_V(8); PG8_WAIT_L(0); PG8_BAR; PG8_MMA(1, 0, At, B0); PG8_MMA(1, 1, At, B1); PG8_BAR; PG8_SCHED;
            } else {
            PG8_LDB(B0, 0, 0); PG8_SCHED; PG8_LDA(At, 0, 0); PG8_STAGE(PG8_SA(1, 1), a1 + hstep, voffA);
            PG8_WAIT_L(8); PG8_BAR; PG8_WAIT_L(0); PG8_MMA(0, 0, At, B0); PG8_BAR; PG8_SCHED;
            PG8_LDB(B1, 0, 1); PG8_STAGE(PG8_SB(0, 0), b2, voffB);
            PG8_BAR; PG8_WAIT_L(0); PG8_MMA(0, 1, At, B1); PG8_BAR;
            PG8_LDA(At, 0, 1); PG8_STAGE(PG8_SA(0, 0), a2, voffA);
            PG8_BAR; PG8_WAIT_L(0); PG8_MMA(1, 0, At, B0); PG8_BAR; PG8_SCHED;
            PG8_STAGE(PG8_SB(0, 1), b2 + hstep, voffB);
            PG8_WAIT_V(6); PG8_BAR; PG8_MMA(1, 1, At, B1); PG8_BAR;
            PG8_LDB(B0, 1, 0); PG8_SCHED; PG8_LDA(At, 1, 0); PG8_STAGE(PG8_SA(0, 1), a2 + hstep, voffA);
            PG8_WAIT_L(8); PG8_BAR; PG8_WAIT_L(0); PG8_MMA(0, 0, At, B0); PG8_BAR; PG8_SCHED;
            PG8_LDB(B1, 1, 1); PG8_STAGE(PG8_SB(1, 0), b3, voffB);
            PG8_BAR; PG8_WAIT_L(0); PG8_MMA(0, 1, At, B1); PG8_BAR;
            PG8_LDA(At, 1, 1); PG8_STAGE(PG8_SA(1, 0), a3, voffA);
            PG8_BAR; PG8_WAIT_L(0); PG8_MMA(1, 0, At, B0); PG8_BAR; PG8_SCHED;
            PG8_STAGE(PG8_SB(1, 1), b3 + hstep, voffB);
            PG8_WAIT_V(6); PG8_BAR; PG8_MMA(1, 1, At, B1); PG8_BAR;
            }
        }
        if constexpr (ALIGN_EPI) { if (wr == 0) PG8_BAR; }
        if constexpr (!Epi::AFTER_DRAIN) { E(acc, cur, wr, wc, fr, fq); S.done(cur); }
        if (!has_next) break;
#pragma unroll
        for (int a = 0; a < 2; ++a)
#pragma unroll
            for (int b = 0; b < 2; ++b)
#pragma unroll
                for (int m = 0; m < 4; ++m)
#pragma unroll
                    for (int n = 0; n < 2; ++n) acc[a][b][m][n] = (f32x4){0.f, 0.f, 0.f, 0.f};
        cur = nxt; cA = nA; cB = nB; ++ui;
        if constexpr (ALIGN_EPI) { if (wr == 1) PG8_BAR; }
    }
    PG8_WAIT_V(0);
    if constexpr (!ALIGN_EPI) { if (wr == 0) PG8_BAR; }
    PG8_BAR;
    if constexpr (Epi::AFTER_DRAIN) { E.fused(acc, cur, wr, wc, fr, fq, lds, wid, lane); S.done(cur); }
#undef PG8_SA
#undef PG8_SB
#undef PG8_STAGE
#undef PG8_LDA
#undef PG8_LDB
#undef PG8_MMA
#undef PG8_WAIT_V
#undef PG8_WAIT_L
#undef PG8_BAR
#undef PG8_SCHED
}
}

constexpr int NWAVES = 8, NTHREADS = 512;
constexpr int RING_BYTES = 131072, LDS_BYTES = 163840, LDSCTL_OFF = LDS_BYTES - 512, MISC_OFF = LDSCTL_OFF + 320;
#define GAS __attribute__((address_space(1)))
typedef unsigned v4u __attribute__((ext_vector_type(4)));
typedef unsigned v2u __attribute__((ext_vector_type(2)));
typedef GAS unsigned gu32;
#define LDS_WAIT() asm volatile("s_waitcnt lgkmcnt(0)" ::: "memory")
#define VM_WAIT() asm volatile("s_waitcnt vmcnt(0)" ::: "memory")
__device__ __forceinline__ unsigned pk2(float lo, float hi) { return cvtpk(lo, hi); }
constexpr int CW_BAR = 4096, CW_Q = 65536;
constexpr size_t CTL_ZERO_BYTES = 1 * MiB;

#define XB_TMO      128
#define XB_XCNT(j)  (256  + 64 * (j))
#define XB_XSUB(j)  (1280 + 64 * (j))
#define XB_XGEN(j)  (2304 + 64 * (j))
#define XB_TOP      3328
#define XB_TOPGEN   3392
#define XCD_BAR_WORDS 3456
#define XB_SPIN_CAP (1u << 18)

__device__ __forceinline__ unsigned xb_ld(unsigned* p)              { return __hip_atomic_load(p, __ATOMIC_RELAXED, __HIP_MEMORY_SCOPE_AGENT); }
__device__ __forceinline__ unsigned xb_add(unsigned* p, unsigned v) { return __hip_atomic_fetch_add(p, v, __ATOMIC_RELAXED, __HIP_MEMORY_SCOPE_AGENT); }
__device__ __forceinline__ unsigned xb_xcc_id() { return (unsigned)__builtin_amdgcn_s_getreg((3 << 11) | 20) & 0xFu; }
#define XB_SPIN(cond, bar) do { unsigned _sp = 0; while (cond) { __builtin_amdgcn_s_sleep(1); \
    if ((++_sp & 255u) == 0u) { if (xb_ld(&(bar)[XB_TMO])) break; if (_sp > XB_SPIN_CAP) { atomicAdd(&(bar)[XB_TMO], 1u); break; } } } } while (0)

struct XcdBarrier {
    unsigned* bar; unsigned x;
    volatile LAS unsigned* st;
};

__device__ __forceinline__ XcdBarrier xcd_barrier_post(unsigned* bar, volatile LAS unsigned* st) {
    XcdBarrier b; b.bar = bar; b.x = xb_xcc_id(); b.st = st;
    if (threadIdx.x == 0) (void)xb_add(&bar[XB_XCNT(b.x)], 1u);
    return b;
}
__device__ __forceinline__ void xcd_barrier_complete(unsigned* bar, unsigned x, unsigned& nloc, unsigned& nx) {
    const unsigned G = gridDim.x * gridDim.y * gridDim.z;
    unsigned sum, cnt, mine, sp = 0u;
    for (;;) {
        sum = 0u; cnt = 0u; mine = 0u;
#pragma unroll
        for (unsigned j = 0; j < 16; ++j) { const unsigned c = xb_ld(&bar[XB_XCNT(j)]); sum += c; cnt += (c > 0u) ? 1u : 0u; mine = (j == x) ? c : mine; }
        if (sum == G) break;
        __builtin_amdgcn_s_sleep(1);
        if ((++sp & 255u) == 0u) { if (xb_ld(&bar[XB_TMO])) break; if (sp > XB_SPIN_CAP) { atomicAdd(&bar[XB_TMO], 1u); break; } }
    }
    nloc = mine > 0u ? mine : 1u; nx = cnt > 0u ? cnt : 1u;
}

__device__ __forceinline__ void xcd_barrier(const XcdBarrier& b, const bool is_t0) {
    asm volatile("s_waitcnt vmcnt(0)" ::: "memory");
    __syncthreads();
    if (is_t0) {
        unsigned* bar = b.bar;
        __builtin_amdgcn_s_waitcnt(0);
        unsigned nloc = b.st[0], nx = b.st[1];
        if (nloc == 0u) { xcd_barrier_complete(bar, b.x, nloc, nx); b.st[0] = nloc; b.st[1] = nx; }
        const unsigned old = xb_add(&bar[XB_XSUB(b.x)], 1u);
        const unsigned gen = old / nloc;
        if (old + 1u == (gen + 1u) * nloc) {
            __builtin_amdgcn_fence(__ATOMIC_RELEASE, "agent");
            asm volatile("s_waitcnt vmcnt(0)" ::: "memory");
            const unsigned og = xb_add(&bar[XB_TOP], 1u);
            const unsigned tg = og / nx;
            if (og + 1u == (tg + 1u) * nx) xb_add(&bar[XB_TOPGEN], 1u);
            else XB_SPIN(xb_ld(&bar[XB_TOPGEN]) == tg, bar);
            __builtin_amdgcn_fence(__ATOMIC_ACQUIRE, "agent");
            xb_add(&bar[XB_XGEN(b.x)], 1u);
            asm volatile("s_waitcnt vmcnt(0)" ::: "memory");
        } else {
            XB_SPIN(xb_ld(&bar[XB_XGEN(b.x)]) == gen, bar);
            __builtin_amdgcn_fence(__ATOMIC_ACQUIRE, "agent");
            asm volatile("s_waitcnt vmcnt(0)" ::: "memory");
        }
    }
    __syncthreads();
}


struct InPtrs { const GAS float* const* p; __device__ __forceinline__ const float* operator[](int k) const { return (const float*)p[k]; } };
struct Frame {
    LAS unsigned char* lds;
    volatile LAS unsigned* MISC;
    unsigned* ctl;
    int tid, lane, wave, vcu, G;
    InPtrs in; float* out; unsigned char* ws;
};
constexpr int PH_PRO = 0, PH_PRE = 1, PH_L0 = 2, PH_PER_LAYER = 6, PH_G1 = 0, PH_MIXA = 1, PH_MIXB = 2, PH_G3 = 3, PH_G4 = 4, PH_G5 = 5, PH_FINAL = PH_L0 + DEPTH * PH_PER_LAYER, PH_END = PH_FINAL + 1;

__device__ __forceinline__ int queue_next(Frame& F, unsigned* ctr);
constexpr int TR_P = 144;
__device__ __forceinline__ void transpose_item(const float* W, int K, int Nsrc, int src_n0, bf16_t* WT, int dst_n0, int k0, LAS unsigned char* scr, int lane, int nvalid = 64) {
    const int l16 = lane & 15, l4 = lane >> 4;
    f32x4 v[16];
#pragma unroll
    for (int i = 0; i < 16; ++i) v[i] = (src_n0 >= 0 && 4 * l16 < nvalid) ? __builtin_nontemporal_load((const f32x4*)(W + (size_t)(k0 + 4 * i + l4) * Nsrc + src_n0 + 4 * l16)) : (f32x4){0.f, 0.f, 0.f, 0.f};
#pragma unroll
    for (int i = 0; i < 16; ++i)
#pragma unroll
        for (int e = 0; e < 4; ++e) *(LAS bf16_t*)(scr + (4 * l16 + e) * TR_P + (4 * i + l4) * 2) = f2bf(v[i][e]);
    LDS_WAIT(); asm volatile("" ::: "memory");
#pragma unroll
    for (int jn = 0; jn < 8; ++jn) { const int n = 8 * jn + (lane >> 3), c = lane & 7;
        *(v4u*)(WT + (size_t)(dst_n0 + n) * K + k0 + 8 * c) = *(LAS const v4u*)(scr + n * TR_P + c * 16); }
    LDS_WAIT(); asm volatile("" ::: "memory");
}
constexpr int TR_IN = 16 * (PNP / 64), TR_OUT = 16 * 16, TR_F1 = 16 * (DFF / 64), TR_F2 = (DFF / 64) * 16, TR_GLU = 4 * 4, TR_L = TR_IN + TR_OUT + TR_F1 + TR_F2 + TR_GLU;
constexpr int TR_WG = (TR_L + 7) / 8;
__device__ __forceinline__ void transpose_layer_item(Frame& F, int l, int r) {
    const InPtrs in = F.in;
    LAS unsigned char* scr = F.lds + F.wave * (64 * TR_P);
    if (r < TR_IN) { const int nb = r % (PNP / 64), kb = r / (PNP / 64), n0 = nb * 64; const int src = n0 > PN ? -1 : (n0 == PN ? 1024 : (n0 >= 1024 ? n0 + 12 : n0));
        transpose_item(in[13] + (size_t)l * 1024 * IN_COLS, 1024, IN_COLS, src, (bf16_t*)(F.ws + OFF_WIN) + (size_t)l * PNP * 1024, n0, kb * 64, scr, F.lane, n0 == PN ? 12 : 64); }
    else if ((r -= TR_IN) < TR_OUT) { const int nb = r % 16, kb = r / 16; transpose_item(in[31] + (size_t)l * 1024 * 1024, 1024, 1024, nb * 64, (bf16_t*)(F.ws + OFF_WOUT) + (size_t)l * 1024 * 1024, nb * 64, kb * 64, scr, F.lane); }
    else if ((r -= TR_OUT) < TR_F1) { const int nb = r % (DFF / 64), kb = r / (DFF / 64); transpose_item(in[32] + (size_t)l * 1024 * DFF, 1024, DFF, nb * 64, (bf16_t*)(F.ws + OFF_WFF1) + (size_t)l * DFF * 1024, nb * 64, kb * 64, scr, F.lane); }
    else if ((r -= TR_F1) < TR_F2) { const int nb = r % 16, kb = r / 16; transpose_item(in[33] + (size_t)l * DFF * 1024, DFF, 1024, nb * 64, (bf16_t*)(F.ws + OFF_WFF2) + (size_t)l * 1024 * DFF, nb * 64, kb * 64, scr, F.lane); }
    else { r -= TR_F2; const int nb = r % 4, kb = r / 4; transpose_item(in[28] + (size_t)l * 65536, 256, 256, nb * 64, (bf16_t*)(F.ws + OFF_WGLU) + (size_t)l * 65536, nb * 64, kb * 64, scr, F.lane); }
}
__device__ __forceinline__ void transpose_layer_queue(Frame& F, int l, unsigned* ctr) {
    for (;;) { const int u = queue_next(F, ctr); if (u >= TR_WG) break; const int it = u * 8 + F.wave; if (it < TR_L) transpose_layer_item(F, l, it); }
}
__device__ __forceinline__ void phase_prologue(Frame& F) {
    const InPtrs in = F.in;
    for (int idx = F.vcu * NTHREADS + F.tid; idx < 8192; idx += F.G * NTHREADS) {
        const int pp = idx & 63, g = (idx >> 6) & 15, dir = (idx >> 10) & 1, l = idx >> 11;
        const float are = in[20][idx], aim = in[21][idx];
        const float dt = __expf(in[22][(l * 2 + dir) * 16 + g]);
        const float zr = are * dt, zi = aim * dt;
        const float e = expf(zr); float rev = zi * 0.15915494309189535f; rev -= rintf(rev);
        const float ar = e * cosf(rev * 6.283185307179586f), ai = e * sinf(rev * 6.283185307179586f);
        float* abar = (float*)(F.ws + OFF_TAB + TAB_ABAR);
        abar[idx * 2] = ar; abar[idx * 2 + 1] = ai;
        const float xr = ar - 1.f, xi = ai, den = are * are + aim * aim;
        const float fr = (xr * are + xi * aim) / den, fi = (xi * are - xr * aim) / den;
        for (int c = 0; c < 16; ++c) {
            const float br = in[23][((l * 16 + g) * 64 + pp) * 16 + c], bi = in[24][((l * 16 + g) * 64 + pp) * 16 + c];
            bf16_t* bbt = (bf16_t*)(F.ws + OFF_TAB + TAB_BBT) + ((size_t)(((l * 2 + dir) * 16 + g) * 2) * 64 + pp) * 16 + c;
            bbt[0] = f2bf(fr * br - fi * bi); bbt[64 * 16] = f2bf(fr * bi + fi * br);
            float2 b32; b32.x = fr * br - fi * bi; b32.y = fr * bi + fi * br; ((float2*)(F.ws + OFF_BB32))[(size_t)idx * 16 + c] = b32;
        }
        {
            float sr = ar, si = ai;
            bf16_t* pt = (bf16_t*)(F.ws + OFF_PT64) + (size_t)((l * 2 + dir) * 16 + g) * 64 * 128 + pp;
            for (int e2 = 1; e2 <= 64; ++e2) { const int t = dir == 0 ? e2 - 1 : 64 - e2; pt[t * 128] = f2bf(sr); pt[t * 128 + 64] = f2bf(si);
                const float nr = sr * ar - si * ai, ni = sr * ai + si * ar; sr = nr; si = ni; }
        }
    }
    for (int i = F.vcu * NTHREADS + F.tid; i < 4 * 16 * 16 * 128; i += F.G * NTHREADS) {
        const int pos = i & 127, c = (i >> 7) & 15, g = (i >> 11) & 15, l = i >> 15;
        const int ks = pos >> 5, fq_ = (pos >> 3) & 3, e = pos & 7, k = 32 * ks + (e < 4 ? 4 * fq_ + e : 16 + 4 * fq_ + e - 4), ri = k >> 6, pp = k & 63;
        const size_t si = ((size_t)(l * 16 + g) * 16 + c) * 64 + pp;
        ((bf16_t*)(F.ws + OFF_TAB + TAB_CC1))[i] = f2bf(ri ? -in[26][si] : in[25][si]);
    }
    for (int i = F.vcu * NTHREADS + F.tid; i < 2 * 3145728 / 8; i += F.G * NTHREADS) {
        const int which = i >= 3145728 / 8; const size_t e = (size_t)(which ? i - 3145728 / 8 : i) * 8;
        const float* src = in[which ? 3 : 2] + e; const f32x4 a = __builtin_nontemporal_load((const f32x4*)src), b = __builtin_nontemporal_load((const f32x4*)(src + 4));
        v4u o; o[0] = pk2(a[0], a[1]); o[1] = pk2(a[2], a[3]); o[2] = pk2(b[0], b[1]); o[3] = pk2(b[2], b[3]);
        *(v4u*)((bf16_t*)(F.ws + (which ? OFF_CV : OFF_CK)) + e) = o;
    }
    constexpr int N_UNITS = 96 + TR_WG;
    unsigned* ctr = F.ctl + CW_Q + 64 * 63;
    for (;;) {
        const int u = queue_next(F, ctr); if (u >= N_UNITS) break;
        if (u < 96) {
            LAS float* ssil = (LAS float*)F.lds;
            LAS float* part = (LAS float*)(F.lds + 9 * 1024 * 4);
            for (int i = F.tid; i < 9 * 1024; i += NTHREADS) { const int r = i >> 10, k = i & 1023; const float v = r == 0 ? in[8][k] : in[7][(r - 1) * 1024 + k]; ssil[i] = silu_f(v); }
            __syncthreads();
            const int l = u / 24, n0 = (u % 24) * 256;
            const float* w = in[9] + (size_t)l * 1024 * 6144 + n0 + 4 * F.lane;
            f32x4 acc[9];
#pragma unroll
            for (int r = 0; r < 9; ++r) acc[r] = (f32x4){0.f, 0.f, 0.f, 0.f};
            const int kb = F.wave * 128;
            for (int k = 0; k < 128; k += 4) {
                f32x4 wv[4];
#pragma unroll
                for (int e = 0; e < 4; ++e) wv[e] = __builtin_nontemporal_load((const f32x4*)(w + (size_t)(kb + k + e) * 6144));
#pragma unroll
                for (int r = 0; r < 9; ++r) { const f32x4 sv = *(LAS const f32x4*)(ssil + r * 1024 + kb + k);
                    acc[r] += wv[0] * sv[0]; acc[r] += wv[1] * sv[1]; acc[r] += wv[2] * sv[2]; acc[r] += wv[3] * sv[3]; }
            }
#pragma unroll
            for (int r = 0; r < 9; ++r) *(LAS f32x4*)(part + (F.wave * 9 + r) * 256 + 4 * F.lane) = acc[r];
            __syncthreads();
            float* mods = (float*)(F.ws + OFF_MODS);
            for (int i = F.tid; i < 9 * 256; i += NTHREADS) { const int r = i >> 8, jn = i & 255; float sacc = in[10][l * 6144 + n0 + jn];
#pragma unroll
                for (int w8 = 0; w8 < 8; ++w8) sacc += part[(w8 * 9 + r) * 256 + jn];
                mods[(size_t)(l * 9 + r) * 6144 + n0 + jn] = sacc; }
        } else {
            const int it = (u - 96) * 8 + F.wave;
            if (it < TR_L) transpose_layer_item(F, 0, it);
        }
    }
}
__device__ __forceinline__ void bias_task(Frame& F, int l, int t);
__device__ __forceinline__ void tk_gen_task(Frame& F, int l, int g, int half);
__device__ __forceinline__ void phase_pre(Frame& F) {
    const InPtrs in = F.in; const int lane = F.lane;
    for (int row = F.vcu * NWAVES + F.wave; row < M; row += F.G * NWAVES) {
        const float* xr = row < MC ? in[0] + (size_t)row * D : in[1] + (size_t)(row - MC) * D;
        const float* sc = (const float*)(F.ws + OFF_MODS) + (size_t)mod_row(row) * 6144 + 1024; const float* gw = in[11];
        bf16_t* h = (bf16_t*)(F.ws + OFF_H) + (size_t)row * D;
        float s = 0.f;
#pragma unroll
        for (int j = 0; j < 4; ++j) { const int c = 4 * lane + 256 * j; const f32x4 v = __builtin_nontemporal_load((const f32x4*)(xr + c)), g = *(const f32x4*)(gw + c), a = *(const f32x4*)(sc + c);
            s += v.x * v.x + v.y * v.y + v.z * v.z + v.w * v.w;
            uint2 o; o.x = pk2(v.x * g.x * (1.f + a.x), v.y * g.y * (1.f + a.y)); o.y = pk2(v.z * g.z * (1.f + a.z), v.w * g.w * (1.f + a.w)); *(uint2*)(h + c) = o; }
        s = wave_sum(s);
        if (lane < 16) ((float*)(F.ws + OFF_TAB + TAB_SQ1))[(size_t)row * 16 + lane] = lane == 0 ? s : 0.f;
    }
    for (int task = F.vcu - 128; task >= 0 && task < 128; task += F.G) tk_gen_task(F, task >> 5, (task >> 1) & 15, task & 1);
    for (int task = F.vcu; task < 104; task += F.G) bias_task(F, 0, task);
}
__device__ __forceinline__ void bias_task(Frame& F, int l, int t) {
    const int lane = F.lane, fr = lane & 15, fq = lane >> 4, w = F.wave;
    LAS float* red = (LAS float*)F.lds;
    {
        const int which = t >= 40, n0 = (which ? t - 40 : t) * 64;
        const float* mods = (const float*)(F.ws + OFF_MODS) + (size_t)l * 9 * 6144 + (which ? 3 : 0) * 1024;
        const bf16_t* wt = which ? (const bf16_t*)(F.ws + OFF_WFF1) + (size_t)l * DFF * 1024 : (const bf16_t*)(F.ws + OFF_WIN) + (size_t)l * PNP * 1024;
        float* bo = (float*)(F.ws + OFF_TAB + (which ? TAB_B2 : TAB_B1)) + (size_t)l * 9 * (which ? DFF : PNP);
        f32x4 acc[4];
#pragma unroll
        for (int nb = 0; nb < 4; ++nb) acc[nb] = (f32x4){0.f, 0.f, 0.f, 0.f};
#pragma unroll
        for (int ks = 0; ks < 4; ++ks) {
            const int k0 = 128 * w + 32 * ks + 8 * fq;
            union { bf16x8 v; unsigned u[4]; } af; af.u[0] = af.u[1] = af.u[2] = af.u[3] = 0u;
            if (fr < 9) { const f32x4 a0 = *(const f32x4*)(mods + (size_t)fr * 6144 + k0), a1 = *(const f32x4*)(mods + (size_t)fr * 6144 + k0 + 4);
                af.u[0] = pk2(a0[0], a0[1]); af.u[1] = pk2(a0[2], a0[3]); af.u[2] = pk2(a1[0], a1[1]); af.u[3] = pk2(a1[2], a1[3]); }
#pragma unroll
            for (int nb = 0; nb < 4; ++nb) { const bf16x8 bfr = *(const bf16x8*)(wt + (size_t)(n0 + 16 * nb + fr) * 1024 + k0); acc[nb] = __builtin_amdgcn_mfma_f32_16x16x32_bf16(af.v, bfr, acc[nb], 0, 0, 0); }
        }
        __syncthreads();
#pragma unroll
        for (int nb = 0; nb < 4; ++nb) *(LAS f32x4*)(red + ((w * 4 + nb) * 64 + lane) * 4) = acc[nb];
        __syncthreads();
        for (int i = F.tid; i < 1024; i += NTHREADS) { float sacc = 0.f;
#pragma unroll
            for (int w8 = 0; w8 < 8; ++w8) sacc += red[w8 * 1024 + i];
            const int nb = i >> 8, ln = (i >> 2) & 63, e = i & 3, r = 4 * (ln >> 4) + e;
            if (r < 9) bo[(size_t)r * (which ? DFF : PNP) + n0 + 16 * nb + (ln & 15)] = sacc; }
    }
}
constexpr int EPI_SIDE_OFF = RING_BYTES;
template <class Sched>
__device__ __forceinline__ void epi_side_fill(Frame& F, const Sched& S, const float* ssq, const float* bias, int ldb) {
    LAS float* side = (LAS float*)(F.lds + EPI_SIDE_OFF);
    pg8::Unit u;
    for (int i = 0; i < 4 && S.next(i, u); ++i) {
        if (F.tid < 256) { const f32x4* p = (const f32x4*)(ssq + (size_t)(u.pm * 256 + F.tid) * 16); const f32x4 a = p[0], b = p[1], c = p[2], d = p[3];
            const float sm = ((a[0] + a[1]) + (a[2] + a[3])) + ((b[0] + b[1]) + (b[2] + b[3])) + ((c[0] + c[1]) + (c[2] + c[3])) + ((d[0] + d[1]) + (d[2] + d[3]));
            side[i * 256 + F.tid] = rsqrtf(sm * (1.f / 1024.f) + EPS); }
        else { const int r = u.pm < 32 ? 0 : 1 + ((u.pm - 32) >> 2); side[1024 + i * 256 + F.tid - 256] = bias[(size_t)r * ldb + u.pn * 256 + F.tid - 256]; }
    }
    __syncthreads();
}
__device__ __forceinline__ void phase_final(Frame& F) {
    const int lane = F.lane; const float* gw = F.in[34];
    for (int row = F.vcu * NWAVES + F.wave; row < M; row += F.G * NWAVES) {
        const bf16_t* xr = (const bf16_t*)(F.ws + OFF_X) + (size_t)row * D;
        f32x4 v[4]; float s = 0.f;
#pragma unroll
        for (int j = 0; j < 4; ++j) { const uint2 q = *(const uint2*)(xr + 4 * lane + 256 * j); v[j] = (f32x4){__uint_as_float(q.x << 16), __uint_as_float(q.x & 0xffff0000u), __uint_as_float(q.y << 16), __uint_as_float(q.y & 0xffff0000u)};
            s += v[j].x * v[j].x + v[j].y * v[j].y + v[j].z * v[j].z + v[j].w * v[j].w; }
        const float rstd = rsqrtf(wave_sum(s) * (1.f / D) + EPS);
        float* o = F.out + (size_t)row * D;
#pragma unroll
        for (int j = 0; j < 4; ++j) { const int c = 4 * lane + 256 * j; const f32x4 g = *(const f32x4*)(gw + c); f32x4 r = {v[j].x * rstd * g.x, v[j].y * rstd * g.y, v[j].z * rstd * g.z, v[j].w * rstd * g.w}; __builtin_nontemporal_store(r, (f32x4*)(o + c)); }
    }
}


typedef short v4i16_t __attribute__((ext_vector_type(4)));
constexpr int AT_KP = 160;
constexpr int AT_TILE = 128 * AT_KP;
constexpr int AT_K0 = 0, AT_V0 = 2 * AT_TILE, AT_RPB = 4 * AT_TILE, AT_END = AT_RPB + 2048;
__device__ __forceinline__ int queue_next(Frame& F, unsigned* ctr) {
    int t_ = F.wave * 64 + lane_id(); asm volatile("" : "+v"(t_));
    unsigned slot = MISC_OFF + 64; asm volatile("" : "+v"(slot));
    volatile LAS unsigned* bw = (volatile LAS unsigned*)(F.lds + slot);
    __syncthreads();
    if (t_ == 0) *bw = atomicAdd(ctr, 1u);
    __syncthreads();
    F.tid = t_; F.lane = t_ & 63;
    return (int)*bw;
}
__device__ __forceinline__ bf16x8 tr2(LAS const unsigned char* a, LAS const unsigned char* b) {
    const v4i16_t x = __builtin_amdgcn_ds_read_tr16_b64_v4i16((LAS v4i16_t*)a), y = __builtin_amdgcn_ds_read_tr16_b64_v4i16((LAS v4i16_t*)b);
    return (bf16x8){x[0], x[1], x[2], x[3], y[0], y[1], y[2], y[3]};
}
struct AttnState { f32x4 o[4]; float m, l; };
template <int NKB, bool MASKED>
__device__ __forceinline__ void attn_tile(AttnState& st, LAS const unsigned char* Kt, LAS const unsigned char* Vt, const bf16x8 (&qf)[2], int c0, int lane,
                                          LAS const float* rpbrow, int cw, int qc) {
    const int fr = lane & 15, fq = lane >> 4;
    f32x4 s[NKB];
#pragma unroll
    for (int kb = 0; kb < NKB; ++kb) {
        s[kb] = (f32x4){0.f, 0.f, 0.f, 0.f};
#pragma unroll
        for (int ks = 0; ks < 2; ++ks) {
            const bf16x8 a = *(LAS const bf16x8*)(Kt + (c0 + 16 * kb + fr) * AT_KP + (32 * ks + 8 * fq) * 2);
            s[kb] = __builtin_amdgcn_mfma_f32_16x16x32_bf16(a, qf[ks], s[kb], 0, 0, 0);
        }
    }
    float mloc = -1e30f;
#pragma unroll
    for (int kb = 0; kb < NKB; ++kb)
#pragma unroll
        for (int i = 0; i < 4; ++i) {
            float t = s[kb][i] * 0.125f;
            if (MASKED) { const int kc = cw + 16 * kb + 4 * fq + i, cs = min(max(qc - 8, 0), 48); t = (kc >= cs && kc < cs + 16) ? t + rpbrow[kc - qc + 15] : -1e30f; }
            s[kb][i] = t; mloc = fmaxf(mloc, t);
        }
    mloc = xmax32(xmax16(mloc));
    const float mn = fmaxf(st.m, mloc), alpha = __expf(st.m - mn);
    st.m = mn;
    float ls = 0.f;
#pragma unroll
    for (int kb = 0; kb < NKB; ++kb)
#pragma unroll
        for (int i = 0; i < 4; ++i) { const float pv = __expf(s[kb][i] - mn); s[kb][i] = pv; ls += pv; }
    st.l = st.l * alpha + ls;
#pragma unroll
    for (int db = 0; db < 4; ++db) st.o[db] = st.o[db] * alpha;
#pragma unroll
    for (int kk = 0; kk < NKB / 2; ++kk) {
        union { bf16x8 v; unsigned u[4]; } pf;
        pf.u[0] = pk2(s[2 * kk][0], s[2 * kk][1]); pf.u[1] = pk2(s[2 * kk][2], s[2 * kk][3]);
        pf.u[2] = pk2(s[2 * kk + 1][0], s[2 * kk + 1][1]); pf.u[3] = pk2(s[2 * kk + 1][2], s[2 * kk + 1][3]);
        LAS const unsigned char* va = Vt + (c0 + 32 * kk + 4 * fq + (fr >> 2)) * AT_KP + (4 * (fr & 3)) * 2;
#pragma unroll
        for (int db = 0; db < 4; ++db) {
            const bf16x8 vf = tr2(va + db * 32, va + 16 * AT_KP + db * 32);
            st.o[db] = __builtin_amdgcn_mfma_f32_16x16x32_bf16(vf, pf.v, st.o[db], 0, 0, 0);
        }
    }
}
struct AttnChain { AttnState st; bf16x8 qf[2]; int qrow, c0; };
__device__ __forceinline__ void attn_chain_init(AttnChain& ch, const bf16_t* proj, int qrow, int c0, int h, bool nat, int fq) {
    ch.qrow = qrow; ch.c0 = c0;
#pragma unroll
    for (int ks = 0; ks < 2; ++ks) ch.qf[ks] = *(const bf16x8*)(proj + (size_t)qrow * PN + PQ + h * 64 + 32 * ks + 8 * fq);
    ch.st.m = -1e30f; ch.st.l = 0.f;
#pragma unroll
    for (int db = 0; db < 4; ++db) ch.st.o[db] = (f32x4){0.f, 0.f, 0.f, 0.f};
}
__device__ __forceinline__ void attn_chain_store(const AttnChain& ch, bf16_t* mixb, int h, int fq) {
    const float inv = 1.f / xsum32(xsum16(ch.st.l));
    bf16_t* mix = mixb + (size_t)ch.qrow * D + 640 + h * 64 + 4 * fq;
#pragma unroll
    for (int db = 0; db < 4; ++db) { uint2 o; o.x = pk2(ch.st.o[db][0] * inv, ch.st.o[db][1] * inv); o.y = pk2(ch.st.o[db][2] * inv, ch.st.o[db][3] * inv); *(uint2*)(mix + 16 * db) = o; }
}
__device__ __forceinline__ void attn_unit(Frame& F, int l, int unit) {
    const int tid = F.tid, w = F.wave, fr = F.lane & 15, fq = F.lane >> 4;
    const bf16_t* proj = (const bf16_t*)(F.ws + OFF_PROJ);
    LAS unsigned char* lds = F.lds;
    const bool nat = unit < 192;
    int b, h, r = 0, rs_w = 0, rs0 = 0, nlat = 0;
    AttnChain ch0, ch1;
    if (nat) { b = unit / 24; h = (unit / 4) % 6; const int rq = unit % 4; r = 4 * rq + (w >> 1);
        rs_w = min(max(r - 4, 0), 8); rs0 = min(max(4 * rq - 4, 0), 8); const int rsl = min(max(4 * rq + 3 - 4, 0), 8); nlat = rsl + 8 - rs0;
        const int qb = MC + b * 1024 + r * 64 + fr;
        if (w & 1) { attn_chain_init(ch0, proj, qb + 32, 24, h, true, fq); attn_chain_init(ch1, proj, qb + 48, 32, h, true, fq); }
        else { attn_chain_init(ch0, proj, qb, 0, h, true, fq); attn_chain_init(ch1, proj, qb + 16, 8, h, true, fq); }
    } else { const int v = unit - 192; b = v / 6; h = v % 6; const int qb = b * 256 + 32 * w + fr;
        attn_chain_init(ch0, proj, qb, 0, h, false, fq); attn_chain_init(ch1, proj, qb + 16, 0, h, false, fq); }
    const int nlt = (nlat + 1) >> 1;
    const int ntiles = nat ? nlt + 2 : 2;
    if (nat) { const float* rpb = F.in[30] + (size_t)(l * 6 + h) * 465; for (int i = tid; i < 465; i += NTHREADS) ((LAS float*)(lds + AT_RPB))[i] = rpb[i]; }
    const int skey = tid >> 2, sch = (tid & 3) * 2;
    v4u rk0 = {0u, 0u, 0u, 0u}, rk1 = rk0, rv0 = rk0, rv1 = rk0;
#define AT_LOAD(ti_) do { const int ti__ = (ti_); \
        if (nat && ti__ >= nlt) { const size_t off = ((size_t)(b * 4 + l) * 256 + (ti__ - nlt) * 128 + skey) * 384 + h * 64 + sch * 8; \
            const bf16_t* pk_ = (const bf16_t*)(F.ws + OFF_CK) + off; const bf16_t* pv_ = (const bf16_t*)(F.ws + OFF_CV) + off; \
            rk0 = *(const v4u*)pk_; rk1 = *(const v4u*)(pk_ + 8); rv0 = *(const v4u*)pv_; rv1 = *(const v4u*)(pv_ + 8); \
        } else { const int grow = nat ? MC + b * 1024 + min(rs0 + 2 * ti__ + (skey >> 6), 15) * 64 + (skey & 63) : b * 256 + ti__ * 128 + skey; \
            const bf16_t* pr = proj + (size_t)grow * PN + h * 64 + sch * 8; rk0 = *(const v4u*)(pr + PK); rk1 = *(const v4u*)(pr + PK + 8); rv0 = *(const v4u*)(pr + PV); rv1 = *(const v4u*)(pr + PV + 8); } } while (0)
#define AT_WRITE(buf_) do { const int buf__ = (buf_); \
        *(LAS v4u*)(lds + AT_K0 + buf__ * AT_TILE + skey * AT_KP + sch * 16) = rk0; *(LAS v4u*)(lds + AT_K0 + buf__ * AT_TILE + skey * AT_KP + sch * 16 + 16) = rk1; \
        *(LAS v4u*)(lds + AT_V0 + buf__ * AT_TILE + skey * AT_KP + sch * 16) = rv0; *(LAS v4u*)(lds + AT_V0 + buf__ * AT_TILE + skey * AT_KP + sch * 16 + 16) = rv1; } while (0)
    AT_LOAD(0); AT_WRITE(0);
    __syncthreads();
    for (int ti = 0; ti < ntiles; ++ti) {
        const int buf = ti & 1;
        if (ti + 1 < ntiles) AT_LOAD(ti + 1);
        int lane = F.lane; asm volatile("" : "+v"(lane));
        LAS const unsigned char* Kt = lds + AT_K0 + buf * AT_TILE; LAS const unsigned char* Vt = lds + AT_V0 + buf * AT_TILE;
        if (nat && ti < nlt) {
#pragma unroll
            for (int sub = 0; sub < 2; ++sub) { const int kr = rs0 + 2 * ti + sub;
                if (kr >= rs_w && kr < rs_w + 8) { LAS const float* rrow = (LAS const float*)(lds + AT_RPB) + (kr - r + 7) * 31;
                    attn_tile<2, true>(ch0.st, Kt, Vt, ch0.qf, 64 * sub + ch0.c0, lane, rrow, ch0.c0, (ch0.qrow - MC) & 63); attn_tile<2, true>(ch1.st, Kt, Vt, ch1.qf, 64 * sub + ch1.c0, lane, rrow, ch1.c0, (ch1.qrow - MC) & 63); }
                __builtin_amdgcn_sched_barrier(0); }
        } else {
#pragma unroll
            for (int hf = 0; hf < 2; ++hf) {
                attn_tile<4, false>(ch0.st, Kt, Vt, ch0.qf, 64 * hf, lane, (LAS const float*)(lds + AT_RPB), 0, 0);
                attn_tile<4, false>(ch1.st, Kt, Vt, ch1.qf, 64 * hf, lane, (LAS const float*)(lds + AT_RPB), 0, 0); __builtin_amdgcn_sched_barrier(0); }
        }
        if (ti + 1 < ntiles) AT_WRITE(buf ^ 1);
        __syncthreads();
    }
    attn_chain_store(ch0, (bf16_t*)(F.ws + OFF_MIX), h, fq); attn_chain_store(ch1, (bf16_t*)(F.ws + OFF_MIX), h, fq);
}
constexpr int SS_P = 144;
constexpr int SS_IMG = 128 * SS_P;
constexpr int SS_HP = 144, SS_HIMG = 64 * SS_HP;
constexpr int SSA_B = 0, SSA_X = SS_IMG, SSA_TAB = 7 * SS_IMG;
constexpr int SSB_B = 0, SSB_C = SS_IMG, SSB_X = 2 * SS_IMG, SSB_H = 5 * SS_IMG, SSB_TAB = 5 * SS_IMG + 6 * SS_HIMG;
static_assert(SSB_TAB + 3 * 4 * 128 * 4 <= 163328 && SSA_TAB + 3 * 4 * 128 * 4 <= 163328, "SSD LDS map");
__device__ __forceinline__ void conv4x8(const bf16_t* proj, const float* cw, const float* cb, int seq_start, int seq_L, int t, int ch0, float (&v)[4][8]) {
    float xin[8][8];
#pragma unroll
    for (int rr = 0; rr < 8; ++rr) { const int tt = t - 2 + rr; v4u r = {0u, 0u, 0u, 0u};
        if (tt >= 0 && tt < seq_L) r = *(const v4u*)(proj + (size_t)(seq_start + tt) * PN + PX + ch0);
#pragma unroll
        for (int e = 0; e < 4; ++e) { xin[rr][2 * e] = __uint_as_float(r[e] << 16); xin[rr][2 * e + 1] = __uint_as_float(r[e] & 0xffff0000u); } }
    const f32x4 b0 = *(const f32x4*)(cb + ch0), b1 = *(const f32x4*)(cb + ch0 + 4);
#pragma unroll
    for (int k = 0; k < 4; ++k) { v[k][0] = b0[0]; v[k][1] = b0[1]; v[k][2] = b0[2]; v[k][3] = b0[3]; v[k][4] = b1[0]; v[k][5] = b1[1]; v[k][6] = b1[2]; v[k][7] = b1[3]; }
#pragma unroll
    for (int j = 0; j < 5; ++j) { const f32x4 w0 = *(const f32x4*)(cw + j * 640 + ch0), w1 = *(const f32x4*)(cw + j * 640 + ch0 + 4);
#pragma unroll
        for (int k = 0; k < 4; ++k) { v[k][0] += w0[0] * xin[k + j][0]; v[k][1] += w0[1] * xin[k + j][1]; v[k][2] += w0[2] * xin[k + j][2]; v[k][3] += w0[3] * xin[k + j][3];
            v[k][4] += w1[0] * xin[k + j][4]; v[k][5] += w1[1] * xin[k + j][5]; v[k][6] += w1[2] * xin[k + j][6]; v[k][7] += w1[3] * xin[k + j][7]; } }
#pragma unroll
    for (int k = 0; k < 4; ++k)
#pragma unroll
        for (int e = 0; e < 8; ++e) v[k][e] = silu_f(v[k][e]);
}
__device__ __forceinline__ void store8(LAS unsigned char* dst, const float (&v)[8], float sc) {
    v4u o; o[0] = pk2(v[0] * sc, v[1] * sc); o[1] = pk2(v[2] * sc, v[3] * sc); o[2] = pk2(v[4] * sc, v[5] * sc); o[3] = pk2(v[6] * sc, v[7] * sc);
    *(LAS v4u*)dst = o;
}
__device__ __forceinline__ void ssd_table(const float* dtraw  , float bias, float a, int dir, LAS float* tab, int lane) {
    const float d0 = softplus_f(dtraw[(2 * lane) * 12] + bias), d1 = softplus_f(dtraw[(2 * lane + 1) * 12] + bias);
    const float ps = d0 + d1; float x = ps;
    x += dppf<0x111>(x); x += dppf<0x112>(x); x += dppf<0x114>(x); x += dppf<0x118>(x);
    { const float t15 = rdlane(x, 15), t31 = rdlane(x, 31), t47 = rdlane(x, 47); const int rw = lane >> 4;
      x += (rw >= 1 ? t15 : 0.f) + (rw >= 2 ? t31 : 0.f) + (rw >= 3 ? t47 : 0.f); }
    tab[2 * lane] = d0; tab[2 * lane + 1] = d1;
    if (dir == 0) { const float ex = x - ps; tab[128 + 2 * lane] = a * (ex + d0); tab[128 + 2 * lane + 1] = a * (ex + ps); }
    else { const float tot = rdlane(x, 63); const float sx = tot - x; tab[128 + 2 * lane + 1] = a * (sx + d1); tab[128 + 2 * lane] = a * (sx + ps); }
}
__device__ __forceinline__ void ssd_a_unit(Frame& F, int l, int unit) {
    const int tid = F.tid, lane = F.lane, w = F.wave, fr = lane & 15, fq = lane >> 4;
    const int ci = unit >> 1, g = unit & 1, row0 = ci * 128;
    const SeqInfo q = row_seq(row0); const int t0 = row0 - q.start;
    const bf16_t* proj = (const bf16_t*)(F.ws + OFF_PROJ);
    const float* cw = F.in[14] + l * 5 * 640; const float* cb = F.in[15] + l * 640;
    LAS unsigned char* lds = F.lds; LAS float* tabs = (LAS float*)(lds + SSA_TAB);
    if (w < 6) { const int hh = w >> 1, dir = w & 1, h = 3 * g + hh;
        ssd_table((const float*)(F.ws + OFF_DT) + (size_t)row0 * 12 + dir * 6 + h, F.in[16][(l * 2 + dir) * 6 + h], -__expf(F.in[17][(l * 2 + dir) * 6 + h]), dir, tabs + (hh * 4 + dir * 2) * 128, lane); }
    float cv[2][4][8];
#pragma unroll
    for (int k2 = 0; k2 < 2; ++k2) { const int task = tid + k2 * NTHREADS, img = task >> 8, oc = (task >> 5) & 7, tb = task & 31;
        conv4x8(proj, cw, cb, q.start, q.L, t0 + 4 * tb, (img == 0 ? 384 + g * 64 : (3 * g + img - 1) * 64) + 8 * oc, cv[k2]); }
    __syncthreads();
#pragma unroll
    for (int k2 = 0; k2 < 2; ++k2) { const int task = tid + k2 * NTHREADS, img = task >> 8, oc = (task >> 5) & 7, tb = task & 31;
        if (img == 0) {
#pragma unroll
            for (int k = 0; k < 4; ++k) store8(lds + SSA_B + (4 * tb + k) * SS_P + oc * 16, cv[k2][k], 1.f);
        } else { const int hh = img - 1; LAS const float* tb4 = tabs + hh * 4 * 128;
#pragma unroll
            for (int k = 0; k < 4; ++k) { const int t = 4 * tb + k;
                const float wf = __expf(tb4[128 + 127] - tb4[128 + t]) * tb4[t], wb = __expf(tb4[384] - tb4[384 + t]) * tb4[256 + t];
                store8(lds + SSA_X + (2 * hh) * SS_IMG + t * SS_P + oc * 16, cv[k2][k], wf); store8(lds + SSA_X + (2 * hh + 1) * SS_IMG + t * SS_P + oc * 16, cv[k2][k], wb); } }
    }
    __syncthreads();
    const int dir = w >> 2, pb = w & 3;
    for (int hh = 0; hh < 3; ++hh) {
        const int h = 3 * g + hh;
        LAS const unsigned char* xa = lds + SSA_X + (2 * hh + dir) * SS_IMG + (4 * fq + (fr >> 2)) * SS_P + (16 * pb + 4 * (fr & 3)) * 2;
        LAS const unsigned char* ba = lds + SSA_B + (4 * fq + (fr >> 2)) * SS_P + (4 * (fr & 3)) * 2;
        f32x4 acc[4];
#pragma unroll
        for (int nb = 0; nb < 4; ++nb) acc[nb] = (f32x4){0.f, 0.f, 0.f, 0.f};
#pragma unroll
        for (int kk = 0; kk < 4; ++kk) {
            const bf16x8 af = tr2(xa + kk * 32 * SS_P, xa + (kk * 32 + 16) * SS_P);
#pragma unroll
            for (int nb = 0; nb < 4; ++nb) { const bf16x8 bfr = tr2(ba + kk * 32 * SS_P + nb * 32, ba + (kk * 32 + 16) * SS_P + nb * 32); acc[nb] = __builtin_amdgcn_mfma_f32_16x16x32_bf16(af, bfr, acc[nb], 0, 0, 0); }
        }
        bf16_t* cs = (bf16_t*)(F.ws + OFF_CS) + ((size_t)(ci * 6 + h) * 2 + dir) * 4096;
#pragma unroll
        for (int nb = 0; nb < 4; ++nb)
#pragma unroll
            for (int i = 0; i < 4; ++i) cs[(16 * pb + 4 * fq + i) * 64 + 16 * nb + fr] = f2bf(acc[nb][i]);
        if (tid == 0) { LAS const float* tb = tabs + hh * 4 * 128; float* cd = (float*)(F.ws + OFF_TAB + TAB_CD) + (size_t)(ci * 6 + h) * 2; cd[0] = __expf(tb[128 + 127]); cd[1] = __expf(tb[384]); }
    }
}
__device__ __forceinline__ void ssd_state_pass(Frame& F, int l) {
    const int tid = F.tid, p = tid >> 3, n0 = (tid & 7) * 8;
    const float* cdt = (const float*)(F.ws + OFF_TAB + TAB_CD); const bf16_t* csb = (const bf16_t*)(F.ws + OFF_CS);
    bf16_t* hin = (bf16_t*)(F.ws + OFF_HIN);
    for (int task = F.vcu; task < NSEQ * 12; task += F.G) {
        int s, hd; if (task < LB * 12) { s = CB + task / 12; hd = task % 12; } else { s = (task - LB * 12) / 12; hd = (task - LB * 12) % 12; }
        const int h = hd >> 1, dir = hd & 1;
        const SeqInfo q = seq_info(s); const int nch = q.L >> 7, ci0 = q.start >> 7;
        f32x4 s0 = {0.f, 0.f, 0.f, 0.f}, s1 = s0;
        if (!q.ctx) { const float* h0 = F.in[4] + ((((size_t)q.b * 4 + l) * 2 + dir) * 6 + h) * 4096 + p * 64 + n0; s0 = *(const f32x4*)h0; s1 = *(const f32x4*)(h0 + 4); }
        for (int k = 0; k < nch; k += 2) {
            size_t ix[2]; float dcy[2]; f32x4 c0[2], c1[2];
#pragma unroll
            for (int u = 0; u < 2; ++u) { const int c = dir == 0 ? k + u : nch - 1 - (k + u); ix[u] = (size_t)((ci0 + c) * 6 + h) * 2 + dir;
                dcy[u] = cdt[ix[u]]; const v4u cq = *(const v4u*)(csb + ix[u] * 4096 + p * 64 + n0);
                c0[u] = (f32x4){__uint_as_float(cq[0] << 16), __uint_as_float(cq[0] & 0xffff0000u), __uint_as_float(cq[1] << 16), __uint_as_float(cq[1] & 0xffff0000u)}; c1[u] = (f32x4){__uint_as_float(cq[2] << 16), __uint_as_float(cq[2] & 0xffff0000u), __uint_as_float(cq[3] << 16), __uint_as_float(cq[3] & 0xffff0000u)}; }
#pragma unroll
            for (int u = 0; u < 2; ++u) {
                v4u o; o[0] = pk2(s0[0], s0[1]); o[1] = pk2(s0[2], s0[3]); o[2] = pk2(s1[0], s1[1]); o[3] = pk2(s1[2], s1[3]);
                if (!(q.ctx && k + u == 0)) *(v4u*)(hin + ix[u] * 4096 + p * 64 + n0) = o;
                s0 = s0 * dcy[u] + c0[u]; s1 = s1 * dcy[u] + c1[u];
            }
        }
        if (q.ctx) { float* o4 = F.out + O_SSD + ((((size_t)q.b * 4 + l) * 2 + dir) * 6 + h) * 4096 + p * 64 + n0; *(f32x4*)o4 = s0; *(f32x4*)(o4 + 4) = s1; }
    }
}
__device__ __forceinline__ void ssd_b_unit(Frame& F, int l, int unit) {
    const int tid = F.tid, lane = F.lane, w = F.wave, fr = lane & 15, fq = lane >> 4;
    const int ci = unit >> 1, g = unit & 1, row0 = ci * 128;
    const SeqInfo q = row_seq(row0); const int t0 = row0 - q.start;
    const bf16_t* proj = (const bf16_t*)(F.ws + OFF_PROJ);
    const float* cw = F.in[14] + l * 5 * 640; const float* cb = F.in[15] + l * 640;
    LAS unsigned char* lds = F.lds; LAS float* tabs = (LAS float*)(lds + SSB_TAB);
    if (w < 6) { const int hh = w >> 1, dir = w & 1, h = 3 * g + hh;
        ssd_table((const float*)(F.ws + OFF_DT) + (size_t)row0 * 12 + dir * 6 + h, F.in[16][(l * 2 + dir) * 6 + h], -__expf(F.in[17][(l * 2 + dir) * 6 + h]), dir, tabs + (hh * 4 + dir * 2) * 128, lane); }
    {
        const bf16_t* hin = (const bf16_t*)(F.ws + OFF_HIN) + (size_t)((ci * 6 + 3 * g) * 2) * 4096 + (tid >> 3) * 64 + (tid & 7) * 8;
#pragma unroll
        for (int k = 0; k < 6; ++k) { const bool zero = q.ctx && ((k & 1) == (t0 == 0 ? 0 : 1));
            *(LAS v4u*)(lds + SSB_H + k * SS_HIMG + (tid >> 3) * SS_HP + (tid & 7) * 16) = zero ? (v4u){0u, 0u, 0u, 0u} : *(const v4u*)(hin + (size_t)k * 4096); }
    }
    for (int task = tid; task < 1280; task += NTHREADS) {
        const int img = task >> 8, oc = (task >> 5) & 7, tb = task & 31;
        const int chb = img == 0 ? 384 + g * 64 : (img == 1 ? 512 + g * 64 : (3 * g + img - 2) * 64);
        float v[4][8]; conv4x8(proj, cw, cb, q.start, q.L, t0 + 4 * tb, chb + 8 * oc, v);
        LAS unsigned char* dst = lds + (img == 0 ? SSB_B : (img == 1 ? SSB_C : SSB_X + (img - 2) * SS_IMG)) + (4 * tb) * SS_P + oc * 16;
#pragma unroll
        for (int k = 0; k < 4; ++k) store8(dst + k * SS_P, v[k], 1.f);
    }
    __syncthreads();
    bf16x8 cf[2];
#pragma unroll
    for (int ks = 0; ks < 2; ++ks) cf[ks] = *(LAS const bf16x8*)(lds + SSB_C + (16 * w + fr) * SS_P + (32 * ks + 8 * fq) * 2);
    f32x4 gt[8];
#pragma unroll
    for (int sb = 0; sb < 8; ++sb) { gt[sb] = (f32x4){0.f, 0.f, 0.f, 0.f};
#pragma unroll
        for (int ks = 0; ks < 2; ++ks) { const bf16x8 bfr = *(LAS const bf16x8*)(lds + SSB_B + (16 * sb + fr) * SS_P + (32 * ks + 8 * fq) * 2); gt[sb] = __builtin_amdgcn_mfma_f32_16x16x32_bf16(bfr, cf[ks], gt[sb], 0, 0, 0); } }
    float ss[4] = {0.f, 0.f, 0.f, 0.f};
    bf16_t* yup = (bf16_t*)(F.ws + OFF_MIX) + (size_t)(row0 + 16 * w + 4 * fq) * D + fr;
    for (int hh = 0; hh < 3; ++hh) {
        const int h = 3 * g + hh;
        LAS const float* tb = tabs + hh * 4 * 128;
        unsigned short zv[4][4];
#pragma unroll
        for (int i = 0; i < 4; ++i)
#pragma unroll
            for (int pb = 0; pb < 4; ++pb) zv[i][pb] = proj[(size_t)(row0 + 16 * w + 4 * fq + i) * PN + PZ + h * 64 + 16 * pb + fr];
        const float at = tb[128 + 16 * w + fr], bt = tb[384 + 16 * w + fr];
        f32x4 y[4];
#pragma unroll
        for (int pb = 0; pb < 4; ++pb) y[pb] = (f32x4){0.f, 0.f, 0.f, 0.f};
        LAS const unsigned char* xa = lds + SSB_X + hh * SS_IMG + (4 * fq + (fr >> 2)) * SS_P + (4 * (fr & 3)) * 2;
#pragma unroll
        for (int kk = 0; kk < 4; ++kk) {
            float mv[8];
#pragma unroll
            for (int half = 0; half < 2; ++half) { const int sb = 2 * kk + half; const int s0i = 16 * sb + 4 * fq;
                if (sb < w) { const f32x4 cumf = *(LAS const f32x4*)(tb + 128 + s0i), dtf = *(LAS const f32x4*)(tb + s0i);
#pragma unroll
                    for (int i = 0; i < 4; ++i) mv[half * 4 + i] = __expf(at - cumf[i]) * dtf[i] * gt[sb][i];
                } else if (sb > w) { const f32x4 cumb = *(LAS const f32x4*)(tb + 384 + s0i), dtb = *(LAS const f32x4*)(tb + 256 + s0i);
#pragma unroll
                    for (int i = 0; i < 4; ++i) mv[half * 4 + i] = __expf(bt - cumb[i]) * dtb[i] * gt[sb][i];
                } else { const f32x4 cumf = *(LAS const f32x4*)(tb + 128 + s0i), dtf = *(LAS const f32x4*)(tb + s0i), cumb = *(LAS const f32x4*)(tb + 384 + s0i), dtb = *(LAS const f32x4*)(tb + 256 + s0i);
#pragma unroll
                    for (int i = 0; i < 4; ++i) { const int s = s0i + i, t = 16 * w + fr; float m = 0.f;
                        if (s <= t) m += __expf(at - cumf[i]) * dtf[i];
                        if (s >= t) m += __expf(bt - cumb[i]) * dtb[i];
                        mv[half * 4 + i] = m * gt[sb][i]; } } }
            union { bf16x8 v; unsigned u[4]; } mf; mf.u[0] = pk2(mv[0], mv[1]); mf.u[1] = pk2(mv[2], mv[3]); mf.u[2] = pk2(mv[4], mv[5]); mf.u[3] = pk2(mv[6], mv[7]);
#pragma unroll
            for (int pb = 0; pb < 4; ++pb) { const bf16x8 xf = tr2(xa + kk * 32 * SS_P + pb * 32, xa + (kk * 32 + 16) * SS_P + pb * 32); y[pb] = __builtin_amdgcn_mfma_f32_16x16x32_bf16(mf.v, xf, y[pb], 0, 0, 0); }
        }
        f32x4 yf[4], yb[4];
#pragma unroll
        for (int pb = 0; pb < 4; ++pb) { yf[pb] = (f32x4){0.f, 0.f, 0.f, 0.f}; yb[pb] = yf[pb];
#pragma unroll
            for (int ks = 0; ks < 2; ++ks) {
                const bf16x8 hf = *(LAS const bf16x8*)(lds + SSB_H + (2 * hh) * SS_HIMG + (16 * pb + fr) * SS_HP + (32 * ks + 8 * fq) * 2);
                const bf16x8 hb = *(LAS const bf16x8*)(lds + SSB_H + (2 * hh + 1) * SS_HIMG + (16 * pb + fr) * SS_HP + (32 * ks + 8 * fq) * 2);
                yf[pb] = __builtin_amdgcn_mfma_f32_16x16x32_bf16(cf[ks], hf, yf[pb], 0, 0, 0);
                yb[pb] = __builtin_amdgcn_mfma_f32_16x16x32_bf16(cf[ks], hb, yb[pb], 0, 0, 0); } }
        const float dsk = F.in[18][l * 6 + h];
        float nwv[4];
#pragma unroll
        for (int pb = 0; pb < 4; ++pb) nwv[pb] = F.in[19][l * 384 + h * 64 + 16 * pb + fr];
        const f32x4 cumf4 = *(LAS const f32x4*)(tb + 128 + 16 * w + 4 * fq), cumb4 = *(LAS const f32x4*)(tb + 384 + 16 * w + 4 * fq);
#pragma unroll
        for (int i = 0; i < 4; ++i) { const float ef = __expf(cumf4[i]), eb = __expf(cumb4[i]); const int tl = 16 * w + 4 * fq + i;
#pragma unroll
            for (int pb = 0; pb < 4; ++pb) { const float xv = bf2f(*(LAS const bf16_t*)(lds + SSB_X + hh * SS_IMG + tl * SS_P + (16 * pb + fr) * 2));
                const float yv = y[pb][i] + ef * yf[pb][i] + eb * yb[pb][i] + dsk * xv;
                const float gv = yv * silu_f(bf2f(zv[i][pb])); ss[i] += gv * gv;
                yup[(size_t)i * D + h * 64 + 16 * pb] = f2bf(gv * nwv[pb]); } }
    }
#pragma unroll
    for (int i = 0; i < 4; ++i) { const float v = row16_sum(ss[i]);
        if (fr == 0) ((float*)(F.ws + OFF_TAB + TAB_SSQ))[(size_t)(row0 + 16 * w + 4 * fq + i) * 2 + g] = v; }
}
constexpr int S5_HP = 144;
constexpr int S5_IMG = 128 * S5_HP;
constexpr int S5_GP = 528, S5_G = 4 * S5_IMG, S5_END = S5_G + 64 * S5_GP;
typedef float f32x16 __attribute__((ext_vector_type(16)));
typedef float f32x8 __attribute__((ext_vector_type(8)));
__device__ __forceinline__ float swap32sel(float x, int odd) {
    const auto r = __builtin_amdgcn_permlane32_swap(__float_as_uint(x), __float_as_uint(x), false, false);
    return __uint_as_float(odd ? r[1] : r[0]);
}
template <int DIR, bool FULL>
__device__ __forceinline__ void s5_dir(Frame& F, int l, int g, int p, int hi, const bf16x8 (&uf)[2], float& cr, float& ci, f32x16 (&hr)[2], f32x16 (&hq)[2]) {
    const float* ab = (const float*)(F.ws + OFF_TAB + TAB_ABAR) + (size_t)((((l * 2 + DIR) * 16 + g) * 64) + p) * 2;
    const float ar = ab[0], ai = ab[1];
    const float a2r = ar * ar - ai * ai, a2i = 2.f * ar * ai, a3r = a2r * ar - a2i * ai, a3i = a2r * ai + a2i * ar, a4r = a2r * a2r - a2i * a2i, a4i = 2.f * a2r * a2i;
    const bf16_t* bbt = (const bf16_t*)(F.ws + OFF_TAB + TAB_BBT) + ((size_t)(((l * 2 + DIR) * 16 + g) * 2) * 64 + p) * 16 + 8 * hi;
    const bf16x8 bre = *(const bf16x8*)bbt, bim = *(const bf16x8*)(bbt + 64 * 16);
    f32x16 xr[2], xi[2];
#pragma unroll
    for (int rb = 0; rb < 2; ++rb) {
        const f32x16 z = {0.f, 0.f, 0.f, 0.f, 0.f, 0.f, 0.f, 0.f, 0.f, 0.f, 0.f, 0.f, 0.f, 0.f, 0.f, 0.f};
        xr[rb] = __builtin_amdgcn_mfma_f32_32x32x16_bf16(uf[rb], bre, z, 0, 0, 0); xi[rb] = __builtin_amdgcn_mfma_f32_32x32x16_bf16(uf[rb], bim, z, 0, 0, 0);
    }
#pragma unroll
    for (int rb = 0; rb < 2; ++rb)
#pragma unroll
        for (int G4 = 0; G4 < 4; ++G4) {
            if (DIR == 0) {
#pragma unroll
                for (int e = 1; e < 4; ++e) { const int i = 4 * G4 + e; const float pr = xr[rb][i - 1], pi = xi[rb][i - 1]; xr[rb][i] += ar * pr - ai * pi; xi[rb][i] += ar * pi + ai * pr; }
            } else {
#pragma unroll
                for (int e = 2; e >= 0; --e) { const int i = 4 * G4 + e; const float pr = xr[rb][i + 1], pi = xi[rb][i + 1]; xr[rb][i] += ar * pr - ai * pi; xi[rb][i] += ar * pi + ai * pr; }
            }
        }
    f32x8 cinr = {0.f, 0.f, 0.f, 0.f, 0.f, 0.f, 0.f, 0.f}, cini = cinr;
#pragma unroll
    for (int kk = 0; kk < 16; ++kk) {
        const int k = DIR == 0 ? kk : 15 - kk, gi = k >> 1, rb = gi >> 2, il = 4 * (gi & 3) + (DIR == 0 ? 3 : 0), odd = k & 1;
        const bool first = DIR == 0 ? !odd : odd;
        if (first) { cinr[gi] = cr; cini[gi] = ci; } else { const bool own = (hi == odd); cinr[gi] = own ? cr : cinr[gi]; cini[gi] = own ? ci : cini[gi]; }
        const float nr = a4r * cr - a4i * ci + xr[rb][il], ni = a4r * ci + a4i * cr + xi[rb][il];
        cr = swap32sel(nr, odd); ci = swap32sel(ni, odd);
    }
    if (FULL) {
#pragma unroll
        for (int rb = 0; rb < 2; ++rb)
#pragma unroll
            for (int G4 = 0; G4 < 4; ++G4) {
                const int gi = rb * 4 + G4;
#pragma unroll
                for (int e = 0; e < 4; ++e) {
                    const int i = 4 * G4 + e, pw = DIR == 0 ? e + 1 : 4 - e;
                    const float pr = pw == 1 ? ar : (pw == 2 ? a2r : (pw == 3 ? a3r : a4r)), pi = pw == 1 ? ai : (pw == 2 ? a2i : (pw == 3 ? a3i : a4i));
                    hr[rb][i] += xr[rb][i] + pr * cinr[gi] - pi * cini[gi];
                    hq[rb][i] += xi[rb][i] + pr * cini[gi] + pi * cinr[gi];
                }
            }
    }
}
template <bool FULL>
__device__ __forceinline__ void s5_wave_unit(Frame& F, int l, int row0, int g, int ph, float& cfr, float& cfi, float& cbr, float& cbi, LAS unsigned char* himg) {
    const int lane = F.lane, r32 = lane & 31, hi = lane >> 5, p = 32 * ph + r32;
    const bf16_t* proj = (const bf16_t*)(F.ws + OFF_PROJ);
    bf16x8 uf[2];
#pragma unroll
    for (int rb = 0; rb < 2; ++rb) uf[rb] = *(const bf16x8*)(proj + (size_t)(row0 + 32 * rb + r32) * PN + PU + g * 16 + 8 * hi);
    f32x16 hr[2], hq[2];
#pragma unroll
    for (int rb = 0; rb < 2; ++rb) { hr[rb] = (f32x16){0.f, 0.f, 0.f, 0.f, 0.f, 0.f, 0.f, 0.f, 0.f, 0.f, 0.f, 0.f, 0.f, 0.f, 0.f, 0.f}; hq[rb] = hr[rb]; }
    s5_dir<0, FULL>(F, l, g, p, hi, uf, cfr, cfi, hr, hq);
    s5_dir<1, FULL>(F, l, g, p, hi, uf, cbr, cbi, hr, hq);
    if (FULL) {
#pragma unroll
        for (int rb = 0; rb < 2; ++rb)
#pragma unroll
            for (int G4 = 0; G4 < 4; ++G4) { const int t = 32 * rb + 8 * G4 + 4 * hi;
                v2u qr, qi; qr.x = pk2(hr[rb][4 * G4], hr[rb][4 * G4 + 1]); qr.y = pk2(hr[rb][4 * G4 + 2], hr[rb][4 * G4 + 3]); qi.x = pk2(hq[rb][4 * G4], hq[rb][4 * G4 + 1]); qi.y = pk2(hq[rb][4 * G4 + 2], hq[rb][4 * G4 + 3]);
                *(LAS v2u*)(himg + p * S5_HP + t * 2) = qr; *(LAS v2u*)(himg + (64 + p) * S5_HP + t * 2) = qi; }
    }
}
__device__ __forceinline__ void cpow64(float ar, float ai, float& or_, float& oi_) {
#pragma unroll
    for (int s = 0; s < 6; ++s) { const float nr = ar * ar - ai * ai, ni = 2.f * ar * ai; ar = nr; ai = ni; }
    or_ = ar; oi_ = ai;
}
__device__ __forceinline__ void s5_a_unit(Frame& F, int l, int cj) {
    const int w = F.wave, lane = F.lane, row0 = cj * 64;
    float* E = (float*)(F.ws + OFF_E);
    for (int it = w; it < 32; it += NWAVES) {
        const int g = it >> 1, ph = it & 1;
        float cfr = 0.f, cfi = 0.f, cbr = 0.f, cbi = 0.f;
        s5_wave_unit<false>(F, l, row0, g, ph, cfr, cfi, cbr, cbi, F.lds);
        if (lane < 32) { ((unsigned*)E)[(size_t)((cj * 2 + 0) * 16 + g) * 64 + 32 * ph + lane] = pk2(cfr, cfi);
                         ((unsigned*)E)[(size_t)((cj * 2 + 1) * 16 + g) * 64 + 32 * ph + lane] = pk2(cbr, cbi); }
    }
}
__device__ __forceinline__ void tk_gen_task(Frame& F, int l, int g, int half) {
    const int lane = F.lane, fr = lane & 15, fq = lane >> 4, w = F.wave;
    const int di = 16 * w + fr;
    f32x4 acc[8];
#pragma unroll
    for (int nb = 0; nb < 8; ++nb) acc[nb] = (f32x4){0.f, 0.f, 0.f, 0.f};
#pragma unroll 1
    for (int c4 = 0; c4 < 4; ++c4) {
        const int dir = c4 >> 1, p0 = 32 * (c4 & 1) + 8 * fq;
        const int ex = dir == 0 ? di - 64 : 64 - di;
        const bool valid = ex >= 0 && ex <= 63;
        const float* ab = (const float*)(F.ws + OFF_TAB + TAB_ABAR) + ((size_t)((l * 2 + dir) * 16 + g) * 64 + p0) * 2;
        float zr[8], zi[8];
#pragma unroll
        for (int e = 0; e < 8; ++e) {
            float br = ab[2 * e], bi = ab[2 * e + 1], rr = 1.f, rq = 0.f; int n = valid ? ex : 0;
#pragma unroll
            for (int bit = 0; bit < 6; ++bit) { const bool on = n & 1; const float nr = rr * br - rq * bi, ni = rr * bi + rq * br; rr = on ? nr : rr; rq = on ? ni : rq; n >>= 1;
                const float s2r = br * br - bi * bi, s2i = 2.f * br * bi; br = s2r; bi = s2i; }
            zr[e] = valid ? rr : 0.f; zi[e] = valid ? rq : 0.f;
        }
        v4u t0, t1;
#pragma unroll
        for (int h2 = 0; h2 < 4; ++h2) { t0[h2] = pk2(zr[2 * h2], zr[2 * h2 + 1]); t1[h2] = pk2(zi[2 * h2], zi[2 * h2 + 1]); }
        const bf16x8 azr = __builtin_bit_cast(bf16x8, t0), azi = __builtin_bit_cast(bf16x8, t1);
        float2 bb[8];
#pragma unroll
        for (int e = 0; e < 8; ++e) bb[e] = ((const float2*)(F.ws + OFF_BB32))[((size_t)((l * 2 + dir) * 16 + g) * 64 + p0 + e) * 16 + fr];
#pragma unroll
        for (int nb = 0; nb < 8; ++nb) {
            size_t co = ((size_t)(l * 16 + g) * 16 + 8 * half + nb) * 64 + p0; if ((nb & 3) == 0 && nb) asm volatile("" : "+v"(co), "+v"(acc[nb - 1]));
            const f32x4 c0 = *(const f32x4*)(F.in[25] + co), c1 = *(const f32x4*)(F.in[25] + co + 4), d0 = *(const f32x4*)(F.in[26] + co), d1 = *(const f32x4*)(F.in[26] + co + 4);
            v4u wre, wim;
#pragma unroll
            for (int h2 = 0; h2 < 4; ++h2) {
                const int e0 = 2 * h2, e1 = e0 + 1;
                const float cr0 = e0 < 4 ? c0[e0] : c1[e0 - 4], ci0 = e0 < 4 ? d0[e0] : d1[e0 - 4], cr1 = e1 < 4 ? c0[e1] : c1[e1 - 4], ci1 = e1 < 4 ? d0[e1] : d1[e1 - 4];
                wre[h2] = pk2(cr0 * bb[e0].x - ci0 * bb[e0].y, cr1 * bb[e1].x - ci1 * bb[e1].y);
                wim[h2] = pk2(-(cr0 * bb[e0].y + ci0 * bb[e0].x), -(cr1 * bb[e1].y + ci1 * bb[e1].x));
            }
            acc[nb] = __builtin_amdgcn_mfma_f32_16x16x32_bf16(azr, __builtin_bit_cast(bf16x8, wre), acc[nb], 0, 0, 0);
            acc[nb] = __builtin_amdgcn_mfma_f32_16x16x32_bf16(azi, __builtin_bit_cast(bf16x8, wim), acc[nb], 0, 0, 0);
        }
    }
    bf16_t* tk = (bf16_t*)(F.ws + OFF_TK) + (size_t)(l * 16 + g) * 128 * 256;
#pragma unroll
    for (int nb = 0; nb < 8; ++nb) { const int co = 8 * half + nb; const float dsk = F.in[27][l * 256 + g * 16 + co];
#pragma unroll
        for (int i = 0; i < 4; ++i) { const int dr = 16 * w + 4 * fq + i; tk[(size_t)dr * 256 + co * 16 + fr] = f2bf(acc[nb][i] + ((dr == 64 && co == fr) ? dsk : 0.f)); } }
}
constexpr int S5C_PL = 1536, S5C_H = 32 * S5C_PL, S5C_RING = S5C_H + 16384, S5C_PT0 = S5C_RING + 32768;
constexpr size_t OFF_GS5 = 154 * MiB;
__device__ __forceinline__ void s5c_unit(Frame& F, int l, int u) {
    const int w = F.wave, gp = u & 7, cg = u >> 3, g0 = 2 * gp, row0 = cg * 512, cj0 = cg * 8;
    const bf16_t* proj = (const bf16_t*)(F.ws + OFF_PROJ);
    LAS unsigned char* lds = F.lds;
    int ln = F.tid; asm volatile("" : "+v"(ln)); ln &= 63; const int fr = ln & 15, fq = ln >> 4;
    const int gl = w & 1, g = g0 + gl, cp = w >> 1;
    const bf16_t* tkw = (const bf16_t*)(F.ws + OFF_TK) + (size_t)(l * 16 + g) * 128 * 256 + (size_t)(fq >> 1) * 256 + fr * 16 + 8 * (fq & 1) + (size_t)(4 * cp) * 256;
    LAS unsigned char* ringw = lds + S5C_RING + (gl * 8 + 2 * cp) * 1024 + ln * 16;
    LAS const unsigned char* ringr = lds + S5C_RING + (gl * 8) * 1024 + ln * 16;
    v4u tf[8][2];
    {
        const int tid = F.tid;
        v4u uu[4], hh[2];
#pragma unroll
        for (int k = 0; k < 4; ++k) { const int i = tid + k * NTHREADS, token = i >> 2; uu[k] = *(const v4u*)(proj + (size_t)(row0 + token) * PN + PU + (g0 + ((i >> 1) & 1)) * 16 + 8 * (i & 1)); }
#pragma unroll
        for (int k = 0; k < 1; ++k) { const int i = tid; hh[k] = *(const v4u*)((const unsigned*)(F.ws + OFF_H5) + (size_t)(((cj0 + (i >> 6)) * 2 + ((i >> 5) & 1)) * 16 + g0) * 64 + 4 * (i & 31)); }
#pragma unroll
        for (int jb = 0; jb < 8; ++jb) { tf[jb][0] = *(const v4u*)(tkw + (size_t)(16 * jb) * 256); tf[jb][1] = *(const v4u*)(tkw + (size_t)(16 * jb + 2) * 256); }
#pragma unroll
        for (int k = 0; k < 2; ++k) { const int i = tid + k * NTHREADS, r = i & 31; *(LAS v4u*)(lds + (i >> 5) * S5C_PL + (r < 16 ? r : 64 + r) * 16) = (v4u){0u, 0u, 0u, 0u}; }
#pragma unroll
        for (int k = 0; k < 4; ++k) { const int i = tid + k * NTHREADS, token = i >> 2; *(LAS v4u*)(lds + (((token >> 6) * 2 + ((i >> 1) & 1)) * 2 + (i & 1)) * S5C_PL + (16 + (token & 63)) * 16) = uu[k]; }
#pragma unroll
        for (int k = 0; k < 1; ++k) { const int i = tid; *(LAS v4u*)(lds + S5C_H + 16 * i) = hh[k]; }
        *(LAS v4u*)ringw = tf[0][0]; *(LAS v4u*)(ringw + 1024) = tf[0][1];
    }
    __syncthreads();
    f32x4 acc[2][4];
#pragma unroll
    for (int ch = 0; ch < 2; ++ch)
#pragma unroll
        for (int tb = 0; tb < 4; ++tb) acc[ch][tb] = (f32x4){0.f, 0.f, 0.f, 0.f};
    LAS const unsigned char* ulo = lds + (((2 * cp) * 2 + gl) * 2 + (fq & 1)) * S5C_PL + (fr + 2 - (fq >> 1)) * 16;
    f32x4 cc[8];
    v4u pf[2][4];
#pragma unroll
    for (int jo = 0; jo < 8; ++jo) {
        if (jo == 4) {
#pragma unroll
            for (int hp = 0; hp < 2; ++hp) { const size_t co = ((size_t)(l * 16 + g) * 16 + fr) * 64 + 32 * hp + 8 * fq;
                cc[4 * hp] = *(const f32x4*)(F.in[25] + co); cc[4 * hp + 1] = *(const f32x4*)(F.in[25] + co + 4); cc[4 * hp + 2] = *(const f32x4*)(F.in[26] + co); cc[4 * hp + 3] = *(const f32x4*)(F.in[26] + co + 4); }
#pragma unroll
            for (int dir = 0; dir < 2; ++dir)
#pragma unroll
                for (int ks = 0; ks < 4; ++ks) pf[dir][ks] = *(const v4u*)((const bf16_t*)(F.ws + OFF_PT64) + ((size_t)((l * 2 + dir) * 16 + g) * 64 + 16 * cp + fr) * 128 + 8 * fq + 32 * ks);
        }
        bf16x8 a[8];
#pragma unroll
        for (int ji = 0; ji < 8; ++ji) a[ji] = *(LAS const bf16x8*)(ringr + (jo & 1) * 16384 + ji * 1024);
        __builtin_amdgcn_sched_barrier(0);
        {
            const int tb_lo = jo > 4 ? jo - 4 : 0, tb_hi = jo < 3 ? jo : 3, ntb = tb_hi - tb_lo + 1, ns = 16 * ntb;
            bf16x8 bq[8];
#pragma unroll
            for (int s = 0; s < 8; ++s) bq[s] = *(LAS const bf16x8*)(ulo + (s % 2) * (4 * S5C_PL) + (2 * (39 - 8 * (jo - (tb_lo + (s / 2) % ntb)) - s / (2 * ntb))) * 16);
            __builtin_amdgcn_sched_barrier(0);
#pragma unroll
            for (int s = 0; s < ns; ++s) {
                const int ch = s % 2, tb = tb_lo + (s / 2) % ntb, ji = s / (2 * ntb);
                acc[ch][tb] = __builtin_amdgcn_mfma_f32_16x16x32_bf16(a[ji], bq[s & 7], acc[ch][tb], 0, 0, 0);
                if (s + 8 < ns) { const int s2 = s + 8; bq[s & 7] = *(LAS const bf16x8*)(ulo + (s2 % 2) * (4 * S5C_PL) + (2 * (39 - 8 * (jo - (tb_lo + (s2 / 2) % ntb)) - s2 / (2 * ntb))) * 16); }
                __builtin_amdgcn_sched_barrier(0);
            }
        }
        if (jo < 7) { *(LAS v4u*)(ringw + ((jo + 1) & 1) * 16384) = tf[jo + 1][0]; *(LAS v4u*)(ringw + ((jo + 1) & 1) * 16384 + 1024) = tf[jo + 1][1]; }
        else {
#pragma unroll
            for (int ks = 0; ks < 4; ++ks) *(LAS v4u*)(lds + S5C_PT0 + (gl * 16 + 4 * cp + ks) * 1024 + ln * 16) = pf[0][ks];
        }
        __syncthreads();
    }
#pragma unroll
    for (int ks = 0; ks < 4; ++ks) *(LAS v4u*)(lds + S5C_RING + (gl * 16 + 4 * cp + ks) * 1024 + ln * 16) = pf[1][ks];
#pragma unroll
    for (int dir = 0; dir < 2; ++dir) {
        if (dir == 1) __syncthreads();
        bf16x8 rg[16];
#pragma unroll
        for (int i = 0; i < 16; ++i) rg[i] = *(LAS const bf16x8*)(lds + (dir == 0 ? S5C_PT0 : S5C_RING) + (gl * 16 + i) * 1024 + ln * 16);
#pragma unroll
        for (int ch = 0; ch < 2; ++ch) {
            v4u fA[4];
#pragma unroll
            for (int hp = 0; hp < 2; ++hp) {
                const int p0 = 32 * hp + 8 * fq;
#pragma unroll
                for (int e2 = 0; e2 < 4; ++e2) { const v2u hq = *(LAS const v2u*)(lds + S5C_H + ((((2 * cp + ch) * 2 + dir) * 2 + gl) * 64 + p0 + 2 * e2) * 4);
                    const f32x4 h = {__uint_as_float(hq.x << 16), __uint_as_float(hq.x & 0xffff0000u), __uint_as_float(hq.y << 16), __uint_as_float(hq.y & 0xffff0000u)};
                    const int e0 = 2 * e2, e1 = e0 + 1;
                    const float cr0 = e0 < 4 ? cc[4 * hp][e0] : cc[4 * hp + 1][e0 - 4], ci0 = e0 < 4 ? cc[4 * hp + 2][e0] : cc[4 * hp + 3][e0 - 4], cr1 = e1 < 4 ? cc[4 * hp][e1] : cc[4 * hp + 1][e1 - 4], ci1 = e1 < 4 ? cc[4 * hp + 2][e1] : cc[4 * hp + 3][e1 - 4];
                    fA[hp][e2] = pk2(cr0 * h[0] - ci0 * h[1], cr1 * h[2] - ci1 * h[3]); fA[2 + hp][e2] = pk2(-(cr0 * h[1] + ci0 * h[0]), -(cr1 * h[3] + ci1 * h[2])); }
            }
#pragma unroll
            for (int tb = 0; tb < 4; ++tb)
#pragma unroll
                for (int ks = 0; ks < 4; ++ks) acc[ch][tb] = __builtin_amdgcn_mfma_f32_16x16x32_bf16(__builtin_bit_cast(bf16x8, fA[ks]), rg[4 * tb + ks], acc[ch][tb], 0, 0, 0);
        }
        __builtin_amdgcn_sched_barrier(0);
    }
    bf16_t* gs = (bf16_t*)(F.ws + OFF_GS5) + (size_t)(row0 + 128 * cp + fr) * 256 + g * 16 + 4 * fq;
#pragma unroll
    for (int ch = 0; ch < 2; ++ch)
#pragma unroll
        for (int tb = 0; tb < 4; ++tb) { v2u o; o.x = pk2(gelu_tanh_f(acc[ch][tb][0]), gelu_tanh_f(acc[ch][tb][1])); o.y = pk2(gelu_tanh_f(acc[ch][tb][2]), gelu_tanh_f(acc[ch][tb][3]));
            *(v2u*)(gs + (size_t)(64 * ch + 16 * tb) * 256) = o; }
}
__device__ __forceinline__ void glu_unit(Frame& F, int l, int u) {
    const int w = F.wave, row0 = 64 * u;
    LAS unsigned char* lds = F.lds;
    int ln3 = F.tid; asm volatile("" : "+v"(ln3)); ln3 &= 63; const int fr = ln3 & 15, fq = ln3 >> 4;
    const bf16_t* wg = (const bf16_t*)(F.ws + OFF_WGLU) + (size_t)l * 65536 + (size_t)(32 * w + fr) * 256 + 8 * fq;
    {
        const int tid = F.tid; v4u gg[4];
#pragma unroll
        for (int k = 0; k < 4; ++k) { const int i = tid + k * NTHREADS; gg[k] = *(const v4u*)((const bf16_t*)(F.ws + OFF_GS5) + (size_t)(row0 + (i >> 5)) * 256 + 8 * (i & 31)); }
#pragma unroll
        for (int k = 0; k < 4; ++k) { const int i = tid + k * NTHREADS; *(LAS v4u*)(lds + (i >> 5) * S5_GP + 16 * (i & 31)) = gg[k]; }
    }
    bf16x8 b0[8], b1[8];
#pragma unroll
    for (int ks = 0; ks < 8; ++ks) { b0[ks] = *(const bf16x8*)(wg + ks * 32); b1[ks] = *(const bf16x8*)(wg + 16 * 256 + ks * 32); }
    __syncthreads();
    f32x4 acc[2][4];
#pragma unroll
    for (int a = 0; a < 2; ++a)
#pragma unroll
        for (int tb = 0; tb < 4; ++tb) acc[a][tb] = (f32x4){0.f, 0.f, 0.f, 0.f};
#pragma unroll
    for (int ks = 0; ks < 8; ++ks)
#pragma unroll
        for (int tb = 0; tb < 4; ++tb) { const bf16x8 a = *(LAS const bf16x8*)(lds + (16 * tb + fr) * S5_GP + ks * 64 + 16 * fq);
            acc[0][tb] = __builtin_amdgcn_mfma_f32_16x16x32_bf16(b0[ks], a, acc[0][tb], 0, 0, 0); acc[1][tb] = __builtin_amdgcn_mfma_f32_16x16x32_bf16(b1[ks], a, acc[1][tb], 0, 0, 0); }
#pragma unroll
    for (int a = 0; a < 2; ++a) { const int n0 = 32 * w + 16 * a + 4 * fq; const f32x4 bg = *(const f32x4*)(F.in[29] + l * 256 + n0);
#pragma unroll
        for (int tb = 0; tb < 4; ++tb) { const int t = 16 * tb + fr; const v2u gq = *(LAS const v2u*)(lds + t * S5_GP + n0 * 2);
            const float g0 = __uint_as_float(gq.x << 16), g1 = __uint_as_float(gq.x & 0xffff0000u), g2 = __uint_as_float(gq.y << 16), g3 = __uint_as_float(gq.y & 0xffff0000u);
            v2u o; o.x = pk2(g0 * sigmoid_f(acc[a][tb][0] + bg[0]), g1 * sigmoid_f(acc[a][tb][1] + bg[1])); o.y = pk2(g2 * sigmoid_f(acc[a][tb][2] + bg[2]), g3 * sigmoid_f(acc[a][tb][3] + bg[3]));
            *(v2u*)((bf16_t*)(F.ws + OFF_MIX) + (size_t)(row0 + t) * D + 384 + n0) = o; } }
}

__device__ __forceinline__ void s5_state_pass(Frame& F, int l) {
    const float* E = (const float*)(F.ws + OFF_E); float* H5 = (float*)(F.ws + OFF_H5);
    for (int idx = (F.G - 1 - F.vcu) * NTHREADS + F.tid; idx < NSEQ * 2048; idx += F.G * NTHREADS) {
        const int p = idx & 63, g = (idx >> 6) & 15, dir = (idx >> 10) & 1, sq = idx >> 11;
        const int s_ = sq < LB ? CB + sq : sq - LB;
        const SeqInfo q = seq_info(s_); const int nj = q.L >> 6, cj0 = q.start >> 6;
        const float* ab = (const float*)(F.ws + OFF_TAB + TAB_ABAR) + (size_t)((((l * 2 + dir) * 16 + g) * 64) + p) * 2;
        float a64r, a64i; cpow64(ab[0], ab[1], a64r, a64i);
        float cr = 0.f, ci = 0.f;
        if (!q.ctx) { const size_t o = (((size_t)q.b * 4 + l) * 2 + dir) * 1024 + g * 64 + p; cr = F.in[5][o]; ci = F.in[6][o]; }
        for (int k = 0; k < nj; k += 4) {
            float2 e[4];
#pragma unroll
            for (int u = 0; u < 4; ++u) { const int jj = dir == 0 ? k + u : nj - 1 - (k + u); const unsigned eq = ((const unsigned*)E)[(size_t)(((cj0 + jj) * 2 + dir) * 16 + g) * 64 + p]; e[u].x = __uint_as_float(eq << 16); e[u].y = __uint_as_float(eq & 0xffff0000u); }
#pragma unroll
            for (int u = 0; u < 4; ++u) { const int jj = dir == 0 ? k + u : nj - 1 - (k + u);
                ((unsigned*)H5)[(size_t)(((cj0 + jj) * 2 + dir) * 16 + g) * 64 + p] = pk2(cr, ci);
                const float nr = a64r * cr - a64i * ci + e[u].x, ni = a64r * ci + a64i * cr + e[u].y; cr = nr; ci = ni; }
        }
        if (q.ctx) { const size_t o = (((size_t)q.b * 4 + l) * 2 + dir) * 1024 + g * 64 + p; F.out[O_RE + o] = cr; F.out[O_IM + o] = ci; }
    }
}
__device__ __forceinline__ void phase_mixa(Frame& F, int l) {
    unsigned* ctr = F.ctl + CW_Q + 64 * (l * 8);
    const int nbias = l + 1 < DEPTH ? 104 : 0;
    int u = F.vcu;
#define QNEXT() (F.G + queue_next(F, ctr))
    while (u < 192) { attn_unit(F, l, u); u = QNEXT(); }
    while (u < 448) { ssd_a_unit(F, l, u - 192); u = QNEXT(); }
    while (u < 640) { attn_unit(F, l, 192 + u - 448); u = QNEXT(); }
    while (u < 896) { s5_a_unit(F, l, u - 640); u = QNEXT(); }
    while (u < 896 + nbias) { bias_task(F, l + 1, u - 896); u = QNEXT(); }
}
__device__ __forceinline__ void phase_mixb(Frame& F, int l) {
    unsigned* ctr = F.ctl + CW_Q + 64 * (l * 8 + 4);
    int u = F.vcu;
    while (u < 256) { ssd_b_unit(F, l, u); u = QNEXT(); }
    while (u < 512) { s5c_unit(F, l, u - 256); u = QNEXT(); }
}
__device__ __forceinline__ void phase_mixc(Frame& F, int l) { for (int u = F.vcu; u < 256; u += F.G) glu_unit(F, l, u); }
#undef QNEXT

struct Args { const float* in[35]; float* out; unsigned char* ws; int ph_lo, ph_hi, li, pad; };
#ifdef MK_PHASE_RANGE
#define IN(k) (lo <= (k) && (k) < hi)
#else
#define IN(k) true
#endif
#define REFRESH() do { int t_ = F.wave * 64 + lane_id(); asm volatile("" : "+v"(t_)); F.tid = t_; F.lane = t_ & 63; \
        GAS unsigned char* w_ = (GAS unsigned char*)args.ws; asm volatile("" : "+s"(w_)); F.ws = (unsigned char*)w_; F.ctl = (unsigned*)(w_ + OFF_CTL); GAS float* o_ = (GAS float*)args.out; asm volatile("" : "+s"(o_)); F.out = (float*)o_; \
        const GAS float* const* i_ = (const GAS float* const*)__builtin_amdgcn_kernarg_segment_ptr(); asm volatile("" : "+s"(i_)); F.in.p = i_; \
        int g_ = gridDim.x, v_ = vcu0; asm volatile("" : "+s"(g_), "+s"(v_)); F.G = g_; F.vcu = v_; modsb = (const float*)(F.ws + OFF_MODS); XB = (bf16_t*)(F.ws + OFF_X); } while (0)
#define SEAM(k) do { if (IN(k) && IN((k) + 1) && (k) + 1 < PH_END) xcd_barrier(bar, F.wave == 0 && lane_id() == 0); } while (0)
template <int l>
__device__ __forceinline__ void layer_body(Frame& F, const Args& args, const XcdBarrier& bar, const int vcu0) {
    const int lo = args.ph_lo, hi = args.ph_hi; (void)lo; (void)hi;
    const float* modsb = (const float*)(F.ws + OFF_MODS);
    bf16_t* XB = (bf16_t*)(F.ws + OFF_X);
        const int pb = PH_L0 + l * PH_PER_LAYER;
        if (IN(pb + PH_G1)) { REFRESH();
            pg8::Gemm g{(const bf16_t*)(F.ws + OFF_H), (const bf16_t*)(F.ws + OFF_WIN) + (size_t)l * PNP * 1024, M, PNP, 1024}; pg8::StaticOrder S; S.init(M, PNP, F.G, (int)blockIdx.x);
            epi_side_fill(F, S, (const float*)(F.ws + OFF_TAB + TAB_SQ1), (const float*)(F.ws + OFF_TAB + TAB_B1) + (size_t)l * 9 * PNP, PNP);
            pg8::EpiProj E{(bf16_t*)(F.ws + OFF_PROJ), F.out + O_K, F.out + O_V, (float*)(F.ws + OFF_DT), (LAS const float*)(F.lds + EPI_SIDE_OFF), l, 0};
            pg8::gemm_phase<pg8::EpiProj, pg8::StaticOrder, true, true>(F.lds, g, S, E, F.wave);
            { pg8::Unit u3; if (l + 1 < DEPTH && !S.next(2, u3)) { REFRESH(); transpose_layer_queue(F, l + 1, F.ctl + CW_Q + 64 * (48 + l)); } }
        }
        SEAM(pb + PH_G1);
        if (IN(pb + PH_MIXA)) { REFRESH(); phase_mixa(F, l); }
        SEAM(pb + PH_MIXA);
        if (IN(pb + PH_MIXB)) { REFRESH(); ssd_state_pass(F, l); s5_state_pass(F, l); xcd_barrier(bar, F.wave == 0 && lane_id() == 0); REFRESH(); phase_mixb(F, l); xcd_barrier(bar, F.wave == 0 && lane_id() == 0); REFRESH(); phase_mixc(F, l); }
        SEAM(pb + PH_MIXB);
        if (IN(pb + PH_G3)) { REFRESH();
            pg8::Gemm g{(const bf16_t*)(F.ws + OFF_MIX), (const bf16_t*)(F.ws + OFF_WOUT) + (size_t)l * 1024 * 1024, M, D, 1024}; pg8::StaticOrder S; S.init(M, D, F.G, (int)blockIdx.x);
            { pg8::Unit u; if (S.next(0, u) && F.tid < 256) { const float* q2 = (const float*)(F.ws + OFF_TAB + TAB_SSQ) + (size_t)(u.pm * 256 + F.tid) * 2;
                ((LAS float*)(F.lds + EPI_SIDE_OFF))[F.tid] = rsqrtf((q2[0] + q2[1]) * (1.f / 384.f) + EPS); } __syncthreads(); }
            typedef pg8::EpiRes<6, l == 0> Epi3;
            Epi3 E{l == 0 ? (const void*)F.in[0] : (const void*)XB, l == 0 ? (const void*)(F.in[1] - (size_t)MC * D) : (const void*)XB, XB, modsb + (size_t)l * 9 * 6144 + 2 * 1024, F.in[12] + l * D, modsb + (size_t)l * 9 * 6144 + 4 * 1024,
                   (bf16_t*)(F.ws + OFF_H), (float*)(F.ws + OFF_TAB + TAB_SQ2), (LAS const float*)(F.lds + EPI_SIDE_OFF)};
            pg8::gemm_phase<Epi3, pg8::StaticOrder, true, true>(F.lds, g, S, E, F.wave);
        }
        SEAM(pb + PH_G3);
        if (IN(pb + PH_G4)) { REFRESH();
            pg8::Gemm g{(const bf16_t*)(F.ws + OFF_H), (const bf16_t*)(F.ws + OFF_WFF1) + (size_t)l * DFF * 1024, M, DFF, 1024}; pg8::StaticOrder S; S.init(M, DFF, F.G, (int)blockIdx.x);
            epi_side_fill(F, S, (const float*)(F.ws + OFF_TAB + TAB_SQ2), (const float*)(F.ws + OFF_TAB + TAB_B2) + (size_t)l * 9 * DFF, DFF);
            pg8::EpiFF1 E{(bf16_t*)(F.ws + OFF_FFH), (LAS const float*)(F.lds + EPI_SIDE_OFF), 0};
            pg8::gemm_phase<pg8::EpiFF1, pg8::StaticOrder, true, true>(F.lds, g, S, E, F.wave);
        }
        SEAM(pb + PH_G4);
        if (IN(pb + PH_G5)) { REFRESH();
            pg8::Gemm g{(const bf16_t*)(F.ws + OFF_FFH), (const bf16_t*)(F.ws + OFF_WFF2) + (size_t)l * 1024 * DFF, M, D, DFF}; pg8::StaticOrder S; S.init(M, D, F.G, (int)blockIdx.x);
            const int ln = l + 1 < DEPTH ? l + 1 : l;
            typedef pg8::EpiRes<0, false> Epi5;
            Epi5 E{(const void*)XB, (const void*)XB, XB, modsb + (size_t)l * 9 * 6144 + 5 * 1024, F.in[11] + ln * D, modsb + (size_t)ln * 9 * 6144 + 1 * 1024,
                   l + 1 < DEPTH ? (bf16_t*)(F.ws + OFF_H) : (bf16_t*)nullptr, (float*)(F.ws + OFF_TAB + TAB_SQ1), (LAS const float*)(F.lds + EPI_SIDE_OFF)};
            pg8::gemm_phase<Epi5, pg8::StaticOrder, true, true>(F.lds, g, S, E, F.wave);
        }
        SEAM(pb + PH_G5);
    }
__global__ void __launch_bounds__(NTHREADS, 2) mega(Args args) {
    extern __shared__ __attribute__((aligned(16))) unsigned char lds[];
    Frame F;
    F.lds = (LAS unsigned char*)lds;
    F.MISC = (volatile LAS unsigned*)(F.lds + MISC_OFF);
    F.tid = threadIdx.x; F.lane = F.tid & 63; F.wave = __builtin_amdgcn_readfirstlane(F.tid >> 6);
    F.G = gridDim.x; { const int bx = blockIdx.x; F.vcu = (F.G % 8 == 0) ? (bx % 8) * (F.G / 8) + bx / 8 : bx; }
    { const GAS float* const* inp = (const GAS float* const*)__builtin_amdgcn_kernarg_segment_ptr(); asm volatile("" : "+s"(inp)); F.in.p = inp; }
    F.out = args.out; F.ws = args.ws; F.ctl = (unsigned*)(args.ws + OFF_CTL);
    for (int u = F.tid; u < (LDS_BYTES - LDSCTL_OFF) / 4; u += NTHREADS) ((LAS unsigned*)(F.lds + LDSCTL_OFF))[u] = 0u;
    __syncthreads();
    XcdBarrier bar = xcd_barrier_post(F.ctl + CW_BAR + args.li * XCD_BAR_WORDS, F.MISC + 8);
    const int lo = args.ph_lo, hi = args.ph_hi; (void)lo; (void)hi;
    const float* modsb = (const float*)(F.ws + OFF_MODS);
    bf16_t* XB = (bf16_t*)(F.ws + OFF_X);
    const int vcu0 = F.vcu;
    if (IN(PH_PRO)) phase_prologue(F);
    SEAM(PH_PRO);
    if (IN(PH_PRE)) { REFRESH(); phase_pre(F); }
    SEAM(PH_PRE);
    layer_body<0>(F, args, bar, vcu0); layer_body<1>(F, args, bar, vcu0); layer_body<2>(F, args, bar, vcu0); layer_body<3>(F, args, bar, vcu0);
    if (IN(PH_FINAL)) phase_final(F);
#undef IN
#undef SEAM
}
static void launch_mega(const Args& base, int lo, int hi, int li, hipStream_t stream) {
    Args a = base; a.ph_lo = lo; a.ph_hi = hi; a.li = li;
    hipLaunchKernelGGL(mega, dim3(256), dim3(NTHREADS), LDS_BYTES, stream, a);
}
extern "C" void kernel_launch(void* const* d_in, const int* in_sizes, int n_in, void* d_out, int out_size, void* d_ws, size_t ws_size, hipStream_t stream) {
    static int ready = 0;
    if (!ready) {
        if (n_in != 35 || out_size != (int)O_END || ws_size < WS_END) { fprintf(stderr, "kernel_launch: unexpected shapes n_in %d out %d ws %zu\n", n_in, out_size, ws_size); ready = -1; return; }
        if (hipFuncSetAttribute((const void*)mega, hipFuncAttributeMaxDynamicSharedMemorySize, LDS_BYTES) != hipSuccess) { fprintf(stderr, "kernel_launch: hipFuncSetAttribute failed\n"); ready = -1; return; }
        ready = 1;
    }
    if (ready < 0) return;
    Args a{}; for (int i = 0; i < 35; ++i) a.in[i] = (const float*)d_in[i]; a.out = (float*)d_out; a.ws = (unsigned char*)d_ws;
    (void)hipMemsetAsync((char*)d_ws + OFF_CTL, 0, CTL_ZERO_BYTES, stream);
    launch_mega(a, 0, PH_END, 0, stream);
}
```
